# Optimizing an MI355X kernel written in HIP

```python
import math
import jax, jax.numpy as jnp
from jax import lax
import numpy as np

D_MODEL = 1024
BATCH = 8
SEQ = 2048
DEPTH = 2

CHUNK = 64
N_META = 16
Q_BLOCK = 128
EPS = 1e-5

N_A_LAYERS = DEPTH // 2
N_B_LAYERS = DEPTH - N_A_LAYERS

DIFF_HEAD_DIM = 64
DIFF_HEADS = D_MODEL // (2 * DIFF_HEAD_DIM)
DIFF_V_DIM = 2 * DIFF_HEAD_DIM
ROPE_THETA = 500000.0
ROT_DIM = DIFF_HEAD_DIM // 4

MLA_HEADS = D_MODEL // 64
MLA_NOPE = 64
MLA_ROPE = 32
MLA_V = 64
Q_LORA = 3 * D_MODEL // 8
KV_LORA = D_MODEL // 4
MLA_ROPE_THETA = 10000.0

D_FF = 128 * ((8 * D_MODEL // 3 + 127) // 128)
CONV_W = 3

kernel_name = "yoco_diffattn_mla_convffn_meta"


def rms_norm(x, g):
    xf = x.astype(jnp.float32)
    y = xf * lax.rsqrt(jnp.mean(xf * xf, axis=-1, keepdims=True) + EPS)
    return (y * g.astype(jnp.float32)).astype(x.dtype)


def rotary(x, pos, theta, rot_dim):
    half = rot_dim // 2
    inv = 1.0 / (theta ** (jnp.arange(half, dtype=jnp.float32) / half))
    ang = pos.astype(jnp.float32)[:, None] * inv[None, :]
    cos = jnp.cos(ang)[None, :, None, :]
    sin = jnp.sin(ang)[None, :, None, :]
    xr = x[..., :rot_dim].astype(jnp.float32)
    x1, x2 = xr[..., :half], xr[..., half:]
    rot = jnp.concatenate([x1 * cos - x2 * sin, x2 * cos + x1 * sin], axis=-1).astype(x.dtype)
    return jnp.concatenate([rot, x[..., rot_dim:]], axis=-1)


def chunk_ids(pos):
    return jnp.where(pos < N_META, 0, 1 + (pos - N_META) // CHUNK)


def to_query_blocks(q, n_blocks):
    B, L, H, d = q.shape
    q = jnp.pad(q, ((0, 0), (0, n_blocks * Q_BLOCK - L), (0, 0), (0, 0)))
    return q.reshape(B, n_blocks, Q_BLOCK, H, d).transpose(1, 0, 2, 3, 4)


def from_query_blocks(o, L):
    nb, B, qb, H, d = o.shape
    return o.transpose(1, 0, 2, 3, 4).reshape(B, nb * qb, H, d)[:, :L]


def diff_attention(q1, q2, k1, k2, v, lam, q_chunk_blocks, k_chunk):
    L = k1.shape[1]
    nb = q_chunk_blocks.shape[0]
    scale = DIFF_HEAD_DIM ** -0.5

    def block(args):
        qb1, qb2, qc = args
        mask = k_chunk[None, :] <= qc[:, None]

        def probs(qb, k):
            s = jnp.einsum('bqhd,bkhd->bhqk', qb, k).astype(jnp.float32) * scale
            return jax.nn.softmax(jnp.where(mask, s, -jnp.inf), axis=-1)

        a = probs(qb1, k1) - lam * probs(qb2, k2)
        return jnp.einsum('bhqk,bkhd->bqhd', a.astype(v.dtype), v)

    o = lax.map(block, (to_query_blocks(q1, nb), to_query_blocks(q2, nb), q_chunk_blocks))
    return from_query_blocks(o, L)


def mla_attention(q_nope, q_rope, k_nope, k_rope, v, q_chunk_blocks, k_chunk):
    L = k_nope.shape[1]
    nb = q_chunk_blocks.shape[0]
    scale = (MLA_NOPE + MLA_ROPE) ** -0.5

    def block(args):
        qn, qr, qc = args
        mask = k_chunk[None, :] <= qc[:, None]
        s = (jnp.einsum('bqhd,bkhd->bhqk', qn, k_nope)
             + jnp.einsum('bqhr,bkr->bhqk', qr, k_rope)).astype(jnp.float32) * scale
        p = jax.nn.softmax(jnp.where(mask, s, -jnp.inf), axis=-1)
        return jnp.einsum('bhqk,bkhd->bqhd', p.astype(v.dtype), v)

    o = lax.map(block, (to_query_blocks(q_nope, nb), to_query_blocks(q_rope, nb), q_chunk_blocks))
    return from_query_blocks(o, L)


def diff_attn_layer(h, g_norm, w_qkv, lq1, lk1, lq2, lk2, g_sub, w_o, layer_idx, pos, qcb, kc):
    B, L, _ = h.shape
    H, d = DIFF_HEADS, DIFF_HEAD_DIM
    xn = rms_norm(h, g_norm)
    qkv = xn @ w_qkv
    q, k, v = jnp.split(qkv, [2 * H * d, 4 * H * d], axis=-1)
    q = rotary(q.reshape(B, L, 2 * H, d), pos, ROPE_THETA, ROT_DIM).reshape(B, L, H, 2, d)
    k = rotary(k.reshape(B, L, 2 * H, d), pos, ROPE_THETA, ROT_DIM).reshape(B, L, H, 2, d)
    v = v.reshape(B, L, H, DIFF_V_DIM)
    lam_init = 0.8 - 0.6 * math.exp(-0.3 * layer_idx)
    lam = (jnp.exp(jnp.sum(lq1.astype(jnp.float32) * lk1.astype(jnp.float32)))
           - jnp.exp(jnp.sum(lq2.astype(jnp.float32) * lk2.astype(jnp.float32))) + lam_init)
    o = diff_attention(q[..., 0, :], q[..., 1, :], k[..., 0, :], k[..., 1, :], v, lam, qcb, kc)
    o = rms_norm(o, g_sub) * (1.0 - lam_init)
    return h + o.reshape(B, L, H * DIFF_V_DIM) @ w_o


def shared_latent_kv(h, g_norm, w_dkv, g_kv, w_ukv, pos):
    B, L, _ = h.shape
    xn = rms_norm(h, g_norm)
    ckv = xn @ w_dkv
    c_kv = rms_norm(ckv[..., :KV_LORA], g_kv)
    k_rope = rotary(ckv[..., None, KV_LORA:], pos, MLA_ROPE_THETA, MLA_ROPE)[:, :, 0]
    kv = (c_kv @ w_ukv).reshape(B, L, MLA_HEADS, MLA_NOPE + MLA_V)
    return kv[..., :MLA_NOPE], k_rope, kv[..., MLA_NOPE:]


def mla_layer(h, g_norm, w_dq, g_q, w_uq, w_o, k_nope, k_rope, v, pos, qcb, kc):
    B, L, _ = h.shape
    xn = rms_norm(h, g_norm)
    c_q = rms_norm(xn @ w_dq, g_q)
    q = (c_q @ w_uq).reshape(B, L, MLA_HEADS, MLA_NOPE + MLA_ROPE)
    q_nope = q[..., :MLA_NOPE]
    q_rope = rotary(q[..., MLA_NOPE:], pos, MLA_ROPE_THETA, MLA_ROPE)
    o = mla_attention(q_nope, q_rope, k_nope, k_rope, v, qcb, kc)
    return h + o.reshape(B, L, MLA_HEADS * MLA_V) @ w_o


def conv_ffn(h, g_norm, w_in, conv_w, conv_b, w_out):
    L = h.shape[1]
    xn = rms_norm(h, g_norm)
    a, b = jnp.split(xn @ w_in, 2, axis=-1)
    ap = jnp.pad(a, ((0, 0), (CONV_W - 1, 0), (0, 0)))
    a_conv = conv_b
    for j in range(CONV_W):
        a_conv = a_conv + ap[:, j:j + L] * conv_w[j]
    return h + (jax.nn.silu(a_conv) * b) @ w_out


def setup_inputs(seed: int = 0) -> dict:
    key = jax.random.key(seed)
    ks = iter(jax.random.split(key, 32))
    f32 = jnp.float32

    def nrm(shape, scale):
        return jax.random.normal(next(ks), shape, f32) * scale

    def gain(shape):
        return 1.0 + 0.02 * jax.random.normal(next(ks), shape, f32)

    nA, nB = N_A_LAYERS, N_B_LAYERS
    qkv_out = 4 * DIFF_HEADS * DIFF_HEAD_DIM + DIFF_HEADS * DIFF_V_DIM
    return {
        "x": nrm((BATCH, SEQ, D_MODEL), 1.0),
        "meta_tokens": nrm((N_META, D_MODEL), 1.0),
        "a_attn_norm": gain((nA, D_MODEL)),
        "a_w_qkv": nrm((nA, D_MODEL, qkv_out), D_MODEL ** -0.5),
        "a_lambda_q1": nrm((nA, DIFF_HEAD_DIM), 0.1),
        "a_lambda_k1": nrm((nA, DIFF_HEAD_DIM), 0.1),
        "a_lambda_q2": nrm((nA, DIFF_HEAD_DIM), 0.1),
        "a_lambda_k2": nrm((nA, DIFF_HEAD_DIM), 0.1),
        "a_sub_norm": gain((nA, DIFF_V_DIM)),
        "a_w_o": nrm((nA, DIFF_HEADS * DIFF_V_DIM, D_MODEL), (DIFF_HEADS * DIFF_V_DIM) ** -0.5),
        "kv_norm": gain((D_MODEL,)),
        "kv_w_dkv": nrm((D_MODEL, KV_LORA + MLA_ROPE), D_MODEL ** -0.5),
        "kv_a_norm": gain((KV_LORA,)),
        "kv_w_ukv": nrm((KV_LORA, MLA_HEADS * (MLA_NOPE + MLA_V)), KV_LORA ** -0.5),
        "b_attn_norm": gain((nB, D_MODEL)),
        "b_w_dq": nrm((nB, D_MODEL, Q_LORA), D_MODEL ** -0.5),
        "b_q_a_norm": gain((nB, Q_LORA)),
        "b_w_uq": nrm((nB, Q_LORA, MLA_HEADS * (MLA_NOPE + MLA_ROPE)), Q_LORA ** -0.5),
        "b_w_o": nrm((nB, MLA_HEADS * MLA_V, D_MODEL), (MLA_HEADS * MLA_V) ** -0.5),
        "ffn_norm": gain((DEPTH, D_MODEL)),
        "ffn_w_in": nrm((DEPTH, D_MODEL, 2 * D_FF), D_MODEL ** -0.5),
        "ffn_conv_w": nrm((DEPTH, CONV_W, D_FF), CONV_W ** -0.5),
        "ffn_conv_b": nrm((DEPTH, D_FF), 0.01),
        "ffn_w_out": nrm((DEPTH, D_FF, D_MODEL), D_FF ** -0.5),
        "final_norm": gain((D_MODEL,)),
    }


def reference(x, meta_tokens, a_attn_norm, a_w_qkv, a_lambda_q1, a_lambda_k1, a_lambda_q2,
              a_lambda_k2, a_sub_norm, a_w_o, kv_norm, kv_w_dkv, kv_a_norm, kv_w_ukv,
              b_attn_norm, b_w_dq, b_q_a_norm, b_w_uq, b_w_o, ffn_norm, ffn_w_in,
              ffn_conv_w, ffn_conv_b, ffn_w_out, final_norm):
    B = x.shape[0]
    meta = jnp.broadcast_to(meta_tokens[None].astype(x.dtype), (B, N_META, D_MODEL))
    h = jnp.concatenate([meta, x], axis=1)
    L = h.shape[1]
    pos = jnp.arange(L, dtype=jnp.int32)
    n_blocks = -(-L // Q_BLOCK)
    kc = chunk_ids(pos)
    qcb = chunk_ids(jnp.arange(n_blocks * Q_BLOCK, dtype=jnp.int32)).reshape(n_blocks, Q_BLOCK)

    k_nope = k_rope = v_shared = None
    for layer in range(DEPTH):
        if layer < N_A_LAYERS:
            h = diff_attn_layer(h, a_attn_norm[layer], a_w_qkv[layer], a_lambda_q1[layer],
                                a_lambda_k1[layer], a_lambda_q2[layer], a_lambda_k2[layer],
                                a_sub_norm[layer], a_w_o[layer], layer, pos, qcb, kc)
        else:
            if layer == N_A_LAYERS:
                k_nope, k_rope, v_shared = shared_latent_kv(h, kv_norm, kv_w_dkv, kv_a_norm,
                                                            kv_w_ukv, pos)
            i = layer - N_A_LAYERS
            h = mla_layer(h, b_attn_norm[i], b_w_dq[i], b_q_a_norm[i], b_w_uq[i], b_w_o[i],
                          k_nope, k_rope, v_shared, pos, qcb, kc)
        h = conv_ffn(h, ffn_norm[layer], ffn_w_in[layer], ffn_conv_w[layer],
                     ffn_conv_b[layer], ffn_w_out[layer])
    return rms_norm(h, final_norm)[:, N_META:]
```

```cpp
#include <hip/hip_runtime.h>
#include <hip/hip_cooperative_groups.h>
#include <cstdio>
#include <cstdint>
#include <cmath>
namespace cg = cooperative_groups;

#define LAS __attribute__((address_space(3)))
typedef unsigned short bf16_t;
typedef short bf16x8 __attribute__((ext_vector_type(8)));
typedef short s16x4 __attribute__((ext_vector_type(4)));
typedef float f32x4 __attribute__((ext_vector_type(4)));
typedef float f32x16 __attribute__((ext_vector_type(16)));
typedef unsigned u32x4 __attribute__((ext_vector_type(4)));
typedef unsigned u32x2 __attribute__((ext_vector_type(2)));

constexpr int NB = 8, SEQ = 2048, NMETA = 16, D = 1024, DFF = 2816;
constexpr int RR = NB * SEQ;
constexpr int RV = RR + NMETA;
constexpr int RT = 16640;
constexpr int NWAVES = 8, NTHREADS = 512;
constexpr float EPS = 1e-5f;
constexpr float LOG2E = 1.4426950408889634f;
constexpr float QS_A = 0.125f * LOG2E;
constexpr float QS_B = 0.10206207261596575f * LOG2E;
constexpr float LAM_INIT = 0.2f;

constexpr size_t KiB = 1024, MiB = 1024 * 1024;
constexpr size_t WS_CTL = 0;
constexpr size_t W_QKV = 1 * MiB;
constexpr size_t W_OA = 7 * MiB;
constexpr size_t W_IN0 = 9 * MiB, W_IN1 = 20 * MiB;
constexpr size_t W_OUT0 = 31 * MiB, W_OUT1 = 31 * MiB + 5632 * KiB;
constexpr size_t W_D = 42 * MiB;
constexpr size_t W_UKV = 43 * MiB + 512 * KiB;
constexpr size_t W_UQ = 44 * MiB + 512 * KiB;
constexpr size_t W_OB = 45 * MiB + 640 * KiB;
constexpr size_t WS_HB = 48 * MiB;
constexpr size_t WS_BIG = WS_HB + 33280 * KiB;
constexpr size_t ROWB1024 = (size_t)RT * 1024 * 2;
constexpr size_t WS_Q = WS_BIG, WS_K = WS_BIG + ROWB1024, WS_V = WS_BIG + 2 * ROWB1024;
constexpr size_t WS_G = WS_BIG;
constexpr size_t WS_Q2 = WS_BIG;
constexpr size_t WS_KV2 = WS_BIG + (size_t)RT * 1536 * 2;
constexpr size_t WS_CQ = WS_BIG + 116480 * KiB;
constexpr size_t WS_CKV = WS_CQ + (size_t)RT * 384 * 2;
constexpr size_t WS_KR = WS_CKV + (size_t)RT * 256 * 2;
constexpr size_t WS_OB2 = 216 * MiB;
constexpr size_t WS_HMETA = WS_OB2 + 33280 * KiB;
constexpr size_t WS_RSS = WS_HMETA + 1 * MiB;
constexpr size_t WS_ROPE = WS_RSS + 512 * KiB;
constexpr size_t WS_END = 256 * MiB;
static_assert(WS_KR + (size_t)RT * 32 * 2 <= WS_OB2, "ws map");
static_assert(WS_KV2 + (size_t)RT * 2048 * 2 <= WS_CQ, "ws map");
static_assert(WS_ROPE + 512 * KiB <= WS_END, "ws map");
static_assert(W_OB + 2 * MiB <= WS_HB, "ws map");

constexpr int LDS_BYTES = 147456;

struct Params {
    const float* in[25];
    float* out;
    unsigned char* ws;
    int ph_lo, ph_hi;
};
enum { I_X = 0, I_META, I_A_NORM, I_A_WQKV, I_LQ1, I_LK1, I_LQ2, I_LK2, I_A_SUB, I_A_WO, I_KV_NORM, I_KV_WDKV, I_KV_ANORM, I_KV_WUKV,
       I_B_NORM, I_B_WDQ, I_B_QANORM, I_B_WUQ, I_B_WO, I_FFN_NORM, I_FFN_WIN, I_FFN_CW, I_FFN_CB, I_FFN_WOUT, I_FINAL };

struct Ctx { int tid, lane, wave, gw, ngw, vcu, G; LAS unsigned char* lds; };

__device__ __forceinline__ unsigned f2bf(float f) { unsigned u = __builtin_bit_cast(unsigned, f); return (u + 0x7fffu + ((u >> 16) & 1u)) >> 16; }
__device__ __forceinline__ unsigned pk2(float lo, float hi) { return f2bf(lo) | (f2bf(hi) << 16); }
__device__ __forceinline__ float bf2f(bf16_t b) { return __builtin_bit_cast(float, (unsigned)b << 16); }
__device__ __forceinline__ float wave_sum(float v) {
#pragma unroll
    for (int o = 1; o < 64; o <<= 1) v += __shfl_xor(v, o);
    return v;
}
__device__ __forceinline__ int row_pos(int r) { return r < RR ? NMETA + (r & (SEQ - 1)) : r - RR; }
__device__ __forceinline__ float* hrow(const Params& p, int r) { return r < RR ? p.out + (size_t)r * D : (float*)(p.ws + WS_HMETA) + (size_t)(r - RR) * D; }
__device__ __forceinline__ float* rss_ptr(const Params& p, int site) { return (float*)(p.ws + WS_RSS) + (size_t)site * RT; }
__device__ __forceinline__ int crow(int r, int hi) { return (r & 3) + 8 * (r >> 2) + 4 * hi; }

struct WSrc { const float* W; int pitch; int col0; const float* gain; int gmask; float scale; };
__device__ __forceinline__ void wdims(int id, int& N, int& K, size_t& off) {
    switch (id) {
        case 0: N = 3072; K = 1024; off = W_QKV; break;
        case 1: N = 1024; K = 1024; off = W_OA; break;
        case 2: N = 5632; K = 1024; off = W_IN0; break;
        case 3: N = 5632; K = 1024; off = W_IN1; break;
        case 4: N = 1024; K = 2816; off = W_OUT0; break;
        case 5: N = 1024; K = 2816; off = W_OUT1; break;
        case 6: N = 768; K = 1024; off = W_D; break;
        case 7: N = 2048; K = 256; off = W_UKV; break;
        case 8: N = 1536; K = 384; off = W_UQ; break;
        default: N = 1024; K = 1024; off = W_OB; break;
    }
}
__device__ __forceinline__ WSrc wsrc(const Params& p, int id, int n0) {
    WSrc s; s.gain = nullptr; s.gmask = 0; s.scale = 1.f; s.W = nullptr; s.pitch = 0; s.col0 = 0;
    switch (id) {
        case 0: s.W = p.in[I_A_WQKV]; s.pitch = 3072; s.col0 = n0; s.gain = p.in[I_A_NORM]; s.gmask = 1023; s.scale = n0 < 1024 ? QS_A : 1.f; break;
        case 1: s.W = p.in[I_A_WO]; s.pitch = 1024; s.col0 = n0; s.gain = p.in[I_A_SUB]; s.gmask = 127; s.scale = 1.f - LAM_INIT; break;
        case 2: case 3: { const int l = id - 2; s.W = p.in[I_FFN_WIN] + (size_t)l * 1024 * 5632; s.pitch = 5632; const int j = n0 >> 8, u = n0 & 255;
            s.col0 = u < 128 ? 128 * j + u : DFF + 128 * j + (u - 128); s.gain = p.in[I_FFN_NORM] + l * 1024; s.gmask = 1023; break; }
        case 4: case 5: { const int l = id - 4; s.W = p.in[I_FFN_WOUT] + (size_t)l * DFF * 1024; s.pitch = 1024; s.col0 = n0; break; }
        case 6: if (n0 < 384) { s.W = p.in[I_B_WDQ]; s.pitch = 384; s.col0 = n0; s.gain = p.in[I_B_NORM]; s.gmask = 1023; }
                else if (n0 < 672) { s.W = p.in[I_KV_WDKV]; s.pitch = 288; s.col0 = n0 - 384; s.gain = p.in[I_KV_NORM]; s.gmask = 1023; }
                break;
        case 7: s.W = p.in[I_KV_WUKV]; s.pitch = 2048; s.col0 = n0; s.gain = p.in[I_KV_ANORM]; s.gmask = 255; break;
        case 8: s.W = p.in[I_B_WUQ]; s.pitch = 1536; s.col0 = n0; s.gain = p.in[I_B_QANORM]; s.gmask = 511; s.scale = QS_B; break;
        default: s.W = p.in[I_B_WO]; s.pitch = 1024; s.col0 = n0; break;
    }
    return s;
}
__device__ __forceinline__ void transpose_item(const WSrc& s, int K, bf16_t* WT, int k0, int n0, LAS float* scr, int lane) {
    if (s.W) {
#pragma unroll 8
        for (int i = 0; i < 32; ++i) { const int kk = 2 * i + (lane >> 5); float g = s.scale; if (s.gain) g *= s.gain[(k0 + kk) & s.gmask];
            scr[kk * 33 + (lane & 31)] = s.W[(size_t)(k0 + kk) * s.pitch + s.col0 + (lane & 31)] * g; }
    } else {
#pragma unroll 8
        for (int i = 0; i < 32; ++i) { const int kk = 2 * i + (lane >> 5); scr[kk * 33 + (lane & 31)] = 0.f; }
    }
    asm volatile("s_waitcnt lgkmcnt(0)" ::: "memory");
    const int c = lane & 7;
#pragma unroll
    for (int j = 0; j < 4; ++j) { const int n = (lane >> 3) + 8 * j; const LAS float* q = scr + (8 * c) * 33 + n;
        u32x4 o; o.x = pk2(q[0 * 33], q[1 * 33]); o.y = pk2(q[2 * 33], q[3 * 33]); o.z = pk2(q[4 * 33], q[5 * 33]); o.w = pk2(q[6 * 33], q[7 * 33]);
        *(u32x4*)(WT + (size_t)(n0 + n) * K + k0 + 8 * c) = o; }
    asm volatile("s_waitcnt lgkmcnt(0)" ::: "memory");
}
__device__ __forceinline__ void ph_prologue(const Params& p, const Ctx& c) {
    LAS float* scr = (LAS float*)(c.lds + c.wave * 16384);
    int base = 0;
    for (int id = 0; id < 10; ++id) {
        int N, K; size_t off; wdims(id, N, K, off);
        const int nkb = K / 64, nnb = N / 32, items = nkb * nnb;
        for (int it = ((c.gw - base) % c.ngw + c.ngw) % c.ngw; it < items; it += c.ngw) {
            const int kb = it / nnb, nb = it % nnb; const WSrc s = wsrc(p, id, nb * 32);
            transpose_item(s, K, (bf16_t*)(p.ws + off), kb * 64, nb * 32, scr, c.lane); }
        base += items;
    }
    { float2* TA = (float2*)(p.ws + WS_ROPE); float2* TB = TA + 2064 * 8;
      const int gt = c.gw * 64 + c.lane, ngt = c.ngw * 64;
      for (int i = gt; i < 2064 * 8; i += ngt) { const int pos = i >> 3, k = i & 7; const float inv = 1.0f / powf(500000.0f, (float)k / 8.0f); const float a = (float)pos * inv; TA[i] = make_float2(cosf(a), sinf(a)); }
      for (int i = gt; i < 2064 * 16; i += ngt) { const int pos = i >> 4, k = i & 15; const float inv = 1.0f / powf(10000.0f, (float)k / 16.0f); const float a = (float)pos * inv; TB[i] = make_float2(cosf(a), sinf(a)); } }
    float* rss0 = rss_ptr(p, 0);
    for (int r = c.gw; r < RT; r += c.ngw) {
        const float* src = r < RR ? p.in[I_X] + (size_t)r * D : (r < RV ? p.in[I_META] + (size_t)(r - RR) * D : nullptr);
        f32x4 v[4]; float ss = 0.f;
#pragma unroll
        for (int j = 0; j < 4; ++j) { v[j] = src ? *(const f32x4*)(src + 4 * c.lane + 256 * j) : (f32x4){0.f, 0.f, 0.f, 0.f}; ss += v[j].x * v[j].x + v[j].y * v[j].y + v[j].z * v[j].z + v[j].w * v[j].w; }
        ss = wave_sum(ss);
        float* h = hrow(p, r); bf16_t* hb = (bf16_t*)(p.ws + WS_HB) + (size_t)r * D;
#pragma unroll
        for (int j = 0; j < 4; ++j) { *(f32x4*)(h + 4 * c.lane + 256 * j) = v[j]; u32x2 w; w.x = pk2(v[j].x, v[j].y); w.y = pk2(v[j].z, v[j].w); *(u32x2*)(hb + 4 * c.lane + 256 * j) = w; }
        if (c.lane == 0) rss0[r] = ss;
    }
}
__device__ __forceinline__ void ph_rowstat(const Params& p, const Ctx& c, int site) {
    float* rss = rss_ptr(p, site);
    for (int r = c.gw; r < RT; r += c.ngw) {
        const float* h = hrow(p, r); f32x4 v[4]; float ss = 0.f;
#pragma unroll
        for (int j = 0; j < 4; ++j) { v[j] = *(const f32x4*)(h + 4 * c.lane + 256 * j); ss += v[j].x * v[j].x + v[j].y * v[j].y + v[j].z * v[j].z + v[j].w * v[j].w; }
        ss = wave_sum(ss);
        bf16_t* hb = (bf16_t*)(p.ws + WS_HB) + (size_t)r * D;
#pragma unroll
        for (int j = 0; j < 4; ++j) { u32x2 w; w.x = pk2(v[j].x, v[j].y); w.y = pk2(v[j].z, v[j].w); *(u32x2*)(hb + 4 * c.lane + 256 * j) = w; }
        if (c.lane == 0) rss[r] = ss;
    }
}
__device__ __forceinline__ void ph_final(const Params& p, const Ctx& c) {
    const float* g = p.in[I_FINAL];
    for (int r = c.gw; r < RR; r += c.ngw) {
        float* h = p.out + (size_t)r * D; f32x4 v[4]; float ss = 0.f;
#pragma unroll
        for (int j = 0; j < 4; ++j) { v[j] = *(const f32x4*)(h + 4 * c.lane + 256 * j); ss += v[j].x * v[j].x + v[j].y * v[j].y + v[j].z * v[j].z + v[j].w * v[j].w; }
        ss = wave_sum(ss); const float rstd = 1.0f / sqrtf(ss * (1.0f / D) + EPS);
#pragma unroll
        for (int j = 0; j < 4; ++j) { const f32x4 gg = *(const f32x4*)(g + 4 * c.lane + 256 * j); *(f32x4*)(h + 4 * c.lane + 256 * j) = v[j] * rstd * gg; }
    }
}

template <class Epi>
__device__ __forceinline__ void gemm_simple(const bf16_t* A, int lda, const bf16_t* Bt, int K, int N, int nrows, const Epi& epi, const Ctx& c) {
    const int nct = N / 64, nrt = (nrows + 31) / 32, items = nrt * nct;
    const int l15 = c.lane & 15, q4 = c.lane >> 4;
    for (int it = c.gw; it < items; it += c.ngw) {
        const int rt = it / nct, ct = it % nct;
        f32x4 acc[2][4];
#pragma unroll
        for (int m = 0; m < 2; ++m)
#pragma unroll
            for (int n = 0; n < 4; ++n) acc[m][n] = (f32x4){0.f, 0.f, 0.f, 0.f};
        const bf16_t* ap = A + (size_t)(rt * 32 + l15) * lda + 8 * q4;
        const bf16_t* bp = Bt + (size_t)(ct * 64 + l15) * K + 8 * q4;
        for (int k0 = 0; k0 < K; k0 += 32) {
            bf16x8 a[2], b[4];
#pragma unroll
            for (int m = 0; m < 2; ++m) a[m] = *(const bf16x8*)(ap + (size_t)(16 * m) * lda + k0);
#pragma unroll
            for (int n = 0; n < 4; ++n) b[n] = *(const bf16x8*)(bp + (size_t)(16 * n) * K + k0);
#pragma unroll
            for (int m = 0; m < 2; ++m)
#pragma unroll
                for (int n = 0; n < 4; ++n) acc[m][n] = __builtin_amdgcn_mfma_f32_16x16x32_bf16(a[m], b[n], acc[m][n], 0, 0, 0);
        }
#pragma unroll
        for (int m = 0; m < 2; ++m)
#pragma unroll
            for (int n = 0; n < 4; ++n)
#pragma unroll
                for (int i = 0; i < 4; ++i) epi(rt * 32 + 16 * m + 4 * q4 + i, ct * 64 + 16 * n + l15, acc[m][n][i]);
    }
}
struct EpiQKV { const float* rss; bf16_t* Q; bf16_t* K; bf16_t* V;
    __device__ __forceinline__ void operator()(int row, int col, float v) const { v *= 1.0f / sqrtf(rss[row] * (1.0f / D) + EPS);
        Q[(size_t)(col >> 10) * (ROWB1024 / 2) + (size_t)row * 1024 + (col & 1023)] = (bf16_t)f2bf(v); } };
struct EpiRes { float* out; float* hmeta;
    __device__ __forceinline__ void operator()(int row, int col, float v) const { float* h = row < RR ? out + (size_t)row * D : hmeta + (size_t)(row - RR) * D; h[col] += v; } };
struct EpiD { const float* rss; bf16_t* CQ; bf16_t* CKV; bf16_t* KR;
    __device__ __forceinline__ void operator()(int row, int col, float v) const { v *= 1.0f / sqrtf(rss[row] * (1.0f / D) + EPS); const bf16_t b = (bf16_t)f2bf(v);
        if (col < 384) CQ[(size_t)row * 384 + col] = b; else if (col < 640) CKV[(size_t)row * 256 + col - 384] = b; else if (col < 672) KR[(size_t)row * 32 + col - 640] = b; } };
struct EpiScaled { const float* rss; float invk; bf16_t* O; int ldo;
    __device__ __forceinline__ void operator()(int row, int col, float v) const { v *= 1.0f / sqrtf(rss[row] * invk + EPS); O[(size_t)row * ldo + col] = (bf16_t)f2bf(v); } };

__device__ __forceinline__ void ph_rot_a(const Params& p, const Ctx& c) {
    const float2* TA = (const float2*)(p.ws + WS_ROPE);
    const int gt = c.gw * 64 + c.lane, ngt = c.ngw * 64;
    for (int t = gt; t < RV * 256; t += ngt) {
        const int i = t & 7, sh = (t >> 3) & 15, which = (t >> 7) & 1, row = t >> 8;
        bf16_t* buf = (bf16_t*)(p.ws + (which ? WS_K : WS_Q)) + (size_t)row * 1024 + sh * 64;
        const float x1 = bf2f(buf[i]), x2 = bf2f(buf[8 + i]); const float2 cs = TA[row_pos(row) * 8 + i];
        buf[i] = (bf16_t)f2bf(x1 * cs.x - x2 * cs.y); buf[8 + i] = (bf16_t)f2bf(x2 * cs.x + x1 * cs.y);
    }
}
__device__ __forceinline__ void ph_dpost(const Params& p, const Ctx& c) {
    const float2* TB = (const float2*)(p.ws + WS_ROPE) + 2064 * 8;
    const int gt = c.gw * 64 + c.lane, ngt = c.ngw * 64;
    for (int t = gt; t < RV * 16; t += ngt) {
        const int i = t & 15, row = t >> 4; bf16_t* buf = (bf16_t*)(p.ws + WS_KR) + (size_t)row * 32;
        const float x1 = bf2f(buf[i]), x2 = bf2f(buf[16 + i]); const float2 cs = TB[row_pos(row) * 16 + i];
        buf[i] = (bf16_t)f2bf(x1 * cs.x - x2 * cs.y); buf[16 + i] = (bf16_t)f2bf(x2 * cs.x + x1 * cs.y);
    }
    float* rq = rss_ptr(p, 5); float* rkv = rss_ptr(p, 6);
    for (int r = c.gw; r < RT; r += c.ngw) {
        const bf16_t* cq = (const bf16_t*)(p.ws + WS_CQ) + (size_t)r * 384; const bf16_t* ckv = (const bf16_t*)(p.ws + WS_CKV) + (size_t)r * 256;
        float s1 = 0.f, s2 = 0.f;
        for (int k = c.lane; k < 384; k += 64) { const float v = bf2f(cq[k]); s1 += v * v; }
        for (int k = c.lane; k < 256; k += 64) { const float v = bf2f(ckv[k]); s2 += v * v; }
        s1 = wave_sum(s1); s2 = wave_sum(s2);
        if (c.lane == 0) { rq[r] = s1; rkv[r] = s2; }
    }
}
__device__ __forceinline__ void ph_rot_b(const Params& p, const Ctx& c) {
    const float2* TB = (const float2*)(p.ws + WS_ROPE) + 2064 * 8;
    const int gt = c.gw * 64 + c.lane, ngt = c.ngw * 64;
    for (int t = gt; t < RV * 256; t += ngt) {
        const int i = t & 15, h = (t >> 4) & 15, row = t >> 8; bf16_t* buf = (bf16_t*)(p.ws + WS_Q2) + (size_t)row * 1536 + h * 96 + 64;
        const float x1 = bf2f(buf[i]), x2 = bf2f(buf[16 + i]); const float2 cs = TB[row_pos(row) * 16 + i];
        buf[i] = (bf16_t)f2bf(x1 * cs.x - x2 * cs.y); buf[16 + i] = (bf16_t)f2bf(x2 * cs.x + x1 * cs.y);
    }
}

__device__ __forceinline__ int prev_row(int r, int d, bool& has) {
    has = true;
    if (r < RR) { const int t = r & (SEQ - 1); if (t >= d) return r - d; return RV - d + t; }
    if (r < RV) { const int i = r - RR; if (i >= d) return r - d; has = false; return r; }
    has = false; return r;
}
__device__ __forceinline__ void ph_ffn_in(const Params& p, const Ctx& c, int layer, int site) {
    const bf16_t* A = (const bf16_t*)(p.ws + WS_HB); const bf16_t* Wt = (const bf16_t*)(p.ws + (layer ? W_IN1 : W_IN0));
    bf16_t* G = (bf16_t*)(p.ws + WS_G); const float* rss = rss_ptr(p, site);
    const float* cw = p.in[I_FFN_CW] + (size_t)layer * 3 * DFF; const float* cb = p.in[I_FFN_CB] + (size_t)layer * DFF;
    const int nct = DFF / 64, nrt = (RV + 15) / 16, items = nrt * nct;
    const int l15 = c.lane & 15, q4 = c.lane >> 4;
    for (int it = c.gw; it < items; it += c.ngw) {
        const int rt = it / nct, ct = it % nct;
        f32x4 a0[4], a1[4], a2[4], bb[4];
#pragma unroll
        for (int n = 0; n < 4; ++n) { a0[n] = a1[n] = a2[n] = bb[n] = (f32x4){0.f, 0.f, 0.f, 0.f}; }
        const int ra = rt * 16 + l15; bool h1, h2; const int r1 = prev_row(ra, 1, h1), r2 = prev_row(ra, 2, h2);
        const bf16_t* ap0 = A + (size_t)ra * D + 8 * q4; const bf16_t* ap1 = A + (size_t)r1 * D + 8 * q4; const bf16_t* ap2 = A + (size_t)r2 * D + 8 * q4;
        const bf16_t* bpa[4]; const bf16_t* bpb[4];
#pragma unroll
        for (int n = 0; n < 4; ++n) { const int cc = ct * 64 + 16 * n + l15; const int wr = 256 * (cc >> 7) + (cc & 127); bpa[n] = Wt + (size_t)wr * D + 8 * q4; bpb[n] = bpa[n] + (size_t)128 * D; }
        for (int k0 = 0; k0 < D; k0 += 32) {
            const bf16x8 x0 = *(const bf16x8*)(ap0 + k0), x1 = *(const bf16x8*)(ap1 + k0), x2 = *(const bf16x8*)(ap2 + k0);
#pragma unroll
            for (int n = 0; n < 4; ++n) { const bf16x8 wa = *(const bf16x8*)(bpa[n] + k0), wb = *(const bf16x8*)(bpb[n] + k0);
                a0[n] = __builtin_amdgcn_mfma_f32_16x16x32_bf16(x0, wa, a0[n], 0, 0, 0);
                a1[n] = __builtin_amdgcn_mfma_f32_16x16x32_bf16(x1, wa, a1[n], 0, 0, 0);
                a2[n] = __builtin_amdgcn_mfma_f32_16x16x32_bf16(x2, wa, a2[n], 0, 0, 0);
                bb[n] = __builtin_amdgcn_mfma_f32_16x16x32_bf16(x0, wb, bb[n], 0, 0, 0); }
        }
#pragma unroll
        for (int i = 0; i < 4; ++i) {
            const int row = rt * 16 + 4 * q4 + i; bool g1, g2; const int p1 = prev_row(row, 1, g1), p2 = prev_row(row, 2, g2);
            const float s0 = 1.0f / sqrtf(rss[row] * (1.0f / D) + EPS);
            const float s1 = g1 ? 1.0f / sqrtf(rss[p1] * (1.0f / D) + EPS) : 0.f, s2 = g2 ? 1.0f / sqrtf(rss[p2] * (1.0f / D) + EPS) : 0.f;
#pragma unroll
            for (int n = 0; n < 4; ++n) { const int cc = ct * 64 + 16 * n + l15;
                const float ac = cb[cc] + cw[cc] * (a2[n][i] * s2) + cw[DFF + cc] * (a1[n][i] * s1) + cw[2 * DFF + cc] * (a0[n][i] * s0);
                const float bv = bb[n][i] * s0; const float g = ac / (1.0f + __expf(-ac)) * bv;
                G[(size_t)row * DFF + cc] = (bf16_t)f2bf(g); }
        }
    }
}

__device__ __forceinline__ s16x4 vtr(const LAS unsigned char* p) { typedef short v4i16_t __attribute__((ext_vector_type(4)));
    return __builtin_bit_cast(s16x4, __builtin_amdgcn_ds_read_tr16_b64_v4i16((LAS v4i16_t*)p)); }
__device__ __forceinline__ unsigned cvtpk(float lo, float hi) { typedef float f32x2_t __attribute__((ext_vector_type(2))); typedef __bf16 bf16x2_t __attribute__((ext_vector_type(2)));
    f32x2_t v = {lo, hi}; bf16x2_t b = __builtin_convertvector(v, bf16x2_t); return __builtin_bit_cast(unsigned, b); }

struct SrcA { const bf16_t* K; const bf16_t* V; int h, s;
    __device__ __forceinline__ const bf16_t* kptr(int krow, int ch) const { return K + (size_t)krow * 1024 + h * 128 + s * 64 + ch * 8; }
    __device__ __forceinline__ const bf16_t* vptr(int krow, int ch) const { return V + (size_t)krow * 1024 + h * 128 + ch * 8; } };
struct SrcB { const bf16_t* KV; const bf16_t* KR; int h;
    __device__ __forceinline__ const bf16_t* kptr(int krow, int ch) const { return ch < 8 ? KV + (size_t)krow * 2048 + h * 128 + ch * 8 : KR + (size_t)krow * 32 + (ch - 8) * 8; }
    __device__ __forceinline__ const bf16_t* vptr(int krow, int ch) const { return KV + (size_t)krow * 2048 + h * 128 + 64 + ch * 8; } };

template <int DQK, int DV> struct ACfg { static constexpr int KS = DQK * 2 + 16, VS = DV * 2 + 64, KOFF = 0, VOFF = 64 * KS, SCR = VOFF + 64 * VS; };

template <int DQK, int DV, bool META>
__device__ __forceinline__ void attn_tile(const LAS unsigned char* Kt, const LAS unsigned char* Vt, LAS float* scr, const bf16x8 (&qf)[DQK / 16], f32x16 (&o)[DV / 32], float& m, float& lsum, int lane) {
    constexpr int KS = ACfg<DQK, DV>::KS, VS = ACfg<DQK, DV>::VS;
    const int r32 = lane & 31, hi = lane >> 5;
    f32x16 p0, p1;
#pragma unroll
    for (int r = 0; r < 16; ++r) { p0[r] = 0.f; p1[r] = 0.f; }
#pragma unroll
    for (int kk = 0; kk < DQK / 16; ++kk) {
        const bf16x8 k0 = *(const LAS bf16x8*)(Kt + r32 * KS + (16 * kk + 8 * hi) * 2);
        p0 = __builtin_amdgcn_mfma_f32_32x32x16_bf16(k0, qf[kk], p0, 0, 0, 0);
        if (!META) { const bf16x8 k1 = *(const LAS bf16x8*)(Kt + (32 + r32) * KS + (16 * kk + 8 * hi) * 2);
            p1 = __builtin_amdgcn_mfma_f32_32x32x16_bf16(k1, qf[kk], p1, 0, 0, 0); }
        if (kk & 1) __builtin_amdgcn_sched_barrier(0);
    }
    float mx = -INFINITY;
    if (META) {
#pragma unroll
        for (int r = 0; r < 8; ++r) mx = fmaxf(mx, p0[r]);
    } else {
#pragma unroll
        for (int r = 0; r < 16; ++r) mx = fmaxf(mx, fmaxf(p0[r], p1[r]));
    }
    mx = fmaxf(mx, __shfl_xor(mx, 32));
    const float mn = fmaxf(m, mx); const float alpha = __builtin_amdgcn_exp2f(m - mn); m = mn;
    float ps = 0.f;
    if (META) {
#pragma unroll
        for (int r = 0; r < 8; ++r) { p0[r] = __builtin_amdgcn_exp2f(p0[r] - mn); ps += p0[r]; }
    } else {
#pragma unroll
        for (int r = 0; r < 16; ++r) { p0[r] = __builtin_amdgcn_exp2f(p0[r] - mn); p1[r] = __builtin_amdgcn_exp2f(p1[r] - mn); ps += p0[r] + p1[r]; }
    }
    lsum = lsum * alpha + ps;
    if (__any(alpha != 1.0f)) {
        if (hi == 0) scr[r32] = alpha;
        asm volatile("s_waitcnt lgkmcnt(0)" ::: "memory");
#pragma unroll
        for (int r = 0; r < 16; ++r) { const float a = scr[crow(r, hi)];
#pragma unroll
            for (int d0 = 0; d0 < DV / 32; ++d0) o[d0][r] *= a; }
    }
    bf16x8 pa[4];
    { u32x4 w; w.x = cvtpk(p0[0], p0[1]); w.y = cvtpk(p0[2], p0[3]); w.z = cvtpk(p0[4], p0[5]); w.w = cvtpk(p0[6], p0[7]); pa[0] = __builtin_bit_cast(bf16x8, w); }
    if (!META) {
        { u32x4 w; w.x = cvtpk(p0[8], p0[9]); w.y = cvtpk(p0[10], p0[11]); w.z = cvtpk(p0[12], p0[13]); w.w = cvtpk(p0[14], p0[15]); pa[1] = __builtin_bit_cast(bf16x8, w); }
        { u32x4 w; w.x = cvtpk(p1[0], p1[1]); w.y = cvtpk(p1[2], p1[3]); w.z = cvtpk(p1[4], p1[5]); w.w = cvtpk(p1[6], p1[7]); pa[2] = __builtin_bit_cast(bf16x8, w); }
        { u32x4 w; w.x = cvtpk(p1[8], p1[9]); w.y = cvtpk(p1[10], p1[11]); w.z = cvtpk(p1[12], p1[13]); w.w = cvtpk(p1[14], p1[15]); pa[3] = __builtin_bit_cast(bf16x8, w); }
    }
    const LAS unsigned char* vb = Vt + (4 * hi + ((lane & 15) >> 2)) * VS + (16 * ((lane >> 4) & 1) + 4 * (lane & 3)) * 2;
#pragma unroll
    for (int ks = 0; ks < (META ? 1 : 4); ++ks) {
#pragma unroll
        for (int d0 = 0; d0 < DV / 32; ++d0) {
            const s16x4 lo = vtr(vb + (16 * ks) * VS + 64 * d0), hh = vtr(vb + (16 * ks + 8) * VS + 64 * d0);
            const bf16x8 vf = (bf16x8){lo[0], lo[1], lo[2], lo[3], hh[0], hh[1], hh[2], hh[3]};
            o[d0] = __builtin_amdgcn_mfma_f32_32x32x16_bf16(pa[ks], vf, o[d0], 0, 0, 0);
        }
        __builtin_amdgcn_sched_barrier(0);
    }
}

template <int DQK, int DV, class Src>
__device__ __forceinline__ void attn_pass(const Ctx& c, const Src& src, int b, int qb, const bf16x8 (&qf)[DQK / 16], f32x16 (&o)[DV / 32]) {
    typedef ACfg<DQK, DV> C;
    LAS unsigned char* Kt = c.lds + C::KOFF; LAS unsigned char* Vt = c.lds + C::VOFF; LAS float* scr = (LAS float*)(c.lds + C::SCR) + c.wave * 64;
    const int hi = c.lane >> 5, r32 = c.lane & 31;
    float m = -INFINITY, lsum = 0.f;
#pragma unroll
    for (int d0 = 0; d0 < DV / 32; ++d0)
#pragma unroll
        for (int r = 0; r < 16; ++r) o[d0][r] = 0.f;
    const int NT = qb < 0 ? 0 : 4 * (qb + 1);
    const int myc = qb < 0 ? -1 : 4 * qb + (c.wave >> 1);
    const bool active = qb >= 0 || c.wave == 0;
    for (int jt = -1; jt < NT; ++jt) {
        __syncthreads();
        const int krow0 = jt < 0 ? RR : b * SEQ + 64 * jt;
        const int nk = jt < 0 ? 32 : 64, nv = jt < 0 ? 16 : 64;
        for (int idx = c.tid; idx < nk * (DQK / 8); idx += NTHREADS) { const int key = idx / (DQK / 8), ch = idx % (DQK / 8);
            *(LAS u32x4*)(Kt + key * C::KS + ch * 16) = *(const u32x4*)src.kptr(krow0 + key, ch); }
        for (int idx = c.tid; idx < nv * (DV / 8); idx += NTHREADS) { const int key = idx / (DV / 8), ch = idx % (DV / 8);
            *(LAS u32x4*)(Vt + key * C::VS + ch * 16) = *(const u32x4*)src.vptr(krow0 + key, ch); }
        __syncthreads();
        if (active && jt <= myc) {
            if (jt < 0) attn_tile<DQK, DV, true>(Kt, Vt, scr, qf, o, m, lsum, c.lane);
            else attn_tile<DQK, DV, false>(Kt, Vt, scr, qf, o, m, lsum, c.lane);
        }
    }
    const float lt = lsum + __shfl_xor(lsum, 32);
    if (hi == 0) scr[32 + r32] = 1.0f / lt;
    asm volatile("s_waitcnt lgkmcnt(0)" ::: "memory");
#pragma unroll
    for (int r = 0; r < 16; ++r) { const float a = scr[32 + crow(r, hi)];
#pragma unroll
        for (int d0 = 0; d0 < DV / 32; ++d0) o[d0][r] *= a; }
}

__device__ __forceinline__ void attn_unit_a(const Params& p, const Ctx& c, int b, int h, int qb, float lam) {
    const int q0 = qb < 0 ? RR : b * SEQ + 256 * qb; const int hi = c.lane >> 5, r32 = c.lane & 31;
    bf16_t* Qb = (bf16_t*)(p.ws + WS_Q); bf16_t* O1 = (bf16_t*)(p.ws + WS_OB2);
    const bool active = qb >= 0 || c.wave == 0;
    f32x16 o[4];
#pragma nounroll
    for (int s = 0; s < 2; ++s) {
        const bf16_t* qrow = Qb + (size_t)(q0 + 32 * c.wave + r32) * 1024 + h * 128 + s * 64;
        bf16x8 qf[4];
#pragma unroll
        for (int kk = 0; kk < 4; ++kk) qf[kk] = *(const bf16x8*)(qrow + 16 * kk + 8 * hi);
        SrcA src{(const bf16_t*)(p.ws + WS_K), (const bf16_t*)(p.ws + WS_V), h, s};
        attn_pass<64, 128, SrcA>(c, src, b, qb, qf, o);
        if (s == 0 && active) {
            int rb = q0 + 32 * c.wave; asm volatile("" : "+s"(rb));
#pragma unroll
            for (int r = 0; r < 16; ++r) { bf16_t* orow = O1 + (size_t)(rb + crow(r, hi)) * 1024 + h * 128 + r32;
                orow[0] = (bf16_t)f2bf(o[0][r]); orow[32] = (bf16_t)f2bf(o[1][r]); orow[64] = (bf16_t)f2bf(o[2][r]); orow[96] = (bf16_t)f2bf(o[3][r]); }
        }
    }
    if (!active) return;
    int rb = q0 + 32 * c.wave; asm volatile("" : "+s"(rb));
#pragma unroll
    for (int r = 0; r < 16; ++r) {
        const size_t off = (size_t)(rb + crow(r, hi)) * 1024 + h * 128 + r32;
        const float v0 = bf2f(O1[off]) - lam * o[0][r], v1 = bf2f(O1[off + 32]) - lam * o[1][r], v2 = bf2f(O1[off + 64]) - lam * o[2][r], v3 = bf2f(O1[off + 96]) - lam * o[3][r];
        float ss = v0 * v0 + v1 * v1 + v2 * v2 + v3 * v3;
#pragma unroll
        for (int sh = 1; sh < 32; sh <<= 1) ss += __shfl_xor(ss, sh);
        const float rs = 1.0f / sqrtf(ss * (1.0f / 128.0f) + EPS);
        bf16_t* orow = Qb + off;
        orow[0] = (bf16_t)f2bf(v0 * rs); orow[32] = (bf16_t)f2bf(v1 * rs); orow[64] = (bf16_t)f2bf(v2 * rs); orow[96] = (bf16_t)f2bf(v3 * rs);
        if ((r & 3) == 3) asm volatile("" ::: "memory");
    }
}
__device__ __forceinline__ void ph_attn_a(const Params& p, const Ctx& c) {
    const float d1 = wave_sum(p.in[I_LQ1][c.lane] * p.in[I_LK1][c.lane]), d2 = wave_sum(p.in[I_LQ2][c.lane] * p.in[I_LK2][c.lane]);
    const float lam = expf(d1) - expf(d2) + LAM_INIT;
#pragma nounroll
    for (int pi = c.vcu; pi < 256 + 8; pi += c.G) {
        const int nsub = pi < 256 ? 2 : 1;
#pragma nounroll
        for (int sub = 0; sub < nsub; ++sub) {
            int b, h, qb;
            if (pi < 256) { const int bh = pi >> 2, s = pi & 3; b = bh >> 3; h = bh & 7; qb = sub ? 7 - s : s; } else { b = 0; h = pi - 256; qb = -1; }
            attn_unit_a(p, c, b, h, qb, lam);
        }
    }
}
__device__ __forceinline__ void attn_unit_b(const Params& p, const Ctx& c, int b, int h, int qb) {
    const int q0 = qb < 0 ? RR : b * SEQ + 256 * qb; const int hi = c.lane >> 5, r32 = c.lane & 31;
    const bf16_t* qrow = (const bf16_t*)(p.ws + WS_Q2) + (size_t)(q0 + 32 * c.wave + r32) * 1536 + h * 96;
    bf16x8 qf[6];
#pragma unroll
    for (int kk = 0; kk < 6; ++kk) qf[kk] = *(const bf16x8*)(qrow + 16 * kk + 8 * hi);
    f32x16 o[2];
    SrcB src{(const bf16_t*)(p.ws + WS_KV2), (const bf16_t*)(p.ws + WS_KR), h};
    attn_pass<96, 64, SrcB>(c, src, b, qb, qf, o);
    const bool active = qb >= 0 || c.wave == 0;
    if (!active) return;
    bf16_t* Ob = (bf16_t*)(p.ws + WS_OB2);
    int rb = q0 + 32 * c.wave; asm volatile("" : "+s"(rb));
#pragma unroll
    for (int r = 0; r < 16; ++r) { bf16_t* orow = Ob + (size_t)(rb + crow(r, hi)) * 1024 + h * 64 + r32;
        orow[0] = (bf16_t)f2bf(o[0][r]); orow[32] = (bf16_t)f2bf(o[1][r]); }
}
__device__ __forceinline__ void ph_attn_b(const Params& p, const Ctx& c) {
#pragma nounroll
    for (int pi = c.vcu; pi < 512 + 16; pi += c.G) {
        const int nsub = pi < 512 ? 2 : 1;
#pragma nounroll
        for (int sub = 0; sub < nsub; ++sub) {
            int b, h, qb;
            if (pi < 512) { const int bh = pi >> 2, s = pi & 3; b = bh >> 4; h = bh & 15; qb = sub ? 7 - s : s; } else { b = 0; h = pi - 512; qb = -1; }
            attn_unit_b(p, c, b, h, qb);
        }
    }
}

#ifndef PHMASK
#define PHMASK 0xFFFFFFFFull
#endif
#define PHON(x) ((PHMASK >> (x)) & 1ull)
enum { PH_PROLOGUE = 0, PH_QKV, PH_ROT_A, PH_ATTN_A, PH_WO_A, PH_STAT1, PH_FFNIN_A, PH_FFNOUT_A, PH_STAT2, PH_DPROJ, PH_DPOST, PH_UPROJ, PH_ROT_B,
       PH_ATTN_B, PH_WO_B, PH_STAT3, PH_FFNIN_B, PH_FFNOUT_B, PH_FINAL, PH_COUNT };

__global__ void __launch_bounds__(NTHREADS, 2) fwd_kernel(Params pin) {
    extern __shared__ __attribute__((aligned(16))) unsigned char smem[];
#pragma nounroll
    for (int ph = pin.ph_lo; ph < pin.ph_hi; ++ph) {
        Params p = pin; asm volatile("" : "+s"(p.ws), "+s"(p.out));
        int tid_ = threadIdx.x; asm volatile("" : "+v"(tid_));
        Ctx c; c.lds = (LAS unsigned char*)smem; c.tid = tid_; c.lane = c.tid & 63; c.wave = __builtin_amdgcn_readfirstlane(c.tid >> 6);
        c.G = gridDim.x; { const int bx = blockIdx.x; c.vcu = (c.G % 8 == 0) ? (bx % 8) * (c.G / 8) + bx / 8 : bx; }
        c.gw = c.vcu * NWAVES + c.wave; c.ngw = c.G * NWAVES;
        unsigned char* ws = p.ws;
        const bf16_t* HB = (const bf16_t*)(ws + WS_HB);
        float* hmeta = (float*)(ws + WS_HMETA);
        switch (ph) {
            case PH_PROLOGUE: if (PHON(PH_PROLOGUE))  ph_prologue(p, c); break;
            case PH_QKV: if (PHON(PH_QKV))  { EpiQKV e{rss_ptr(p, 0), (bf16_t*)(ws + WS_Q), (bf16_t*)(ws + WS_K), (bf16_t*)(ws + WS_V)};
                gemm_simple(HB, D, (const bf16_t*)(ws + W_QKV), D, 3072, RV, e, c); break; }
            case PH_ROT_A: if (PHON(PH_ROT_A))  ph_rot_a(p, c); break;
            case PH_ATTN_A: if (PHON(PH_ATTN_A))  ph_attn_a(p, c); break;
            case PH_WO_A: if (PHON(PH_WO_A))  { EpiRes e{p.out, hmeta}; gemm_simple((const bf16_t*)(ws + WS_Q), 1024, (const bf16_t*)(ws + W_OA), 1024, 1024, RV, e, c); break; }
            case PH_STAT1: if (PHON(PH_STAT1))  ph_rowstat(p, c, 1); break;
            case PH_FFNIN_A: if (PHON(PH_FFNIN_A))  ph_ffn_in(p, c, 0, 1); break;
            case PH_FFNOUT_A: if (PHON(PH_FFNOUT_A))  { EpiRes e{p.out, hmeta}; gemm_simple((const bf16_t*)(ws + WS_G), DFF, (const bf16_t*)(ws + W_OUT0), DFF, 1024, RV, e, c); break; }
            case PH_STAT2: if (PHON(PH_STAT2))  ph_rowstat(p, c, 2); break;
            case PH_DPROJ: if (PHON(PH_DPROJ))  { EpiD e{rss_ptr(p, 2), (bf16_t*)(ws + WS_CQ), (bf16_t*)(ws + WS_CKV), (bf16_t*)(ws + WS_KR)};
                gemm_simple(HB, D, (const bf16_t*)(ws + W_D), D, 768, RV, e, c); break; }
            case PH_DPOST: if (PHON(PH_DPOST))  ph_dpost(p, c); break;
            case PH_UPROJ: if (PHON(PH_UPROJ))  { EpiScaled e1{rss_ptr(p, 6), 1.0f / 256.0f, (bf16_t*)(ws + WS_KV2), 2048};
                gemm_simple((const bf16_t*)(ws + WS_CKV), 256, (const bf16_t*)(ws + W_UKV), 256, 2048, RV, e1, c);
                EpiScaled e2{rss_ptr(p, 5), 1.0f / 384.0f, (bf16_t*)(ws + WS_Q2), 1536};
                gemm_simple((const bf16_t*)(ws + WS_CQ), 384, (const bf16_t*)(ws + W_UQ), 384, 1536, RV, e2, c); break; }
            case PH_ROT_B: if (PHON(PH_ROT_B))  ph_rot_b(p, c); break;
            case PH_ATTN_B: if (PHON(PH_ATTN_B))  ph_attn_b(p, c); break;
            case PH_WO_B: if (PHON(PH_WO_B))  { EpiRes e{p.out, hmeta}; gemm_simple((const bf16_t*)(ws + WS_OB2), 1024, (const bf16_t*)(ws + W_OB), 1024, 1024, RV, e, c); break; }
            case PH_STAT3: if (PHON(PH_STAT3))  ph_rowstat(p, c, 3); break;
            case PH_FFNIN_B: if (PHON(PH_FFNIN_B))  ph_ffn_in(p, c, 1, 3); break;
            case PH_FFNOUT_B: if (PHON(PH_FFNOUT_B))  { EpiRes e{p.out, hmeta}; gemm_simple((const bf16_t*)(ws + WS_G), DFF, (const bf16_t*)(ws + W_OUT1), DFF, 1024, RV, e, c); break; }
            case PH_FINAL: if (PHON(PH_FINAL))  ph_final(p, c); break;
            default: break;
        }
        if (ph + 1 < pin.ph_hi) { cg::this_grid().sync(); }
    }
}

extern "C" void kernel_launch(void* const* d_in, const int* in_sizes, int n_in, void* d_out, int out_size, void* d_ws, size_t ws_size, hipStream_t stream) {
    static int grid = 0;
    if (grid == 0) {
        if (n_in != 25 || ws_size < WS_END || out_size != RR * D) { fprintf(stderr, "kernel_launch: unexpected shapes (n_in %d, ws %zu, out %d)\n", n_in, ws_size, out_size); grid = -1; return; }
        int dev = 0, cus = 0, per_cu = 0;
        hipGetDevice(&dev); hipDeviceGetAttribute(&cus, hipDeviceAttributeMultiprocessorCount, dev);
        hipFuncSetAttribute((const void*)fwd_kernel, hipFuncAttributeMaxDynamicSharedMemorySize, LDS_BYTES);
        hipOccupancyMaxActiveBlocksPerMultiprocessor(&per_cu, (const void*)fwd_kernel, NTHREADS, LDS_BYTES);
        if (per_cu < 1) { fprintf(stderr, "kernel_launch: occupancy query says %d blocks per CU\n", per_cu); per_cu = 1; }
        (void)hipGetLastError();
        grid = cus;
    }
    if (grid < 0) return;
    Params p{};
    for (int i = 0; i < 25; ++i) p.in[i] = (const float*)d_in[i];
    p.out = (float*)d_out; p.ws = (unsigned char*)d_ws;
    for (int ph = 0; ph < PH_COUNT; ++ph) {
        p.ph_lo = ph; p.ph_hi = ph + 1;
        hipLaunchKernelGGL(fwd_kernel, dim3(grid), dim3(NTHREADS), LDS_BYTES, stream, p);
    }
}
```

```cpp
#include <hip/hip_runtime.h>
#include <hip/hip_cooperative_groups.h>
#include <cstdio>
#include <cstdint>
#include <cmath>
namespace cg = cooperative_groups;

#define LAS __attribute__((address_space(3)))
typedef unsigned short bf16_t;
typedef short bf16x8 __attribute__((ext_vector_type(8)));
typedef short s16x4 __attribute__((ext_vector_type(4)));
typedef float f32x4 __attribute__((ext_vector_type(4)));
typedef float f32x16 __attribute__((ext_vector_type(16)));
typedef unsigned u32x4 __attribute__((ext_vector_type(4)));
typedef unsigned u32x2 __attribute__((ext_vector_type(2)));

constexpr int NB = 8, SEQ = 2048, NMETA = 16, D = 1024, DFF = 2816;
constexpr int RR = NB * SEQ;
constexpr int RV = RR + NMETA;
constexpr int RT = 16640;
constexpr int NWAVES = 8, NTHREADS = 512;
constexpr float EPS = 1e-5f;
constexpr float LOG2E = 1.4426950408889634f;
constexpr float QS_A = 0.125f * LOG2E;
constexpr float QS_B = 0.10206207261596575f * LOG2E;
constexpr float LAM_INIT = 0.2f;

constexpr size_t KiB = 1024, MiB = 1024 * 1024;
constexpr size_t WS_CTL = 0;
constexpr size_t W_QKV = 1 * MiB;
constexpr size_t W_OA = 7 * MiB;
constexpr size_t W_IN0 = 9 * MiB, W_IN1 = 20 * MiB;
constexpr size_t W_OUT0 = 31 * MiB, W_OUT1 = 31 * MiB + 5632 * KiB;
constexpr size_t W_D = 42 * MiB;
constexpr size_t W_UKV = 43 * MiB + 512 * KiB;
constexpr size_t W_UQ = 44 * MiB + 512 * KiB;
constexpr size_t W_OB = 45 * MiB + 640 * KiB;
constexpr size_t WS_HB = 48 * MiB;
constexpr size_t WS_BIG = WS_HB + 33280 * KiB;
constexpr size_t ROWB1024 = (size_t)RT * 1024 * 2;
constexpr size_t WS_Q = WS_BIG, WS_K = WS_BIG + ROWB1024, WS_V = WS_BIG + 2 * ROWB1024;
constexpr size_t WS_G = WS_BIG;
constexpr size_t WS_Q2 = WS_BIG;
constexpr size_t WS_KV2 = WS_BIG + (size_t)RT * 1536 * 2;
constexpr size_t WS_CQ = WS_BIG + 116480 * KiB;
constexpr size_t WS_CKV = WS_CQ + (size_t)RT * 384 * 2;
constexpr size_t WS_KR = WS_CKV + (size_t)RT * 256 * 2;
constexpr size_t WS_OB2 = 216 * MiB;
constexpr size_t WS_HMETA = WS_OB2 + 33280 * KiB;
constexpr size_t WS_RSS = WS_HMETA + 1 * MiB;
constexpr size_t WS_ROPE = WS_RSS + 512 * KiB;
constexpr size_t WS_END = 256 * MiB;
static_assert(WS_KR + (size_t)RT * 32 * 2 <= WS_OB2, "ws map");
static_assert(WS_KV2 + (size_t)RT * 2048 * 2 <= WS_CQ, "ws map");
static_assert(WS_ROPE + 512 * KiB <= WS_END, "ws map");
static_assert(W_OB + 2 * MiB <= WS_HB, "ws map");

constexpr int LDS_BYTES = 147456;

struct Params {
    const float* in[25];
    float* out;
    unsigned char* ws;
    int ph_lo, ph_hi;
};
enum { I_X = 0, I_META, I_A_NORM, I_A_WQKV, I_LQ1, I_LK1, I_LQ2, I_LK2, I_A_SUB, I_A_WO, I_KV_NORM, I_KV_WDKV, I_KV_ANORM, I_KV_WUKV,
       I_B_NORM, I_B_WDQ, I_B_QANORM, I_B_WUQ, I_B_WO, I_FFN_NORM, I_FFN_WIN, I_FFN_CW, I_FFN_CB, I_FFN_WOUT, I_FINAL };

struct Ctx { int tid, lane, wave, gw, ngw, vcu, G; LAS unsigned char* lds; };

__device__ __forceinline__ unsigned f2bf(float f) { unsigned u = __builtin_bit_cast(unsigned, f); return (u + 0x7fffu + ((u >> 16) & 1u)) >> 16; }
__device__ __forceinline__ unsigned pk2(float lo, float hi) { return f2bf(lo) | (f2bf(hi) << 16); }
__device__ __forceinline__ float bf2f(bf16_t b) { return __builtin_bit_cast(float, (unsigned)b << 16); }
__device__ __forceinline__ float wave_sum(float v) {
#pragma unroll
    for (int o = 1; o < 64; o <<= 1) v += __shfl_xor(v, o);
    return v;
}
__device__ __forceinline__ int row_pos(int r) { return r < RR ? NMETA + (r & (SEQ - 1)) : r - RR; }
__device__ __forceinline__ float* hrow(const Params& p, int r) { return r < RR ? p.out + (size_t)r * D : (float*)(p.ws + WS_HMETA) + (size_t)(r - RR) * D; }
__device__ __forceinline__ float* rss_ptr(const Params& p, int site) { return (float*)(p.ws + WS_RSS) + (size_t)site * RT; }
__device__ __forceinline__ int crow(int r, int hi) { return (r & 3) + 8 * (r >> 2) + 4 * hi; }

struct WSrc { const float* W; int pitch; int col0; const float* gain; int gmask; float scale; };
__device__ __forceinline__ void wdims(int id, int& N, int& K, size_t& off) {
    switch (id) {
        case 0: N = 3072; K = 1024; off = W_QKV; break;
        case 1: N = 1024; K = 1024; off = W_OA; break;
        case 2: N = 5632; K = 1024; off = W_IN0; break;
        case 3: N = 5632; K = 1024; off = W_IN1; break;
        case 4: N = 1024; K = 2816; off = W_OUT0; break;
        case 5: N = 1024; K = 2816; off = W_OUT1; break;
        case 6: N = 768; K = 1024; off = W_D; break;
        case 7: N = 2048; K = 256; off = W_UKV; break;
        case 8: N = 1536; K = 384; off = W_UQ; break;
        default: N = 1024; K = 1024; off = W_OB; break;
    }
}
__device__ __forceinline__ WSrc wsrc(const Params& p, int id, int n0) {
    WSrc s; s.gain = nullptr; s.gmask = 0; s.scale = 1.f; s.W = nullptr; s.pitch = 0; s.col0 = 0;
    switch (id) {
        case 0: s.W = p.in[I_A_WQKV]; s.pitch = 3072; s.col0 = n0; s.gain = p.in[I_A_NORM]; s.gmask = 1023; s.scale = n0 < 1024 ? QS_A : 1.f; break;
        case 1: s.W = p.in[I_A_WO]; s.pitch = 1024; s.col0 = n0; s.gain = p.in[I_A_SUB]; s.gmask = 127; s.scale = 1.f - LAM_INIT; break;
        case 2: case 3: { const int l = id - 2; s.W = p.in[I_FFN_WIN] + (size_t)l * 1024 * 5632; s.pitch = 5632; const int j = n0 >> 8, u = n0 & 255;
            s.col0 = u < 128 ? 128 * j + u : DFF + 128 * j + (u - 128); s.gain = p.in[I_FFN_NORM] + l * 1024; s.gmask = 1023; break; }
        case 4: case 5: { const int l = id - 4; s.W = p.in[I_FFN_WOUT] + (size_t)l * DFF * 1024; s.pitch = 1024; s.col0 = n0; break; }
        case 6: if (n0 < 384) { s.W = p.in[I_B_WDQ]; s.pitch = 384; s.col0 = n0; s.gain = p.in[I_B_NORM]; s.gmask = 1023; }
                else if (n0 < 672) { s.W = p.in[I_KV_WDKV]; s.pitch = 288; s.col0 = n0 - 384; s.gain = p.in[I_KV_NORM]; s.gmask = 1023; }
                break;
        case 7: s.W = p.in[I_KV_WUKV]; s.pitch = 2048; s.col0 = n0; s.gain = p.in[I_KV_ANORM]; s.gmask = 255; break;
        case 8: s.W = p.in[I_B_WUQ]; s.pitch = 1536; s.col0 = n0; s.gain = p.in[I_B_QANORM]; s.gmask = 511; s.scale = QS_B; break;
        default: s.W = p.in[I_B_WO]; s.pitch = 1024; s.col0 = n0; break;
    }
    return s;
}
__device__ __forceinline__ void transpose_item(const WSrc& s, int K, bf16_t* WT, int k0, int n0, LAS float* scr, int lane) {
    if (s.W) {
#pragma unroll 8
        for (int i = 0; i < 32; ++i) { const int kk = 2 * i + (lane >> 5); float g = s.scale; if (s.gain) g *= s.gain[(k0 + kk) & s.gmask];
            scr[kk * 33 + (lane & 31)] = s.W[(size_t)(k0 + kk) * s.pitch + s.col0 + (lane & 31)] * g; }
    } else {
#pragma unroll 8
        for (int i = 0; i < 32; ++i) { const int kk = 2 * i + (lane >> 5); scr[kk * 33 + (lane & 31)] = 0.f; }
    }
    asm volatile("s_waitcnt lgkmcnt(0)" ::: "memory");
    const int c = lane & 7;
#pragma unroll
    for (int j = 0; j < 4; ++j) { const int n = (lane >> 3) + 8 * j; const LAS float* q = scr + (8 * c) * 33 + n;
        u32x4 o; o.x = pk2(q[0 * 33], q[1 * 33]); o.y = pk2(q[2 * 33], q[3 * 33]); o.z = pk2(q[4 * 33], q[5 * 33]); o.w = pk2(q[6 * 33], q[7 * 33]);
        *(u32x4*)(WT + (size_t)(n0 + n) * K + k0 + 8 * c) = o; }
    asm volatile("s_waitcnt lgkmcnt(0)" ::: "memory");
}
__device__ __forceinline__ void ph_prologue(const Params& p, const Ctx& c) {
    LAS float* scr = (LAS float*)(c.lds + c.wave * 16384);
    int base = 0;
    for (int id = 0; id < 10; ++id) {
        int N, K; size_t off; wdims(id, N, K, off);
        const int nkb = K / 64, nnb = N / 32, items = nkb * nnb;
        for (int it = ((c.gw - base) % c.ngw + c.ngw) % c.ngw; it < items; it += c.ngw) {
            const int kb = it / nnb, nb = it % nnb; const WSrc s = wsrc(p, id, nb * 32);
            transpose_item(s, K, (bf16_t*)(p.ws + off), kb * 64, nb * 32, scr, c.lane); }
        base += items;
    }
    { float2* TA = (float2*)(p.ws + WS_ROPE); float2* TB = TA + 2064 * 8;
      const int gt = c.gw * 64 + c.lane, ngt = c.ngw * 64;
      for (int i = gt; i < 2064 * 8; i += ngt) { const int pos = i >> 3, k = i & 7; const float inv = 1.0f / powf(500000.0f, (float)k / 8.0f); const float a = (float)pos * inv; TA[i] = make_float2(cosf(a), sinf(a)); }
      for (int i = gt; i < 2064 * 16; i += ngt) { const int pos = i >> 4, k = i & 15; const float inv = 1.0f / powf(10000.0f, (float)k / 16.0f); const float a = (float)pos * inv; TB[i] = make_float2(cosf(a), sinf(a)); } }
    float* rss0 = rss_ptr(p, 0);
    for (int r = c.gw; r < RT; r += c.ngw) {
        const float* src = r < RR ? p.in[I_X] + (size_t)r * D : (r < RV ? p.in[I_META] + (size_t)(r - RR) * D : nullptr);
        f32x4 v[4]; float ss = 0.f;
#pragma unroll
        for (int j = 0; j < 4; ++j) { v[j] = src ? *(const f32x4*)(src + 4 * c.lane + 256 * j) : (f32x4){0.f, 0.f, 0.f, 0.f}; ss += v[j].x * v[j].x + v[j].y * v[j].y + v[j].z * v[j].z + v[j].w * v[j].w; }
        ss = wave_sum(ss);
        float* h = hrow(p, r); bf16_t* hb = (bf16_t*)(p.ws + WS_HB) + (size_t)r * D;
#pragma unroll
        for (int j = 0; j < 4; ++j) { *(f32x4*)(h + 4 * c.lane + 256 * j) = v[j]; u32x2 w; w.x = pk2(v[j].x, v[j].y); w.y = pk2(v[j].z, v[j].w); *(u32x2*)(hb + 4 * c.lane + 256 * j) = w; }
        if (c.lane == 0) rss0[r] = ss;
    }
}
__device__ __forceinline__ void ph_rowstat(const Params& p, const Ctx& c, int site) {
    float* rss = rss_ptr(p, site);
    for (int r = c.gw; r < RT; r += c.ngw) {
        const float* h = hrow(p, r); f32x4 v[4]; float ss = 0.f;
#pragma unroll
        for (int j = 0; j < 4; ++j) { v[j] = *(const f32x4*)(h + 4 * c.lane + 256 * j); ss += v[j].x * v[j].x + v[j].y * v[j].y + v[j].z * v[j].z + v[j].w * v[j].w; }
        ss = wave_sum(ss);
        bf16_t* hb = (bf16_t*)(p.ws + WS_HB) + (size_t)r * D;
#pragma unroll
        for (int j = 0; j < 4; ++j) { u32x2 w; w.x = pk2(v[j].x, v[j].y); w.y = pk2(v[j].z, v[j].w); *(u32x2*)(hb + 4 * c.lane + 256 * j) = w; }
        if (c.lane == 0) rss[r] = ss;
    }
}
__device__ __forceinline__ void ph_final(const Params& p, const Ctx& c) {
    const float* g = p.in[I_FINAL];
    for (int r = c.gw; r < RR; r += c.ngw) {
        float* h = p.out + (size_t)r * D; f32x4 v[4]; float ss = 0.f;
#pragma unroll
        for (int j = 0; j < 4; ++j) { v[j] = *(const f32x4*)(h + 4 * c.lane + 256 * j); ss += v[j].x * v[j].x + v[j].y * v[j].y + v[j].z * v[j].z + v[j].w * v[j].w; }
        ss = wave_sum(ss); const float rstd = 1.0f / sqrtf(ss * (1.0f / D) + EPS);
#pragma unroll
        for (int j = 0; j < 4; ++j) { const f32x4 gg = *(const f32x4*)(g + 4 * c.lane + 256 * j); *(f32x4*)(h + 4 * c.lane + 256 * j) = v[j] * rstd * gg; }
    }
}

template <class Epi>
__device__ __forceinline__ void gemm_simple(const bf16_t* A, int lda, const bf16_t* Bt, int K, int N, int nrows, const Epi& epi, const Ctx& c) {
    const int nct = N / 64, nrt = (nrows + 31) / 32, items = nrt * nct;
    const int l15 = c.lane & 15, q4 = c.lane >> 4;
    for (int it = c.gw; it < items; it += c.ngw) {
        const int rt = it / nct, ct = it % nct;
        f32x4 acc[2][4];
#pragma unroll
        for (int m = 0; m < 2; ++m)
#pragma unroll
            for (int n = 0; n < 4; ++n) acc[m][n] = (f32x4){0.f, 0.f, 0.f, 0.f};
        const bf16_t* ap = A + (size_t)(rt * 32 + l15) * lda + 8 * q4;
        const bf16_t* bp = Bt + (size_t)(ct * 64 + l15) * K + 8 * q4;
        for (int k0 = 0; k0 < K; k0 += 32) {
            bf16x8 a[2], b[4];
#pragma unroll
            for (int m = 0; m < 2; ++m) a[m] = *(const bf16x8*)(ap + (size_t)(16 * m) * lda + k0);
#pragma unroll
            for (int n = 0; n < 4; ++n) b[n] = *(const bf16x8*)(bp + (size_t)(16 * n) * K + k0);
#pragma unroll
            for (int m = 0; m < 2; ++m)
#pragma unroll
                for (int n = 0; n < 4; ++n) acc[m][n] = __builtin_amdgcn_mfma_f32_16x16x32_bf16(a[m], b[n], acc[m][n], 0, 0, 0);
        }
#pragma unroll
        for (int m = 0; m < 2; ++m)
#pragma unroll
            for (int n = 0; n < 4; ++n)
#pragma unroll
                for (int i = 0; i < 4; ++i) epi(rt * 32 + 16 * m + 4 * q4 + i, ct * 64 + 16 * n + l15, acc[m][n][i]);
    }
}
struct EpiQKV { const float* rss; bf16_t* Q; bf16_t* K; bf16_t* V;
    __device__ __forceinline__ void operator()(int row, int col, float v) const { v *= 1.0f / sqrtf(rss[row] * (1.0f / D) + EPS);
        Q[(size_t)(col >> 10) * (ROWB1024 / 2) + (size_t)row * 1024 + (col & 1023)] = (bf16_t)f2bf(v); } };
struct EpiRes { float* out; float* hmeta;
    __device__ __forceinline__ void operator()(int row, int col, float v) const { float* h = row < RR ? out + (size_t)row * D : hmeta + (size_t)(row - RR) * D; h[col] += v; } };
struct EpiD { const float* rss; bf16_t* CQ; bf16_t* CKV; bf16_t* KR;
    __device__ __forceinline__ void operator()(int row, int col, float v) const { v *= 1.0f / sqrtf(rss[row] * (1.0f / D) + EPS); const bf16_t b = (bf16_t)f2bf(v);
        if (col < 384) CQ[(size_t)row * 384 + col] = b; else if (col < 640) CKV[(size_t)row * 256 + col - 384] = b; else if (col < 672) KR[(size_t)row * 32 + col - 640] = b; } };
struct EpiScaled { const float* rss; float invk; bf16_t* O; int ldo;
    __device__ __forceinline__ void operator()(int row, int col, float v) const { v *= 1.0f / sqrtf(rss[row] * invk + EPS); O[(size_t)row * ldo + col] = (bf16_t)f2bf(v); } };

__device__ __forceinline__ void ph_rot_a(const Params& p, const Ctx& c) {
    const float2* TA = (const float2*)(p.ws + WS_ROPE);
    const int gt = c.gw * 64 + c.lane, ngt = c.ngw * 64;
    for (int t = gt; t < RV * 256; t += ngt) {
        const int i = t & 7, sh = (t >> 3) & 15, which = (t >> 7) & 1, row = t >> 8;
        bf16_t* buf = (bf16_t*)(p.ws + (which ? WS_K : WS_Q)) + (size_t)row * 1024 + sh * 64;
        const float x1 = bf2f(buf[i]), x2 = bf2f(buf[8 + i]); const float2 cs = TA[row_pos(row) * 8 + i];
        buf[i] = (bf16_t)f2bf(x1 * cs.x - x2 * cs.y); buf[8 + i] = (bf16_t)f2bf(x2 * cs.x + x1 * cs.y);
    }
}
__device__ __forceinline__ void ph_dpost(const Params& p, const Ctx& c) {
    const float2* TB = (const float2*)(p.ws + WS_ROPE) + 2064 * 8;
    const int gt = c.gw * 64 + c.lane, ngt = c.ngw * 64;
    for (int t = gt; t < RV * 16; t += ngt) {
        const int i = t & 15, row = t >> 4; bf16_t* buf = (bf16_t*)(p.ws + WS_KR) + (size_t)row * 32;
        const float x1 = bf2f(buf[i]), x2 = bf2f(buf[16 + i]); const float2 cs = TB[row_pos(row) * 16 + i];
        buf[i] = (bf16_t)f2bf(x1 * cs.x - x2 * cs.y); buf[16 + i] = (bf16_t)f2bf(x2 * cs.x + x1 * cs.y);
    }
    float* rq = rss_ptr(p, 5); float* rkv = rss_ptr(p, 6);
    for (int r = c.gw; r < RT; r += c.ngw) {
        const bf16_t* cq = (const bf16_t*)(p.ws + WS_CQ) + (size_t)r * 384; const bf16_t* ckv = (const bf16_t*)(p.ws + WS_CKV) + (size_t)r * 256;
        float s1 = 0.f, s2 = 0.f;
        for (int k = c.lane; k < 384; k += 64) { const float v = bf2f(cq[k]); s1 += v * v; }
        for (int k = c.lane; k < 256; k += 64) { const float v = bf2f(ckv[k]); s2 += v * v; }
        s1 = wave_sum(s1); s2 = wave_sum(s2);
        if (c.lane == 0) { rq[r] = s1; rkv[r] = s2; }
    }
}
__device__ __forceinline__ void ph_rot_b(const Params& p, const Ctx& c) {
    const float2* TB = (const float2*)(p.ws + WS_ROPE) + 2064 * 8;
    const int gt = c.gw * 64 + c.lane, ngt = c.ngw * 64;
    for (int t = gt; t < RV * 256; t += ngt) {
        const int i = t & 15, h = (t >> 4) & 15, row = t >> 8; bf16_t* buf = (bf16_t*)(p.ws + WS_Q2) + (size_t)row * 1536 + h * 96 + 64;
        const float x1 = bf2f(buf[i]), x2 = bf2f(buf[16 + i]); const float2 cs = TB[row_pos(row) * 16 + i];
        buf[i] = (bf16_t)f2bf(x1 * cs.x - x2 * cs.y); buf[16 + i] = (bf16_t)f2bf(x2 * cs.x + x1 * cs.y);
    }
}

__device__ __forceinline__ int prev_row(int r, int d, bool& has) {
    has = true;
    if (r < RR) { const int t = r & (SEQ - 1); if (t >= d) return r - d; return RV - d + t; }
    if (r < RV) { const int i = r - RR; if (i >= d) return r - d; has = false; return r; }
    has = false; return r;
}
__device__ __forceinline__ void ph_ffn_in(const Params& p, const Ctx& c, int layer, int site) {
    const bf16_t* A = (const bf16_t*)(p.ws + WS_HB); const bf16_t* Wt = (const bf16_t*)(p.ws + (layer ? W_IN1 : W_IN0));
    bf16_t* G = (bf16_t*)(p.ws + WS_G); const float* rss = rss_ptr(p, site);
    const float* cw = p.in[I_FFN_CW] + (size_t)layer * 3 * DFF; const float* cb = p.in[I_FFN_CB] + (size_t)layer * DFF;
    const int nct = DFF / 64, nrt = (RV + 15) / 16, items = nrt * nct;
    const int l15 = c.lane & 15, q4 = c.lane >> 4;
    for (int it = c.gw; it < items; it += c.ngw) {
        const int rt = it / nct, ct = it % nct;
        f32x4 a0[4], a1[4], a2[4], bb[4];
#pragma unroll
        for (int n = 0; n < 4; ++n) { a0[n] = a1[n] = a2[n] = bb[n] = (f32x4){0.f, 0.f, 0.f, 0.f}; }
        const int ra = rt * 16 + l15; bool h1, h2; const int r1 = prev_row(ra, 1, h1), r2 = prev_row(ra, 2, h2);
        const bf16_t* ap0 = A + (size_t)ra * D + 8 * q4; const bf16_t* ap1 = A + (size_t)r1 * D + 8 * q4; const bf16_t* ap2 = A + (size_t)r2 * D + 8 * q4;
        const bf16_t* bpa[4]; const bf16_t* bpb[4];
#pragma unroll
        for (int n = 0; n < 4; ++n) { const int cc = ct * 64 + 16 * n + l15; const int wr = 256 * (cc >> 7) + (cc & 127); bpa[n] = Wt + (size_t)wr * D + 8 * q4; bpb[n] = bpa[n] + (size_t)128 * D; }
        for (int k0 = 0; k0 < D; k0 += 32) {
            const bf16x8 x0 = *(const bf16x8*)(ap0 + k0), x1 = *(const bf16x8*)(ap1 + k0), x2 = *(const bf16x8*)(ap2 + k0);
#pragma unroll
            for (int n = 0; n < 4; ++n) { const bf16x8 wa = *(const bf16x8*)(bpa[n] + k0), wb = *(const bf16x8*)(bpb[n] + k0);
                a0[n] = __builtin_amdgcn_mfma_f32_16x16x32_bf16(x0, wa, a0[n], 0, 0, 0);
                a1[n] = __builtin_amdgcn_mfma_f32_16x16x32_bf16(x1, wa, a1[n], 0, 0, 0);
                a2[n] = __builtin_amdgcn_mfma_f32_16x16x32_bf16(x2, wa, a2[n], 0, 0, 0);
                bb[n] = __builtin_amdgcn_mfma_f32_16x16x32_bf16(x0, wb, bb[n], 0, 0, 0); }
        }
#pragma unroll
        for (int i = 0; i < 4; ++i) {
            const int row = rt * 16 + 4 * q4 + i; bool g1, g2; const int p1 = prev_row(row, 1, g1), p2 = prev_row(row, 2, g2);
            const float s0 = 1.0f / sqrtf(rss[row] * (1.0f / D) + EPS);
            const float s1 = g1 ? 1.0f / sqrtf(rss[p1] * (1.0f / D) + EPS) : 0.f, s2 = g2 ? 1.0f / sqrtf(rss[p2] * (1.0f / D) + EPS) : 0.f;
#pragma unroll
            for (int n = 0; n < 4; ++n) { const int cc = ct * 64 + 16 * n + l15;
                const float ac = cb[cc] + cw[cc] * (a2[n][i] * s2) + cw[DFF + cc] * (a1[n][i] * s1) + cw[2 * DFF + cc] * (a0[n][i] * s0);
                const float bv = bb[n][i] * s0; const float g = ac / (1.0f + __expf(-ac)) * bv;
                G[(size_t)row * DFF + cc] = (bf16_t)f2bf(g); }
        }
    }
}

__device__ __forceinline__ s16x4 vtr(const LAS unsigned char* p) { typedef short v4i16_t __attribute__((ext_vector_type(4)));
    return __builtin_bit_cast(s16x4, __builtin_amdgcn_ds_read_tr16_b64_v4i16((LAS v4i16_t*)p)); }
__device__ __forceinline__ unsigned cvtpk(float lo, float hi) { typedef float f32x2_t __attribute__((ext_vector_type(2))); typedef __bf16 bf16x2_t __attribute__((ext_vector_type(2)));
    f32x2_t v = {lo, hi}; bf16x2_t b = __builtin_convertvector(v, bf16x2_t); return __builtin_bit_cast(unsigned, b); }

struct SrcA { const bf16_t* K; const bf16_t* V; int h, s;
    __device__ __forceinline__ const bf16_t* kptr(int krow, int ch) const { return K + (size_t)krow * 1024 + h * 128 + s * 64 + ch * 8; }
    __device__ __forceinline__ const bf16_t* vptr(int krow, int ch) const { return V + (size_t)krow * 1024 + h * 128 + ch * 8; } };
struct SrcB { const bf16_t* KV; const bf16_t* KR; int h;
    __device__ __forceinline__ const bf16_t* kptr(int krow, int ch) const { return ch < 8 ? KV + (size_t)krow * 2048 + h * 128 + ch * 8 : KR + (size_t)krow * 32 + (ch - 8) * 8; }
    __device__ __forceinline__ const bf16_t* vptr(int krow, int ch) const { return KV + (size_t)krow * 2048 + h * 128 + 64 + ch * 8; } };

template <int DQK, int DV> struct ACfg { static constexpr int KS = DQK * 2 + 16, VS = DV * 2 + 64, KOFF = 0, VOFF = 64 * KS, SCR = VOFF + 64 * VS; };

template <int DQK, int DV, bool META>
__device__ __forceinline__ void attn_tile(const LAS unsigned char* Kt, const LAS unsigned char* Vt, LAS float* scr, const bf16x8 (&qf)[DQK / 16], f32x16 (&o)[DV / 32], float& m, float& lsum, int lane) {
    constexpr int KS = ACfg<DQK, DV>::KS, VS = ACfg<DQK, DV>::VS;
    const int r32 = lane & 31, hi = lane >> 5;
    f32x16 p0, p1;
#pragma unroll
    for (int r = 0; r < 16; ++r) { p0[r] = 0.f; p1[r] = 0.f; }
#pragma unroll
    for (int kk = 0; kk < DQK / 16; ++kk) {
        const bf16x8 k0 = *(const LAS bf16x8*)(Kt + r32 * KS + (16 * kk + 8 * hi) * 2);
        p0 = __builtin_amdgcn_mfma_f32_32x32x16_bf16(k0, qf[kk], p0, 0, 0, 0);
        if (!META) { const bf16x8 k1 = *(const LAS bf16x8*)(Kt + (32 + r32) * KS + (16 * kk + 8 * hi) * 2);
            p1 = __builtin_amdgcn_mfma_f32_32x32x16_bf16(k1, qf[kk], p1, 0, 0, 0); }
        if (kk & 1) __builtin_amdgcn_sched_barrier(0);
    }
    float mx = -INFINITY;
    if (META) {
#pragma unroll
        for (int r = 0; r < 8; ++r) mx = fmaxf(mx, p0[r]);
    } else {
#pragma unroll
        for (int r = 0; r < 16; ++r) mx = fmaxf(mx, fmaxf(p0[r], p1[r]));
    }
    mx = fmaxf(mx, __shfl_xor(mx, 32));
    const float mn = fmaxf(m, mx); const float alpha = __builtin_amdgcn_exp2f(m - mn); m = mn;
    float ps = 0.f;
    if (META) {
#pragma unroll
        for (int r = 0; r < 8; ++r) { p0[r] = __builtin_amdgcn_exp2f(p0[r] - mn); ps += p0[r]; }
    } else {
#pragma unroll
        for (int r = 0; r < 16; ++r) { p0[r] = __builtin_amdgcn_exp2f(p0[r] - mn); p1[r] = __builtin_amdgcn_exp2f(p1[r] - mn); ps += p0[r] + p1[r]; }
    }
    lsum = lsum * alpha + ps;
    if (__any(alpha != 1.0f)) {
        if (hi == 0) scr[r32] = alpha;
        asm volatile("s_waitcnt lgkmcnt(0)" ::: "memory");
#pragma unroll
        for (int r = 0; r < 16; ++r) { const float a = scr[crow(r, hi)];
#pragma unroll
            for (int d0 = 0; d0 < DV / 32; ++d0) o[d0][r] *= a; }
    }
    bf16x8 pa[4];
    { u32x4 w; w.x = cvtpk(p0[0], p0[1]); w.y = cvtpk(p0[2], p0[3]); w.z = cvtpk(p0[4], p0[5]); w.w = cvtpk(p0[6], p0[7]); pa[0] = __builtin_bit_cast(bf16x8, w); }
    if (!META) {
        { u32x4 w; w.x = cvtpk(p0[8], p0[9]); w.y = cvtpk(p0[10], p0[11]); w.z = cvtpk(p0[12], p0[13]); w.w = cvtpk(p0[14], p0[15]); pa[1] = __builtin_bit_cast(bf16x8, w); }
        { u32x4 w; w.x = cvtpk(p1[0], p1[1]); w.y = cvtpk(p1[2], p1[3]); w.z = cvtpk(p1[4], p1[5]); w.w = cvtpk(p1[6], p1[7]); pa[2] = __builtin_bit_cast(bf16x8, w); }
        { u32x4 w; w.x = cvtpk(p1[8], p1[9]); w.y = cvtpk(p1[10], p1[11]); w.z = cvtpk(p1[12], p1[13]); w.w = cvtpk(p1[14], p1[15]); pa[3] = __builtin_bit_cast(bf16x8, w); }
    }
    const LAS unsigned char* vb = Vt + (4 * hi + ((lane & 15) >> 2)) * VS + (16 * ((lane >> 4) & 1) + 4 * (lane & 3)) * 2;
#pragma unroll
    for (int ks = 0; ks < (META ? 1 : 4); ++ks) {
#pragma unroll
        for (int d0 = 0; d0 < DV / 32; ++d0) {
            const s16x4 lo = vtr(vb + (16 * ks) * VS + 64 * d0), hh = vtr(vb + (16 * ks + 8) * VS + 64 * d0);
            const bf16x8 vf = (bf16x8){lo[0], lo[1], lo[2], lo[3], hh[0], hh[1], hh[2], hh[3]};
            o[d0] = __builtin_amdgcn_mfma_f32_32x32x16_bf16(pa[ks], vf, o[d0], 0, 0, 0);
        }
        __builtin_amdgcn_sched_barrier(0);
    }
}

template <int DQK, int DV, class Src>
__device__ __forceinline__ void attn_pass(const Ctx& c, const Src& src, int b, int qb, const bf16x8 (&qf)[DQK / 16], f32x16 (&o)[DV / 32]) {
    typedef ACfg<DQK, DV> C;
    LAS unsigned char* Kt = c.lds + C::KOFF; LAS unsigned char* Vt = c.lds + C::VOFF; LAS float* scr = (LAS float*)(c.lds + C::SCR) + c.wave * 64;
    const int hi = c.lane >> 5, r32 = c.lane & 31;
    float m = -INFINITY, lsum = 0.f;
#pragma unroll
    for (int d0 = 0; d0 < DV / 32; ++d0)
#pragma unroll
        for (int r = 0; r < 16; ++r) o[d0][r] = 0.f;
    const int NT = qb < 0 ? 0 : 4 * (qb + 1);
    const int myc = qb < 0 ? -1 : 4 * qb + (c.wave >> 1);
    const bool active = qb >= 0 || c.wave == 0;
    for (int jt = -1; jt < NT; ++jt) {
        __syncthreads();
        const int krow0 = jt < 0 ? RR : b * SEQ + 64 * jt;
        const int nk = jt < 0 ? 32 : 64, nv = jt < 0 ? 16 : 64;
        for (int idx = c.tid; idx < nk * (DQK / 8); idx += NTHREADS) { const int key = idx / (DQK / 8), ch = idx % (DQK / 8);
            *(LAS u32x4*)(Kt + key * C::KS + ch * 16) = *(const u32x4*)src.kptr(krow0 + key, ch); }
        for (int idx = c.tid; idx < nv * (DV / 8); idx += NTHREADS) { const int key = idx / (DV / 8), ch = idx % (DV / 8);
            *(LAS u32x4*)(Vt + key * C::VS + ch * 16) = *(const u32x4*)src.vptr(krow0 + key, ch); }
        __syncthreads();
        if (active && jt <= myc) {
            if (jt < 0) attn_tile<DQK, DV, true>(Kt, Vt, scr, qf, o, m, lsum, c.lane);
            else attn_tile<DQK, DV, false>(Kt, Vt, scr, qf, o, m, lsum, c.lane);
        }
    }
    const float lt = lsum + __shfl_xor(lsum, 32);
    if (hi == 0) scr[32 + r32] = 1.0f / lt;
    asm volatile("s_waitcnt lgkmcnt(0)" ::: "memory");
#pragma unroll
    for (int r = 0; r < 16; ++r) { const float a = scr[32 + crow(r, hi)];
#pragma unroll
        for (int d0 = 0; d0 < DV / 32; ++d0) o[d0][r] *= a; }
}

__device__ __forceinline__ void attn_unit_a(const Params& p, const Ctx& c, int b, int h, int qb, float lam) {
    const int q0 = qb < 0 ? RR : b * SEQ + 256 * qb; const int hi = c.lane >> 5, r32 = c.lane & 31;
    bf16_t* Qb = (bf16_t*)(p.ws + WS_Q); bf16_t* O1 = (bf16_t*)(p.ws + WS_OB2);
    const bool active = qb >= 0 || c.wave == 0;
    f32x16 o[4];
#pragma nounroll
    for (int s = 0; s < 2; ++s) {
        const bf16_t* qrow = Qb + (size_t)(q0 + 32 * c.wave + r32) * 1024 + h * 128 + s * 64;
        bf16x8 qf[4];
#pragma unroll
        for (int kk = 0; kk < 4; ++kk) qf[kk] = *(const bf16x8*)(qrow + 16 * kk + 8 * hi);
        SrcA src{(const bf16_t*)(p.ws + WS_K), (const bf16_t*)(p.ws + WS_V), h, s};
        attn_pass<64, 128, SrcA>(c, src, b, qb, qf, o);
        if (s == 0 && active) {
            int rb = q0 + 32 * c.wave; asm volatile("" : "+s"(rb));
#pragma unroll
            for (int r = 0; r < 16; ++r) { bf16_t* orow = O1 + (size_t)(rb + crow(r, hi)) * 1024 + h * 128 + r32;
                orow[0] = (bf16_t)f2bf(o[0][r]); orow[32] = (bf16_t)f2bf(o[1][r]); orow[64] = (bf16_t)f2bf(o[2][r]); orow[96] = (bf16_t)f2bf(o[3][r]); }
        }
    }
    if (!active) return;
    int rb = q0 + 32 * c.wave; asm volatile("" : "+s"(rb));
#pragma unroll
    for (int r = 0; r < 16; ++r) {
        const size_t off = (size_t)(rb + crow(r, hi)) * 1024 + h * 128 + r32;
        const float v0 = bf2f(O1[off]) - lam * o[0][r], v1 = bf2f(O1[off + 32]) - lam * o[1][r], v2 = bf2f(O1[off + 64]) - lam * o[2][r], v3 = bf2f(O1[off + 96]) - lam * o[3][r];
        float ss = v0 * v0 + v1 * v1 + v2 * v2 + v3 * v3;
#pragma unroll
        for (int sh = 1; sh < 32; sh <<= 1) ss += __shfl_xor(ss, sh);
        const float rs = 1.0f / sqrtf(ss * (1.0f / 128.0f) + EPS);
        bf16_t* orow = Qb + off;
        orow[0] = (bf16_t)f2bf(v0 * rs); orow[32] = (bf16_t)f2bf(v1 * rs); orow[64] = (bf16_t)f2bf(v2 * rs); orow[96] = (bf16_t)f2bf(v3 * rs);
        if ((r & 3) == 3) asm volatile("" ::: "memory");
    }
}
__device__ __forceinline__ void ph_attn_a(const Params& p, const Ctx& c) {
    const float d1 = wave_sum(p.in[I_LQ1][c.lane] * p.in[I_LK1][c.lane]), d2 = wave_sum(p.in[I_LQ2][c.lane] * p.in[I_LK2][c.lane]);
    const float lam = expf(d1) - expf(d2) + LAM_INIT;
#pragma nounroll
    for (int pi = c.vcu; pi < 256 + 8; pi += c.G) {
        const int nsub = pi < 256 ? 2 : 1;
#pragma nounroll
        for (int sub = 0; sub < nsub; ++sub) {
            int b, h, qb;
            if (pi < 256) { const int bh = pi >> 2, s = pi & 3; b = bh >> 3; h = bh & 7; qb = sub ? 7 - s : s; } else { b = 0; h = pi - 256; qb = -1; }
            attn_unit_a(p, c, b, h, qb, lam);
        }
    }
}
__device__ __forceinline__ void attn_unit_b(const Params& p, const Ctx& c, int b, int h, int qb) {
    const int q0 = qb < 0 ? RR : b * SEQ + 256 * qb; const int hi = c.lane >> 5, r32 = c.lane & 31;
    const bf16_t* qrow = (const bf16_t*)(p.ws + WS_Q2) + (size_t)(q0 + 32 * c.wave + r32) * 1536 + h * 96;
    bf16x8 qf[6];
#pragma unroll
    for (int kk = 0; kk < 6; ++kk) qf[kk] = *(const bf16x8*)(qrow + 16 * kk + 8 * hi);
    f32x16 o[2];
    SrcB src{(const bf16_t*)(p.ws + WS_KV2), (const bf16_t*)(p.ws + WS_KR), h};
    attn_pass<96, 64, SrcB>(c, src, b, qb, qf, o);
    const bool active = qb >= 0 || c.wave == 0;
    if (!active) return;
    bf16_t* Ob = (bf16_t*)(p.ws + WS_OB2);
    int rb = q0 + 32 * c.wave; asm volatile("" : "+s"(rb));
#pragma unroll
    for (int r = 0; r < 16; ++r) { bf16_t* orow = Ob + (size_t)(rb + crow(r, hi)) * 1024 + h * 64 + r32;
        orow[0] = (bf16_t)f2bf(o[0][r]); orow[32] = (bf16_t)f2bf(o[1][r]); }
}
__device__ __forceinline__ void ph_attn_b(const Params& p, const Ctx& c) {
#pragma nounroll
    for (int pi = c.vcu; pi < 512 + 16; pi += c.G) {
        const int nsub = pi < 512 ? 2 : 1;
#pragma nounroll
        for (int sub = 0; sub < nsub; ++sub) {
            int b, h, qb;
            if (pi < 512) { const int bh = pi >> 2, s = pi & 3; b = bh >> 4; h = bh & 15; qb = sub ? 7 - s : s; } else { b = 0; h = pi - 512; qb = -1; }
            attn_unit_b(p, c, b, h, qb);
        }
    }
}

#ifndef PHMASK
#define PHMASK 0xFFFFFFFFull
#endif
#define PHON(x) ((PHMASK >> (x)) & 1ull)
enum { PH_PROLOGUE = 0, PH_QKV, PH_ROT_A, PH_ATTN_A, PH_WO_A, PH_STAT1, PH_FFNIN_A, PH_FFNOUT_A, PH_STAT2, PH_DPROJ, PH_DPOST, PH_UPROJ, PH_ROT_B,
       PH_ATTN_B, PH_WO_B, PH_STAT3, PH_FFNIN_B, PH_FFNOUT_B, PH_FINAL, PH_COUNT };

__global__ void __launch_bounds__(NTHREADS, 2) fwd_kernel(Params pin) {
    extern __shared__ __attribute__((aligned(16))) unsigned char smem[];
#pragma nounroll
    for (int ph = pin.ph_lo; ph < pin.ph_hi; ++ph) {
        Params p = pin; asm volatile("" : "+s"(p.ws), "+s"(p.out));
        int tid_ = threadIdx.x; asm volatile("" : "+v"(tid_));
        Ctx c; c.lds = (LAS unsigned char*)smem; c.tid = tid_; c.lane = c.tid & 63; c.wave = __builtin_amdgcn_readfirstlane(c.tid >> 6);
        c.G = gridDim.x; { const int bx = blockIdx.x; c.vcu = (c.G % 8 == 0) ? (bx % 8) * (c.G / 8) + bx / 8 : bx; }
        c.gw = c.vcu * NWAVES + c.wave; c.ngw = c.G * NWAVES;
        unsigned char* ws = p.ws;
        const bf16_t* HB = (const bf16_t*)(ws + WS_HB);
        float* hmeta = (float*)(ws + WS_HMETA);
        switch (ph) {
            case PH_PROLOGUE: if (PHON(PH_PROLOGUE))  ph_prologue(p, c); break;
            case PH_QKV: if (PHON(PH_QKV))  { EpiQKV e{rss_ptr(p, 0), (bf16_t*)(ws + WS_Q), (bf16_t*)(ws + WS_K), (bf16_t*)(ws + WS_V)};
                gemm_simple(HB, D, (const bf16_t*)(ws + W_QKV), D, 3072, RV, e, c); break; }
            case PH_ROT_A: if (PHON(PH_ROT_A))  ph_rot_a(p, c); break;
            case PH_ATTN_A: if (PHON(PH_ATTN_A))  ph_attn_a(p, c); break;
            case PH_WO_A: if (PHON(PH_WO_A))  { EpiRes e{p.out, hmeta}; gemm_simple((const bf16_t*)(ws + WS_Q), 1024, (const bf16_t*)(ws + W_OA), 1024, 1024, RV, e, c); break; }
            case PH_STAT1: if (PHON(PH_STAT1))  ph_rowstat(p, c, 1); break;
            case PH_FFNIN_A: if (PHON(PH_FFNIN_A))  ph_ffn_in(p, c, 0, 1); break;
            case PH_FFNOUT_A: if (PHON(PH_FFNOUT_A))  { EpiRes e{p.out, hmeta}; gemm_simple((const bf16_t*)(ws + WS_G), DFF, (const bf16_t*)(ws + W_OUT0), DFF, 1024, RV, e, c); break; }
            case PH_STAT2: if (PHON(PH_STAT2))  ph_rowstat(p, c, 2); break;
            case PH_DPROJ: if (PHON(PH_DPROJ))  { EpiD e{rss_ptr(p, 2), (bf16_t*)(ws + WS_CQ), (bf16_t*)(ws + WS_CKV), (bf16_t*)(ws + WS_KR)};
                gemm_simple(HB, D, (const bf16_t*)(ws + W_D), D, 768, RV, e, c); break; }
            case PH_DPOST: if (PHON(PH_DPOST))  ph_dpost(p, c); break;
            case PH_UPROJ: if (PHON(PH_UPROJ))  { EpiScaled e1{rss_ptr(p, 6), 1.0f / 256.0f, (bf16_t*)(ws + WS_KV2), 2048};
                gemm_simple((const bf16_t*)(ws + WS_CKV), 256, (const bf16_t*)(ws + W_UKV), 256, 2048, RV, e1, c);
                EpiScaled e2{rss_ptr(p, 5), 1.0f / 384.0f, (bf16_t*)(ws + WS_Q2), 1536};
                gemm_simple((const bf16_t*)(ws + WS_CQ), 384, (const bf16_t*)(ws + W_UQ), 384, 1536, RV, e2, c); break; }
            case PH_ROT_B: if (PHON(PH_ROT_B))  ph_rot_b(p, c); break;
            case PH_ATTN_B: if (PHON(PH_ATTN_B))  ph_attn_b(p, c); break;
            case PH_WO_B: if (PHON(PH_WO_B))  { EpiRes e{p.out, hmeta}; gemm_simple((const bf16_t*)(ws + WS_OB2), 1024, (const bf16_t*)(ws + W_OB), 1024, 1024, RV, e, c); break; }
            case PH_STAT3: if (PHON(PH_STAT3))  ph_rowstat(p, c, 3); break;
            case PH_FFNIN_B: if (PHON(PH_FFNIN_B))  ph_ffn_in(p, c, 1, 3); break;
            case PH_FFNOUT_B: if (PHON(PH_FFNOUT_B))  { EpiRes e{p.out, hmeta}; gemm_simple((const bf16_t*)(ws + WS_G), DFF, (const bf16_t*)(ws + W_OUT1), DFF, 1024, RV, e, c); break; }
            case PH_FINAL: if (PHON(PH_FINAL))  ph_final(p, c); break;
            default: break;
        }
        if (ph + 1 < pin.ph_hi) { cg::this_grid().sync(); }
    }
}

extern "C" void kernel_launch(void* const* d_in, const int* in_sizes, int n_in, void* d_out, int out_size, void* d_ws, size_t ws_size, hipStream_t stream) {
    static int grid = 0;
    if (grid == 0) {
        if (n_in != 25 || ws_size < WS_END || out_size != RR * D) { fprintf(stderr, "kernel_launch: unexpected shapes (n_in %d, ws %zu, out %d)\n", n_in, ws_size, out_size); grid = -1; return; }
        int dev = 0, cus = 0, per_cu = 0;
        hipGetDevice(&dev); hipDeviceGetAttribute(&cus, hipDeviceAttributeMultiprocessorCount, dev);
        hipFuncSetAttribute((const void*)fwd_kernel, hipFuncAttributeMaxDynamicSharedMemorySize, LDS_BYTES);
        hipOccupancyMaxActiveBlocksPerMultiprocessor(&per_cu, (const void*)fwd_kernel, NTHREADS, LDS_BYTES);
        if (per_cu < 1) { fprintf(stderr, "kernel_launch: occupancy query says %d blocks per CU\n", per_cu); per_cu = 1; }
        (void)hipGetLastError();
        grid = cus * per_cu;
    }
    if (grid < 0) return;
    Params p{};
    for (int i = 0; i < 25; ++i) p.in[i] = (const float*)d_in[i];
    p.out = (float*)d_out; p.ws = (unsigned char*)d_ws;
    p.ph_lo = 0; p.ph_hi = PH_COUNT;
    void* args[] = {&p};
    hipError_t e = hipLaunchCooperativeKernel((const void*)fwd_kernel, dim3(grid), dim3(NTHREADS), args, LDS_BYTES, stream);
    if (e != hipSuccess) fprintf(stderr, "kernel_launch: cooperative launch failed: %s (grid %d)\n", hipGetErrorString(e), grid);
}
```

```cpp
#include <hip/hip_runtime.h>
#include <hip/hip_cooperative_groups.h>
#include <cstdio>
#include <cstdint>
#include <cmath>
namespace cg = cooperative_groups;

#define LAS __attribute__((address_space(3)))
typedef unsigned short bf16_t;
typedef short bf16x8 __attribute__((ext_vector_type(8)));
typedef short s16x4 __attribute__((ext_vector_type(4)));
typedef float f32x4 __attribute__((ext_vector_type(4)));
typedef float f32x16 __attribute__((ext_vector_type(16)));
typedef unsigned u32x4 __attribute__((ext_vector_type(4)));
typedef unsigned u32x2 __attribute__((ext_vector_type(2)));

constexpr int NB = 8, SEQ = 2048, NMETA = 16, D = 1024, DFF = 2816;
constexpr int RR = NB * SEQ;
constexpr int RV = RR + NMETA;
constexpr int RT = 16640;
constexpr int NWAVES = 8, NTHREADS = 512;
constexpr float EPS = 1e-5f;
constexpr float LOG2E = 1.4426950408889634f;
constexpr float QS_A = 0.125f * LOG2E;
constexpr float QS_B = 0.10206207261596575f * LOG2E;
constexpr float LAM_INIT = 0.2f;

constexpr size_t KiB = 1024, MiB = 1024 * 1024;
constexpr size_t WS_CTL = 0;
constexpr size_t W_QKV = 1 * MiB;
constexpr size_t W_OA = 7 * MiB;
constexpr size_t W_IN0 = 9 * MiB, W_IN1 = 20 * MiB;
constexpr size_t W_OUT0 = 31 * MiB, W_OUT1 = 31 * MiB + 5632 * KiB;
constexpr size_t W_D = 42 * MiB;
constexpr size_t W_UKV = 43 * MiB + 512 * KiB;
constexpr size_t W_UQ = 44 * MiB + 512 * KiB;
constexpr size_t W_OB = 45 * MiB + 640 * KiB;
constexpr size_t WS_HB = 48 * MiB;
constexpr size_t WS_BIG = WS_HB + 33280 * KiB;
constexpr size_t ROWB1024 = (size_t)RT * 1024 * 2;
constexpr size_t WS_Q = WS_BIG, WS_K = WS_BIG + ROWB1024, WS_V = WS_BIG + 2 * ROWB1024;
constexpr size_t WS_G = WS_BIG;
constexpr size_t WS_Q2 = WS_BIG;
constexpr size_t WS_KV2 = WS_BIG + (size_t)RT * 1536 * 2;
constexpr size_t WS_CQ = WS_BIG + 116480 * KiB;
constexpr size_t WS_CKV = WS_CQ + (size_t)RT * 384 * 2;
constexpr size_t WS_KR = WS_CKV + (size_t)RT * 256 * 2;
constexpr size_t WS_OB2 = 216 * MiB;
constexpr size_t WS_HMETA = WS_OB2 + 33280 * KiB;
constexpr size_t WS_RSS = WS_HMETA + 1 * MiB;
constexpr size_t WS_ROPE = WS_RSS + 512 * KiB;
constexpr size_t WS_SA = 251 * MiB;
constexpr size_t WS_SB = WS_SA + (size_t)65 * 4 * 2816 * 4;
constexpr size_t WS_END = 256 * MiB;
static_assert(WS_SB + (size_t)65 * 2 * 2816 * 4 <= WS_END, "ws map");
static_assert(WS_KR + (size_t)RT * 32 * 2 <= WS_OB2, "ws map");
static_assert(WS_KV2 + (size_t)RT * 2048 * 2 <= WS_CQ, "ws map");
static_assert(WS_ROPE + 512 * KiB <= WS_END, "ws map");
static_assert(W_OB + 2 * MiB <= WS_HB, "ws map");

constexpr int LDS_BYTES = 147456;
constexpr int XLDS_OFF = 131072;
#ifndef FAST_MASK
#define FAST_MASK 0x1f
#endif
constexpr bool FAST_QKV = (FAST_MASK >> 0) & 1, FAST_RES = (FAST_MASK >> 1) & 1, FAST_FFN = (FAST_MASK >> 2) & 1, FAST_D = (FAST_MASK >> 3) & 1, FAST_U = (FAST_MASK >> 4) & 1;

struct Params {
    const float* in[25];
    float* out;
    unsigned char* ws;
    int ph_lo, ph_hi;
};
enum { I_X = 0, I_META, I_A_NORM, I_A_WQKV, I_LQ1, I_LK1, I_LQ2, I_LK2, I_A_SUB, I_A_WO, I_KV_NORM, I_KV_WDKV, I_KV_ANORM, I_KV_WUKV,
       I_B_NORM, I_B_WDQ, I_B_QANORM, I_B_WUQ, I_B_WO, I_FFN_NORM, I_FFN_WIN, I_FFN_CW, I_FFN_CB, I_FFN_WOUT, I_FINAL };

struct Ctx { int tid, lane, wave, gw, ngw, vcu, G; LAS unsigned char* lds; };

__device__ __forceinline__ unsigned f2bf(float f) { unsigned u = __builtin_bit_cast(unsigned, f); return (u + 0x7fffu + ((u >> 16) & 1u)) >> 16; }
__device__ __forceinline__ unsigned pk2(float lo, float hi) { return f2bf(lo) | (f2bf(hi) << 16); }
__device__ __forceinline__ float bf2f(bf16_t b) { return __builtin_bit_cast(float, (unsigned)b << 16); }
__device__ __forceinline__ float wave_sum(float v) {
#pragma unroll
    for (int o = 1; o < 64; o <<= 1) v += __shfl_xor(v, o);
    return v;
}
__device__ __forceinline__ int row_pos(int r) { return r < RR ? NMETA + (r & (SEQ - 1)) : r - RR; }
__device__ __forceinline__ float* hrow(const Params& p, int r) { return r < RR ? p.out + (size_t)r * D : (float*)(p.ws + WS_HMETA) + (size_t)(r - RR) * D; }
__device__ __forceinline__ float* rss_ptr(const Params& p, int site) { return (float*)(p.ws + WS_RSS) + (size_t)site * RT; }
__device__ __forceinline__ int crow(int r, int hi) { return (r & 3) + 8 * (r >> 2) + 4 * hi; }

struct WSrc { const float* W; int pitch; int col0; const float* gain; int gmask; float scale; };
__device__ __forceinline__ void wdims(int id, int& N, int& K, size_t& off) {
    switch (id) {
        case 0: N = 3072; K = 1024; off = W_QKV; break;
        case 1: N = 1024; K = 1024; off = W_OA; break;
        case 2: N = 5632; K = 1024; off = W_IN0; break;
        case 3: N = 5632; K = 1024; off = W_IN1; break;
        case 4: N = 1024; K = 2816; off = W_OUT0; break;
        case 5: N = 1024; K = 2816; off = W_OUT1; break;
        case 6: N = 768; K = 1024; off = W_D; break;
        case 7: N = 2048; K = 256; off = W_UKV; break;
        case 8: N = 1536; K = 384; off = W_UQ; break;
        default: N = 1024; K = 1024; off = W_OB; break;
    }
}
__device__ __forceinline__ WSrc wsrc(const Params& p, int id, int n0) {
    WSrc s; s.gain = nullptr; s.gmask = 0; s.scale = 1.f; s.W = nullptr; s.pitch = 0; s.col0 = 0;
    switch (id) {
        case 0: s.W = p.in[I_A_WQKV]; s.pitch = 3072; s.col0 = n0; s.gain = p.in[I_A_NORM]; s.gmask = 1023; s.scale = n0 < 1024 ? QS_A : 1.f; break;
        case 1: s.W = p.in[I_A_WO]; s.pitch = 1024; s.col0 = n0; s.gain = p.in[I_A_SUB]; s.gmask = 127; s.scale = 1.f - LAM_INIT; break;
        case 2: case 3: { const int l = id - 2; s.W = p.in[I_FFN_WIN] + (size_t)l * 1024 * 5632; s.pitch = 5632; const int j = n0 >> 8, u = n0 & 255;
            s.col0 = u < 128 ? 128 * j + u : DFF + 128 * j + (u - 128); s.gain = p.in[I_FFN_NORM] + l * 1024; s.gmask = 1023; break; }
        case 4: case 5: { const int l = id - 4; s.W = p.in[I_FFN_WOUT] + (size_t)l * DFF * 1024; s.pitch = 1024; s.col0 = n0; break; }
        case 6: if (n0 < 384) { s.W = p.in[I_B_WDQ]; s.pitch = 384; s.col0 = n0; s.gain = p.in[I_B_NORM]; s.gmask = 1023; }
                else if (n0 < 672) { s.W = p.in[I_KV_WDKV]; s.pitch = 288; s.col0 = n0 - 384; s.gain = p.in[I_KV_NORM]; s.gmask = 1023; }
                break;
        case 7: s.W = p.in[I_KV_WUKV]; s.pitch = 2048; s.col0 = n0; s.gain = p.in[I_KV_ANORM]; s.gmask = 255; break;
        case 8: s.W = p.in[I_B_WUQ]; s.pitch = 1536; s.col0 = n0; s.gain = p.in[I_B_QANORM]; s.gmask = 511; s.scale = QS_B; break;
        default: s.W = p.in[I_B_WO]; s.pitch = 1024; s.col0 = n0; break;
    }
    return s;
}
__device__ __forceinline__ void transpose_item(const WSrc& s, int K, bf16_t* WT, int k0, int n0, LAS float* scr, int lane) {
    if (s.W) {
#pragma unroll 8
        for (int i = 0; i < 32; ++i) { const int kk = 2 * i + (lane >> 5); float g = s.scale; if (s.gain) g *= s.gain[(k0 + kk) & s.gmask];
            scr[kk * 33 + (lane & 31)] = s.W[(size_t)(k0 + kk) * s.pitch + s.col0 + (lane & 31)] * g; }
    } else {
#pragma unroll 8
        for (int i = 0; i < 32; ++i) { const int kk = 2 * i + (lane >> 5); scr[kk * 33 + (lane & 31)] = 0.f; }
    }
    asm volatile("s_waitcnt lgkmcnt(0)" ::: "memory");
    const int c = lane & 7;
#pragma unroll
    for (int j = 0; j < 4; ++j) { const int n = (lane >> 3) + 8 * j; const LAS float* q = scr + (8 * c) * 33 + n;
        u32x4 o; o.x = pk2(q[0 * 33], q[1 * 33]); o.y = pk2(q[2 * 33], q[3 * 33]); o.z = pk2(q[4 * 33], q[5 * 33]); o.w = pk2(q[6 * 33], q[7 * 33]);
        *(u32x4*)(WT + (size_t)(n0 + n) * K + k0 + 8 * c) = o; }
    asm volatile("s_waitcnt lgkmcnt(0)" ::: "memory");
}
__device__ __forceinline__ void ph_prologue(const Params& p, const Ctx& c) {
    LAS float* scr = (LAS float*)(c.lds + c.wave * 16384);
    int base = 0;
    for (int id = 0; id < 10; ++id) {
        int N, K; size_t off; wdims(id, N, K, off);
        const int nkb = K / 64, nnb = N / 32, items = nkb * nnb;
        for (int it = ((c.gw - base) % c.ngw + c.ngw) % c.ngw; it < items; it += c.ngw) {
            const int kb = it / nnb, nb = it % nnb; const WSrc s = wsrc(p, id, nb * 32);
            transpose_item(s, K, (bf16_t*)(p.ws + off), kb * 64, nb * 32, scr, c.lane); }
        base += items;
    }
    { float2* TA = (float2*)(p.ws + WS_ROPE); float2* TB = TA + 2064 * 8;
      const int gt = c.gw * 64 + c.lane, ngt = c.ngw * 64;
      for (int i = gt; i < 2064 * 8; i += ngt) { const int pos = i >> 3, k = i & 7; const float inv = 1.0f / powf(500000.0f, (float)k / 8.0f); const float a = (float)pos * inv; TA[i] = make_float2(cosf(a), sinf(a)); }
      for (int i = gt; i < 2064 * 16; i += ngt) { const int pos = i >> 4, k = i & 15; const float inv = 1.0f / powf(10000.0f, (float)k / 16.0f); const float a = (float)pos * inv; TB[i] = make_float2(cosf(a), sinf(a)); } }
    { float* r1 = rss_ptr(p, 1); const int gt = c.gw * 64 + c.lane, ngt = c.ngw * 64; for (int i = gt; i < 6 * RT; i += ngt) r1[i] = 0.f; }
    float* rss0 = rss_ptr(p, 0);
    for (int r = c.gw; r < RT; r += c.ngw) {
        const float* src = r < RR ? p.in[I_X] + (size_t)r * D : (r < RV ? p.in[I_META] + (size_t)(r - RR) * D : nullptr);
        f32x4 v[4]; float ss = 0.f;
#pragma unroll
        for (int j = 0; j < 4; ++j) { v[j] = src ? *(const f32x4*)(src + 4 * c.lane + 256 * j) : (f32x4){0.f, 0.f, 0.f, 0.f}; ss += v[j].x * v[j].x + v[j].y * v[j].y + v[j].z * v[j].z + v[j].w * v[j].w; }
        ss = wave_sum(ss);
        float* h = hrow(p, r); bf16_t* hb = (bf16_t*)(p.ws + WS_HB) + (size_t)r * D;
#pragma unroll
        for (int j = 0; j < 4; ++j) { *(f32x4*)(h + 4 * c.lane + 256 * j) = v[j]; u32x2 w; w.x = pk2(v[j].x, v[j].y); w.y = pk2(v[j].z, v[j].w); *(u32x2*)(hb + 4 * c.lane + 256 * j) = w; }
        if (c.lane == 0) rss0[r] = ss;
    }
}
__device__ __forceinline__ void ph_rowstat(const Params& p, const Ctx& c, int site) {
    float* rss = rss_ptr(p, site);
    for (int r = c.gw; r < RT; r += c.ngw) {
        const float* h = hrow(p, r); f32x4 v[4]; float ss = 0.f;
#pragma unroll
        for (int j = 0; j < 4; ++j) { v[j] = *(const f32x4*)(h + 4 * c.lane + 256 * j); ss += v[j].x * v[j].x + v[j].y * v[j].y + v[j].z * v[j].z + v[j].w * v[j].w; }
        ss = wave_sum(ss);
        bf16_t* hb = (bf16_t*)(p.ws + WS_HB) + (size_t)r * D;
#pragma unroll
        for (int j = 0; j < 4; ++j) { u32x2 w; w.x = pk2(v[j].x, v[j].y); w.y = pk2(v[j].z, v[j].w); *(u32x2*)(hb + 4 * c.lane + 256 * j) = w; }
        if (c.lane == 0) rss[r] = ss;
    }
}
__device__ __forceinline__ void ph_final(const Params& p, const Ctx& c) {
    const float* g = p.in[I_FINAL];
    for (int r = c.gw; r < RR; r += c.ngw) {
        float* h = p.out + (size_t)r * D; f32x4 v[4]; float ss = 0.f;
#pragma unroll
        for (int j = 0; j < 4; ++j) { v[j] = *(const f32x4*)(h + 4 * c.lane + 256 * j); ss += v[j].x * v[j].x + v[j].y * v[j].y + v[j].z * v[j].z + v[j].w * v[j].w; }
        ss = wave_sum(ss); const float rstd = 1.0f / sqrtf(ss * (1.0f / D) + EPS);
#pragma unroll
        for (int j = 0; j < 4; ++j) { const f32x4 gg = *(const f32x4*)(g + 4 * c.lane + 256 * j); *(f32x4*)(h + 4 * c.lane + 256 * j) = v[j] * rstd * gg; }
    }
}

template <class Epi>
__device__ __forceinline__ void gemm_simple(const bf16_t* A, int lda, const bf16_t* Bt, int K, int N, int nrows, const Epi& epi, const Ctx& c) {
    const int nct = N / 64, nrt = (nrows + 31) / 32, items = nrt * nct;
    const int l15 = c.lane & 15, q4 = c.lane >> 4;
    for (int it = c.gw; it < items; it += c.ngw) {
        const int rt = it / nct, ct = it % nct;
        f32x4 acc[2][4];
#pragma unroll
        for (int m = 0; m < 2; ++m)
#pragma unroll
            for (int n = 0; n < 4; ++n) acc[m][n] = (f32x4){0.f, 0.f, 0.f, 0.f};
        const bf16_t* ap = A + (size_t)(rt * 32 + l15) * lda + 8 * q4;
        const bf16_t* bp = Bt + (size_t)(ct * 64 + l15) * K + 8 * q4;
        for (int k0 = 0; k0 < K; k0 += 32) {
            bf16x8 a[2], b[4];
#pragma unroll
            for (int m = 0; m < 2; ++m) a[m] = *(const bf16x8*)(ap + (size_t)(16 * m) * lda + k0);
#pragma unroll
            for (int n = 0; n < 4; ++n) b[n] = *(const bf16x8*)(bp + (size_t)(16 * n) * K + k0);
#pragma unroll
            for (int m = 0; m < 2; ++m)
#pragma unroll
                for (int n = 0; n < 4; ++n) acc[m][n] = __builtin_amdgcn_mfma_f32_16x16x32_bf16(a[m], b[n], acc[m][n], 0, 0, 0);
        }
#pragma unroll
        for (int m = 0; m < 2; ++m)
#pragma unroll
            for (int n = 0; n < 4; ++n)
#pragma unroll
                for (int i = 0; i < 4; ++i) epi(rt * 32 + 16 * m + 4 * q4 + i, ct * 64 + 16 * n + l15, acc[m][n][i]);
    }
}
struct EpiQKV { const float* rss; bf16_t* Q; bf16_t* K; bf16_t* V;
    __device__ __forceinline__ void operator()(int row, int col, float v) const { v *= 1.0f / sqrtf(rss[row] * (1.0f / D) + EPS);
        Q[(size_t)(col >> 10) * (ROWB1024 / 2) + (size_t)row * 1024 + (col & 1023)] = (bf16_t)f2bf(v); } };
struct EpiRes { float* out; float* hmeta;
    __device__ __forceinline__ void operator()(int row, int col, float v) const { float* h = row < RR ? out + (size_t)row * D : hmeta + (size_t)(row - RR) * D; h[col] += v; } };
struct EpiD { const float* rss; bf16_t* CQ; bf16_t* CKV; bf16_t* KR;
    __device__ __forceinline__ void operator()(int row, int col, float v) const { v *= 1.0f / sqrtf(rss[row] * (1.0f / D) + EPS); const bf16_t b = (bf16_t)f2bf(v);
        if (col < 384) CQ[(size_t)row * 384 + col] = b; else if (col < 640) CKV[(size_t)row * 256 + col - 384] = b; else if (col < 672) KR[(size_t)row * 32 + col - 640] = b; } };
struct EpiScaled { const float* rss; float invk; bf16_t* O; int ldo;
    __device__ __forceinline__ void operator()(int row, int col, float v) const { v *= 1.0f / sqrtf(rss[row] * invk + EPS); O[(size_t)row * ldo + col] = (bf16_t)f2bf(v); } };

namespace pg8 {
#define PG8_LAS __attribute__((address_space(3)))
typedef unsigned short bf16_t;
typedef short bf16x8 __attribute__((ext_vector_type(8)));
typedef float f32x4 __attribute__((ext_vector_type(4)));
typedef unsigned u32x4 __attribute__((ext_vector_type(4)));
constexpr int BM = 256, BK = 64, HALF = 128, HTB = HALF * BK * 2  , STAGE_BYTES = 8 * HTB, NXCD = 8, WGM = 8;

__host__ __device__ __forceinline__ int lds_byte(int r, int c) { const int st = (r >> 4) * 2 + (c >> 5), rr = r & 15, cc = c & 31, ob = rr * 64 + cc * 2; return st * 1024 + (ob ^ (((ob >> 9) & 1) << 5)); }
__host__ __device__ __forceinline__ void stage_rc(int b, int& R, int& C) { const int st = b / 1024, sb = b % 1024, swz = sb ^ (((sb >> 9) & 1) << 5); R = (st >> 1) * 16 + swz / 64; C = (st & 1) * 32 + (swz % 64) / 2; }
__host__ __device__ __forceinline__ int perm32(int rho) { const int n = rho >> 4, i = rho & 15; return 8 * (i >> 2) + 4 * n + (i & 3); }

struct Unit { int pm, pn; };
struct Gemm { const bf16_t* A; const bf16_t* Bt; int M, N, K; };

struct StaticOrder {
    int nM, nN, nwg, G, c;
    __host__ __device__ void init(int M, int N, int G_, int c_) { nM = M / BM; nN = N / BM; nwg = nM * nN; G = G_; c = c_; }
    __host__ __device__ bool next(int i, Unit& u) const {
        const long L = (long)i * G + c; if (L >= nwg) return false;
        int wgid = (int)L; { const int q = nwg / NXCD, r = nwg % NXCD, xcd = wgid % NXCD, off = wgid / NXCD; wgid = (xcd < r ? xcd * (q + 1) : r * (q + 1) + (xcd - r) * q) + off; }
        const int nig = WGM * nN, gid = wgid / nig, fm = gid * WGM, gsz = (nM - fm) < WGM ? (nM - fm) : WGM;
        u.pm = fm + ((wgid % nig) % gsz); u.pn = (wgid % nig) / gsz; return true;
    }
    __device__ __forceinline__ void a_ready(const Unit&) const {}
    __device__ __forceinline__ void done(const Unit&) const {}
};
template <class Epi, class Sched, bool ALIGN_EPI = false, bool SP2 = false>
__device__ __forceinline__ void gemm_phase(PG8_LAS unsigned char* lds, const Gemm g, const Sched& S, const Epi& E, const int tid_in) {
    const int tid = tid_in, wid = __builtin_amdgcn_readfirstlane(tid >> 6), lane = tid & 63, wr = wid >> 2, wc = wid & 3, fr = lane & 15, fq = lane >> 4;
    const int K = g.K, nt = K / BK;
    unsigned voffA[2], voffB[2];
#pragma unroll
    for (int i = 0; i < 2; ++i) { int R, C; stage_rc(tid * 16 + i * 8192, R, C); const int Rb = Epi::PERM ? ((R & ~31) + perm32(R & 31)) : R;
        voffA[i] = (unsigned)(R * K + C) * 2u; voffB[i] = (unsigned)(Rb * K + C) * 2u; }
    const size_t kstep = (size_t)(BK * 2);
    const size_t hstep = (size_t)HALF * K * 2;
    const size_t tstep = 2 * hstep;
    const unsigned ldsw = (unsigned)wid * 1024u;
    const int aoff = lds_byte(wr * 64 + fr, fq * 8), boff = lds_byte(wc * 32 + fr, fq * 8);
#define PG8_SA(b, h) (((b) * 2 + (h)) * HTB)
#define PG8_SB(b, h) ((4 + (b) * 2 + (h)) * HTB)
#define PG8_STAGE(bufoff, gbase, voff) do { _Pragma("unroll") for (int _i = 0; _i < 2; ++_i) \
        __builtin_amdgcn_global_load_lds((const unsigned*)((const char*)(gbase) + (voff)[_i]), (PG8_LAS unsigned*)(lds + (bufoff) + ldsw + _i * 8192), 16, 0, 0); } while (0)
#define PG8_LDA(dst, b, h) do { _Pragma("unroll") for (int m = 0; m < 4; ++m) _Pragma("unroll") for (int k = 0; k < 2; ++k) dst[m][k] = *(const PG8_LAS bf16x8*)(lds + PG8_SA(b, h) + aoff + m * 2048 + k * 1024); } while (0)
#define PG8_LDB(dst, b, h) do { _Pragma("unroll") for (int n = 0; n < 2; ++n) _Pragma("unroll") for (int k = 0; k < 2; ++k) dst[n][k] = *(const PG8_LAS bf16x8*)(lds + PG8_SB(b, h) + boff + n * 2048 + k * 1024); } while (0)
#define PG8_MMA(ai, bj, At, Bt) do { __builtin_amdgcn_s_setprio(1); _Pragma("unroll") for (int m = 0; m < 4; ++m) _Pragma("unroll") for (int n = 0; n < 2; ++n) _Pragma("unroll") for (int k = 0; k < 2; ++k) \
        acc[ai][bj][m][n] = __builtin_amdgcn_mfma_f32_16x16x32_bf16(Bt[n][k], At[m][k], acc[ai][bj][m][n], 0, 0, 0); __builtin_amdgcn_s_setprio(0); } while (0)
#define PG8_WAIT_V(n) asm volatile("s_waitcnt vmcnt(" #n ")" ::: "memory")
#define PG8_WAIT_L(n) asm volatile("s_waitcnt lgkmcnt(" #n ")" ::: "memory")
#define PG8_BAR __builtin_amdgcn_s_barrier()
#define PG8_SCHED __builtin_amdgcn_sched_barrier(0)
    Unit cur, nxt; int ui = 0;
    if (!S.next(0, cur)) return;
    f32x4 acc[2][2][4][2];
#pragma unroll
    for (int a = 0; a < 2; ++a)
#pragma unroll
        for (int b = 0; b < 2; ++b)
#pragma unroll
            for (int m = 0; m < 4; ++m)
#pragma unroll
                for (int n = 0; n < 2; ++n) acc[a][b][m][n] = (f32x4){0.f, 0.f, 0.f, 0.f};
    bf16x8 At[4][2], B0[2][2], B1[2][2];
    const char* cA = (const char*)g.A + (size_t)cur.pm * tstep; const char* cB = (const char*)g.Bt + (size_t)cur.pn * tstep;
    S.a_ready(cur);
    if constexpr (SP2) {
        PG8_STAGE(PG8_SB(0, 0), cB, voffB); PG8_STAGE(PG8_SB(0, 1), cB + hstep, voffB); PG8_STAGE(PG8_SA(0, 0), cA, voffA); PG8_STAGE(PG8_SA(0, 1), cA + hstep, voffA);
        if (wr == 1) PG8_BAR;
        PG8_WAIT_V(2); PG8_BAR;
        PG8_STAGE(PG8_SB(1, 0), cB + kstep, voffB); PG8_STAGE(PG8_SA(1, 0), cA + kstep, voffA); PG8_STAGE(PG8_SB(1, 1), cB + hstep + kstep, voffB);
        PG8_WAIT_V(6); PG8_BAR;
    } else {
        PG8_STAGE(PG8_SB(0, 0), cB, voffB); PG8_STAGE(PG8_SA(0, 0), cA, voffA); PG8_STAGE(PG8_SB(0, 1), cB + hstep, voffB); PG8_STAGE(PG8_SA(0, 1), cA + hstep, voffA);
        if (wr == 1) PG8_BAR;
        PG8_WAIT_V(4); PG8_BAR;
        PG8_STAGE(PG8_SB(1, 0), cB + kstep, voffB); PG8_STAGE(PG8_SA(1, 0), cA + kstep, voffA); PG8_STAGE(PG8_SB(1, 1), cB + hstep + kstep, voffB);
        PG8_WAIT_V(6); PG8_BAR;
    }
    for (;;) {
        const bool has_next = S.next(ui + 1, nxt);
        const char* nA = has_next ? (const char*)g.A + (size_t)nxt.pm * tstep : cA; const char* nB = has_next ? (const char*)g.Bt + (size_t)nxt.pn * tstep : cB;
        for (int t = 0; t < nt; t += 2) {
            const bool last = (t == nt - 2);
            const char* a1 = cA + (size_t)(t + 1) * kstep;
            const char* a2 = last ? nA : cA + (size_t)(t + 2) * kstep; const char* b2 = last ? nB : cB + (size_t)(t + 2) * kstep;
            const char* a3 = a2 + kstep; const char* b3 = b2 + kstep;
            if (last && has_next) S.a_ready(nxt);
            if constexpr (SP2) {
            PG8_LDB(B0, 0, 0); PG8_LDB(B1, 0, 1); PG8_SCHED; PG8_LDA(At, 0, 0); PG8_STAGE(PG8_SA(1, 1), a1 + hstep, voffA);
            PG8_WAIT_V(8); PG8_WAIT_L(0); PG8_BAR; PG8_MMA(0, 0, At, B0); PG8_MMA(0, 1, At, B1); PG8_BAR; PG8_SCHED;
            PG8_LDA(At, 0, 1); PG8_STAGE(PG8_SB(0, 0), b2, voffB); PG8_STAGE(PG8_SB(0, 1), b2 + hstep, voffB); PG8_STAGE(PG8_SA(0, 0), a2, voffA);
            PG8_WAIT_V(8); PG8_WAIT_L(0); PG8_BAR; PG8_MMA(1, 0, At, B0); PG8_MMA(1, 1, At, B1); PG8_BAR; PG8_SCHED;
            PG8_LDB(B0, 1, 0); PG8_LDB(B1, 1, 1); PG8_SCHED; PG8_LDA(At, 1, 0); PG8_STAGE(PG8_SA(0, 1), a2 + hstep, voffA);
            PG8_WAIT_V(8); PG8_WAIT_L(0); PG8_BAR; PG8_MMA(0, 0, At, B0); PG8_MMA(0, 1, At, B1); PG8_BAR; PG8_SCHED;
            PG8_LDA(At, 1, 1); PG8_STAGE(PG8_SB(1, 0), b3, voffB); PG8_STAGE(PG8_SB(1, 1), b3 + hstep, voffB); PG8_STAGE(PG8_SA(1, 0), a3, voffA);
            PG8_WAIT_V(8); PG8_WAIT_L(0); PG8_BAR; PG8_MMA(1, 0, At, B0); PG8_MMA(1, 1, At, B1); PG8_BAR; PG8_SCHED;
            } else {
            PG8_LDB(B0, 0, 0); PG8_SCHED; PG8_LDA(At, 0, 0); PG8_STAGE(PG8_SA(1, 1), a1 + hstep, voffA);
            PG8_WAIT_L(8); PG8_BAR; PG8_WAIT_L(0); PG8_MMA(0, 0, At, B0); PG8_BAR; PG8_SCHED;
            PG8_LDB(B1, 0, 1); PG8_STAGE(PG8_SB(0, 0), b2, voffB);
            PG8_BAR; PG8_WAIT_L(0); PG8_MMA(0, 1, At, B1); PG8_BAR;
            PG8_LDA(At, 0, 1); PG8_STAGE(PG8_SA(0, 0), a2, voffA);
            PG8_BAR; PG8_WAIT_L(0); PG8_MMA(1, 0, At, B0); PG8_BAR; PG8_SCHED;
            PG8_STAGE(PG8_SB(0, 1), b2 + hstep, voffB);
            PG8_WAIT_V(6); PG8_BAR; PG8_MMA(1, 1, At, B1); PG8_BAR;
            PG8_LDB(B0, 1, 0); PG8_SCHED; PG8_LDA(At, 1, 0); PG8_STAGE(PG8_SA(0, 1), a2 + hstep, voffA);
            PG8_WAIT_L(8); PG8_BAR; PG8_WAIT_L(0); PG8_MMA(0, 0, At, B0); PG8_BAR; PG8_SCHED;
            PG8_LDB(B1, 1, 1); PG8_STAGE(PG8_SB(1, 0), b3, voffB);
            PG8_BAR; PG8_WAIT_L(0); PG8_MMA(0, 1, At, B1); PG8_BAR;
            PG8_LDA(At, 1, 1); PG8_STAGE(PG8_SA(1, 0), a3, voffA);
            PG8_BAR; PG8_WAIT_L(0); PG8_MMA(1, 0, At, B0); PG8_BAR; PG8_SCHED;
            PG8_STAGE(PG8_SB(1, 1), b3 + hstep, voffB);
            PG8_WAIT_V(6); PG8_BAR; PG8_MMA(1, 1, At, B1); PG8_BAR;
            }
        }
        if constexpr (ALIGN_EPI) { if (wr == 0) PG8_BAR; }
        if constexpr (!Epi::AFTER_DRAIN) { E(acc, cur, wr, wc, fr, fq); S.done(cur); }
        if (!has_next) break;
#pragma unroll
        for (int a = 0; a < 2; ++a)
#pragma unroll
            for (int b = 0; b < 2; ++b)
#pragma unroll
                for (int m = 0; m < 4; ++m)
#pragma unroll
                    for (int n = 0; n < 2; ++n) acc[a][b][m][n] = (f32x4){0.f, 0.f, 0.f, 0.f};
        cur = nxt; cA = nA; cB = nB; ++ui;
        if constexpr (ALIGN_EPI) { if (wr == 1) PG8_BAR; }
    }
    PG8_WAIT_V(0);
    if constexpr (!ALIGN_EPI) { if (wr == 0) PG8_BAR; }
    PG8_BAR;
    if constexpr (Epi::AFTER_DRAIN) { E.fused(acc, cur, wr, wc, fr, fq, lds, wid, lane); S.done(cur); }
#undef PG8_SA
#undef PG8_SB
#undef PG8_STAGE
#undef PG8_LDA
#undef PG8_LDB
#undef PG8_MMA
#undef PG8_WAIT_V
#undef PG8_WAIT_L
#undef PG8_BAR
#undef PG8_SCHED
}

__device__ __forceinline__ unsigned cvt2(float lo, float hi) { typedef float f32x2_t __attribute__((ext_vector_type(2))); typedef __bf16 bf16x2_t __attribute__((ext_vector_type(2)));
    f32x2_t v = {lo, hi}; bf16x2_t b = __builtin_convertvector(v, bf16x2_t); return __builtin_bit_cast(unsigned, b); }
__device__ __forceinline__ u32x4 pack8(const f32x4& v0, const f32x4& v1) { u32x4 w; w.x = cvt2(v0[0], v0[1]); w.y = cvt2(v0[2], v0[3]); w.z = cvt2(v1[0], v1[1]); w.w = cvt2(v1[2], v1[3]); return w; }
__device__ __forceinline__ float rstdf(const float* rss, int row, float invk) { return 1.0f / sqrtf(rss[row] * invk + EPS); }

struct FEpiQKV {
    static constexpr bool PERM = true, AFTER_DRAIN = false;
    const float* rss; bf16_t* Q; const float* TA;
    __device__ __forceinline__ void operator()(const f32x4 (&acc)[2][2][4][2], const Unit& u, int wr, int wc, int fr_, int fq_) const {
        (void)fr_; (void)fq_; int lane_e; asm volatile("v_mbcnt_lo_u32_b32 %0, -1, 0\n\tv_mbcnt_hi_u32_b32 %0, -1, %0" : "=v"(lane_e));
        const int fr = lane_e & 15, fq = lane_e >> 4;
        const int colt = u.pn * BM, t = colt >> 10;
        bf16_t* base = Q + (size_t)t * (ROWB1024 / 2) + (colt & 1023) + wc * 32 + 8 * fq;
        const bool rot = (t < 2) && ((wc & 1) == 0);
        const float sgn = fq == 0 ? -1.f : 1.f; const bool mine = fq < 2;
#pragma unroll
        for (int ai = 0; ai < 2; ++ai)
#pragma unroll
            for (int m = 0; m < 4; ++m) {
                const int row = u.pm * BM + ai * HALF + wr * 64 + m * 16 + fr;
                const float rs = rstdf(rss, row, 1.0f / 1024.0f);
                f32x4 cs[4];
                if (rot) { const f32x4* tp = (const f32x4*)(TA + (size_t)row_pos(row) * 16);
#pragma unroll
                    for (int k = 0; k < 4; ++k) cs[k] = tp[k]; }
#pragma unroll
                for (int bj = 0; bj < 2; ++bj) {
                    f32x4 v0 = acc[ai][bj][m][0] * rs, v1 = acc[ai][bj][m][1] * rs;
                    if (rot) {
                        f32x4 r0, r1;
#pragma unroll
                        for (int e = 0; e < 4; ++e) { const float o0 = __shfl_xor(v0[e], 16), o1 = __shfl_xor(v1[e], 16);
                            r0[e] = v0[e] * cs[e >> 1][(e & 1) * 2] + sgn * o0 * cs[e >> 1][(e & 1) * 2 + 1];
                            r1[e] = v1[e] * cs[2 + (e >> 1)][(e & 1) * 2] + sgn * o1 * cs[2 + (e >> 1)][(e & 1) * 2 + 1]; }
                        if (mine) { v0 = r0; v1 = r1; }
                    }
                    *(u32x4*)(base + (size_t)row * 1024 + bj * HALF) = pack8(v0, v1);
                }
            }
    }
};
struct FEpiRes {
    static constexpr bool PERM = true, AFTER_DRAIN = false;
    float* out; float* hmeta; bf16_t* HB; float* rss;
    __device__ __forceinline__ void operator()(const f32x4 (&acc)[2][2][4][2], const Unit& u, int wr, int wc, int fr_, int fq_) const {
        (void)fr_; (void)fq_; int lane_e; asm volatile("v_mbcnt_lo_u32_b32 %0, -1, 0\n\tv_mbcnt_hi_u32_b32 %0, -1, %0" : "=v"(lane_e));
        const int fr = lane_e & 15, fq = lane_e >> 4;
        float* hb_ = u.pm < 64 ? out + (size_t)u.pm * BM * 1024 : hmeta;
        const int col0 = u.pn * BM + wc * 32 + 8 * fq;
#pragma unroll
        for (int ai = 0; ai < 2; ++ai)
#pragma unroll
            for (int m = 0; m < 4; ++m) {
                const int rl = ai * HALF + wr * 64 + m * 16 + fr, row = u.pm * BM + rl; float* hp = hb_ + (size_t)rl * 1024 + col0;
                float ss = 0.f;
#pragma unroll
                for (int bj = 0; bj < 2; ++bj) {
                    const f32x4 h0 = *(const f32x4*)(hp + bj * HALF) + acc[ai][bj][m][0], h1 = *(const f32x4*)(hp + bj * HALF + 4) + acc[ai][bj][m][1];
                    *(f32x4*)(hp + bj * HALF) = h0; *(f32x4*)(hp + bj * HALF + 4) = h1;
                    ss += (h0[0] * h0[0] + h0[1] * h0[1]) + (h0[2] * h0[2] + h0[3] * h0[3]) + (h1[0] * h1[0] + h1[1] * h1[1]) + (h1[2] * h1[2] + h1[3] * h1[3]);
                    if (HB) *(u32x4*)(HB + (size_t)row * 1024 + col0 + bj * HALF) = pack8(h0, h1);
                    asm volatile("" ::: "memory");
                }
                ss += __shfl_xor(ss, 16); ss += __shfl_xor(ss, 32);
                if (fq == 0) atomicAdd(rss + row, ss);
                asm volatile("" ::: "memory");
            }
    }
};
struct FEpiFFN {
    static constexpr bool PERM = true, AFTER_DRAIN = false;
    const float* rss; const float* cw; const float* cb; bf16_t* G; float* SA; float* SB; PG8_LAS float* X;
    __device__ __forceinline__ void operator()(const f32x4 (&acc)[2][2][4][2], const Unit& u, int wr, int wc, int fr_, int fq_) const {
        (void)fr_; (void)fq_; int lane_e; asm volatile("v_mbcnt_lo_u32_b32 %0, -1, 0\n\tv_mbcnt_hi_u32_b32 %0, -1, %0" : "=v"(lane_e));
        const int fr = lane_e & 15, fq = lane_e >> 4;
        const int lane = fr + 16 * fq;
        const int cc0 = u.pn * HALF + wc * 32 + 8 * fq;
        f32x4 w0[2], w1[2], w2[2], bs[2];
#pragma unroll
        for (int n = 0; n < 2; ++n) { w0[n] = *(const f32x4*)(cw + cc0 + 4 * n); w1[n] = *(const f32x4*)(cw + DFF + cc0 + 4 * n); w2[n] = *(const f32x4*)(cw + 2 * DFF + cc0 + 4 * n); bs[n] = *(const f32x4*)(cb + cc0 + 4 * n); }
        float rsl[2];
#pragma unroll
        for (int ai = 0; ai < 2; ++ai) { const int row = u.pm * BM + ai * HALF + wr * 64 + 48 + fr; rsl[ai] = rstdf(rss, row, 1.0f / 1024.0f);
            if (fr >= 14) { PG8_LAS float* xp = X + (((2 * ai + wr) * 4 + wc) * 2 + (fr - 14)) * 32 + 8 * fq;
                *(PG8_LAS f32x4*)xp = acc[ai][0][3][0] * rsl[ai]; *(PG8_LAS f32x4*)(xp + 4) = acc[ai][0][3][1] * rsl[ai]; } }
        asm volatile("s_waitcnt lgkmcnt(0)" ::: "memory"); __builtin_amdgcn_s_barrier(); asm volatile("" ::: "memory");
        const int src1 = (lane & 48) | ((fr - 1) & 15), src2 = (lane & 48) | ((fr - 2) & 15);
#pragma unroll
        for (int ai = 0; ai < 2; ++ai) {
            const int strip = 2 * ai + wr;
            f32x4 pa[2] = {(f32x4){0.f, 0.f, 0.f, 0.f}, (f32x4){0.f, 0.f, 0.f, 0.f}};
#pragma unroll
            for (int m = 0; m < 4; ++m) {
                const int rl = ai * HALF + wr * 64 + m * 16 + fr, row = u.pm * BM + rl;
                const float rs = rstdf(rss, row, 1.0f / 1024.0f);
                f32x4 a[2], b[2], p1[2], p2[2];
#pragma unroll
                for (int n = 0; n < 2; ++n) { a[n] = acc[ai][0][m][n] * rs; b[n] = acc[ai][1][m][n] * rs; }
#pragma unroll
                for (int n = 0; n < 2; ++n)
#pragma unroll
                    for (int e = 0; e < 4; ++e) { const float s1 = (m > 0 && fr == 15) ? pa[n][e] : a[n][e], s2 = (m > 0 && fr >= 14) ? pa[n][e] : a[n][e];
                        p1[n][e] = __shfl(s1, src1); p2[n][e] = __shfl(s2, src2); }
                if (m == 0 && strip > 0) {
                    const PG8_LAS float* xp = X + (((strip - 1) * 4 + wc) * 2) * 32 + 8 * fq;
#pragma unroll
                    for (int n = 0; n < 2; ++n) { const f32x4 h62 = *(const PG8_LAS f32x4*)(xp + 4 * n), h63 = *(const PG8_LAS f32x4*)(xp + 32 + 4 * n);
                        if (fr == 0) { p1[n] = h63; p2[n] = h62; } else if (fr == 1) { p2[n] = h63; } }
                }
                f32x4 g[2];
#pragma unroll
                for (int n = 0; n < 2; ++n)
#pragma unroll
                    for (int e = 0; e < 4; ++e) { const float ac = bs[n][e] + w0[n][e] * p2[n][e] + w1[n][e] * p1[n][e] + w2[n][e] * a[n][e];
                        g[n][e] = ac * __builtin_amdgcn_rcpf(1.0f + __builtin_amdgcn_exp2f(-LOG2E * ac)) * b[n][e]; }
                const bool head = (strip == 0 && m == 0 && fr < 2);
                if (!head) *(u32x4*)(G + (size_t)row * DFF + cc0) = pack8(g[0], g[1]);
                else { float* sa = SA + ((size_t)u.pm * 4 + fr) * DFF + cc0; float* sb = SB + ((size_t)u.pm * 2 + fr) * DFF + cc0;
                    *(f32x4*)sa = a[0]; *(f32x4*)(sa + 4) = a[1]; *(f32x4*)sb = b[0]; *(f32x4*)(sb + 4) = b[1]; }
                const bool tail = (u.pm < 64) ? (strip == 3 && m == 3 && fr >= 14) : (strip == 0 && m == 0 && fr >= 14);
                if (tail) { float* sa = SA + ((size_t)u.pm * 4 + 2 + (fr - 14)) * DFF + cc0; *(f32x4*)sa = a[0]; *(f32x4*)(sa + 4) = a[1]; }
                pa[0] = a[0]; pa[1] = a[1];
            }
        }
    }
};
__device__ __forceinline__ void rope32(f32x4& v0, f32x4& v1, const float* TB, int pos, int fq) {
    const f32x4* tp = (const f32x4*)(TB + (size_t)pos * 32 + 16 * (fq & 1)); const float sgn = fq < 2 ? -1.f : 1.f;
    f32x4 cs[4];
#pragma unroll
    for (int k = 0; k < 4; ++k) cs[k] = tp[k];
#pragma unroll
    for (int e = 0; e < 4; ++e) { const float o0 = __shfl_xor(v0[e], 32), o1 = __shfl_xor(v1[e], 32);
        v0[e] = v0[e] * cs[e >> 1][(e & 1) * 2] + sgn * o0 * cs[e >> 1][(e & 1) * 2 + 1];
        v1[e] = v1[e] * cs[2 + (e >> 1)][(e & 1) * 2] + sgn * o1 * cs[2 + (e >> 1)][(e & 1) * 2 + 1]; }
}
struct FEpiD {
    static constexpr bool PERM = true, AFTER_DRAIN = false;
    const float* rss; bf16_t* CQ; bf16_t* CKV; bf16_t* KR; float* rssq; float* rsskv; const float* TB;
    __device__ __forceinline__ void operator()(const f32x4 (&acc)[2][2][4][2], const Unit& u, int wr, int wc, int fr_, int fq_) const {
        (void)fr_; (void)fq_; int lane_e; asm volatile("v_mbcnt_lo_u32_b32 %0, -1, 0\n\tv_mbcnt_hi_u32_b32 %0, -1, %0" : "=v"(lane_e));
        const int fr = lane_e & 15, fq = lane_e >> 4;
#pragma unroll
        for (int ai = 0; ai < 2; ++ai)
#pragma unroll
            for (int m = 0; m < 4; ++m) {
                const int row = u.pm * BM + ai * HALF + wr * 64 + m * 16 + fr; const float rs = rstdf(rss, row, 1.0f / 1024.0f);
                float sq = 0.f, skv = 0.f;
#pragma unroll
                for (int bj = 0; bj < 2; ++bj) {
                    const int g128 = u.pn * 2 + bj, c = wc * 32 + 8 * fq;
                    f32x4 v0 = acc[ai][bj][m][0] * rs, v1 = acc[ai][bj][m][1] * rs;
                    const float s = (v0[0] * v0[0] + v0[1] * v0[1]) + (v0[2] * v0[2] + v0[3] * v0[3]) + (v1[0] * v1[0] + v1[1] * v1[1]) + (v1[2] * v1[2] + v1[3] * v1[3]);
                    if (g128 < 3) { sq += s; *(u32x4*)(CQ + (size_t)row * 384 + g128 * 128 + c) = pack8(v0, v1); }
                    else if (g128 < 5) { skv += s; *(u32x4*)(CKV + (size_t)row * 256 + (g128 - 3) * 128 + c) = pack8(v0, v1); }
                    else if (wc == 0) { rope32(v0, v1, TB, row_pos(row), fq); *(u32x4*)(KR + (size_t)row * 32 + c) = pack8(v0, v1); }
                }
                if (u.pn < 2) { sq += __shfl_xor(sq, 16); sq += __shfl_xor(sq, 32); if (fq == 0) atomicAdd(rssq + row, sq); }
                if (u.pn > 0) { skv += __shfl_xor(skv, 16); skv += __shfl_xor(skv, 32); if (fq == 0) atomicAdd(rsskv + row, skv); }
            }
    }
};
template <bool ROPE> struct FEpiUp {
    static constexpr bool PERM = true, AFTER_DRAIN = false;
    const float* rss; float invk; bf16_t* O; int ldo; const float* TB;
    __device__ __forceinline__ void operator()(const f32x4 (&acc)[2][2][4][2], const Unit& u, int wr, int wc, int fr_, int fq_) const {
        (void)fr_; (void)fq_; int lane_e; asm volatile("v_mbcnt_lo_u32_b32 %0, -1, 0\n\tv_mbcnt_hi_u32_b32 %0, -1, %0" : "=v"(lane_e));
        const int fr = lane_e & 15, fq = lane_e >> 4;
#pragma unroll
        for (int ai = 0; ai < 2; ++ai)
#pragma unroll
            for (int m = 0; m < 4; ++m) {
                const int row = u.pm * BM + ai * HALF + wr * 64 + m * 16 + fr; const float rs = rstdf(rss, row, invk);
#pragma unroll
                for (int bj = 0; bj < 2; ++bj) {
                    f32x4 v0 = acc[ai][bj][m][0] * rs, v1 = acc[ai][bj][m][1] * rs;
                    if (ROPE) { const int g32 = 8 * u.pn + 4 * bj + wc; if (g32 % 3 == 2) rope32(v0, v1, TB, row_pos(row), fq); }
                    *(u32x4*)(O + (size_t)row * ldo + u.pn * BM + bj * HALF + wc * 32 + 8 * fq) = pack8(v0, v1);
                    asm volatile("" ::: "memory");
                }
            }
    }
};
}

__device__ __forceinline__ void ph_rot_a(const Params& p, const Ctx& c) {
    const float2* TA = (const float2*)(p.ws + WS_ROPE);
    const int gt = c.gw * 64 + c.lane, ngt = c.ngw * 64;
    for (int t = gt; t < RV * 256; t += ngt) {
        const int i = t & 7, sh = (t >> 3) & 15, which = (t >> 7) & 1, row = t >> 8;
        bf16_t* buf = (bf16_t*)(p.ws + (which ? WS_K : WS_Q)) + (size_t)row * 1024 + sh * 64;
        const float x1 = bf2f(buf[i]), x2 = bf2f(buf[8 + i]); const float2 cs = TA[row_pos(row) * 8 + i];
        buf[i] = (bf16_t)f2bf(x1 * cs.x - x2 * cs.y); buf[8 + i] = (bf16_t)f2bf(x2 * cs.x + x1 * cs.y);
    }
}
__device__ __forceinline__ void ph_dpost(const Params& p, const Ctx& c) {
    const float2* TB = (const float2*)(p.ws + WS_ROPE) + 2064 * 8;
    const int gt = c.gw * 64 + c.lane, ngt = c.ngw * 64;
    for (int t = gt; t < RV * 16; t += ngt) {
        const int i = t & 15, row = t >> 4; bf16_t* buf = (bf16_t*)(p.ws + WS_KR) + (size_t)row * 32;
        const float x1 = bf2f(buf[i]), x2 = bf2f(buf[16 + i]); const float2 cs = TB[row_pos(row) * 16 + i];
        buf[i] = (bf16_t)f2bf(x1 * cs.x - x2 * cs.y); buf[16 + i] = (bf16_t)f2bf(x2 * cs.x + x1 * cs.y);
    }
    float* rq = rss_ptr(p, 5); float* rkv = rss_ptr(p, 6);
    for (int r = c.gw; r < RT; r += c.ngw) {
        const bf16_t* cq = (const bf16_t*)(p.ws + WS_CQ) + (size_t)r * 384; const bf16_t* ckv = (const bf16_t*)(p.ws + WS_CKV) + (size_t)r * 256;
        float s1 = 0.f, s2 = 0.f;
        for (int k = c.lane; k < 384; k += 64) { const float v = bf2f(cq[k]); s1 += v * v; }
        for (int k = c.lane; k < 256; k += 64) { const float v = bf2f(ckv[k]); s2 += v * v; }
        s1 = wave_sum(s1); s2 = wave_sum(s2);
        if (c.lane == 0) { rq[r] = s1; rkv[r] = s2; }
    }
}
__device__ __forceinline__ void ph_rot_b(const Params& p, const Ctx& c) {
    const float2* TB = (const float2*)(p.ws + WS_ROPE) + 2064 * 8;
    const int gt = c.gw * 64 + c.lane, ngt = c.ngw * 64;
    for (int t = gt; t < RV * 256; t += ngt) {
        const int i = t & 15, h = (t >> 4) & 15, row = t >> 8; bf16_t* buf = (bf16_t*)(p.ws + WS_Q2) + (size_t)row * 1536 + h * 96 + 64;
        const float x1 = bf2f(buf[i]), x2 = bf2f(buf[16 + i]); const float2 cs = TB[row_pos(row) * 16 + i];
        buf[i] = (bf16_t)f2bf(x1 * cs.x - x2 * cs.y); buf[16 + i] = (bf16_t)f2bf(x2 * cs.x + x1 * cs.y);
    }
}

__device__ __forceinline__ int prev_row(int r, int d, bool& has) {
    has = true;
    if (r < RR) { const int t = r & (SEQ - 1); if (t >= d) return r - d; return RV - d + t; }
    if (r < RV) { const int i = r - RR; if (i >= d) return r - d; has = false; return r; }
    has = false; return r;
}
__device__ __forceinline__ void ph_ffn_in(const Params& p, const Ctx& c, int layer, int site) {
    const bf16_t* A = (const bf16_t*)(p.ws + WS_HB); const bf16_t* Wt = (const bf16_t*)(p.ws + (layer ? W_IN1 : W_IN0));
    bf16_t* G = (bf16_t*)(p.ws + WS_G); const float* rss = rss_ptr(p, site);
    const float* cw = p.in[I_FFN_CW] + (size_t)layer * 3 * DFF; const float* cb = p.in[I_FFN_CB] + (size_t)layer * DFF;
    const int nct = DFF / 64, nrt = (RV + 15) / 16, items = nrt * nct;
    const int l15 = c.lane & 15, q4 = c.lane >> 4;
    for (int it = c.gw; it < items; it += c.ngw) {
        const int rt = it / nct, ct = it % nct;
        f32x4 a0[4], a1[4], a2[4], bb[4];
#pragma unroll
        for (int n = 0; n < 4; ++n) { a0[n] = a1[n] = a2[n] = bb[n] = (f32x4){0.f, 0.f, 0.f, 0.f}; }
        const int ra = rt * 16 + l15; bool h1, h2; const int r1 = prev_row(ra, 1, h1), r2 = prev_row(ra, 2, h2);
        const bf16_t* ap0 = A + (size_t)ra * D + 8 * q4; const bf16_t* ap1 = A + (size_t)r1 * D + 8 * q4; const bf16_t* ap2 = A + (size_t)r2 * D + 8 * q4;
        const bf16_t* bpa[4]; const bf16_t* bpb[4];
#pragma unroll
        for (int n = 0; n < 4; ++n) { const int cc = ct * 64 + 16 * n + l15; const int wr = 256 * (cc >> 7) + (cc & 127); bpa[n] = Wt + (size_t)wr * D + 8 * q4; bpb[n] = bpa[n] + (size_t)128 * D; }
        for (int k0 = 0; k0 < D; k0 += 32) {
            const bf16x8 x0 = *(const bf16x8*)(ap0 + k0), x1 = *(const bf16x8*)(ap1 + k0), x2 = *(const bf16x8*)(ap2 + k0);
#pragma unroll
            for (int n = 0; n < 4; ++n) { const bf16x8 wa = *(const bf16x8*)(bpa[n] + k0), wb = *(const bf16x8*)(bpb[n] + k0);
                a0[n] = __builtin_amdgcn_mfma_f32_16x16x32_bf16(x0, wa, a0[n], 0, 0, 0);
                a1[n] = __builtin_amdgcn_mfma_f32_16x16x32_bf16(x1, wa, a1[n], 0, 0, 0);
                a2[n] = __builtin_amdgcn_mfma_f32_16x16x32_bf16(x2, wa, a2[n], 0, 0, 0);
                bb[n] = __builtin_amdgcn_mfma_f32_16x16x32_bf16(x0, wb, bb[n], 0, 0, 0); }
        }
#pragma unroll
        for (int i = 0; i < 4; ++i) {
            const int row = rt * 16 + 4 * q4 + i; bool g1, g2; const int p1 = prev_row(row, 1, g1), p2 = prev_row(row, 2, g2);
            const float s0 = 1.0f / sqrtf(rss[row] * (1.0f / D) + EPS);
            const float s1 = g1 ? 1.0f / sqrtf(rss[p1] * (1.0f / D) + EPS) : 0.f, s2 = g2 ? 1.0f / sqrtf(rss[p2] * (1.0f / D) + EPS) : 0.f;
#pragma unroll
            for (int n = 0; n < 4; ++n) { const int cc = ct * 64 + 16 * n + l15;
                const float ac = cb[cc] + cw[cc] * (a2[n][i] * s2) + cw[DFF + cc] * (a1[n][i] * s1) + cw[2 * DFF + cc] * (a0[n][i] * s0);
                const float bv = bb[n][i] * s0; const float g = ac / (1.0f + __expf(-ac)) * bv;
                G[(size_t)row * DFF + cc] = (bf16_t)f2bf(g); }
        }
    }
}

__device__ __forceinline__ s16x4 vtr(const LAS unsigned char* p) { typedef short v4i16_t __attribute__((ext_vector_type(4)));
    return __builtin_bit_cast(s16x4, __builtin_amdgcn_ds_read_tr16_b64_v4i16((LAS v4i16_t*)p)); }
__device__ __forceinline__ unsigned cvtpk(float lo, float hi) { typedef float f32x2_t __attribute__((ext_vector_type(2))); typedef __bf16 bf16x2_t __attribute__((ext_vector_type(2)));
    f32x2_t v = {lo, hi}; bf16x2_t b = __builtin_convertvector(v, bf16x2_t); return __builtin_bit_cast(unsigned, b); }

struct SrcA { const bf16_t* K; const bf16_t* V; int h, s;
    __device__ __forceinline__ const bf16_t* kptr(int krow, int ch) const { return K + (size_t)krow * 1024 + h * 128 + s * 64 + ch * 8; }
    __device__ __forceinline__ const bf16_t* vptr(int krow, int ch) const { return V + (size_t)krow * 1024 + h * 128 + ch * 8; } };
struct SrcB { const bf16_t* KV; const bf16_t* KR; int h;
    __device__ __forceinline__ const bf16_t* kptr(int krow, int ch) const { return ch < 8 ? KV + (size_t)krow * 2048 + h * 128 + ch * 8 : KR + (size_t)krow * 32 + (ch - 8) * 8; }
    __device__ __forceinline__ const bf16_t* vptr(int krow, int ch) const { return KV + (size_t)krow * 2048 + h * 128 + 64 + ch * 8; } };

template <int DQK, int DV> struct ACfg { static constexpr int KS = DQK * 2 + 16, VS = DV * 2 + 64, KOFF = 0, VOFF = 64 * KS, SCR = VOFF + 64 * VS; };

template <int DQK, int DV, bool META>
__device__ __forceinline__ void attn_tile(const LAS unsigned char* Kt, const LAS unsigned char* Vt, LAS float* scr, const bf16x8 (&qf)[DQK / 16], f32x16 (&o)[DV / 32], float& m, float& lsum, int lane) {
    constexpr int KS = ACfg<DQK, DV>::KS, VS = ACfg<DQK, DV>::VS;
    const int r32 = lane & 31, hi = lane >> 5;
    f32x16 p0, p1;
#pragma unroll
    for (int r = 0; r < 16; ++r) { p0[r] = 0.f; p1[r] = 0.f; }
#pragma unroll
    for (int kk = 0; kk < DQK / 16; ++kk) {
        const bf16x8 k0 = *(const LAS bf16x8*)(Kt + r32 * KS + (16 * kk + 8 * hi) * 2);
        p0 = __builtin_amdgcn_mfma_f32_32x32x16_bf16(k0, qf[kk], p0, 0, 0, 0);
        if (!META) { const bf16x8 k1 = *(const LAS bf16x8*)(Kt + (32 + r32) * KS + (16 * kk + 8 * hi) * 2);
            p1 = __builtin_amdgcn_mfma_f32_32x32x16_bf16(k1, qf[kk], p1, 0, 0, 0); }
        if (kk & 1) __builtin_amdgcn_sched_barrier(0);
    }
    float mx = -INFINITY;
    if (META) {
#pragma unroll
        for (int r = 0; r < 8; ++r) mx = fmaxf(mx, p0[r]);
    } else {
#pragma unroll
        for (int r = 0; r < 16; ++r) mx = fmaxf(mx, fmaxf(p0[r], p1[r]));
    }
    mx = fmaxf(mx, __shfl_xor(mx, 32));
    const float mn = fmaxf(m, mx); const float alpha = __builtin_amdgcn_exp2f(m - mn); m = mn;
    float ps = 0.f;
    if (META) {
#pragma unroll
        for (int r = 0; r < 8; ++r) { p0[r] = __builtin_amdgcn_exp2f(p0[r] - mn); ps += p0[r]; }
    } else {
#pragma unroll
        for (int r = 0; r < 16; ++r) { p0[r] = __builtin_amdgcn_exp2f(p0[r] - mn); p1[r] = __builtin_amdgcn_exp2f(p1[r] - mn); ps += p0[r] + p1[r]; }
    }
    lsum = lsum * alpha + ps;
    if (__any(alpha != 1.0f)) {
        if (hi == 0) scr[r32] = alpha;
        asm volatile("s_waitcnt lgkmcnt(0)" ::: "memory");
#pragma unroll
        for (int r = 0; r < 16; ++r) { const float a = scr[crow(r, hi)];
#pragma unroll
            for (int d0 = 0; d0 < DV / 32; ++d0) o[d0][r] *= a; }
    }
    bf16x8 pa[4];
    { u32x4 w; w.x = cvtpk(p0[0], p0[1]); w.y = cvtpk(p0[2], p0[3]); w.z = cvtpk(p0[4], p0[5]); w.w = cvtpk(p0[6], p0[7]); pa[0] = __builtin_bit_cast(bf16x8, w); }
    if (!META) {
        { u32x4 w; w.x = cvtpk(p0[8], p0[9]); w.y = cvtpk(p0[10], p0[11]); w.z = cvtpk(p0[12], p0[13]); w.w = cvtpk(p0[14], p0[15]); pa[1] = __builtin_bit_cast(bf16x8, w); }
        { u32x4 w; w.x = cvtpk(p1[0], p1[1]); w.y = cvtpk(p1[2], p1[3]); w.z = cvtpk(p1[4], p1[5]); w.w = cvtpk(p1[6], p1[7]); pa[2] = __builtin_bit_cast(bf16x8, w); }
        { u32x4 w; w.x = cvtpk(p1[8], p1[9]); w.y = cvtpk(p1[10], p1[11]); w.z = cvtpk(p1[12], p1[13]); w.w = cvtpk(p1[14], p1[15]); pa[3] = __builtin_bit_cast(bf16x8, w); }
    }
    const LAS unsigned char* vb = Vt + (4 * hi + ((lane & 15) >> 2)) * VS + (16 * ((lane >> 4) & 1) + 4 * (lane & 3)) * 2;
#pragma unroll
    for (int ks = 0; ks < (META ? 1 : 4); ++ks) {
#pragma unroll
        for (int d0 = 0; d0 < DV / 32; ++d0) {
            const s16x4 lo = vtr(vb + (16 * ks) * VS + 64 * d0), hh = vtr(vb + (16 * ks + 8) * VS + 64 * d0);
            const bf16x8 vf = (bf16x8){lo[0], lo[1], lo[2], lo[3], hh[0], hh[1], hh[2], hh[3]};
            o[d0] = __builtin_amdgcn_mfma_f32_32x32x16_bf16(pa[ks], vf, o[d0], 0, 0, 0);
        }
        __builtin_amdgcn_sched_barrier(0);
    }
}

template <int DQK, int DV, class Src>
__device__ __forceinline__ void attn_pass(const Ctx& c, const Src& src, int b, int qb, const bf16x8 (&qf)[DQK / 16], f32x16 (&o)[DV / 32]) {
    typedef ACfg<DQK, DV> C;
    LAS unsigned char* Kt = c.lds + C::KOFF; LAS unsigned char* Vt = c.lds + C::VOFF; LAS float* scr = (LAS float*)(c.lds + C::SCR) + c.wave * 64;
    const int hi = c.lane >> 5, r32 = c.lane & 31;
    float m = -INFINITY, lsum = 0.f;
#pragma unroll
    for (int d0 = 0; d0 < DV / 32; ++d0)
#pragma unroll
        for (int r = 0; r < 16; ++r) o[d0][r] = 0.f;
    const int NT = qb < 0 ? 0 : 4 * (qb + 1);
    const int myc = qb < 0 ? -1 : 4 * qb + (c.wave >> 1);
    const bool active = qb >= 0 || c.wave == 0;
    for (int jt = -1; jt < NT; ++jt) {
        __syncthreads();
        const int krow0 = jt < 0 ? RR : b * SEQ + 64 * jt;
        const int nk = jt < 0 ? 32 : 64, nv = jt < 0 ? 16 : 64;
        for (int idx = c.tid; idx < nk * (DQK / 8); idx += NTHREADS) { const int key = idx / (DQK / 8), ch = idx % (DQK / 8);
            *(LAS u32x4*)(Kt + key * C::KS + ch * 16) = *(const u32x4*)src.kptr(krow0 + key, ch); }
        for (int idx = c.tid; idx < nv * (DV / 8); idx += NTHREADS) { const int key = idx / (DV / 8), ch = idx % (DV / 8);
            *(LAS u32x4*)(Vt + key * C::VS + ch * 16) = *(const u32x4*)src.vptr(krow0 + key, ch); }
        __syncthreads();
        if (active && jt <= myc) {
            if (jt < 0) attn_tile<DQK, DV, true>(Kt, Vt, scr, qf, o, m, lsum, c.lane);
            else attn_tile<DQK, DV, false>(Kt, Vt, scr, qf, o, m, lsum, c.lane);
        }
    }
    const float lt = lsum + __shfl_xor(lsum, 32);
    if (hi == 0) scr[32 + r32] = 1.0f / lt;
    asm volatile("s_waitcnt lgkmcnt(0)" ::: "memory");
#pragma unroll
    for (int r = 0; r < 16; ++r) { const float a = scr[32 + crow(r, hi)];
#pragma unroll
        for (int d0 = 0; d0 < DV / 32; ++d0) o[d0][r] *= a; }
}

__device__ __forceinline__ void attn_unit_a(const Params& p, const Ctx& c, int b, int h, int qb, float lam) {
    const int q0 = qb < 0 ? RR : b * SEQ + 256 * qb; const int hi = c.lane >> 5, r32 = c.lane & 31;
    bf16_t* Qb = (bf16_t*)(p.ws + WS_Q); bf16_t* O1 = (bf16_t*)(p.ws + WS_OB2);
    const bool active = qb >= 0 || c.wave == 0;
    f32x16 o[4];
#pragma nounroll
    for (int s = 0; s < 2; ++s) {
        const bf16_t* qrow = Qb + (size_t)(q0 + 32 * c.wave + r32) * 1024 + h * 128 + s * 64;
        bf16x8 qf[4];
#pragma unroll
        for (int kk = 0; kk < 4; ++kk) qf[kk] = *(const bf16x8*)(qrow + 16 * kk + 8 * hi);
        SrcA src{(const bf16_t*)(p.ws + WS_K), (const bf16_t*)(p.ws + WS_V), h, s};
        attn_pass<64, 128, SrcA>(c, src, b, qb, qf, o);
        if (s == 0 && active) {
            int rb = q0 + 32 * c.wave; asm volatile("" : "+s"(rb));
#pragma unroll
            for (int r = 0; r < 16; ++r) { bf16_t* orow = O1 + (size_t)(rb + crow(r, hi)) * 1024 + h * 128 + r32;
                orow[0] = (bf16_t)f2bf(o[0][r]); orow[32] = (bf16_t)f2bf(o[1][r]); orow[64] = (bf16_t)f2bf(o[2][r]); orow[96] = (bf16_t)f2bf(o[3][r]); }
        }
    }
    if (!active) return;
    int rb = q0 + 32 * c.wave; asm volatile("" : "+s"(rb));
#pragma unroll
    for (int r = 0; r < 16; ++r) {
        const size_t off = (size_t)(rb + crow(r, hi)) * 1024 + h * 128 + r32;
        const float v0 = bf2f(O1[off]) - lam * o[0][r], v1 = bf2f(O1[off + 32]) - lam * o[1][r], v2 = bf2f(O1[off + 64]) - lam * o[2][r], v3 = bf2f(O1[off + 96]) - lam * o[3][r];
        float ss = v0 * v0 + v1 * v1 + v2 * v2 + v3 * v3;
#pragma unroll
        for (int sh = 1; sh < 32; sh <<= 1) ss += __shfl_xor(ss, sh);
        const float rs = 1.0f / sqrtf(ss * (1.0f / 128.0f) + EPS);
        bf16_t* orow = Qb + off;
        orow[0] = (bf16_t)f2bf(v0 * rs); orow[32] = (bf16_t)f2bf(v1 * rs); orow[64] = (bf16_t)f2bf(v2 * rs); orow[96] = (bf16_t)f2bf(v3 * rs);
        if ((r & 3) == 3) asm volatile("" ::: "memory");
    }
}
__device__ __forceinline__ void ph_attn_a(const Params& p, const Ctx& c) {
    const float d1 = wave_sum(p.in[I_LQ1][c.lane] * p.in[I_LK1][c.lane]), d2 = wave_sum(p.in[I_LQ2][c.lane] * p.in[I_LK2][c.lane]);
    const float lam = expf(d1) - expf(d2) + LAM_INIT;
#pragma nounroll
    for (int pi = c.vcu; pi < 256 + 8; pi += c.G) {
        const int nsub = pi < 256 ? 2 : 1;
#pragma nounroll
        for (int sub = 0; sub < nsub; ++sub) {
            int b, h, qb;
            if (pi < 256) { const int bh = pi >> 2, s = pi & 3; b = bh >> 3; h = bh & 7; qb = sub ? 7 - s : s; } else { b = 0; h = pi - 256; qb = -1; }
            attn_unit_a(p, c, b, h, qb, lam);
        }
    }
}
__device__ __forceinline__ void attn_unit_b(const Params& p, const Ctx& c, int b, int h, int qb) {
    const int q0 = qb < 0 ? RR : b * SEQ + 256 * qb; const int hi = c.lane >> 5, r32 = c.lane & 31;
    const bf16_t* qrow = (const bf16_t*)(p.ws + WS_Q2) + (size_t)(q0 + 32 * c.wave + r32) * 1536 + h * 96;
    bf16x8 qf[6];
#pragma unroll
    for (int kk = 0; kk < 6; ++kk) qf[kk] = *(const bf16x8*)(qrow + 16 * kk + 8 * hi);
    f32x16 o[2];
    SrcB src{(const bf16_t*)(p.ws + WS_KV2), (const bf16_t*)(p.ws + WS_KR), h};
    attn_pass<96, 64, SrcB>(c, src, b, qb, qf, o);
    const bool active = qb >= 0 || c.wave == 0;
    if (!active) return;
    bf16_t* Ob = (bf16_t*)(p.ws + WS_OB2);
    int rb = q0 + 32 * c.wave; asm volatile("" : "+s"(rb));
#pragma unroll
    for (int r = 0; r < 16; ++r) { bf16_t* orow = Ob + (size_t)(rb + crow(r, hi)) * 1024 + h * 64 + r32;
        orow[0] = (bf16_t)f2bf(o[0][r]); orow[32] = (bf16_t)f2bf(o[1][r]); }
}
__device__ __forceinline__ void ph_attn_b(const Params& p, const Ctx& c) {
#pragma nounroll
    for (int pi = c.vcu; pi < 512 + 16; pi += c.G) {
        const int nsub = pi < 512 ? 2 : 1;
#pragma nounroll
        for (int sub = 0; sub < nsub; ++sub) {
            int b, h, qb;
            if (pi < 512) { const int bh = pi >> 2, s = pi & 3; b = bh >> 4; h = bh & 15; qb = sub ? 7 - s : s; } else { b = 0; h = pi - 512; qb = -1; }
            attn_unit_b(p, c, b, h, qb);
        }
    }
}

__device__ __forceinline__ void ph_ffn_fix(const Params& p, const Ctx& c, int layer) {
    const float* SA = (const float*)(p.ws + WS_SA); const float* SB = (const float*)(p.ws + WS_SB); bf16_t* G = (bf16_t*)(p.ws + WS_G);
    const float* cw = p.in[I_FFN_CW] + (size_t)layer * 3 * DFF; const float* cb = p.in[I_FFN_CB] + (size_t)layer * DFF;
    const int gt = c.gw * 64 + c.lane, ngt = c.ngw * 64;
    for (int i = gt; i < 65 * DFF; i += ngt) {
        const int pm = i / DFF, col = i - pm * DFF;
        const float a0 = SA[((size_t)pm * 4 + 0) * DFF + col], a1 = SA[((size_t)pm * 4 + 1) * DFF + col];
        const float b0 = SB[((size_t)pm * 2 + 0) * DFF + col], b1 = SB[((size_t)pm * 2 + 1) * DFF + col];
        float l0 = 0.f, l1 = 0.f;
        if (pm < 64) { const int ps = (pm & 7) == 0 ? 64 : pm - 1; l0 = SA[((size_t)ps * 4 + 2) * DFF + col]; l1 = SA[((size_t)ps * 4 + 3) * DFF + col]; }
        const float w0 = cw[col], w1 = cw[DFF + col], w2 = cw[2 * DFF + col], bb = cb[col];
        const float c0 = bb + w0 * l0 + w1 * l1 + w2 * a0, c1 = bb + w0 * l1 + w1 * a0 + w2 * a1;
        const float g0 = c0 / (1.0f + __expf(-c0)) * b0, g1 = c1 / (1.0f + __expf(-c1)) * b1;
        G[(size_t)(pm * 256) * DFF + col] = (bf16_t)f2bf(g0); G[(size_t)(pm * 256 + 1) * DFF + col] = (bf16_t)f2bf(g1);
    }
}

enum { PH_PROLOGUE = 0, PH_QKV, PH_ROT_A, PH_ATTN_A, PH_WO_A, PH_STAT1, PH_FFNIN_A, PH_FIX_A, PH_FFNOUT_A, PH_STAT2, PH_DPROJ, PH_DPOST, PH_UKV, PH_UQ, PH_ROT_B,
       PH_ATTN_B, PH_WO_B, PH_STAT3, PH_FFNIN_B, PH_FIX_B, PH_FFNOUT_B, PH_FINAL, PH_COUNT };
__host__ __device__ constexpr bool phase_active(int ph) {
#ifdef ONLY_PH
    if (ph != ONLY_PH) return false;
#endif
    return !((FAST_QKV && ph == PH_ROT_A) || (FAST_RES && (ph == PH_STAT1 || ph == PH_STAT2 || ph == PH_STAT3)) || (!FAST_FFN && (ph == PH_FIX_A || ph == PH_FIX_B)) ||
             (FAST_D && ph == PH_DPOST) || (FAST_U && ph == PH_ROT_B));
}

__host__ __device__ constexpr bool only_ok(int x) {
#ifdef ONLY_PH
    return x == ONLY_PH;
#else
    return true;
#endif
}
__device__ __forceinline__ Ctx make_ctx(LAS unsigned char* lds, int wave0) {
    int lane_; asm volatile("v_mbcnt_lo_u32_b32 %0, -1, 0\n\tv_mbcnt_hi_u32_b32 %0, -1, %0" : "=v"(lane_));
    int wv = wave0; asm volatile("" : "+s"(wv));
    Ctx c; c.lds = lds; c.lane = lane_; c.wave = wv; c.tid = wv * 64 + lane_;
    c.G = gridDim.x; { const int bx = blockIdx.x; c.vcu = (c.G % 8 == 0) ? (bx % 8) * (c.G / 8) + bx / 8 : bx; }
    c.gw = c.vcu * NWAVES + c.wave; c.ngw = c.G * NWAVES;
    return c;
}
template <class Epi> __device__ __forceinline__ void run_gemm(const Ctx& c, const bf16_t* A, const bf16_t* Bt, int N, int K, const Epi& E) {
    pg8::Gemm g{A, Bt, RT, N, K}; pg8::StaticOrder S; S.init(RT, N, c.G, (int)blockIdx.x);
    pg8::gemm_phase<Epi, pg8::StaticOrder, true, true>(c.lds, g, S, E, c.tid);
}

__global__ void __launch_bounds__(NTHREADS, 2) fwd_kernel(Params pin) {
    extern __shared__ __attribute__((aligned(16))) unsigned char smem[];
    bool first = true;
    int wave0 = __builtin_amdgcn_readfirstlane((int)threadIdx.x >> 6);
#pragma nounroll
    for (int ph = pin.ph_lo; ph < pin.ph_hi; ++ph) {
        if (!phase_active(ph)) continue;
        if (!first && ph != PH_UQ) cg::this_grid().sync();
        first = false;
        Params p = pin; asm volatile("" : "+s"(p.ws), "+s"(p.out));
#define MKCTX() const Ctx c = make_ctx((LAS unsigned char*)smem, wave0)
        unsigned char* ws = p.ws;
        const bf16_t* HB = (const bf16_t*)(ws + WS_HB);
        float* hmeta = (float*)(ws + WS_HMETA);
        const float* TA = (const float*)(ws + WS_ROPE); const float* TB = TA + 2064 * 8 * 2;
        switch (ph) {
            case PH_PROLOGUE: if (!only_ok(PH_PROLOGUE)) break; { MKCTX(); ph_prologue(p, c); break; }
            case PH_QKV: if (!only_ok(PH_QKV)) break; { MKCTX();
                if (FAST_QKV) { pg8::FEpiQKV e{rss_ptr(p, 0), (bf16_t*)(ws + WS_Q), TA}; run_gemm(c, HB, (const bf16_t*)(ws + W_QKV), 3072, 1024, e); }
                else { EpiQKV e{rss_ptr(p, 0), (bf16_t*)(ws + WS_Q), (bf16_t*)(ws + WS_K), (bf16_t*)(ws + WS_V)}; gemm_simple(HB, D, (const bf16_t*)(ws + W_QKV), D, 3072, RV, e, c); }
                break; }
            case PH_ROT_A: if (!only_ok(PH_ROT_A)) break; { MKCTX(); ph_rot_a(p, c); break; }
            case PH_ATTN_A: if (!only_ok(PH_ATTN_A)) break; { MKCTX(); ph_attn_a(p, c); break; }
            case PH_WO_A: if (!only_ok(PH_WO_A)) break; { MKCTX();
                if (FAST_RES) { pg8::FEpiRes e{p.out, hmeta, (bf16_t*)(ws + WS_HB), rss_ptr(p, 1)}; run_gemm(c, (const bf16_t*)(ws + WS_Q), (const bf16_t*)(ws + W_OA), 1024, 1024, e); }
                else { EpiRes e{p.out, hmeta}; gemm_simple((const bf16_t*)(ws + WS_Q), 1024, (const bf16_t*)(ws + W_OA), 1024, 1024, RV, e, c); }
                break; }
            case PH_STAT1: if (!only_ok(PH_STAT1)) break; { MKCTX(); ph_rowstat(p, c, 1); break; }
            case PH_FFNIN_A: case PH_FFNIN_B: if (!only_ok(PH_FFNIN_A) && !only_ok(PH_FFNIN_B)) break; { MKCTX(); { const int layer = ph == PH_FFNIN_B; const int site = layer ? 3 : 1;
                if (FAST_FFN) { pg8::FEpiFFN e{rss_ptr(p, site), p.in[I_FFN_CW] + (size_t)layer * 3 * DFF, p.in[I_FFN_CB] + (size_t)layer * DFF, (bf16_t*)(ws + WS_G), (float*)(ws + WS_SA), (float*)(ws + WS_SB), (LAS float*)(c.lds + XLDS_OFF)};
                    run_gemm(c, HB, (const bf16_t*)(ws + (layer ? W_IN1 : W_IN0)), 5632, 1024, e); }
                else ph_ffn_in(p, c, layer, site);
                break; } }
            case PH_FIX_A: if (!only_ok(PH_FIX_A)) break; { MKCTX(); ph_ffn_fix(p, c, 0); break; }
            case PH_FIX_B: if (!only_ok(PH_FIX_B)) break; { MKCTX(); ph_ffn_fix(p, c, 1); break; }
            case PH_FFNOUT_A: case PH_FFNOUT_B: if (!only_ok(PH_FFNOUT_A) && !only_ok(PH_FFNOUT_B)) break; { MKCTX(); { const int layer = ph == PH_FFNOUT_B;
                if (FAST_RES) { pg8::FEpiRes e{p.out, hmeta, layer ? nullptr : (bf16_t*)(ws + WS_HB), rss_ptr(p, layer ? 4 : 2)}; run_gemm(c, (const bf16_t*)(ws + WS_G), (const bf16_t*)(ws + (layer ? W_OUT1 : W_OUT0)), 1024, DFF, e); }
                else { EpiRes e{p.out, hmeta}; gemm_simple((const bf16_t*)(ws + WS_G), DFF, (const bf16_t*)(ws + (layer ? W_OUT1 : W_OUT0)), DFF, 1024, RV, e, c); }
                break; } }
            case PH_STAT2: if (!only_ok(PH_STAT2)) break; { MKCTX(); ph_rowstat(p, c, 2); break; }
            case PH_DPROJ: if (!only_ok(PH_DPROJ)) break; { MKCTX();
                if (FAST_D) { pg8::FEpiD e{rss_ptr(p, 2), (bf16_t*)(ws + WS_CQ), (bf16_t*)(ws + WS_CKV), (bf16_t*)(ws + WS_KR), rss_ptr(p, 5), rss_ptr(p, 6), TB}; run_gemm(c, HB, (const bf16_t*)(ws + W_D), 768, 1024, e); }
                else { EpiD e{rss_ptr(p, 2), (bf16_t*)(ws + WS_CQ), (bf16_t*)(ws + WS_CKV), (bf16_t*)(ws + WS_KR)}; gemm_simple(HB, D, (const bf16_t*)(ws + W_D), D, 768, RV, e, c); }
                break; }
            case PH_DPOST: if (!only_ok(PH_DPOST)) break; { MKCTX(); ph_dpost(p, c); break; }
            case PH_UKV: if (!only_ok(PH_UKV)) break; { MKCTX();
                if (FAST_U) { pg8::FEpiUp<false> e1{rss_ptr(p, 6), 1.0f / 256.0f, (bf16_t*)(ws + WS_KV2), 2048, TB}; run_gemm(c, (const bf16_t*)(ws + WS_CKV), (const bf16_t*)(ws + W_UKV), 2048, 256, e1); }
                else { EpiScaled e1{rss_ptr(p, 6), 1.0f / 256.0f, (bf16_t*)(ws + WS_KV2), 2048}; gemm_simple((const bf16_t*)(ws + WS_CKV), 256, (const bf16_t*)(ws + W_UKV), 256, 2048, RV, e1, c); }
                break; }
            case PH_UQ: if (!only_ok(PH_UQ)) break; { MKCTX();
                if (FAST_U) { pg8::FEpiUp<true> e2{rss_ptr(p, 5), 1.0f / 384.0f, (bf16_t*)(ws + WS_Q2), 1536, TB}; run_gemm(c, (const bf16_t*)(ws + WS_CQ), (const bf16_t*)(ws + W_UQ), 1536, 384, e2); }
                else { EpiScaled e2{rss_ptr(p, 5), 1.0f / 384.0f, (bf16_t*)(ws + WS_Q2), 1536}; gemm_simple((const bf16_t*)(ws + WS_CQ), 384, (const bf16_t*)(ws + W_UQ), 384, 1536, RV, e2, c); }
                break; }
            case PH_ROT_B: if (!only_ok(PH_ROT_B)) break; { MKCTX(); ph_rot_b(p, c); break; }
            case PH_ATTN_B: if (!only_ok(PH_ATTN_B)) break; { MKCTX(); ph_attn_b(p, c); break; }
            case PH_WO_B: if (!only_ok(PH_WO_B)) break; { MKCTX();
                if (FAST_RES) { pg8::FEpiRes e{p.out, hmeta, (bf16_t*)(ws + WS_HB), rss_ptr(p, 3)}; run_gemm(c, (const bf16_t*)(ws + WS_OB2), (const bf16_t*)(ws + W_OB), 1024, 1024, e); }
                else { EpiRes e{p.out, hmeta}; gemm_simple((const bf16_t*)(ws + WS_OB2), 1024, (const bf16_t*)(ws + W_OB), 1024, 1024, RV, e, c); }
                break; }
            case PH_STAT3: if (!only_ok(PH_STAT3)) break; { MKCTX(); ph_rowstat(p, c, 3); break; }
            case PH_FINAL: if (!only_ok(PH_FINAL)) break; { MKCTX(); ph_final(p, c); break; }
            default: break;
        }
    }
}

extern "C" void kernel_launch(void* const* d_in, const int* in_sizes, int n_in, void* d_out, int out_size, void* d_ws, size_t ws_size, hipStream_t stream) {
    static int grid = 0;
    if (grid == 0) {
        if (n_in != 25 || ws_size < WS_END || out_size != RR * D) { fprintf(stderr, "kernel_launch: unexpected shapes (n_in %d, ws %zu, out %d)\n", n_in, ws_size, out_size); grid = -1; return; }
        int dev = 0, cus = 0, per_cu = 0;
        hipGetDevice(&dev); hipDeviceGetAttribute(&cus, hipDeviceAttributeMultiprocessorCount, dev);
        hipFuncSetAttribute((const void*)fwd_kernel, hipFuncAttributeMaxDynamicSharedMemorySize, LDS_BYTES);
        hipOccupancyMaxActiveBlocksPerMultiprocessor(&per_cu, (const void*)fwd_kernel, NTHREADS, LDS_BYTES);
        if (per_cu < 1) { fprintf(stderr, "kernel_launch: occupancy query says %d blocks per CU\n", per_cu); per_cu = 1; }
        (void)hipGetLastError();
        grid = cus * per_cu;
    }
    if (grid < 0) return;
    Params p{};
    for (int i = 0; i < 25; ++i) p.in[i] = (const float*)d_in[i];
    p.out = (float*)d_out; p.ws = (unsigned char*)d_ws;
    p.ph_lo = 0; p.ph_hi = PH_COUNT;
    void* args[] = {&p};
    hipError_t e = hipLaunchCooperativeKernel((const void*)fwd_kernel, dim3(grid), dim3(NTHREADS), args, LDS_BYTES, stream);
    if (e != hipSuccess) fprintf(stderr, "kernel_launch: cooperative launch failed: %s (grid %d)\n", hipGetErrorString(e), grid);
}
```

```cpp
#include <hip/hip_runtime.h>
#include <hip/hip_cooperative_groups.h>
#include <cstdio>
#include <cstdint>
#include <cmath>
namespace cg = cooperative_groups;

#define LAS __attribute__((address_space(3)))
typedef unsigned short bf16_t;
typedef short bf16x8 __attribute__((ext_vector_type(8)));
typedef short s16x4 __attribute__((ext_vector_type(4)));
typedef float f32x4 __attribute__((ext_vector_type(4)));
typedef float f32x16 __attribute__((ext_vector_type(16)));
typedef unsigned u32x4 __attribute__((ext_vector_type(4)));
typedef unsigned u32x2 __attribute__((ext_vector_type(2)));

constexpr int NB = 8, SEQ = 2048, NMETA = 16, D = 1024, DFF = 2816;
constexpr int RR = NB * SEQ;
constexpr int RV = RR + NMETA;
constexpr int RT = 16640;
constexpr int NWAVES = 8, NTHREADS = 512;
constexpr float EPS = 1e-5f;
constexpr float LOG2E = 1.4426950408889634f;
constexpr float QS_A = 0.125f * LOG2E;
constexpr float QS_B = 0.10206207261596575f * LOG2E;
constexpr float LAM_INIT = 0.2f;

constexpr size_t KiB = 1024, MiB = 1024 * 1024;
constexpr size_t WS_CTL = 0;
constexpr size_t W_QKV = 1 * MiB;
constexpr size_t W_OA = 7 * MiB;
constexpr size_t W_IN0 = 9 * MiB, W_IN1 = 20 * MiB;
constexpr size_t W_OUT0 = 31 * MiB, W_OUT1 = 31 * MiB + 5632 * KiB;
constexpr size_t W_D = 42 * MiB;
constexpr size_t W_UKV = 43 * MiB + 512 * KiB;
constexpr size_t W_UQ = 44 * MiB + 512 * KiB;
constexpr size_t W_OB = 45 * MiB + 640 * KiB;
constexpr size_t WS_HB = 48 * MiB;
constexpr size_t WS_BIG = WS_HB + 33280 * KiB;
constexpr size_t ROWB1024 = (size_t)RT * 1024 * 2;
constexpr size_t WS_Q = WS_BIG, WS_K = WS_BIG + ROWB1024, WS_V = WS_BIG + 2 * ROWB1024;
constexpr size_t WS_G = WS_BIG;
constexpr size_t WS_Q2 = WS_BIG;
constexpr size_t WS_KV2 = WS_BIG + (size_t)RT * 1536 * 2;
constexpr size_t WS_CQ = WS_BIG + 116480 * KiB;
constexpr size_t WS_CKV = WS_CQ + (size_t)RT * 384 * 2;
constexpr size_t WS_KR = WS_CKV + (size_t)RT * 256 * 2;
constexpr size_t WS_OB2 = 216 * MiB;
constexpr size_t WS_HMETA = WS_OB2 + 33280 * KiB;
constexpr size_t WS_RSS = WS_HMETA + 1 * MiB;
constexpr size_t WS_ROPE = WS_RSS + 512 * KiB;
constexpr size_t WS_SA = 251 * MiB;
constexpr size_t WS_SB = WS_SA + (size_t)65 * 4 * 2816 * 4;
constexpr size_t WS_END = 256 * MiB;
static_assert(WS_SB + (size_t)65 * 2 * 2816 * 4 <= WS_END, "ws map");
static_assert(WS_KR + (size_t)RT * 32 * 2 <= WS_OB2, "ws map");
static_assert(WS_KV2 + (size_t)RT * 2048 * 2 <= WS_CQ, "ws map");
static_assert(WS_ROPE + 512 * KiB <= WS_END, "ws map");
static_assert(W_OB + 2 * MiB <= WS_HB, "ws map");

constexpr int LDS_BYTES = 147456;
constexpr int MISC_OFF = 131072 + 4096;
constexpr size_t CTL_ZERO_BYTES = 64 * 1024;
constexpr int CW_BAR = 4096;
constexpr int XLDS_OFF = 131072;
#ifndef FAST_MASK
#define FAST_MASK 0x1f
#endif
constexpr bool FAST_QKV = (FAST_MASK >> 0) & 1, FAST_RES = (FAST_MASK >> 1) & 1, FAST_FFN = (FAST_MASK >> 2) & 1, FAST_D = (FAST_MASK >> 3) & 1, FAST_U = (FAST_MASK >> 4) & 1;

struct Params {
    const float* in[25];
    float* out;
    unsigned char* ws;
    int ph_lo, ph_hi;
};
enum { I_X = 0, I_META, I_A_NORM, I_A_WQKV, I_LQ1, I_LK1, I_LQ2, I_LK2, I_A_SUB, I_A_WO, I_KV_NORM, I_KV_WDKV, I_KV_ANORM, I_KV_WUKV,
       I_B_NORM, I_B_WDQ, I_B_QANORM, I_B_WUQ, I_B_WO, I_FFN_NORM, I_FFN_WIN, I_FFN_CW, I_FFN_CB, I_FFN_WOUT, I_FINAL };

struct Ctx { int tid, lane, wave, gw, ngw, vcu, G; LAS unsigned char* lds; };

__device__ __forceinline__ unsigned f2bf(float f) { unsigned u = __builtin_bit_cast(unsigned, f); return (u + 0x7fffu + ((u >> 16) & 1u)) >> 16; }
__device__ __forceinline__ unsigned pk2(float lo, float hi) { return f2bf(lo) | (f2bf(hi) << 16); }
__device__ __forceinline__ float bf2f(bf16_t b) { return __builtin_bit_cast(float, (unsigned)b << 16); }
__device__ __forceinline__ float wave_sum(float v) {
#pragma unroll
    for (int o = 1; o < 64; o <<= 1) v += __shfl_xor(v, o);
    return v;
}
__device__ __forceinline__ int row_pos(int r) { return r < RR ? NMETA + (r & (SEQ - 1)) : r - RR; }
__device__ __forceinline__ float* hrow(const Params& p, int r) { return r < RR ? p.out + (size_t)r * D : (float*)(p.ws + WS_HMETA) + (size_t)(r - RR) * D; }
__device__ __forceinline__ float* rss_ptr(const Params& p, int site) { return (float*)(p.ws + WS_RSS) + (size_t)site * RT; }
__device__ __forceinline__ int crow(int r, int hi) { return (r & 3) + 8 * (r >> 2) + 4 * hi; }

struct WSrc { const float* W; int pitch; int col0; const float* gain; int gmask; float scale; };
__device__ __forceinline__ void wdims(int id, int& N, int& K, size_t& off) {
    switch (id) {
        case 0: N = 3072; K = 1024; off = W_QKV; break;
        case 1: N = 1024; K = 1024; off = W_OA; break;
        case 2: N = 5632; K = 1024; off = W_IN0; break;
        case 3: N = 5632; K = 1024; off = W_IN1; break;
        case 4: N = 1024; K = 2816; off = W_OUT0; break;
        case 5: N = 1024; K = 2816; off = W_OUT1; break;
        case 6: N = 768; K = 1024; off = W_D; break;
        case 7: N = 2048; K = 256; off = W_UKV; break;
        case 8: N = 1536; K = 384; off = W_UQ; break;
        default: N = 1024; K = 1024; off = W_OB; break;
    }
}
__device__ __forceinline__ WSrc wsrc(const Params& p, int id, int n0) {
    WSrc s; s.gain = nullptr; s.gmask = 0; s.scale = 1.f; s.W = nullptr; s.pitch = 0; s.col0 = 0;
    switch (id) {
        case 0: s.W = p.in[I_A_WQKV]; s.pitch = 3072; s.col0 = n0; s.gain = p.in[I_A_NORM]; s.gmask = 1023; s.scale = n0 < 1024 ? QS_A : 1.f; break;
        case 1: s.W = p.in[I_A_WO]; s.pitch = 1024; s.col0 = n0; s.gain = p.in[I_A_SUB]; s.gmask = 127; s.scale = 1.f - LAM_INIT; break;
        case 2: case 3: { const int l = id - 2; s.W = p.in[I_FFN_WIN] + (size_t)l * 1024 * 5632; s.pitch = 5632; const int j = n0 >> 8, u = n0 & 255;
            s.col0 = u < 128 ? 128 * j + u : DFF + 128 * j + (u - 128); s.gain = p.in[I_FFN_NORM] + l * 1024; s.gmask = 1023; break; }
        case 4: case 5: { const int l = id - 4; s.W = p.in[I_FFN_WOUT] + (size_t)l * DFF * 1024; s.pitch = 1024; s.col0 = n0; break; }
        case 6: if (n0 < 384) { s.W = p.in[I_B_WDQ]; s.pitch = 384; s.col0 = n0; s.gain = p.in[I_B_NORM]; s.gmask = 1023; }
                else if (n0 < 672) { s.W = p.in[I_KV_WDKV]; s.pitch = 288; s.col0 = n0 - 384; s.gain = p.in[I_KV_NORM]; s.gmask = 1023; }
                break;
        case 7: s.W = p.in[I_KV_WUKV]; s.pitch = 2048; s.col0 = n0; s.gain = p.in[I_KV_ANORM]; s.gmask = 255; break;
        case 8: s.W = p.in[I_B_WUQ]; s.pitch = 1536; s.col0 = n0; s.gain = p.in[I_B_QANORM]; s.gmask = 511; s.scale = QS_B; break;
        default: s.W = p.in[I_B_WO]; s.pitch = 1024; s.col0 = n0; break;
    }
    return s;
}
__device__ __forceinline__ void transpose_item(const WSrc& s, int K, bf16_t* WT, int k0, int n0, LAS float* scr, int lane) {
    if (s.W) {
#pragma unroll 8
        for (int i = 0; i < 32; ++i) { const int kk = 2 * i + (lane >> 5); float g = s.scale; if (s.gain) g *= s.gain[(k0 + kk) & s.gmask];
            scr[kk * 33 + (lane & 31)] = s.W[(size_t)(k0 + kk) * s.pitch + s.col0 + (lane & 31)] * g; }
    } else {
#pragma unroll 8
        for (int i = 0; i < 32; ++i) { const int kk = 2 * i + (lane >> 5); scr[kk * 33 + (lane & 31)] = 0.f; }
    }
    asm volatile("s_waitcnt lgkmcnt(0)" ::: "memory");
    const int c = lane & 7;
#pragma unroll
    for (int j = 0; j < 4; ++j) { const int n = (lane >> 3) + 8 * j; const LAS float* q = scr + (8 * c) * 33 + n;
        u32x4 o; o.x = pk2(q[0 * 33], q[1 * 33]); o.y = pk2(q[2 * 33], q[3 * 33]); o.z = pk2(q[4 * 33], q[5 * 33]); o.w = pk2(q[6 * 33], q[7 * 33]);
        *(u32x4*)(WT + (size_t)(n0 + n) * K + k0 + 8 * c) = o; }
    asm volatile("s_waitcnt lgkmcnt(0)" ::: "memory");
}
__device__ __forceinline__ void ph_prologue(const Params& p, const Ctx& c) {
    LAS float* scr = (LAS float*)(c.lds + c.wave * 16384);
    int base = 0;
    for (int id = 0; id < 10; ++id) {
        int N, K; size_t off; wdims(id, N, K, off);
        const int nkb = K / 64, nnb = N / 32, items = nkb * nnb;
        for (int it = ((c.gw - base) % c.ngw + c.ngw) % c.ngw; it < items; it += c.ngw) {
            const int kb = it / nnb, nb = it % nnb; const WSrc s = wsrc(p, id, nb * 32);
            transpose_item(s, K, (bf16_t*)(p.ws + off), kb * 64, nb * 32, scr, c.lane); }
        base += items;
    }
    { float2* TA = (float2*)(p.ws + WS_ROPE); float2* TB = TA + 2064 * 8;
      const int gt = c.gw * 64 + c.lane, ngt = c.ngw * 64;
      for (int i = gt; i < 2064 * 8; i += ngt) { const int pos = i >> 3, k = i & 7; const float inv = 1.0f / powf(500000.0f, (float)k / 8.0f); const float a = (float)pos * inv; TA[i] = make_float2(cosf(a), sinf(a)); }
      for (int i = gt; i < 2064 * 16; i += ngt) { const int pos = i >> 4, k = i & 15; const float inv = 1.0f / powf(10000.0f, (float)k / 16.0f); const float a = (float)pos * inv; TB[i] = make_float2(cosf(a), sinf(a)); } }
    { float* r1 = rss_ptr(p, 1); const int gt = c.gw * 64 + c.lane, ngt = c.ngw * 64; for (int i = gt; i < 6 * RT; i += ngt) r1[i] = 0.f; }
    float* rss0 = rss_ptr(p, 0);
    for (int r = c.gw; r < RT; r += c.ngw) {
        const float* src = r < RR ? p.in[I_X] + (size_t)r * D : (r < RV ? p.in[I_META] + (size_t)(r - RR) * D : nullptr);
        f32x4 v[4]; float ss = 0.f;
#pragma unroll
        for (int j = 0; j < 4; ++j) { v[j] = src ? *(const f32x4*)(src + 4 * c.lane + 256 * j) : (f32x4){0.f, 0.f, 0.f, 0.f}; ss += v[j].x * v[j].x + v[j].y * v[j].y + v[j].z * v[j].z + v[j].w * v[j].w; }
        ss = wave_sum(ss);
        float* h = hrow(p, r); bf16_t* hb = (bf16_t*)(p.ws + WS_HB) + (size_t)r * D;
#pragma unroll
        for (int j = 0; j < 4; ++j) { *(f32x4*)(h + 4 * c.lane + 256 * j) = v[j]; u32x2 w; w.x = pk2(v[j].x, v[j].y); w.y = pk2(v[j].z, v[j].w); *(u32x2*)(hb + 4 * c.lane + 256 * j) = w; }
        if (c.lane == 0) rss0[r] = ss;
    }
}
__device__ __forceinline__ void ph_rowstat(const Params& p, const Ctx& c, int site) {
    float* rss = rss_ptr(p, site);
    for (int r = c.gw; r < RT; r += c.ngw) {
        const float* h = hrow(p, r); f32x4 v[4]; float ss = 0.f;
#pragma unroll
        for (int j = 0; j < 4; ++j) { v[j] = *(const f32x4*)(h + 4 * c.lane + 256 * j); ss += v[j].x * v[j].x + v[j].y * v[j].y + v[j].z * v[j].z + v[j].w * v[j].w; }
        ss = wave_sum(ss);
        bf16_t* hb = (bf16_t*)(p.ws + WS_HB) + (size_t)r * D;
#pragma unroll
        for (int j = 0; j < 4; ++j) { u32x2 w; w.x = pk2(v[j].x, v[j].y); w.y = pk2(v[j].z, v[j].w); *(u32x2*)(hb + 4 * c.lane + 256 * j) = w; }
        if (c.lane == 0) rss[r] = ss;
    }
}
__device__ __forceinline__ void ph_final(const Params& p, const Ctx& c) {
    const float* g = p.in[I_FINAL];
    for (int r = c.gw; r < RR; r += c.ngw) {
        float* h = p.out + (size_t)r * D; f32x4 v[4]; float ss = 0.f;
#pragma unroll
        for (int j = 0; j < 4; ++j) { v[j] = *(const f32x4*)(h + 4 * c.lane + 256 * j); ss += v[j].x * v[j].x + v[j].y * v[j].y + v[j].z * v[j].z + v[j].w * v[j].w; }
        ss = wave_sum(ss); const float rstd = 1.0f / sqrtf(ss * (1.0f / D) + EPS);
#pragma unroll
        for (int j = 0; j < 4; ++j) { const f32x4 gg = *(const f32x4*)(g + 4 * c.lane + 256 * j); *(f32x4*)(h + 4 * c.lane + 256 * j) = v[j] * rstd * gg; }
    }
}

template <class Epi>
__device__ __forceinline__ void gemm_simple(const bf16_t* A, int lda, const bf16_t* Bt, int K, int N, int nrows, const Epi& epi, const Ctx& c) {
    const int nct = N / 64, nrt = (nrows + 31) / 32, items = nrt * nct;
    const int l15 = c.lane & 15, q4 = c.lane >> 4;
    for (int it = c.gw; it < items; it += c.ngw) {
        const int rt = it / nct, ct = it % nct;
        f32x4 acc[2][4];
#pragma unroll
        for (int m = 0; m < 2; ++m)
#pragma unroll
            for (int n = 0; n < 4; ++n) acc[m][n] = (f32x4){0.f, 0.f, 0.f, 0.f};
        const bf16_t* ap = A + (size_t)(rt * 32 + l15) * lda + 8 * q4;
        const bf16_t* bp = Bt + (size_t)(ct * 64 + l15) * K + 8 * q4;
        for (int k0 = 0; k0 < K; k0 += 32) {
            bf16x8 a[2], b[4];
#pragma unroll
            for (int m = 0; m < 2; ++m) a[m] = *(const bf16x8*)(ap + (size_t)(16 * m) * lda + k0);
#pragma unroll
            for (int n = 0; n < 4; ++n) b[n] = *(const bf16x8*)(bp + (size_t)(16 * n) * K + k0);
#pragma unroll
            for (int m = 0; m < 2; ++m)
#pragma unroll
                for (int n = 0; n < 4; ++n) acc[m][n] = __builtin_amdgcn_mfma_f32_16x16x32_bf16(a[m], b[n], acc[m][n], 0, 0, 0);
        }
#pragma unroll
        for (int m = 0; m < 2; ++m)
#pragma unroll
            for (int n = 0; n < 4; ++n)
#pragma unroll
                for (int i = 0; i < 4; ++i) epi(rt * 32 + 16 * m + 4 * q4 + i, ct * 64 + 16 * n + l15, acc[m][n][i]);
    }
}
struct EpiQKV { const float* rss; bf16_t* Q; bf16_t* K; bf16_t* V;
    __device__ __forceinline__ void operator()(int row, int col, float v) const { v *= 1.0f / sqrtf(rss[row] * (1.0f / D) + EPS);
        Q[(size_t)(col >> 10) * (ROWB1024 / 2) + (size_t)row * 1024 + (col & 1023)] = (bf16_t)f2bf(v); } };
struct EpiRes { float* out; float* hmeta;
    __device__ __forceinline__ void operator()(int row, int col, float v) const { float* h = row < RR ? out + (size_t)row * D : hmeta + (size_t)(row - RR) * D; h[col] += v; } };
struct EpiD { const float* rss; bf16_t* CQ; bf16_t* CKV; bf16_t* KR;
    __device__ __forceinline__ void operator()(int row, int col, float v) const { v *= 1.0f / sqrtf(rss[row] * (1.0f / D) + EPS); const bf16_t b = (bf16_t)f2bf(v);
        if (col < 384) CQ[(size_t)row * 384 + col] = b; else if (col < 640) CKV[(size_t)row * 256 + col - 384] = b; else if (col < 672) KR[(size_t)row * 32 + col - 640] = b; } };
struct EpiScaled { const float* rss; float invk; bf16_t* O; int ldo;
    __device__ __forceinline__ void operator()(int row, int col, float v) const { v *= 1.0f / sqrtf(rss[row] * invk + EPS); O[(size_t)row * ldo + col] = (bf16_t)f2bf(v); } };

namespace pg8 {
#define PG8_LAS __attribute__((address_space(3)))
typedef unsigned short bf16_t;
typedef short bf16x8 __attribute__((ext_vector_type(8)));
typedef float f32x4 __attribute__((ext_vector_type(4)));
typedef unsigned u32x4 __attribute__((ext_vector_type(4)));
constexpr int BM = 256, BK = 64, HALF = 128, HTB = HALF * BK * 2  , STAGE_BYTES = 8 * HTB, NXCD = 8, WGM = 8;

__host__ __device__ __forceinline__ int lds_byte(int r, int c) { const int st = (r >> 4) * 2 + (c >> 5), rr = r & 15, cc = c & 31, ob = rr * 64 + cc * 2; return st * 1024 + (ob ^ (((ob >> 9) & 1) << 5)); }
__host__ __device__ __forceinline__ void stage_rc(int b, int& R, int& C) { const int st = b / 1024, sb = b % 1024, swz = sb ^ (((sb >> 9) & 1) << 5); R = (st >> 1) * 16 + swz / 64; C = (st & 1) * 32 + (swz % 64) / 2; }
__host__ __device__ __forceinline__ int perm32(int rho) { const int n = rho >> 4, i = rho & 15; return 8 * (i >> 2) + 4 * n + (i & 3); }

struct Unit { int pm, pn; };
struct Gemm { const bf16_t* A; const bf16_t* Bt; int M, N, K; };

struct StaticOrder {
    int nM, nN, nwg, G, c;
    __host__ __device__ void init(int M, int N, int G_, int c_) { nM = M / BM; nN = N / BM; nwg = nM * nN; G = G_; c = c_; }
    __host__ __device__ bool next(int i, Unit& u) const {
        const long L = (long)i * G + c; if (L >= nwg) return false;
        int wgid = (int)L; { const int q = nwg / NXCD, r = nwg % NXCD, xcd = wgid % NXCD, off = wgid / NXCD; wgid = (xcd < r ? xcd * (q + 1) : r * (q + 1) + (xcd - r) * q) + off; }
        const int nig = WGM * nN, gid = wgid / nig, fm = gid * WGM, gsz = (nM - fm) < WGM ? (nM - fm) : WGM;
        u.pm = fm + ((wgid % nig) % gsz); u.pn = (wgid % nig) / gsz; return true;
    }
    __device__ __forceinline__ void a_ready(const Unit&) const {}
    __device__ __forceinline__ void done(const Unit&) const {}
};
template <class Epi, class Sched, bool ALIGN_EPI = false, bool SP2 = false>
__device__ __forceinline__ void gemm_phase(PG8_LAS unsigned char* lds, const Gemm g, const Sched& S, const Epi& E, const int tid_in) {
    const int tid = tid_in, wid = __builtin_amdgcn_readfirstlane(tid >> 6), lane = tid & 63, wr = wid >> 2, wc = wid & 3, fr = lane & 15, fq = lane >> 4;
    const int K = g.K, nt = K / BK;
    unsigned voffA[2], voffB[2];
#pragma unroll
    for (int i = 0; i < 2; ++i) { int R, C; stage_rc(tid * 16 + i * 8192, R, C); const int Rb = Epi::PERM ? ((R & ~31) + perm32(R & 31)) : R;
        voffA[i] = (unsigned)(R * K + C) * 2u; voffB[i] = (unsigned)(Rb * K + C) * 2u; }
    const size_t kstep = (size_t)(BK * 2);
    const size_t hstep = (size_t)HALF * K * 2;
    const size_t tstep = 2 * hstep;
    const unsigned ldsw = (unsigned)wid * 1024u;
    const int aoff = lds_byte(wr * 64 + fr, fq * 8), boff = lds_byte(wc * 32 + fr, fq * 8);
#define PG8_SA(b, h) (((b) * 2 + (h)) * HTB)
#define PG8_SB(b, h) ((4 + (b) * 2 + (h)) * HTB)
#define PG8_STAGE(bufoff, gbase, voff) do { _Pragma("unroll") for (int _i = 0; _i < 2; ++_i) \
        __builtin_amdgcn_global_load_lds((const unsigned*)((const char*)(gbase) + (voff)[_i]), (PG8_LAS unsigned*)(lds + (bufoff) + ldsw + _i * 8192), 16, 0, 0); } while (0)
#define PG8_LDA(dst, b, h) do { _Pragma("unroll") for (int m = 0; m < 4; ++m) _Pragma("unroll") for (int k = 0; k < 2; ++k) dst[m][k] = *(const PG8_LAS bf16x8*)(lds + PG8_SA(b, h) + aoff + m * 2048 + k * 1024); } while (0)
#define PG8_LDB(dst, b, h) do { _Pragma("unroll") for (int n = 0; n < 2; ++n) _Pragma("unroll") for (int k = 0; k < 2; ++k) dst[n][k] = *(const PG8_LAS bf16x8*)(lds + PG8_SB(b, h) + boff + n * 2048 + k * 1024); } while (0)
#define PG8_MMA(ai, bj, At, Bt) do { __builtin_amdgcn_s_setprio(1); _Pragma("unroll") for (int m = 0; m < 4; ++m) _Pragma("unroll") for (int n = 0; n < 2; ++n) _Pragma("unroll") for (int k = 0; k < 2; ++k) \
        acc[ai][bj][m][n] = __builtin_amdgcn_mfma_f32_16x16x32_bf16(Bt[n][k], At[m][k], acc[ai][bj][m][n], 0, 0, 0); __builtin_amdgcn_s_setprio(0); } while (0)
#define PG8_WAIT_V(n) asm volatile("s_waitcnt vmcnt(" #n ")" ::: "memory")
#define PG8_WAIT_L(n) asm volatile("s_waitcnt lgkmcnt(" #n ")" ::: "memory")
#define PG8_BAR __builtin_amdgcn_s_barrier()
#define PG8_SCHED __builtin_amdgcn_sched_barrier(0)
    Unit cur, nxt; int ui = 0;
    if (!S.next(0, cur)) return;
    f32x4 acc[2][2][4][2];
#pragma unroll
    for (int a = 0; a < 2; ++a)
#pragma unroll
        for (int b = 0; b < 2; ++b)
#pragma unroll
            for (int m = 0; m < 4; ++m)
#pragma unroll
                for (int n = 0; n < 2; ++n) acc[a][b][m][n] = (f32x4){0.f, 0.f, 0.f, 0.f};
    bf16x8 At[4][2], B0[2][2], B1[2][2];
    const char* cA = (const char*)g.A + (size_t)cur.pm * tstep; const char* cB = (const char*)g.Bt + (size_t)cur.pn * tstep;
    S.a_ready(cur);
    if constexpr (SP2) {
        PG8_STAGE(PG8_SB(0, 0), cB, voffB); PG8_STAGE(PG8_SB(0, 1), cB + hstep, voffB); PG8_STAGE(PG8_SA(0, 0), cA, voffA); PG8_STAGE(PG8_SA(0, 1), cA + hstep, voffA);
        if (wr == 1) PG8_BAR;
        PG8_WAIT_V(2); PG8_BAR;
        PG8_STAGE(PG8_SB(1, 0), cB + kstep, voffB); PG8_STAGE(PG8_SA(1, 0), cA + kstep, voffA); PG8_STAGE(PG8_SB(1, 1), cB + hstep + kstep, voffB);
        PG8_WAIT_V(6); PG8_BAR;
    } else {
        PG8_STAGE(PG8_SB(0, 0), cB, voffB); PG8_STAGE(PG8_SA(0, 0), cA, voffA); PG8_STAGE(PG8_SB(0, 1), cB + hstep, voffB); PG8_STAGE(PG8_SA(0, 1), cA + hstep, voffA);
        if (wr == 1) PG8_BAR;
        PG8_WAIT_V(4); PG8_BAR;
        PG8_STAGE(PG8_SB(1, 0), cB + kstep, voffB); PG8_STAGE(PG8_SA(1, 0), cA + kstep, voffA); PG8_STAGE(PG8_SB(1, 1), cB + hstep + kstep, voffB);
        PG8_WAIT_V(6); PG8_BAR;
    }
    for (;;) {
        const bool has_next = S.next(ui + 1, nxt);
        const char* nA = has_next ? (const char*)g.A + (size_t)nxt.pm * tstep : cA; const char* nB = has_next ? (const char*)g.Bt + (size_t)nxt.pn * tstep : cB;
        for (int t = 0; t < nt; t += 2) {
            const bool last = (t == nt - 2);
            const char* a1 = cA + (size_t)(t + 1) * kstep;
            const char* a2 = last ? nA : cA + (size_t)(t + 2) * kstep; const char* b2 = last ? nB : cB + (size_t)(t + 2) * kstep;
            const char* a3 = a2 + kstep; const char* b3 = b2 + kstep;
            if (last && has_next) S.a_ready(nxt);
            if constexpr (SP2) {
            PG8_LDB(B0, 0, 0); PG8_LDB(B1, 0, 1); PG8_SCHED; PG8_LDA(At, 0, 0); PG8_STAGE(PG8_SA(1, 1), a1 + hstep, voffA);
            PG8_WAIT_V(8); PG8_WAIT_L(0); PG8_BAR; PG8_MMA(0, 0, At, B0); PG8_MMA(0, 1, At, B1); PG8_BAR; PG8_SCHED;
            PG8_LDA(At, 0, 1); PG8_STAGE(PG8_SB(0, 0), b2, voffB); PG8_STAGE(PG8_SB(0, 1), b2 + hstep, voffB); PG8_STAGE(PG8_SA(0, 0), a2, voffA);
            PG8_WAIT_V(8); PG8_WAIT_L(0); PG8_BAR; PG8_MMA(1, 0, At, B0); PG8_MMA(1, 1, At, B1); PG8_BAR; PG8_SCHED;
            PG8_LDB(B0, 1, 0); PG8_LDB(B1, 1, 1); PG8_SCHED; PG8_LDA(At, 1, 0); PG8_STAGE(PG8_SA(0, 1), a2 + hstep, voffA);
            PG8_WAIT_V(8); PG8_WAIT_L(0); PG8_BAR; PG8_MMA(0, 0, At, B0); PG8_MMA(0, 1, At, B1); PG8_BAR; PG8_SCHED;
            PG8_LDA(At, 1, 1); PG8_STAGE(PG8_SB(1, 0), b3, voffB); PG8_STAGE(PG8_SB(1, 1), b3 + hstep, voffB); PG8_STAGE(PG8_SA(1, 0), a3, voffA);
            PG8_WAIT_V(8); PG8_WAIT_L(0); PG8_BAR; PG8_MMA(1, 0, At, B0); PG8_MMA(1, 1, At, B1); PG8_BAR; PG8_SCHED;
            } else {
            PG8_LDB(B0, 0, 0); PG8_SCHED; PG8_LDA(At, 0, 0); PG8_STAGE(PG8_SA(1, 1), a1 + hstep, voffA);
            PG8_WAIT_L(8); PG8_BAR; PG8_WAIT_L(0); PG8_MMA(0, 0, At, B0); PG8_BAR; PG8_SCHED;
            PG8_LDB(B1, 0, 1); PG8_STAGE(PG8_SB(0, 0), b2, voffB);
            PG8_BAR; PG8_WAIT_L(0); PG8_MMA(0, 1, At, B1); PG8_BAR;
            PG8_LDA(At, 0, 1); PG8_STAGE(PG8_SA(0, 0), a2, voffA);
            PG8_BAR; PG8_WAIT_L(0); PG8_MMA(1, 0, At, B0); PG8_BAR; PG8_SCHED;
            PG8_STAGE(PG8_SB(0, 1), b2 + hstep, voffB);
            PG8_WAIT_V(6); PG8_BAR; PG8_MMA(1, 1, At, B1); PG8_BAR;
            PG8_LDB(B0, 1, 0); PG8_SCHED; PG8_LDA(At, 1, 0); PG8_STAGE(PG8_SA(0, 1), a2 + hstep, voffA);
            PG8_WAIT_L(8); PG8_BAR; PG8_WAIT_L(0); PG8_MMA(0, 0, At, B0); PG8_BAR; PG8_SCHED;
            PG8_LDB(B1, 1, 1); PG8_STAGE(PG8_SB(1, 0), b3, voffB);
            PG8_BAR; PG8_WAIT_L(0); PG8_MMA(0, 1, At, B1); PG8_BAR;
            PG8_LDA(At, 1, 1); PG8_STAGE(PG8_SA(1, 0), a3, voffA);
            PG8_BAR; PG8_WAIT_L(0); PG8_MMA(1, 0, At, B0); PG8_BAR; PG8_SCHED;
            PG8_STAGE(PG8_SB(1, 1), b3 + hstep, voffB);
            PG8_WAIT_V(6); PG8_BAR; PG8_MMA(1, 1, At, B1); PG8_BAR;
            }
        }
        if constexpr (ALIGN_EPI) { if (wr == 0) PG8_BAR; }
        if constexpr (!Epi::AFTER_DRAIN) { E(acc, cur, wr, wc, fr, fq); S.done(cur); }
        if (!has_next) break;
#pragma unroll
        for (int a = 0; a < 2; ++a)
#pragma unroll
            for (int b = 0; b < 2; ++b)
#pragma unroll
                for (int m = 0; m < 4; ++m)
#pragma unroll
                    for (int n = 0; n < 2; ++n) acc[a][b][m][n] = (f32x4){0.f, 0.f, 0.f, 0.f};
        cur = nxt; cA = nA; cB = nB; ++ui;
        if constexpr (ALIGN_EPI) { if (wr == 1) PG8_BAR; }
    }
    PG8_WAIT_V(0);
    if constexpr (!ALIGN_EPI) { if (wr == 0) PG8_BAR; }
    PG8_BAR;
    if constexpr (Epi::AFTER_DRAIN) { E.fused(acc, cur, wr, wc, fr, fq, lds, wid, lane); S.done(cur); }
#undef PG8_SA
#undef PG8_SB
#undef PG8_STAGE
#undef PG8_LDA
#undef PG8_LDB
#undef PG8_MMA
#undef PG8_WAIT_V
#undef PG8_WAIT_L
#undef PG8_BAR
#undef PG8_SCHED
}

__device__ __forceinline__ unsigned cvt2(float lo, float hi) { typedef float f32x2_t __attribute__((ext_vector_type(2))); typedef __bf16 bf16x2_t __attribute__((ext_vector_type(2)));
    f32x2_t v = {lo, hi}; bf16x2_t b = __builtin_convertvector(v, bf16x2_t); return __builtin_bit_cast(unsigned, b); }
__device__ __forceinline__ u32x4 pack8(const f32x4& v0, const f32x4& v1) { u32x4 w; w.x = cvt2(v0[0], v0[1]); w.y = cvt2(v0[2], v0[3]); w.z = cvt2(v1[0], v1[1]); w.w = cvt2(v1[2], v1[3]); return w; }
__device__ __forceinline__ float rstdf(const float* rss, int row, float invk) { return 1.0f / sqrtf(rss[row] * invk + EPS); }

struct FEpiQKV {
    static constexpr bool PERM = true, AFTER_DRAIN = false;
    const float* rss; bf16_t* Q; const float* TA;
    __device__ __forceinline__ void operator()(const f32x4 (&acc)[2][2][4][2], const Unit& u, int wr, int wc, int fr_, int fq_) const {
        (void)fr_; (void)fq_; int lane_e; asm volatile("v_mbcnt_lo_u32_b32 %0, -1, 0\n\tv_mbcnt_hi_u32_b32 %0, -1, %0" : "=v"(lane_e));
        const int fr = lane_e & 15, fq = lane_e >> 4;
        const int colt = u.pn * BM, t = colt >> 10;
        bf16_t* base = Q + (size_t)t * (ROWB1024 / 2) + (colt & 1023) + wc * 32 + 8 * fq;
        const bool rot = (t < 2) && ((wc & 1) == 0);
        const float sgn = fq == 0 ? -1.f : 1.f; const bool mine = fq < 2;
#pragma unroll
        for (int ai = 0; ai < 2; ++ai)
#pragma unroll
            for (int m = 0; m < 4; ++m) {
                const int row = u.pm * BM + ai * HALF + wr * 64 + m * 16 + fr;
                const float rs = rstdf(rss, row, 1.0f / 1024.0f);
                f32x4 cs[4];
                if (rot) { const f32x4* tp = (const f32x4*)(TA + (size_t)row_pos(row) * 16);
#pragma unroll
                    for (int k = 0; k < 4; ++k) cs[k] = tp[k]; }
#pragma unroll
                for (int bj = 0; bj < 2; ++bj) {
                    f32x4 v0 = acc[ai][bj][m][0] * rs, v1 = acc[ai][bj][m][1] * rs;
                    if (rot) {
                        f32x4 r0, r1;
#pragma unroll
                        for (int e = 0; e < 4; ++e) { const float o0 = __shfl_xor(v0[e], 16), o1 = __shfl_xor(v1[e], 16);
                            r0[e] = v0[e] * cs[e >> 1][(e & 1) * 2] + sgn * o0 * cs[e >> 1][(e & 1) * 2 + 1];
                            r1[e] = v1[e] * cs[2 + (e >> 1)][(e & 1) * 2] + sgn * o1 * cs[2 + (e >> 1)][(e & 1) * 2 + 1]; }
                        if (mine) { v0 = r0; v1 = r1; }
                    }
                    *(u32x4*)(base + (size_t)row * 1024 + bj * HALF) = pack8(v0, v1);
                }
            }
    }
};
struct FEpiRes {
    static constexpr bool PERM = true, AFTER_DRAIN = false;
    float* out; float* hmeta; bf16_t* HB; float* rss;
    __device__ __forceinline__ void operator()(const f32x4 (&acc)[2][2][4][2], const Unit& u, int wr, int wc, int fr_, int fq_) const {
        (void)fr_; (void)fq_; int lane_e; asm volatile("v_mbcnt_lo_u32_b32 %0, -1, 0\n\tv_mbcnt_hi_u32_b32 %0, -1, %0" : "=v"(lane_e));
        const int fr = lane_e & 15, fq = lane_e >> 4;
        float* hb_ = u.pm < 64 ? out + (size_t)u.pm * BM * 1024 : hmeta;
        const int col0 = u.pn * BM + wc * 32 + 8 * fq;
#pragma unroll
        for (int ai = 0; ai < 2; ++ai)
#pragma unroll
            for (int m = 0; m < 4; ++m) {
                const int rl = ai * HALF + wr * 64 + m * 16 + fr, row = u.pm * BM + rl; float* hp = hb_ + (size_t)rl * 1024 + col0;
                float ss = 0.f;
#pragma unroll
                for (int bj = 0; bj < 2; ++bj) {
                    const f32x4 h0 = *(const f32x4*)(hp + bj * HALF) + acc[ai][bj][m][0], h1 = *(const f32x4*)(hp + bj * HALF + 4) + acc[ai][bj][m][1];
                    *(f32x4*)(hp + bj * HALF) = h0; *(f32x4*)(hp + bj * HALF + 4) = h1;
                    ss += (h0[0] * h0[0] + h0[1] * h0[1]) + (h0[2] * h0[2] + h0[3] * h0[3]) + (h1[0] * h1[0] + h1[1] * h1[1]) + (h1[2] * h1[2] + h1[3] * h1[3]);
                    if (HB) *(u32x4*)(HB + (size_t)row * 1024 + col0 + bj * HALF) = pack8(h0, h1);
                    asm volatile("" ::: "memory");
                }
                ss += __shfl_xor(ss, 16); ss += __shfl_xor(ss, 32);
                if (fq == 0) atomicAdd(rss + row, ss);
                asm volatile("" ::: "memory");
            }
    }
};
struct FEpiFFN {
    static constexpr bool PERM = true, AFTER_DRAIN = false;
    const float* rss; const float* cw; const float* cb; bf16_t* G; float* SA; float* SB; PG8_LAS float* X;
    __device__ __forceinline__ void operator()(const f32x4 (&acc)[2][2][4][2], const Unit& u, int wr, int wc, int fr_, int fq_) const {
        (void)fr_; (void)fq_; int lane_e; asm volatile("v_mbcnt_lo_u32_b32 %0, -1, 0\n\tv_mbcnt_hi_u32_b32 %0, -1, %0" : "=v"(lane_e));
        const int fr = lane_e & 15, fq = lane_e >> 4;
        const int lane = fr + 16 * fq;
        const int cc0 = u.pn * HALF + wc * 32 + 8 * fq;
        f32x4 w0[2], w1[2], w2[2], bs[2];
#pragma unroll
        for (int n = 0; n < 2; ++n) { w0[n] = *(const f32x4*)(cw + cc0 + 4 * n); w1[n] = *(const f32x4*)(cw + DFF + cc0 + 4 * n); w2[n] = *(const f32x4*)(cw + 2 * DFF + cc0 + 4 * n); bs[n] = *(const f32x4*)(cb + cc0 + 4 * n); }
        float rsl[2];
#pragma unroll
        for (int ai = 0; ai < 2; ++ai) { const int row = u.pm * BM + ai * HALF + wr * 64 + 48 + fr; rsl[ai] = rstdf(rss, row, 1.0f / 1024.0f);
            if (fr >= 14) { PG8_LAS float* xp = X + (((2 * ai + wr) * 4 + wc) * 2 + (fr - 14)) * 32 + 8 * fq;
                *(PG8_LAS f32x4*)xp = acc[ai][0][3][0] * rsl[ai]; *(PG8_LAS f32x4*)(xp + 4) = acc[ai][0][3][1] * rsl[ai]; } }
        asm volatile("s_waitcnt lgkmcnt(0)" ::: "memory"); __builtin_amdgcn_s_barrier(); asm volatile("" ::: "memory");
        const int src1 = (lane & 48) | ((fr - 1) & 15), src2 = (lane & 48) | ((fr - 2) & 15);
#pragma unroll
        for (int ai = 0; ai < 2; ++ai) {
            const int strip = 2 * ai + wr;
            f32x4 pa[2] = {(f32x4){0.f, 0.f, 0.f, 0.f}, (f32x4){0.f, 0.f, 0.f, 0.f}};
#pragma unroll
            for (int m = 0; m < 4; ++m) {
                const int rl = ai * HALF + wr * 64 + m * 16 + fr, row = u.pm * BM + rl;
                const float rs = rstdf(rss, row, 1.0f / 1024.0f);
                f32x4 a[2], b[2], p1[2], p2[2];
#pragma unroll
                for (int n = 0; n < 2; ++n) { a[n] = acc[ai][0][m][n] * rs; b[n] = acc[ai][1][m][n] * rs; }
#pragma unroll
                for (int n = 0; n < 2; ++n)
#pragma unroll
                    for (int e = 0; e < 4; ++e) { const float s1 = (m > 0 && fr == 15) ? pa[n][e] : a[n][e], s2 = (m > 0 && fr >= 14) ? pa[n][e] : a[n][e];
                        p1[n][e] = __shfl(s1, src1); p2[n][e] = __shfl(s2, src2); }
                if (m == 0 && strip > 0) {
                    const PG8_LAS float* xp = X + (((strip - 1) * 4 + wc) * 2) * 32 + 8 * fq;
#pragma unroll
                    for (int n = 0; n < 2; ++n) { const f32x4 h62 = *(const PG8_LAS f32x4*)(xp + 4 * n), h63 = *(const PG8_LAS f32x4*)(xp + 32 + 4 * n);
                        if (fr == 0) { p1[n] = h63; p2[n] = h62; } else if (fr == 1) { p2[n] = h63; } }
                }
                f32x4 g[2];
#pragma unroll
                for (int n = 0; n < 2; ++n)
#pragma unroll
                    for (int e = 0; e < 4; ++e) { const float ac = bs[n][e] + w0[n][e] * p2[n][e] + w1[n][e] * p1[n][e] + w2[n][e] * a[n][e];
                        g[n][e] = ac * __builtin_amdgcn_rcpf(1.0f + __builtin_amdgcn_exp2f(-LOG2E * ac)) * b[n][e]; }
                const bool head = (strip == 0 && m == 0 && fr < 2);
                if (!head) *(u32x4*)(G + (size_t)row * DFF + cc0) = pack8(g[0], g[1]);
                else { float* sa = SA + ((size_t)u.pm * 4 + fr) * DFF + cc0; float* sb = SB + ((size_t)u.pm * 2 + fr) * DFF + cc0;
                    *(f32x4*)sa = a[0]; *(f32x4*)(sa + 4) = a[1]; *(f32x4*)sb = b[0]; *(f32x4*)(sb + 4) = b[1]; }
                const bool tail = (u.pm < 64) ? (strip == 3 && m == 3 && fr >= 14) : (strip == 0 && m == 0 && fr >= 14);
                if (tail) { float* sa = SA + ((size_t)u.pm * 4 + 2 + (fr - 14)) * DFF + cc0; *(f32x4*)sa = a[0]; *(f32x4*)(sa + 4) = a[1]; }
                pa[0] = a[0]; pa[1] = a[1];
            }
        }
    }
};
__device__ __forceinline__ void rope32(f32x4& v0, f32x4& v1, const float* TB, int pos, int fq) {
    const f32x4* tp = (const f32x4*)(TB + (size_t)pos * 32 + 16 * (fq & 1)); const float sgn = fq < 2 ? -1.f : 1.f;
    f32x4 cs[4];
#pragma unroll
    for (int k = 0; k < 4; ++k) cs[k] = tp[k];
#pragma unroll
    for (int e = 0; e < 4; ++e) { const float o0 = __shfl_xor(v0[e], 32), o1 = __shfl_xor(v1[e], 32);
        v0[e] = v0[e] * cs[e >> 1][(e & 1) * 2] + sgn * o0 * cs[e >> 1][(e & 1) * 2 + 1];
        v1[e] = v1[e] * cs[2 + (e >> 1)][(e & 1) * 2] + sgn * o1 * cs[2 + (e >> 1)][(e & 1) * 2 + 1]; }
}
struct FEpiD {
    static constexpr bool PERM = true, AFTER_DRAIN = false;
    const float* rss; bf16_t* CQ; bf16_t* CKV; bf16_t* KR; float* rssq; float* rsskv; const float* TB;
    __device__ __forceinline__ void operator()(const f32x4 (&acc)[2][2][4][2], const Unit& u, int wr, int wc, int fr_, int fq_) const {
        (void)fr_; (void)fq_; int lane_e; asm volatile("v_mbcnt_lo_u32_b32 %0, -1, 0\n\tv_mbcnt_hi_u32_b32 %0, -1, %0" : "=v"(lane_e));
        const int fr = lane_e & 15, fq = lane_e >> 4;
#pragma unroll
        for (int ai = 0; ai < 2; ++ai)
#pragma unroll
            for (int m = 0; m < 4; ++m) {
                const int row = u.pm * BM + ai * HALF + wr * 64 + m * 16 + fr; const float rs = rstdf(rss, row, 1.0f / 1024.0f);
                float sq = 0.f, skv = 0.f;
#pragma unroll
                for (int bj = 0; bj < 2; ++bj) {
                    const int g128 = u.pn * 2 + bj, c = wc * 32 + 8 * fq;
                    f32x4 v0 = acc[ai][bj][m][0] * rs, v1 = acc[ai][bj][m][1] * rs;
                    const float s = (v0[0] * v0[0] + v0[1] * v0[1]) + (v0[2] * v0[2] + v0[3] * v0[3]) + (v1[0] * v1[0] + v1[1] * v1[1]) + (v1[2] * v1[2] + v1[3] * v1[3]);
                    if (g128 < 3) { sq += s; *(u32x4*)(CQ + (size_t)row * 384 + g128 * 128 + c) = pack8(v0, v1); }
                    else if (g128 < 5) { skv += s; *(u32x4*)(CKV + (size_t)row * 256 + (g128 - 3) * 128 + c) = pack8(v0, v1); }
                    else if (wc == 0) { rope32(v0, v1, TB, row_pos(row), fq); *(u32x4*)(KR + (size_t)row * 32 + c) = pack8(v0, v1); }
                }
                if (u.pn < 2) { sq += __shfl_xor(sq, 16); sq += __shfl_xor(sq, 32); if (fq == 0) atomicAdd(rssq + row, sq); }
                if (u.pn > 0) { skv += __shfl_xor(skv, 16); skv += __shfl_xor(skv, 32); if (fq == 0) atomicAdd(rsskv + row, skv); }
            }
    }
};
template <bool ROPE> struct FEpiUp {
    static constexpr bool PERM = true, AFTER_DRAIN = false;
    const float* rss; float invk; bf16_t* O; int ldo; const float* TB;
    __device__ __forceinline__ void operator()(const f32x4 (&acc)[2][2][4][2], const Unit& u, int wr, int wc, int fr_, int fq_) const {
        (void)fr_; (void)fq_; int lane_e; asm volatile("v_mbcnt_lo_u32_b32 %0, -1, 0\n\tv_mbcnt_hi_u32_b32 %0, -1, %0" : "=v"(lane_e));
        const int fr = lane_e & 15, fq = lane_e >> 4;
#pragma unroll
        for (int ai = 0; ai < 2; ++ai)
#pragma unroll
            for (int m = 0; m < 4; ++m) {
                const int row = u.pm * BM + ai * HALF + wr * 64 + m * 16 + fr; const float rs = rstdf(rss, row, invk);
#pragma unroll
                for (int bj = 0; bj < 2; ++bj) {
                    f32x4 v0 = acc[ai][bj][m][0] * rs, v1 = acc[ai][bj][m][1] * rs;
                    if (ROPE) { const int g32 = 8 * u.pn + 4 * bj + wc; if (g32 % 3 == 2) rope32(v0, v1, TB, row_pos(row), fq); }
                    *(u32x4*)(O + (size_t)row * ldo + u.pn * BM + bj * HALF + wc * 32 + 8 * fq) = pack8(v0, v1);
                    asm volatile("" ::: "memory");
                }
            }
    }
};
}

__device__ __forceinline__ void ph_rot_a(const Params& p, const Ctx& c) {
    const float2* TA = (const float2*)(p.ws + WS_ROPE);
    const int gt = c.gw * 64 + c.lane, ngt = c.ngw * 64;
    for (int t = gt; t < RV * 256; t += ngt) {
        const int i = t & 7, sh = (t >> 3) & 15, which = (t >> 7) & 1, row = t >> 8;
        bf16_t* buf = (bf16_t*)(p.ws + (which ? WS_K : WS_Q)) + (size_t)row * 1024 + sh * 64;
        const float x1 = bf2f(buf[i]), x2 = bf2f(buf[8 + i]); const float2 cs = TA[row_pos(row) * 8 + i];
        buf[i] = (bf16_t)f2bf(x1 * cs.x - x2 * cs.y); buf[8 + i] = (bf16_t)f2bf(x2 * cs.x + x1 * cs.y);
    }
}
__device__ __forceinline__ void ph_dpost(const Params& p, const Ctx& c) {
    const float2* TB = (const float2*)(p.ws + WS_ROPE) + 2064 * 8;
    const int gt = c.gw * 64 + c.lane, ngt = c.ngw * 64;
    for (int t = gt; t < RV * 16; t += ngt) {
        const int i = t & 15, row = t >> 4; bf16_t* buf = (bf16_t*)(p.ws + WS_KR) + (size_t)row * 32;
        const float x1 = bf2f(buf[i]), x2 = bf2f(buf[16 + i]); const float2 cs = TB[row_pos(row) * 16 + i];
        buf[i] = (bf16_t)f2bf(x1 * cs.x - x2 * cs.y); buf[16 + i] = (bf16_t)f2bf(x2 * cs.x + x1 * cs.y);
    }
    float* rq = rss_ptr(p, 5); float* rkv = rss_ptr(p, 6);
    for (int r = c.gw; r < RT; r += c.ngw) {
        const bf16_t* cq = (const bf16_t*)(p.ws + WS_CQ) + (size_t)r * 384; const bf16_t* ckv = (const bf16_t*)(p.ws + WS_CKV) + (size_t)r * 256;
        float s1 = 0.f, s2 = 0.f;
        for (int k = c.lane; k < 384; k += 64) { const float v = bf2f(cq[k]); s1 += v * v; }
        for (int k = c.lane; k < 256; k += 64) { const float v = bf2f(ckv[k]); s2 += v * v; }
        s1 = wave_sum(s1); s2 = wave_sum(s2);
        if (c.lane == 0) { rq[r] = s1; rkv[r] = s2; }
    }
}
__device__ __forceinline__ void ph_rot_b(const Params& p, const Ctx& c) {
    const float2* TB = (const float2*)(p.ws + WS_ROPE) + 2064 * 8;
    const int gt = c.gw * 64 + c.lane, ngt = c.ngw * 64;
    for (int t = gt; t < RV * 256; t += ngt) {
        const int i = t & 15, h = (t >> 4) & 15, row = t >> 8; bf16_t* buf = (bf16_t*)(p.ws + WS_Q2) + (size_t)row * 1536 + h * 96 + 64;
        const float x1 = bf2f(buf[i]), x2 = bf2f(buf[16 + i]); const float2 cs = TB[row_pos(row) * 16 + i];
        buf[i] = (bf16_t)f2bf(x1 * cs.x - x2 * cs.y); buf[16 + i] = (bf16_t)f2bf(x2 * cs.x + x1 * cs.y);
    }
}

__device__ __forceinline__ int prev_row(int r, int d, bool& has) {
    has = true;
    if (r < RR) { const int t = r & (SEQ - 1); if (t >= d) return r - d; return RV - d + t; }
    if (r < RV) { const int i = r - RR; if (i >= d) return r - d; has = false; return r; }
    has = false; return r;
}
__device__ __forceinline__ void ph_ffn_in(const Params& p, const Ctx& c, int layer, int site) {
    const bf16_t* A = (const bf16_t*)(p.ws + WS_HB); const bf16_t* Wt = (const bf16_t*)(p.ws + (layer ? W_IN1 : W_IN0));
    bf16_t* G = (bf16_t*)(p.ws + WS_G); const float* rss = rss_ptr(p, site);
    const float* cw = p.in[I_FFN_CW] + (size_t)layer * 3 * DFF; const float* cb = p.in[I_FFN_CB] + (size_t)layer * DFF;
    const int nct = DFF / 64, nrt = (RV + 15) / 16, items = nrt * nct;
    const int l15 = c.lane & 15, q4 = c.lane >> 4;
    for (int it = c.gw; it < items; it += c.ngw) {
        const int rt = it / nct, ct = it % nct;
        f32x4 a0[4], a1[4], a2[4], bb[4];
#pragma unroll
        for (int n = 0; n < 4; ++n) { a0[n] = a1[n] = a2[n] = bb[n] = (f32x4){0.f, 0.f, 0.f, 0.f}; }
        const int ra = rt * 16 + l15; bool h1, h2; const int r1 = prev_row(ra, 1, h1), r2 = prev_row(ra, 2, h2);
        const bf16_t* ap0 = A + (size_t)ra * D + 8 * q4; const bf16_t* ap1 = A + (size_t)r1 * D + 8 * q4; const bf16_t* ap2 = A + (size_t)r2 * D + 8 * q4;
        const bf16_t* bpa[4]; const bf16_t* bpb[4];
#pragma unroll
        for (int n = 0; n < 4; ++n) { const int cc = ct * 64 + 16 * n + l15; const int wr = 256 * (cc >> 7) + (cc & 127); bpa[n] = Wt + (size_t)wr * D + 8 * q4; bpb[n] = bpa[n] + (size_t)128 * D; }
        for (int k0 = 0; k0 < D; k0 += 32) {
            const bf16x8 x0 = *(const bf16x8*)(ap0 + k0), x1 = *(const bf16x8*)(ap1 + k0), x2 = *(const bf16x8*)(ap2 + k0);
#pragma unroll
            for (int n = 0; n < 4; ++n) { const bf16x8 wa = *(const bf16x8*)(bpa[n] + k0), wb = *(const bf16x8*)(bpb[n] + k0);
                a0[n] = __builtin_amdgcn_mfma_f32_16x16x32_bf16(x0, wa, a0[n], 0, 0, 0);
                a1[n] = __builtin_amdgcn_mfma_f32_16x16x32_bf16(x1, wa, a1[n], 0, 0, 0);
                a2[n] = __builtin_amdgcn_mfma_f32_16x16x32_bf16(x2, wa, a2[n], 0, 0, 0);
                bb[n] = __builtin_amdgcn_mfma_f32_16x16x32_bf16(x0, wb, bb[n], 0, 0, 0); }
        }
#pragma unroll
        for (int i = 0; i < 4; ++i) {
            const int row = rt * 16 + 4 * q4 + i; bool g1, g2; const int p1 = prev_row(row, 1, g1), p2 = prev_row(row, 2, g2);
            const float s0 = 1.0f / sqrtf(rss[row] * (1.0f / D) + EPS);
            const float s1 = g1 ? 1.0f / sqrtf(rss[p1] * (1.0f / D) + EPS) : 0.f, s2 = g2 ? 1.0f / sqrtf(rss[p2] * (1.0f / D) + EPS) : 0.f;
#pragma unroll
            for (int n = 0; n < 4; ++n) { const int cc = ct * 64 + 16 * n + l15;
                const float ac = cb[cc] + cw[cc] * (a2[n][i] * s2) + cw[DFF + cc] * (a1[n][i] * s1) + cw[2 * DFF + cc] * (a0[n][i] * s0);
                const float bv = bb[n][i] * s0; const float g = ac / (1.0f + __expf(-ac)) * bv;
                G[(size_t)row * DFF + cc] = (bf16_t)f2bf(g); }
        }
    }
}

__device__ __forceinline__ s16x4 vtr(const LAS unsigned char* p) { typedef short v4i16_t __attribute__((ext_vector_type(4)));
    return __builtin_bit_cast(s16x4, __builtin_amdgcn_ds_read_tr16_b64_v4i16((LAS v4i16_t*)p)); }
__device__ __forceinline__ unsigned cvtpk(float lo, float hi) { typedef float f32x2_t __attribute__((ext_vector_type(2))); typedef __bf16 bf16x2_t __attribute__((ext_vector_type(2)));
    f32x2_t v = {lo, hi}; bf16x2_t b = __builtin_convertvector(v, bf16x2_t); return __builtin_bit_cast(unsigned, b); }

struct SrcA { const bf16_t* K; const bf16_t* V; int h, s;
    __device__ __forceinline__ const bf16_t* kptr(int krow, int ch) const { return K + (size_t)krow * 1024 + h * 128 + s * 64 + ch * 8; }
    __device__ __forceinline__ const bf16_t* vptr(int krow, int ch) const { return V + (size_t)krow * 1024 + h * 128 + ch * 8; } };
struct SrcB { const bf16_t* KV; const bf16_t* KR; int h;
    __device__ __forceinline__ const bf16_t* kptr(int krow, int ch) const { return ch < 8 ? KV + (size_t)krow * 2048 + h * 128 + ch * 8 : KR + (size_t)krow * 32 + (ch - 8) * 8; }
    __device__ __forceinline__ const bf16_t* vptr(int krow, int ch) const { return KV + (size_t)krow * 2048 + h * 128 + 64 + ch * 8; } };

template <int DQK, int DV> struct ACfg { static constexpr int KS = DQK * 2 + 16, VS = DV * 2 + 64, KOFF = 0, VOFF = 64 * KS, SCR = VOFF + 64 * VS; };

template <int DQK, int DV, bool META>
__device__ __forceinline__ void attn_tile(const LAS unsigned char* Kt, const LAS unsigned char* Vt, LAS float* scr, const bf16x8 (&qf)[DQK / 16], f32x16 (&o)[DV / 32], float& m, float& lsum, int lane) {
    constexpr int KS = ACfg<DQK, DV>::KS, VS = ACfg<DQK, DV>::VS;
    const int r32 = lane & 31, hi = lane >> 5;
    f32x16 p0, p1;
#pragma unroll
    for (int r = 0; r < 16; ++r) { p0[r] = 0.f; p1[r] = 0.f; }
#pragma unroll
    for (int kk = 0; kk < DQK / 16; ++kk) {
        const bf16x8 k0 = *(const LAS bf16x8*)(Kt + r32 * KS + (16 * kk + 8 * hi) * 2);
        p0 = __builtin_amdgcn_mfma_f32_32x32x16_bf16(k0, qf[kk], p0, 0, 0, 0);
        if (!META) { const bf16x8 k1 = *(const LAS bf16x8*)(Kt + (32 + r32) * KS + (16 * kk + 8 * hi) * 2);
            p1 = __builtin_amdgcn_mfma_f32_32x32x16_bf16(k1, qf[kk], p1, 0, 0, 0); }
        if (kk & 1) __builtin_amdgcn_sched_barrier(0);
    }
    float mx = -INFINITY;
    if (META) {
#pragma unroll
        for (int r = 0; r < 8; ++r) mx = fmaxf(mx, p0[r]);
    } else {
#pragma unroll
        for (int r = 0; r < 16; ++r) mx = fmaxf(mx, fmaxf(p0[r], p1[r]));
    }
    mx = fmaxf(mx, __shfl_xor(mx, 32));
    const float mn = fmaxf(m, mx); const float alpha = __builtin_amdgcn_exp2f(m - mn); m = mn;
    float ps = 0.f;
    if (META) {
#pragma unroll
        for (int r = 0; r < 8; ++r) { p0[r] = __builtin_amdgcn_exp2f(p0[r] - mn); ps += p0[r]; }
    } else {
#pragma unroll
        for (int r = 0; r < 16; ++r) { p0[r] = __builtin_amdgcn_exp2f(p0[r] - mn); p1[r] = __builtin_amdgcn_exp2f(p1[r] - mn); ps += p0[r] + p1[r]; }
    }
    lsum = lsum * alpha + ps;
    if (__any(alpha != 1.0f)) {
        if (hi == 0) scr[r32] = alpha;
        asm volatile("s_waitcnt lgkmcnt(0)" ::: "memory");
#pragma unroll
        for (int r = 0; r < 16; ++r) { const float a = scr[crow(r, hi)];
#pragma unroll
            for (int d0 = 0; d0 < DV / 32; ++d0) o[d0][r] *= a; }
    }
    bf16x8 pa[4];
    { u32x4 w; w.x = cvtpk(p0[0], p0[1]); w.y = cvtpk(p0[2], p0[3]); w.z = cvtpk(p0[4], p0[5]); w.w = cvtpk(p0[6], p0[7]); pa[0] = __builtin_bit_cast(bf16x8, w); }
    if (!META) {
        { u32x4 w; w.x = cvtpk(p0[8], p0[9]); w.y = cvtpk(p0[10], p0[11]); w.z = cvtpk(p0[12], p0[13]); w.w = cvtpk(p0[14], p0[15]); pa[1] = __builtin_bit_cast(bf16x8, w); }
        { u32x4 w; w.x = cvtpk(p1[0], p1[1]); w.y = cvtpk(p1[2], p1[3]); w.z = cvtpk(p1[4], p1[5]); w.w = cvtpk(p1[6], p1[7]); pa[2] = __builtin_bit_cast(bf16x8, w); }
        { u32x4 w; w.x = cvtpk(p1[8], p1[9]); w.y = cvtpk(p1[10], p1[11]); w.z = cvtpk(p1[12], p1[13]); w.w = cvtpk(p1[14], p1[15]); pa[3] = __builtin_bit_cast(bf16x8, w); }
    }
    const LAS unsigned char* vb = Vt + (4 * hi + ((lane & 15) >> 2)) * VS + (16 * ((lane >> 4) & 1) + 4 * (lane & 3)) * 2;
#pragma unroll
    for (int ks = 0; ks < (META ? 1 : 4); ++ks) {
#pragma unroll
        for (int d0 = 0; d0 < DV / 32; ++d0) {
            const s16x4 lo = vtr(vb + (16 * ks) * VS + 64 * d0), hh = vtr(vb + (16 * ks + 8) * VS + 64 * d0);
            const bf16x8 vf = (bf16x8){lo[0], lo[1], lo[2], lo[3], hh[0], hh[1], hh[2], hh[3]};
            o[d0] = __builtin_amdgcn_mfma_f32_32x32x16_bf16(pa[ks], vf, o[d0], 0, 0, 0);
        }
        __builtin_amdgcn_sched_barrier(0);
    }
}

template <int DQK, int DV, class Src>
__device__ __forceinline__ void attn_pass(const Ctx& c, const Src& src, int b, int qb, const bf16x8 (&qf)[DQK / 16], f32x16 (&o)[DV / 32]) {
    typedef ACfg<DQK, DV> C;
    LAS unsigned char* Kt = c.lds + C::KOFF; LAS unsigned char* Vt = c.lds + C::VOFF; LAS float* scr = (LAS float*)(c.lds + C::SCR) + c.wave * 64;
    const int hi = c.lane >> 5, r32 = c.lane & 31;
    float m = -INFINITY, lsum = 0.f;
#pragma unroll
    for (int d0 = 0; d0 < DV / 32; ++d0)
#pragma unroll
        for (int r = 0; r < 16; ++r) o[d0][r] = 0.f;
    const int NT = qb < 0 ? 0 : 4 * (qb + 1);
    const int myc = qb < 0 ? -1 : 4 * qb + (c.wave >> 1);
    const bool active = qb >= 0 || c.wave == 0;
    for (int jt = -1; jt < NT; ++jt) {
        __syncthreads();
        const int krow0 = jt < 0 ? RR : b * SEQ + 64 * jt;
        const int nk = jt < 0 ? 32 : 64, nv = jt < 0 ? 16 : 64;
        for (int idx = c.tid; idx < nk * (DQK / 8); idx += NTHREADS) { const int key = idx / (DQK / 8), ch = idx % (DQK / 8);
            *(LAS u32x4*)(Kt + key * C::KS + ch * 16) = *(const u32x4*)src.kptr(krow0 + key, ch); }
        for (int idx = c.tid; idx < nv * (DV / 8); idx += NTHREADS) { const int key = idx / (DV / 8), ch = idx % (DV / 8);
            *(LAS u32x4*)(Vt + key * C::VS + ch * 16) = *(const u32x4*)src.vptr(krow0 + key, ch); }
        __syncthreads();
        if (active && jt <= myc) {
            if (jt < 0) attn_tile<DQK, DV, true>(Kt, Vt, scr, qf, o, m, lsum, c.lane);
            else attn_tile<DQK, DV, false>(Kt, Vt, scr, qf, o, m, lsum, c.lane);
        }
    }
    const float lt = lsum + __shfl_xor(lsum, 32);
    if (hi == 0) scr[32 + r32] = 1.0f / lt;
    asm volatile("s_waitcnt lgkmcnt(0)" ::: "memory");
#pragma unroll
    for (int r = 0; r < 16; ++r) { const float a = scr[32 + crow(r, hi)];
#pragma unroll
        for (int d0 = 0; d0 < DV / 32; ++d0) o[d0][r] *= a; }
}

__device__ __forceinline__ void attn_unit_a(const Params& p, const Ctx& c, int b, int h, int qb, float lam) {
    const int q0 = qb < 0 ? RR : b * SEQ + 256 * qb; const int hi = c.lane >> 5, r32 = c.lane & 31;
    bf16_t* Qb = (bf16_t*)(p.ws + WS_Q); bf16_t* O1 = (bf16_t*)(p.ws + WS_OB2);
    const bool active = qb >= 0 || c.wave == 0;
    f32x16 o[4];
#pragma nounroll
    for (int s = 0; s < 2; ++s) {
        const bf16_t* qrow = Qb + (size_t)(q0 + 32 * c.wave + r32) * 1024 + h * 128 + s * 64;
        bf16x8 qf[4];
#pragma unroll
        for (int kk = 0; kk < 4; ++kk) qf[kk] = *(const bf16x8*)(qrow + 16 * kk + 8 * hi);
        SrcA src{(const bf16_t*)(p.ws + WS_K), (const bf16_t*)(p.ws + WS_V), h, s};
        attn_pass<64, 128, SrcA>(c, src, b, qb, qf, o);
        if (s == 0 && active) {
            int rb = q0 + 32 * c.wave; asm volatile("" : "+s"(rb));
#pragma unroll
            for (int r = 0; r < 16; ++r) { bf16_t* orow = O1 + (size_t)(rb + crow(r, hi)) * 1024 + h * 128 + r32;
                orow[0] = (bf16_t)f2bf(o[0][r]); orow[32] = (bf16_t)f2bf(o[1][r]); orow[64] = (bf16_t)f2bf(o[2][r]); orow[96] = (bf16_t)f2bf(o[3][r]); }
        }
    }
    if (!active) return;
    int rb = q0 + 32 * c.wave; asm volatile("" : "+s"(rb));
#pragma unroll
    for (int r = 0; r < 16; ++r) {
        const size_t off = (size_t)(rb + crow(r, hi)) * 1024 + h * 128 + r32;
        const float v0 = bf2f(O1[off]) - lam * o[0][r], v1 = bf2f(O1[off + 32]) - lam * o[1][r], v2 = bf2f(O1[off + 64]) - lam * o[2][r], v3 = bf2f(O1[off + 96]) - lam * o[3][r];
        float ss = v0 * v0 + v1 * v1 + v2 * v2 + v3 * v3;
#pragma unroll
        for (int sh = 1; sh < 32; sh <<= 1) ss += __shfl_xor(ss, sh);
        const float rs = 1.0f / sqrtf(ss * (1.0f / 128.0f) + EPS);
        bf16_t* orow = Qb + off;
        orow[0] = (bf16_t)f2bf(v0 * rs); orow[32] = (bf16_t)f2bf(v1 * rs); orow[64] = (bf16_t)f2bf(v2 * rs); orow[96] = (bf16_t)f2bf(v3 * rs);
        if ((r & 3) == 3) asm volatile("" ::: "memory");
    }
}
__device__ __forceinline__ void ph_attn_a(const Params& p, const Ctx& c) {
    const float d1 = wave_sum(p.in[I_LQ1][c.lane] * p.in[I_LK1][c.lane]), d2 = wave_sum(p.in[I_LQ2][c.lane] * p.in[I_LK2][c.lane]);
    const float lam = expf(d1) - expf(d2) + LAM_INIT;
#pragma nounroll
    for (int pi = c.vcu; pi < 256 + 8; pi += c.G) {
        const int nsub = pi < 256 ? 2 : 1;
#pragma nounroll
        for (int sub = 0; sub < nsub; ++sub) {
            int b, h, qb;
            if (pi < 256) { const int bh = pi >> 2, s = pi & 3; b = bh >> 3; h = bh & 7; qb = sub ? 7 - s : s; } else { b = 0; h = pi - 256; qb = -1; }
            attn_unit_a(p, c, b, h, qb, lam);
        }
    }
}
__device__ __forceinline__ void attn_unit_b(const Params& p, const Ctx& c, int b, int h, int qb) {
    const int q0 = qb < 0 ? RR : b * SEQ + 256 * qb; const int hi = c.lane >> 5, r32 = c.lane & 31;
    const bf16_t* qrow = (const bf16_t*)(p.ws + WS_Q2) + (size_t)(q0 + 32 * c.wave + r32) * 1536 + h * 96;
    bf16x8 qf[6];
#pragma unroll
    for (int kk = 0; kk < 6; ++kk) qf[kk] = *(const bf16x8*)(qrow + 16 * kk + 8 * hi);
    f32x16 o[2];
    SrcB src{(const bf16_t*)(p.ws + WS_KV2), (const bf16_t*)(p.ws + WS_KR), h};
    attn_pass<96, 64, SrcB>(c, src, b, qb, qf, o);
    const bool active = qb >= 0 || c.wave == 0;
    if (!active) return;
    bf16_t* Ob = (bf16_t*)(p.ws + WS_OB2);
    int rb = q0 + 32 * c.wave; asm volatile("" : "+s"(rb));
#pragma unroll
    for (int r = 0; r < 16; ++r) { bf16_t* orow = Ob + (size_t)(rb + crow(r, hi)) * 1024 + h * 64 + r32;
        orow[0] = (bf16_t)f2bf(o[0][r]); orow[32] = (bf16_t)f2bf(o[1][r]); }
}
__device__ __forceinline__ void ph_attn_b(const Params& p, const Ctx& c) {
#pragma nounroll
    for (int pi = c.vcu; pi < 512 + 16; pi += c.G) {
        const int nsub = pi < 512 ? 2 : 1;
#pragma nounroll
        for (int sub = 0; sub < nsub; ++sub) {
            int b, h, qb;
            if (pi < 512) { const int bh = pi >> 2, s = pi & 3; b = bh >> 4; h = bh & 15; qb = sub ? 7 - s : s; } else { b = 0; h = pi - 512; qb = -1; }
            attn_unit_b(p, c, b, h, qb);
        }
    }
}

__device__ __forceinline__ void ph_ffn_fix(const Params& p, const Ctx& c, int layer) {
    const float* SA = (const float*)(p.ws + WS_SA); const float* SB = (const float*)(p.ws + WS_SB); bf16_t* G = (bf16_t*)(p.ws + WS_G);
    const float* cw = p.in[I_FFN_CW] + (size_t)layer * 3 * DFF; const float* cb = p.in[I_FFN_CB] + (size_t)layer * DFF;
    const int gt = c.gw * 64 + c.lane, ngt = c.ngw * 64;
    for (int i = gt; i < 65 * DFF; i += ngt) {
        const int pm = i / DFF, col = i - pm * DFF;
        const float a0 = SA[((size_t)pm * 4 + 0) * DFF + col], a1 = SA[((size_t)pm * 4 + 1) * DFF + col];
        const float b0 = SB[((size_t)pm * 2 + 0) * DFF + col], b1 = SB[((size_t)pm * 2 + 1) * DFF + col];
        float l0 = 0.f, l1 = 0.f;
        if (pm < 64) { const int ps = (pm & 7) == 0 ? 64 : pm - 1; l0 = SA[((size_t)ps * 4 + 2) * DFF + col]; l1 = SA[((size_t)ps * 4 + 3) * DFF + col]; }
        const float w0 = cw[col], w1 = cw[DFF + col], w2 = cw[2 * DFF + col], bb = cb[col];
        const float c0 = bb + w0 * l0 + w1 * l1 + w2 * a0, c1 = bb + w0 * l1 + w1 * a0 + w2 * a1;
        const float g0 = c0 / (1.0f + __expf(-c0)) * b0, g1 = c1 / (1.0f + __expf(-c1)) * b1;
        G[(size_t)(pm * 256) * DFF + col] = (bf16_t)f2bf(g0); G[(size_t)(pm * 256 + 1) * DFF + col] = (bf16_t)f2bf(g1);
    }
}

#define XB_TMO      128
#define XB_XCNT(j)  (256  + 64 * (j))
#define XB_XSUB(j)  (1280 + 64 * (j))
#define XB_XGEN(j)  (2304 + 64 * (j))
#define XB_TOP      3328
#define XB_TOPGEN   3392
#define XCD_BAR_WORDS 3456
#define XB_SPIN_CAP (1u << 18)

__device__ __forceinline__ unsigned xb_ld(unsigned* p)              { return __hip_atomic_load(p, __ATOMIC_RELAXED, __HIP_MEMORY_SCOPE_AGENT); }
__device__ __forceinline__ unsigned xb_add(unsigned* p, unsigned v) { return __hip_atomic_fetch_add(p, v, __ATOMIC_RELAXED, __HIP_MEMORY_SCOPE_AGENT); }
__device__ __forceinline__ unsigned xb_xcc_id() { return (unsigned)__builtin_amdgcn_s_getreg((3 << 11) | 20) & 0xFu; }
#define XB_SPIN(cond, bar) do { unsigned _sp = 0; while (cond) { __builtin_amdgcn_s_sleep(1); \
    if ((++_sp & 255u) == 0u) { if (xb_ld(&(bar)[XB_TMO])) break; if (_sp > XB_SPIN_CAP) { atomicAdd(&(bar)[XB_TMO], 1u); break; } } } } while (0)

struct XcdBarrier {
    unsigned* bar; unsigned x;
    volatile LAS unsigned* st;
};

__device__ __forceinline__ XcdBarrier xcd_barrier_post(unsigned* bar, volatile LAS unsigned* st) {
    XcdBarrier b; b.bar = bar; b.x = xb_xcc_id(); b.st = st;
    if (threadIdx.x == 0) (void)xb_add(&bar[XB_XCNT(b.x)], 1u);
    return b;
}
__device__ __forceinline__ void xcd_barrier_complete(unsigned* bar, unsigned x, unsigned& nloc, unsigned& nx) {
    const unsigned G = gridDim.x * gridDim.y * gridDim.z;
    unsigned sum, cnt, mine, sp = 0u;
    for (;;) {
        sum = 0u; cnt = 0u; mine = 0u;
#pragma unroll
        for (unsigned j = 0; j < 16; ++j) { const unsigned c = xb_ld(&bar[XB_XCNT(j)]); sum += c; cnt += (c > 0u) ? 1u : 0u; mine = (j == x) ? c : mine; }
        if (sum == G) break;
        __builtin_amdgcn_s_sleep(1);
        if ((++sp & 255u) == 0u) { if (xb_ld(&bar[XB_TMO])) break; if (sp > XB_SPIN_CAP) { atomicAdd(&bar[XB_TMO], 1u); break; } }
    }
    nloc = mine > 0u ? mine : 1u; nx = cnt > 0u ? cnt : 1u;
}

__device__ __forceinline__ void xcd_barrier(const XcdBarrier& b) {
    asm volatile("s_waitcnt vmcnt(0)" ::: "memory");
    __syncthreads();
    if (threadIdx.x == 0) {
        unsigned* bar = b.bar;
        __builtin_amdgcn_s_waitcnt(0);
        unsigned nloc = b.st[0], nx = b.st[1];
        if (nloc == 0u) { xcd_barrier_complete(bar, b.x, nloc, nx); b.st[0] = nloc; b.st[1] = nx; }
        const unsigned old = xb_add(&bar[XB_XSUB(b.x)], 1u);
        const unsigned gen = old / nloc;
        if (old + 1u == (gen + 1u) * nloc) {
            __builtin_amdgcn_fence(__ATOMIC_RELEASE, "agent");
            asm volatile("s_waitcnt vmcnt(0)" ::: "memory");
            const unsigned og = xb_add(&bar[XB_TOP], 1u);
            const unsigned tg = og / nx;
            if (og + 1u == (tg + 1u) * nx) xb_add(&bar[XB_TOPGEN], 1u);
            else XB_SPIN(xb_ld(&bar[XB_TOPGEN]) == tg, bar);
            __builtin_amdgcn_fence(__ATOMIC_ACQUIRE, "agent");
            xb_add(&bar[XB_XGEN(b.x)], 1u);
            asm volatile("s_waitcnt vmcnt(0)" ::: "memory");
        } else {
            XB_SPIN(xb_ld(&bar[XB_XGEN(b.x)]) == gen, bar);
            __builtin_amdgcn_fence(__ATOMIC_ACQUIRE, "agent");
            asm volatile("s_waitcnt vmcnt(0)" ::: "memory");
        }
    }
    __syncthreads();
}

enum { PH_PROLOGUE = 0, PH_QKV, PH_ROT_A, PH_ATTN_A, PH_WO_A, PH_STAT1, PH_FFNIN_A, PH_FIX_A, PH_FFNOUT_A, PH_STAT2, PH_DPROJ, PH_DPOST, PH_UKV, PH_UQ, PH_ROT_B,
       PH_ATTN_B, PH_WO_B, PH_STAT3, PH_FFNIN_B, PH_FIX_B, PH_FFNOUT_B, PH_FINAL, PH_COUNT };
__host__ __device__ constexpr bool phase_active(int ph) {
#ifdef ONLY_PH
    if (ph != ONLY_PH) return false;
#endif
    return !((FAST_QKV && ph == PH_ROT_A) || (FAST_RES && (ph == PH_STAT1 || ph == PH_STAT2 || ph == PH_STAT3)) || (!FAST_FFN && (ph == PH_FIX_A || ph == PH_FIX_B)) ||
             (FAST_D && ph == PH_DPOST) || (FAST_U && ph == PH_ROT_B));
}

__host__ __device__ constexpr bool only_ok(int x) {
#ifdef ONLY_PH
    return x == ONLY_PH;
#else
    return true;
#endif
}
__device__ __forceinline__ Ctx make_ctx(LAS unsigned char* lds, int wave0) {
    int lane_; asm volatile("v_mbcnt_lo_u32_b32 %0, -1, 0\n\tv_mbcnt_hi_u32_b32 %0, -1, %0" : "=v"(lane_));
    int wv = wave0; asm volatile("" : "+s"(wv));
    Ctx c; c.lds = lds; c.lane = lane_; c.wave = wv; c.tid = wv * 64 + lane_;
    c.G = gridDim.x; { const int bx = blockIdx.x; c.vcu = (c.G % 8 == 0) ? (bx % 8) * (c.G / 8) + bx / 8 : bx; }
    c.gw = c.vcu * NWAVES + c.wave; c.ngw = c.G * NWAVES;
    return c;
}
template <class Epi> __device__ __forceinline__ void run_gemm(const Ctx& c, const bf16_t* A, const bf16_t* Bt, int N, int K, const Epi& E) {
    pg8::Gemm g{A, Bt, RT, N, K}; pg8::StaticOrder S; S.init(RT, N, c.G, (int)blockIdx.x);
    pg8::gemm_phase<Epi, pg8::StaticOrder, true, true>(c.lds, g, S, E, c.tid);
}

__global__ void __launch_bounds__(NTHREADS, 2) fwd_kernel(Params pin) {
    extern __shared__ __attribute__((aligned(16))) unsigned char smem[];
    bool first = true;
    int wave0 = __builtin_amdgcn_readfirstlane((int)threadIdx.x >> 6);
    if (threadIdx.x < 64) ((LAS unsigned*)(smem + MISC_OFF))[threadIdx.x] = 0u;
    __syncthreads();
    const XcdBarrier xbar = xcd_barrier_post((unsigned*)(pin.ws + WS_CTL) + CW_BAR, (volatile LAS unsigned*)(smem + MISC_OFF));
    int nsync = 0;
#pragma nounroll
    for (int ph = pin.ph_lo; ph < pin.ph_hi; ++ph) {
        if (!phase_active(ph)) continue;
        if (!first && ph != PH_UQ) {
            if (nsync == 0) cg::this_grid().sync();
            else xcd_barrier(xbar);
            ++nsync;
        }
        first = false;
        Params p = pin; asm volatile("" : "+s"(p.ws), "+s"(p.out));
#define MKCTX() const Ctx c = make_ctx((LAS unsigned char*)smem, wave0)
        unsigned char* ws = p.ws;
        const bf16_t* HB = (const bf16_t*)(ws + WS_HB);
        float* hmeta = (float*)(ws + WS_HMETA);
        const float* TA = (const float*)(ws + WS_ROPE); const float* TB = TA + 2064 * 8 * 2;
        switch (ph) {
            case PH_PROLOGUE: if (!only_ok(PH_PROLOGUE)) break; { MKCTX(); ph_prologue(p, c); break; }
            case PH_QKV: if (!only_ok(PH_QKV)) break; { MKCTX();
                if (FAST_QKV) { pg8::FEpiQKV e{rss_ptr(p, 0), (bf16_t*)(ws + WS_Q), TA}; run_gemm(c, HB, (const bf16_t*)(ws + W_QKV), 3072, 1024, e); }
                else { EpiQKV e{rss_ptr(p, 0), (bf16_t*)(ws + WS_Q), (bf16_t*)(ws + WS_K), (bf16_t*)(ws + WS_V)}; gemm_simple(HB, D, (const bf16_t*)(ws + W_QKV), D, 3072, RV, e, c); }
                break; }
            case PH_ROT_A: if (!only_ok(PH_ROT_A)) break; { MKCTX(); ph_rot_a(p, c); break; }
            case PH_ATTN_A: if (!only_ok(PH_ATTN_A)) break; { MKCTX(); ph_attn_a(p, c); break; }
            case PH_WO_A: if (!only_ok(PH_WO_A)) break; { MKCTX();
                if (FAST_RES) { pg8::FEpiRes e{p.out, hmeta, (bf16_t*)(ws + WS_HB), rss_ptr(p, 1)}; run_gemm(c, (const bf16_t*)(ws + WS_Q), (const bf16_t*)(ws + W_OA), 1024, 1024, e); }
                else { EpiRes e{p.out, hmeta}; gemm_simple((const bf16_t*)(ws + WS_Q), 1024, (const bf16_t*)(ws + W_OA), 1024, 1024, RV, e, c); }
                break; }
            case PH_STAT1: if (!only_ok(PH_STAT1)) break; { MKCTX(); ph_rowstat(p, c, 1); break; }
            case PH_FFNIN_A: case PH_FFNIN_B: if (!only_ok(PH_FFNIN_A) && !only_ok(PH_FFNIN_B)) break; { MKCTX(); { const int layer = ph == PH_FFNIN_B; const int site = layer ? 3 : 1;
                if (FAST_FFN) { pg8::FEpiFFN e{rss_ptr(p, site), p.in[I_FFN_CW] + (size_t)layer * 3 * DFF, p.in[I_FFN_CB] + (size_t)layer * DFF, (bf16_t*)(ws + WS_G), (float*)(ws + WS_SA), (float*)(ws + WS_SB), (LAS float*)(c.lds + XLDS_OFF)};
                    run_gemm(c, HB, (const bf16_t*)(ws + (layer ? W_IN1 : W_IN0)), 5632, 1024, e); }
                else ph_ffn_in(p, c, layer, site);
                break; } }
            case PH_FIX_A: if (!only_ok(PH_FIX_A)) break; { MKCTX(); ph_ffn_fix(p, c, 0); break; }
            case PH_FIX_B: if (!only_ok(PH_FIX_B)) break; { MKCTX(); ph_ffn_fix(p, c, 1); break; }
            case PH_FFNOUT_A: case PH_FFNOUT_B: if (!only_ok(PH_FFNOUT_A) && !only_ok(PH_FFNOUT_B)) break; { MKCTX(); { const int layer = ph == PH_FFNOUT_B;
                if (FAST_RES) { pg8::FEpiRes e{p.out, hmeta, layer ? nullptr : (bf16_t*)(ws + WS_HB), rss_ptr(p, layer ? 4 : 2)}; run_gemm(c, (const bf16_t*)(ws + WS_G), (const bf16_t*)(ws + (layer ? W_OUT1 : W_OUT0)), 1024, DFF, e); }
                else { EpiRes e{p.out, hmeta}; gemm_simple((const bf16_t*)(ws + WS_G), DFF, (const bf16_t*)(ws + (layer ? W_OUT1 : W_OUT0)), DFF, 1024, RV, e, c); }
                break; } }
            case PH_STAT2: if (!only_ok(PH_STAT2)) break; { MKCTX(); ph_rowstat(p, c, 2); break; }
            case PH_DPROJ: if (!only_ok(PH_DPROJ)) break; { MKCTX();
                if (FAST_D) { pg8::FEpiD e{rss_ptr(p, 2), (bf16_t*)(ws + WS_CQ), (bf16_t*)(ws + WS_CKV), (bf16_t*)(ws + WS_KR), rss_ptr(p, 5), rss_ptr(p, 6), TB}; run_gemm(c, HB, (const bf16_t*)(ws + W_D), 768, 1024, e); }
                else { EpiD e{rss_ptr(p, 2), (bf16_t*)(ws + WS_CQ), (bf16_t*)(ws + WS_CKV), (bf16_t*)(ws + WS_KR)}; gemm_simple(HB, D, (const bf16_t*)(ws + W_D), D, 768, RV, e, c); }
                break; }
            case PH_DPOST: if (!only_ok(PH_DPOST)) break; { MKCTX(); ph_dpost(p, c); break; }
            case PH_UKV: if (!only_ok(PH_UKV)) break; { MKCTX();
                if (FAST_U) { pg8::FEpiUp<false> e1{rss_ptr(p, 6), 1.0f / 256.0f, (bf16_t*)(ws + WS_KV2), 2048, TB}; run_gemm(c, (const bf16_t*)(ws + WS_CKV), (const bf16_t*)(ws + W_UKV), 2048, 256, e1); }
                else { EpiScaled e1{rss_ptr(p, 6), 1.0f / 256.0f, (bf16_t*)(ws + WS_KV2), 2048}; gemm_simple((const bf16_t*)(ws + WS_CKV), 256, (const bf16_t*)(ws + W_UKV), 256, 2048, RV, e1, c); }
                break; }
            case PH_UQ: if (!only_ok(PH_UQ)) break; { MKCTX();
                if (FAST_U) { pg8::FEpiUp<true> e2{rss_ptr(p, 5), 1.0f / 384.0f, (bf16_t*)(ws + WS_Q2), 1536, TB}; run_gemm(c, (const bf16_t*)(ws + WS_CQ), (const bf16_t*)(ws + W_UQ), 1536, 384, e2); }
                else { EpiScaled e2{rss_ptr(p, 5), 1.0f / 384.0f, (bf16_t*)(ws + WS_Q2), 1536}; gemm_simple((const bf16_t*)(ws + WS_CQ), 384, (const bf16_t*)(ws + W_UQ), 384, 1536, RV, e2, c); }
                break; }
            case PH_ROT_B: if (!only_ok(PH_ROT_B)) break; { MKCTX(); ph_rot_b(p, c); break; }
            case PH_ATTN_B: if (!only_ok(PH_ATTN_B)) break; { MKCTX(); ph_attn_b(p, c); break; }
            case PH_WO_B: if (!only_ok(PH_WO_B)) break; { MKCTX();
                if (FAST_RES) { pg8::FEpiRes e{p.out, hmeta, (bf16_t*)(ws + WS_HB), rss_ptr(p, 3)}; run_gemm(c, (const bf16_t*)(ws + WS_OB2), (const bf16_t*)(ws + W_OB), 1024, 1024, e); }
                else { EpiRes e{p.out, hmeta}; gemm_simple((const bf16_t*)(ws + WS_OB2), 1024, (const bf16_t*)(ws + W_OB), 1024, 1024, RV, e, c); }
                break; }
            case PH_STAT3: if (!only_ok(PH_STAT3)) break; { MKCTX(); ph_rowstat(p, c, 3); break; }
            case PH_FINAL: if (!only_ok(PH_FINAL)) break; { MKCTX(); ph_final(p, c); break; }
            default: break;
        }
    }
}

extern "C" void kernel_launch(void* const* d_in, const int* in_sizes, int n_in, void* d_out, int out_size, void* d_ws, size_t ws_size, hipStream_t stream) {
    static int grid = 0;
    if (grid == 0) {
        if (n_in != 25 || ws_size < WS_END || out_size != RR * D) { fprintf(stderr, "kernel_launch: unexpected shapes (n_in %d, ws %zu, out %d)\n", n_in, ws_size, out_size); grid = -1; return; }
        int dev = 0, cus = 0, per_cu = 0;
        hipGetDevice(&dev); hipDeviceGetAttribute(&cus, hipDeviceAttributeMultiprocessorCount, dev);
        hipFuncSetAttribute((const void*)fwd_kernel, hipFuncAttributeMaxDynamicSharedMemorySize, LDS_BYTES);
        hipOccupancyMaxActiveBlocksPerMultiprocessor(&per_cu, (const void*)fwd_kernel, NTHREADS, LDS_BYTES);
        if (per_cu < 1) { fprintf(stderr, "kernel_launch: occupancy query says %d blocks per CU\n", per_cu); per_cu = 1; }
        (void)hipGetLastError();
        grid = cus * per_cu;
    }
    if (grid < 0) return;
    Params p{};
    for (int i = 0; i < 25; ++i) p.in[i] = (const float*)d_in[i];
    p.out = (float*)d_out; p.ws = (unsigned char*)d_ws;
    (void)hipMemsetAsync((char*)d_ws + WS_CTL, 0, CTL_ZERO_BYTES, stream);
    p.ph_lo = 0; p.ph_hi = PH_COUNT;
    void* args[] = {&p};
    hipError_t e = hipLaunchCooperativeKernel((const void*)fwd_kernel, dim3(grid), dim3(NTHREADS), args, LDS_BYTES, stream);
    if (e != hipSuccess) fprintf(stderr, "kernel_launch: cooperative launch failed: %s (grid %d)\n", hipGetErrorString(e), grid);
}
```

```cpp
#include <hip/hip_runtime.h>
#include <hip/hip_cooperative_groups.h>
#include <cstdio>
#include <cstdint>
#include <cmath>
namespace cg = cooperative_groups;

#define LAS __attribute__((address_space(3)))
typedef unsigned short bf16_t;
typedef short bf16x8 __attribute__((ext_vector_type(8)));
typedef short s16x4 __attribute__((ext_vector_type(4)));
typedef float f32x4 __attribute__((ext_vector_type(4)));
typedef float f32x16 __attribute__((ext_vector_type(16)));
typedef unsigned u32x4 __attribute__((ext_vector_type(4)));
typedef unsigned u32x2 __attribute__((ext_vector_type(2)));

constexpr int NB = 8, SEQ = 2048, NMETA = 16, D = 1024, DFF = 2816;
constexpr int RR = NB * SEQ;
constexpr int RV = RR + NMETA;
constexpr int RT = 16640;
constexpr int NWAVES = 8, NTHREADS = 512;
constexpr float EPS = 1e-5f;
constexpr float LOG2E = 1.4426950408889634f;
constexpr float QS_A = 0.125f * LOG2E;
constexpr float QS_B = 0.10206207261596575f * LOG2E;
constexpr float LAM_INIT = 0.2f;

constexpr size_t KiB = 1024, MiB = 1024 * 1024;
constexpr size_t WS_CTL = 0;
constexpr size_t W_QKV = 1 * MiB;
constexpr size_t W_OA = 7 * MiB;
constexpr size_t W_IN0 = 9 * MiB, W_IN1 = 20 * MiB;
constexpr size_t W_OUT0 = 31 * MiB, W_OUT1 = 31 * MiB + 5632 * KiB;
constexpr size_t W_D = 42 * MiB;
constexpr size_t W_UKV = 43 * MiB + 512 * KiB;
constexpr size_t W_UQ = 44 * MiB + 512 * KiB;
constexpr size_t W_OB = 45 * MiB + 640 * KiB;
constexpr size_t WS_HB = 48 * MiB;
constexpr size_t WS_BIG = WS_HB + 33280 * KiB;
constexpr size_t ROWB1024 = (size_t)RT * 1024 * 2;
constexpr size_t WS_Q = WS_BIG, WS_K = WS_BIG + ROWB1024, WS_V = WS_BIG + 2 * ROWB1024;
constexpr size_t WS_G = WS_BIG;
constexpr size_t WS_Q2 = WS_BIG;
constexpr size_t WS_KV2 = WS_BIG + (size_t)RT * 1536 * 2;
constexpr size_t WS_CQ = WS_BIG + 116480 * KiB;
constexpr size_t WS_CKV = WS_CQ + (size_t)RT * 384 * 2;
constexpr size_t WS_KR = WS_CKV + (size_t)RT * 256 * 2;
constexpr size_t WS_OB2 = 216 * MiB;
constexpr size_t WS_HMETA = WS_OB2 + 33280 * KiB;
constexpr size_t WS_RSS = WS_HMETA + 1 * MiB;
constexpr size_t WS_ROPE = WS_RSS + 512 * KiB;
constexpr size_t WS_SA = 251 * MiB;
constexpr size_t WS_SB = WS_SA + (size_t)65 * 4 * 2816 * 4;
constexpr size_t WS_END = 256 * MiB;
static_assert(WS_SB + (size_t)65 * 2 * 2816 * 4 <= WS_END, "ws map");
static_assert(WS_KR + (size_t)RT * 32 * 2 <= WS_OB2, "ws map");
static_assert(WS_KV2 + (size_t)RT * 2048 * 2 <= WS_CQ, "ws map");
static_assert(WS_ROPE + 512 * KiB <= WS_END, "ws map");
static_assert(W_OB + 2 * MiB <= WS_HB, "ws map");

constexpr int LDS_BYTES = 147456;
constexpr int MISC_OFF = 131072 + 4096;
constexpr size_t CTL_ZERO_BYTES = 64 * 1024;
constexpr int CW_BAR = 4096;
constexpr int XLDS_OFF = 131072;
#ifndef FAST_MASK
#define FAST_MASK 0x1f
#endif
constexpr bool FAST_QKV = (FAST_MASK >> 0) & 1, FAST_RES = (FAST_MASK >> 1) & 1, FAST_FFN = (FAST_MASK >> 2) & 1, FAST_D = (FAST_MASK >> 3) & 1, FAST_U = (FAST_MASK >> 4) & 1;

struct Params {
    const float* in[25];
    float* out;
    unsigned char* ws;
    int ph_lo, ph_hi;
};
enum { I_X = 0, I_META, I_A_NORM, I_A_WQKV, I_LQ1, I_LK1, I_LQ2, I_LK2, I_A_SUB, I_A_WO, I_KV_NORM, I_KV_WDKV, I_KV_ANORM, I_KV_WUKV,
       I_B_NORM, I_B_WDQ, I_B_QANORM, I_B_WUQ, I_B_WO, I_FFN_NORM, I_FFN_WIN, I_FFN_CW, I_FFN_CB, I_FFN_WOUT, I_FINAL };

struct Ctx { int tid, lane, wave, gw, ngw, vcu, G; LAS unsigned char* lds; };

__device__ __forceinline__ unsigned f2bf(float f) { unsigned u = __builtin_bit_cast(unsigned, f); return (u + 0x7fffu + ((u >> 16) & 1u)) >> 16; }
__device__ __forceinline__ unsigned pk2(float lo, float hi) { return f2bf(lo) | (f2bf(hi) << 16); }
__device__ __forceinline__ float bf2f(bf16_t b) { return __builtin_bit_cast(float, (unsigned)b << 16); }
__device__ __forceinline__ float wave_sum(float v) {
#pragma unroll
    for (int o = 1; o < 64; o <<= 1) v += __shfl_xor(v, o);
    return v;
}
__device__ __forceinline__ int row_pos(int r) { return r < RR ? NMETA + (r & (SEQ - 1)) : r - RR; }
__device__ __forceinline__ float* hrow(const Params& p, int r) { return r < RR ? p.out + (size_t)r * D : (float*)(p.ws + WS_HMETA) + (size_t)(r - RR) * D; }
__device__ __forceinline__ float* rss_ptr(const Params& p, int site) { return (float*)(p.ws + WS_RSS) + (size_t)site * RT; }
__device__ __forceinline__ int crow(int r, int hi) { return (r & 3) + 8 * (r >> 2) + 4 * hi; }

struct WSrc { const float* W; int pitch; int col0; const float* gain; int gmask; float scale; };
__device__ __forceinline__ void wdims(int id, int& N, int& K, size_t& off) {
    switch (id) {
        case 0: N = 3072; K = 1024; off = W_QKV; break;
        case 1: N = 1024; K = 1024; off = W_OA; break;
        case 2: N = 5632; K = 1024; off = W_IN0; break;
        case 3: N = 5632; K = 1024; off = W_IN1; break;
        case 4: N = 1024; K = 2816; off = W_OUT0; break;
        case 5: N = 1024; K = 2816; off = W_OUT1; break;
        case 6: N = 768; K = 1024; off = W_D; break;
        case 7: N = 2048; K = 256; off = W_UKV; break;
        case 8: N = 1536; K = 384; off = W_UQ; break;
        default: N = 1024; K = 1024; off = W_OB; break;
    }
}
__device__ __forceinline__ WSrc wsrc(const Params& p, int id, int n0) {
    WSrc s; s.gain = nullptr; s.gmask = 0; s.scale = 1.f; s.W = nullptr; s.pitch = 0; s.col0 = 0;
    switch (id) {
        case 0: s.W = p.in[I_A_WQKV]; s.pitch = 3072; s.col0 = n0; s.gain = p.in[I_A_NORM]; s.gmask = 1023; s.scale = n0 < 1024 ? QS_A : 1.f; break;
        case 1: s.W = p.in[I_A_WO]; s.pitch = 1024; s.col0 = n0; s.gain = p.in[I_A_SUB]; s.gmask = 127; s.scale = 1.f - LAM_INIT; break;
        case 2: case 3: { const int l = id - 2; s.W = p.in[I_FFN_WIN] + (size_t)l * 1024 * 5632; s.pitch = 5632; const int j = n0 >> 8, u = n0 & 255;
            s.col0 = u < 128 ? 128 * j + u : DFF + 128 * j + (u - 128); s.gain = p.in[I_FFN_NORM] + l * 1024; s.gmask = 1023; break; }
        case 4: case 5: { const int l = id - 4; s.W = p.in[I_FFN_WOUT] + (size_t)l * DFF * 1024; s.pitch = 1024; s.col0 = n0; break; }
        case 6: if (n0 < 384) { s.W = p.in[I_B_WDQ]; s.pitch = 384; s.col0 = n0; s.gain = p.in[I_B_NORM]; s.gmask = 1023; }
                else if (n0 < 672) { s.W = p.in[I_KV_WDKV]; s.pitch = 288; s.col0 = n0 - 384; s.gain = p.in[I_KV_NORM]; s.gmask = 1023; }
                break;
        case 7: s.W = p.in[I_KV_WUKV]; s.pitch = 2048; s.col0 = n0; s.gain = p.in[I_KV_ANORM]; s.gmask = 255; break;
        case 8: s.W = p.in[I_B_WUQ]; s.pitch = 1536; s.col0 = n0; s.gain = p.in[I_B_QANORM]; s.gmask = 511; s.scale = QS_B; break;
        default: s.W = p.in[I_B_WO]; s.pitch = 1024; s.col0 = n0; break;
    }
    return s;
}
__device__ __forceinline__ void transpose_item(const WSrc& s, int K, bf16_t* WT, int k0, int n0, LAS float* scr, int lane) {
    if (s.W) {
#pragma unroll 8
        for (int i = 0; i < 32; ++i) { const int kk = 2 * i + (lane >> 5); float g = s.scale; if (s.gain) g *= s.gain[(k0 + kk) & s.gmask];
            scr[kk * 33 + (lane & 31)] = s.W[(size_t)(k0 + kk) * s.pitch + s.col0 + (lane & 31)] * g; }
    } else {
#pragma unroll 8
        for (int i = 0; i < 32; ++i) { const int kk = 2 * i + (lane >> 5); scr[kk * 33 + (lane & 31)] = 0.f; }
    }
    asm volatile("s_waitcnt lgkmcnt(0)" ::: "memory");
    const int c = lane & 7;
#pragma unroll
    for (int j = 0; j < 4; ++j) { const int n = (lane >> 3) + 8 * j; const LAS float* q = scr + (8 * c) * 33 + n;
        u32x4 o; o.x = pk2(q[0 * 33], q[1 * 33]); o.y = pk2(q[2 * 33], q[3 * 33]); o.z = pk2(q[4 * 33], q[5 * 33]); o.w = pk2(q[6 * 33], q[7 * 33]);
        *(u32x4*)(WT + (size_t)(n0 + n) * K + k0 + 8 * c) = o; }
    asm volatile("s_waitcnt lgkmcnt(0)" ::: "memory");
}
__device__ __forceinline__ void ph_prologue(const Params& p, const Ctx& c) {
    LAS float* scr = (LAS float*)(c.lds + c.wave * 16384);
    int base = 0;
    for (int id = 0; id < 10; ++id) {
        int N, K; size_t off; wdims(id, N, K, off);
        const int nkb = K / 64, nnb = N / 32, items = nkb * nnb;
        for (int it = ((c.gw - base) % c.ngw + c.ngw) % c.ngw; it < items; it += c.ngw) {
            const int kb = it / nnb, nb = it % nnb; const WSrc s = wsrc(p, id, nb * 32);
            transpose_item(s, K, (bf16_t*)(p.ws + off), kb * 64, nb * 32, scr, c.lane); }
        base += items;
    }
    { float2* TA = (float2*)(p.ws + WS_ROPE); float2* TB = TA + 2064 * 8;
      const int gt = c.gw * 64 + c.lane, ngt = c.ngw * 64;
      for (int i = gt; i < 2064 * 8; i += ngt) { const int pos = i >> 3, k = i & 7; const float inv = 1.0f / powf(500000.0f, (float)k / 8.0f); const float a = (float)pos * inv; TA[i] = make_float2(cosf(a), sinf(a)); }
      for (int i = gt; i < 2064 * 16; i += ngt) { const int pos = i >> 4, k = i & 15; const float inv = 1.0f / powf(10000.0f, (float)k / 16.0f); const float a = (float)pos * inv; TB[i] = make_float2(cosf(a), sinf(a)); } }
    { float* r1 = rss_ptr(p, 1); const int gt = c.gw * 64 + c.lane, ngt = c.ngw * 64; for (int i = gt; i < 6 * RT; i += ngt) r1[i] = 0.f; }
    float* rss0 = rss_ptr(p, 0);
    for (int r = c.gw; r < RT; r += c.ngw) {
        const float* src = r < RR ? p.in[I_X] + (size_t)r * D : (r < RV ? p.in[I_META] + (size_t)(r - RR) * D : nullptr);
        f32x4 v[4]; float ss = 0.f;
#pragma unroll
        for (int j = 0; j < 4; ++j) { v[j] = src ? *(const f32x4*)(src + 4 * c.lane + 256 * j) : (f32x4){0.f, 0.f, 0.f, 0.f}; ss += v[j].x * v[j].x + v[j].y * v[j].y + v[j].z * v[j].z + v[j].w * v[j].w; }
        ss = wave_sum(ss);
        float* h = hrow(p, r); bf16_t* hb = (bf16_t*)(p.ws + WS_HB) + (size_t)r * D;
#pragma unroll
        for (int j = 0; j < 4; ++j) { *(f32x4*)(h + 4 * c.lane + 256 * j) = v[j]; u32x2 w; w.x = pk2(v[j].x, v[j].y); w.y = pk2(v[j].z, v[j].w); *(u32x2*)(hb + 4 * c.lane + 256 * j) = w; }
        if (c.lane == 0) rss0[r] = ss;
    }
}
__device__ __forceinline__ void ph_rowstat(const Params& p, const Ctx& c, int site) {
    float* rss = rss_ptr(p, site);
    for (int r = c.gw; r < RT; r += c.ngw) {
        const float* h = hrow(p, r); f32x4 v[4]; float ss = 0.f;
#pragma unroll
        for (int j = 0; j < 4; ++j) { v[j] = *(const f32x4*)(h + 4 * c.lane + 256 * j); ss += v[j].x * v[j].x + v[j].y * v[j].y + v[j].z * v[j].z + v[j].w * v[j].w; }
        ss = wave_sum(ss);
        bf16_t* hb = (bf16_t*)(p.ws + WS_HB) + (size_t)r * D;
#pragma unroll
        for (int j = 0; j < 4; ++j) { u32x2 w; w.x = pk2(v[j].x, v[j].y); w.y = pk2(v[j].z, v[j].w); *(u32x2*)(hb + 4 * c.lane + 256 * j) = w; }
        if (c.lane == 0) rss[r] = ss;
    }
}
__device__ __forceinline__ void ph_final(const Params& p, const Ctx& c) {
    const float* g = p.in[I_FINAL];
    for (int r = c.gw; r < RR; r += c.ngw) {
        float* h = p.out + (size_t)r * D; f32x4 v[4]; float ss = 0.f;
#pragma unroll
        for (int j = 0; j < 4; ++j) { v[j] = *(const f32x4*)(h + 4 * c.lane + 256 * j); ss += v[j].x * v[j].x + v[j].y * v[j].y + v[j].z * v[j].z + v[j].w * v[j].w; }
        ss = wave_sum(ss); const float rstd = 1.0f / sqrtf(ss * (1.0f / D) + EPS);
#pragma unroll
        for (int j = 0; j < 4; ++j) { const f32x4 gg = *(const f32x4*)(g + 4 * c.lane + 256 * j); *(f32x4*)(h + 4 * c.lane + 256 * j) = v[j] * rstd * gg; }
    }
}

template <class Epi>
__device__ __forceinline__ void gemm_simple(const bf16_t* A, int lda, const bf16_t* Bt, int K, int N, int nrows, const Epi& epi, const Ctx& c) {
    const int nct = N / 64, nrt = (nrows + 31) / 32, items = nrt * nct;
    const int l15 = c.lane & 15, q4 = c.lane >> 4;
    for (int it = c.gw; it < items; it += c.ngw) {
        const int rt = it / nct, ct = it % nct;
        f32x4 acc[2][4];
#pragma unroll
        for (int m = 0; m < 2; ++m)
#pragma unroll
            for (int n = 0; n < 4; ++n) acc[m][n] = (f32x4){0.f, 0.f, 0.f, 0.f};
        const bf16_t* ap = A + (size_t)(rt * 32 + l15) * lda + 8 * q4;
        const bf16_t* bp = Bt + (size_t)(ct * 64 + l15) * K + 8 * q4;
        for (int k0 = 0; k0 < K; k0 += 32) {
            bf16x8 a[2], b[4];
#pragma unroll
            for (int m = 0; m < 2; ++m) a[m] = *(const bf16x8*)(ap + (size_t)(16 * m) * lda + k0);
#pragma unroll
            for (int n = 0; n < 4; ++n) b[n] = *(const bf16x8*)(bp + (size_t)(16 * n) * K + k0);
#pragma unroll
            for (int m = 0; m < 2; ++m)
#pragma unroll
                for (int n = 0; n < 4; ++n) acc[m][n] = __builtin_amdgcn_mfma_f32_16x16x32_bf16(a[m], b[n], acc[m][n], 0, 0, 0);
        }
#pragma unroll
        for (int m = 0; m < 2; ++m)
#pragma unroll
            for (int n = 0; n < 4; ++n)
#pragma unroll
                for (int i = 0; i < 4; ++i) epi(rt * 32 + 16 * m + 4 * q4 + i, ct * 64 + 16 * n + l15, acc[m][n][i]);
    }
}
struct EpiQKV { const float* rss; bf16_t* Q; bf16_t* K; bf16_t* V;
    __device__ __forceinline__ void operator()(int row, int col, float v) const { v *= 1.0f / sqrtf(rss[row] * (1.0f / D) + EPS);
        Q[(size_t)(col >> 10) * (ROWB1024 / 2) + (size_t)row * 1024 + (col & 1023)] = (bf16_t)f2bf(v); } };
struct EpiRes { float* out; float* hmeta;
    __device__ __forceinline__ void operator()(int row, int col, float v) const { float* h = row < RR ? out + (size_t)row * D : hmeta + (size_t)(row - RR) * D; h[col] += v; } };
struct EpiD { const float* rss; bf16_t* CQ; bf16_t* CKV; bf16_t* KR;
    __device__ __forceinline__ void operator()(int row, int col, float v) const { v *= 1.0f / sqrtf(rss[row] * (1.0f / D) + EPS); const bf16_t b = (bf16_t)f2bf(v);
        if (col < 384) CQ[(size_t)row * 384 + col] = b; else if (col < 640) CKV[(size_t)row * 256 + col - 384] = b; else if (col < 672) KR[(size_t)row * 32 + col - 640] = b; } };
struct EpiScaled { const float* rss; float invk; bf16_t* O; int ldo;
    __device__ __forceinline__ void operator()(int row, int col, float v) const { v *= 1.0f / sqrtf(rss[row] * invk + EPS); O[(size_t)row * ldo + col] = (bf16_t)f2bf(v); } };

namespace pg8 {
#define PG8_LAS __attribute__((address_space(3)))
typedef unsigned short bf16_t;
typedef short bf16x8 __attribute__((ext_vector_type(8)));
typedef float f32x4 __attribute__((ext_vector_type(4)));
typedef unsigned u32x4 __attribute__((ext_vector_type(4)));
constexpr int BM = 256, BK = 64, HALF = 128, HTB = HALF * BK * 2  , STAGE_BYTES = 8 * HTB, NXCD = 8, WGM = 8;

__host__ __device__ __forceinline__ int lds_byte(int r, int c) { const int st = (r >> 4) * 2 + (c >> 5), rr = r & 15, cc = c & 31, ob = rr * 64 + cc * 2; return st * 1024 + (ob ^ (((ob >> 9) & 1) << 5)); }
__host__ __device__ __forceinline__ void stage_rc(int b, int& R, int& C) { const int st = b / 1024, sb = b % 1024, swz = sb ^ (((sb >> 9) & 1) << 5); R = (st >> 1) * 16 + swz / 64; C = (st & 1) * 32 + (swz % 64) / 2; }
__host__ __device__ __forceinline__ int perm32(int rho) { const int n = rho >> 4, i = rho & 15; return 8 * (i >> 2) + 4 * n + (i & 3); }

struct Unit { int pm, pn; };
struct Gemm { const bf16_t* A; const bf16_t* Bt; int M, N, K; };

struct StaticOrder {
    int nM, nN, nwg, G, c;
    __host__ __device__ void init(int M, int N, int G_, int c_) { nM = M / BM; nN = N / BM; nwg = nM * nN; G = G_; c = c_; }
    __host__ __device__ bool next(int i, Unit& u) const {
        const long L = (long)i * G + c; if (L >= nwg) return false;
        int wgid = (int)L; { const int q = nwg / NXCD, r = nwg % NXCD, xcd = wgid % NXCD, off = wgid / NXCD; wgid = (xcd < r ? xcd * (q + 1) : r * (q + 1) + (xcd - r) * q) + off; }
        const int nig = WGM * nN, gid = wgid / nig, fm = gid * WGM, gsz = (nM - fm) < WGM ? (nM - fm) : WGM;
        u.pm = fm + ((wgid % nig) % gsz); u.pn = (wgid % nig) / gsz; return true;
    }
    __device__ __forceinline__ void a_ready(const Unit&) const {}
    __device__ __forceinline__ void done(const Unit&) const {}
};
template <class Epi, class Sched, bool ALIGN_EPI = false, bool SP2 = false>
__device__ __forceinline__ void gemm_phase(PG8_LAS unsigned char* lds, const Gemm g, const Sched& S, const Epi& E, const int tid_in) {
    const int tid = tid_in, wid = __builtin_amdgcn_readfirstlane(tid >> 6), lane = tid & 63, wr = wid >> 2, wc = wid & 3, fr = lane & 15, fq = lane >> 4;
    const int K = g.K, nt = K / BK;
    unsigned voffA[2], voffB[2];
#pragma unroll
    for (int i = 0; i < 2; ++i) { int R, C; stage_rc(tid * 16 + i * 8192, R, C); const int Rb = Epi::PERM ? ((R & ~31) + perm32(R & 31)) : R;
        voffA[i] = (unsigned)(R * K + C) * 2u; voffB[i] = (unsigned)(Rb * K + C) * 2u; }
    const size_t kstep = (size_t)(BK * 2);
    const size_t hstep = (size_t)HALF * K * 2;
    const size_t tstep = 2 * hstep;
    const unsigned ldsw = (unsigned)wid * 1024u;
    const int aoff = lds_byte(wr * 64 + fr, fq * 8), boff = lds_byte(wc * 32 + fr, fq * 8);
#define PG8_SA(b, h) (((b) * 2 + (h)) * HTB)
#define PG8_SB(b, h) ((4 + (b) * 2 + (h)) * HTB)
#define PG8_STAGE(bufoff, gbase, voff) do { _Pragma("unroll") for (int _i = 0; _i < 2; ++_i) \
        __builtin_amdgcn_global_load_lds((const unsigned*)((const char*)(gbase) + (voff)[_i]), (PG8_LAS unsigned*)(lds + (bufoff) + ldsw + _i * 8192), 16, 0, 0); } while (0)
#define PG8_LDA(dst, b, h) do { _Pragma("unroll") for (int m = 0; m < 4; ++m) _Pragma("unroll") for (int k = 0; k < 2; ++k) dst[m][k] = *(const PG8_LAS bf16x8*)(lds + PG8_SA(b, h) + aoff + m * 2048 + k * 1024); } while (0)
#define PG8_LDB(dst, b, h) do { _Pragma("unroll") for (int n = 0; n < 2; ++n) _Pragma("unroll") for (int k = 0; k < 2; ++k) dst[n][k] = *(const PG8_LAS bf16x8*)(lds + PG8_SB(b, h) + boff + n * 2048 + k * 1024); } while (0)
#define PG8_MMA(ai, bj, At, Bt) do { __builtin_amdgcn_s_setprio(1); _Pragma("unroll") for (int m = 0; m < 4; ++m) _Pragma("unroll") for (int n = 0; n < 2; ++n) _Pragma("unroll") for (int k = 0; k < 2; ++k) \
        acc[ai][bj][m][n] = __builtin_amdgcn_mfma_f32_16x16x32_bf16(Bt[n][k], At[m][k], acc[ai][bj][m][n], 0, 0, 0); __builtin_amdgcn_s_setprio(0); } while (0)
#define PG8_WAIT_V(n) asm volatile("s_waitcnt vmcnt(" #n ")" ::: "memory")
#define PG8_WAIT_L(n) asm volatile("s_waitcnt lgkmcnt(" #n ")" ::: "memory")
#define PG8_BAR __builtin_amdgcn_s_barrier()
#define PG8_SCHED __builtin_amdgcn_sched_barrier(0)
    Unit cur, nxt; int ui = 0;
    if (!S.next(0, cur)) return;
    f32x4 acc[2][2][4][2];
#pragma unroll
    for (int a = 0; a < 2; ++a)
#pragma unroll
        for (int b = 0; b < 2; ++b)
#pragma unroll
            for (int m = 0; m < 4; ++m)
#pragma unroll
                for (int n = 0; n < 2; ++n) acc[a][b][m][n] = (f32x4){0.f, 0.f, 0.f, 0.f};
    bf16x8 At[4][2], B0[2][2], B1[2][2];
    const char* cA = (const char*)g.A + (size_t)cur.pm * tstep; const char* cB = (const char*)g.Bt + (size_t)cur.pn * tstep;
    S.a_ready(cur);
    if constexpr (SP2) {
        PG8_STAGE(PG8_SB(0, 0), cB, voffB); PG8_STAGE(PG8_SB(0, 1), cB + hstep, voffB); PG8_STAGE(PG8_SA(0, 0), cA, voffA); PG8_STAGE(PG8_SA(0, 1), cA + hstep, voffA);
        if (wr == 1) PG8_BAR;
        PG8_WAIT_V(2); PG8_BAR;
        PG8_STAGE(PG8_SB(1, 0), cB + kstep, voffB); PG8_STAGE(PG8_SA(1, 0), cA + kstep, voffA); PG8_STAGE(PG8_SB(1, 1), cB + hstep + kstep, voffB);
        PG8_WAIT_V(6); PG8_BAR;
    } else {
        PG8_STAGE(PG8_SB(0, 0), cB, voffB); PG8_STAGE(PG8_SA(0, 0), cA, voffA); PG8_STAGE(PG8_SB(0, 1), cB + hstep, voffB); PG8_STAGE(PG8_SA(0, 1), cA + hstep, voffA);
        if (wr == 1) PG8_BAR;
        PG8_WAIT_V(4); PG8_BAR;
        PG8_STAGE(PG8_SB(1, 0), cB + kstep, voffB); PG8_STAGE(PG8_SA(1, 0), cA + kstep, voffA); PG8_STAGE(PG8_SB(1, 1), cB + hstep + kstep, voffB);
        PG8_WAIT_V(6); PG8_BAR;
    }
    for (;;) {
        const bool has_next = S.next(ui + 1, nxt);
        const char* nA = has_next ? (const char*)g.A + (size_t)nxt.pm * tstep : cA; const char* nB = has_next ? (const char*)g.Bt + (size_t)nxt.pn * tstep : cB;
        for (int t = 0; t < nt; t += 2) {
            const bool last = (t == nt - 2);
            const char* a1 = cA + (size_t)(t + 1) * kstep;
            const char* a2 = last ? nA : cA + (size_t)(t + 2) * kstep; const char* b2 = last ? nB : cB + (size_t)(t + 2) * kstep;
            const char* a3 = a2 + kstep; const char* b3 = b2 + kstep;
            if (last && has_next) S.a_ready(nxt);
            if constexpr (SP2) {
            PG8_LDB(B0, 0, 0); PG8_LDB(B1, 0, 1); PG8_SCHED; PG8_LDA(At, 0, 0); PG8_STAGE(PG8_SA(1, 1), a1 + hstep, voffA);
            PG8_WAIT_V(8); PG8_WAIT_L(0); PG8_BAR; PG8_MMA(0, 0, At, B0); PG8_MMA(0, 1, At, B1); PG8_BAR; PG8_SCHED;
            PG8_LDA(At, 0, 1); PG8_STAGE(PG8_SB(0, 0), b2, voffB); PG8_STAGE(PG8_SB(0, 1), b2 + hstep, voffB); PG8_STAGE(PG8_SA(0, 0), a2, voffA);
            PG8_WAIT_V(8); PG8_WAIT_L(0); PG8_BAR; PG8_MMA(1, 0, At, B0); PG8_MMA(1, 1, At, B1); PG8_BAR; PG8_SCHED;
            PG8_LDB(B0, 1, 0); PG8_LDB(B1, 1, 1); PG8_SCHED; PG8_LDA(At, 1, 0); PG8_STAGE(PG8_SA(0, 1), a2 + hstep, voffA);
            PG8_WAIT_V(8); PG8_WAIT_L(0); PG8_BAR; PG8_MMA(0, 0, At, B0); PG8_MMA(0, 1, At, B1); PG8_BAR; PG8_SCHED;
            PG8_LDA(At, 1, 1); PG8_STAGE(PG8_SB(1, 0), b3, voffB); PG8_STAGE(PG8_SB(1, 1), b3 + hstep, voffB); PG8_STAGE(PG8_SA(1, 0), a3, voffA);
            PG8_WAIT_V(8); PG8_WAIT_L(0); PG8_BAR; PG8_MMA(1, 0, At, B0); PG8_MMA(1, 1, At, B1); PG8_BAR; PG8_SCHED;
            } else {
            PG8_LDB(B0, 0, 0); PG8_SCHED; PG8_LDA(At, 0, 0); PG8_STAGE(PG8_SA(1, 1), a1 + hstep, voffA);
            PG8_WAIT_L(8); PG8_BAR; PG8_WAIT_L(0); PG8_MMA(0, 0, At, B0); PG8_BAR; PG8_SCHED;
            PG8_LDB(B1, 0, 1); PG8_STAGE(PG8_SB(0, 0), b2, voffB);
            PG8_BAR; PG8_WAIT_L(0); PG8_MMA(0, 1, At, B1); PG8_BAR;
            PG8_LDA(At, 0, 1); PG8_STAGE(PG8_SA(0, 0), a2, voffA);
            PG8_BAR; PG8_WAIT_L(0); PG8_MMA(1, 0, At, B0); PG8_BAR; PG8_SCHED;
            PG8_STAGE(PG8_SB(0, 1), b2 + hstep, voffB);
            PG8_WAIT_V(6); PG8_BAR; PG8_MMA(1, 1, At, B1); PG8_BAR;
            PG8_LDB(B0, 1, 0); PG8_SCHED; PG8_LDA(At, 1, 0); PG8_STAGE(PG8_SA(0, 1), a2 + hstep, voffA);
            PG8_WAIT_L(8); PG8_BAR; PG8_WAIT_L(0); PG8_MMA(0, 0, At, B0); PG8_BAR; PG8_SCHED;
            PG8_LDB(B1, 1, 1); PG8_STAGE(PG8_SB(1, 0), b3, voffB);
            PG8_BAR; PG8_WAIT_L(0); PG8_MMA(0, 1, At, B1); PG8_BAR;
            PG8_LDA(At, 1, 1); PG8_STAGE(PG8_SA(1, 0), a3, voffA);
            PG8_BAR; PG8_WAIT_L(0); PG8_MMA(1, 0, At, B0); PG8_BAR; PG8_SCHED;
            PG8_STAGE(PG8_SB(1, 1), b3 + hstep, voffB);
            PG8_WAIT_V(6); PG8_BAR; PG8_MMA(1, 1, At, B1); PG8_BAR;
            }
        }
        if constexpr (ALIGN_EPI) { if (wr == 0) PG8_BAR; }
        if constexpr (!Epi::AFTER_DRAIN) { E(acc, cur, wr, wc, fr, fq); S.done(cur); }
        if (!has_next) break;
#pragma unroll
        for (int a = 0; a < 2; ++a)
#pragma unroll
            for (int b = 0; b < 2; ++b)
#pragma unroll
                for (int m = 0; m < 4; ++m)
#pragma unroll
                    for (int n = 0; n < 2; ++n) acc[a][b][m][n] = (f32x4){0.f, 0.f, 0.f, 0.f};
        cur = nxt; cA = nA; cB = nB; ++ui;
        if constexpr (ALIGN_EPI) { if (wr == 1) PG8_BAR; }
    }
    PG8_WAIT_V(0);
    if constexpr (!ALIGN_EPI) { if (wr == 0) PG8_BAR; }
    PG8_BAR;
    if constexpr (Epi::AFTER_DRAIN) { E.fused(acc, cur, wr, wc, fr, fq, lds, wid, lane); S.done(cur); }
#undef PG8_SA
#undef PG8_SB
#undef PG8_STAGE
#undef PG8_LDA
#undef PG8_LDB
#undef PG8_MMA
#undef PG8_WAIT_V
#undef PG8_WAIT_L
#undef PG8_BAR
#undef PG8_SCHED
}

__device__ __forceinline__ unsigned cvt2(float lo, float hi) { typedef float f32x2_t __attribute__((ext_vector_type(2))); typedef __bf16 bf16x2_t __attribute__((ext_vector_type(2)));
    f32x2_t v = {lo, hi}; bf16x2_t b = __builtin_convertvector(v, bf16x2_t); return __builtin_bit_cast(unsigned, b); }
__device__ __forceinline__ u32x4 pack8(const f32x4& v0, const f32x4& v1) { u32x4 w; w.x = cvt2(v0[0], v0[1]); w.y = cvt2(v0[2], v0[3]); w.z = cvt2(v1[0], v1[1]); w.w = cvt2(v1[2], v1[3]); return w; }
__device__ __forceinline__ float rstdf(const float* rss, int row, float invk) { return 1.0f / sqrtf(rss[row] * invk + EPS); }

struct FEpiQKV {
    static constexpr bool PERM = true, AFTER_DRAIN = false;
    const float* rss; bf16_t* Q; const float* TA;
    __device__ __forceinline__ void operator()(const f32x4 (&acc)[2][2][4][2], const Unit& u, int wr, int wc, int, int) const { apply<false>(acc, u, wr, wc); }
    template <bool SK> __device__ __forceinline__ void apply(const f32x4 (&acc)[2][2][4][2], const Unit& u, int wr, int wc) const {
        constexpr int NAI = SK ? 1 : 2, NM = SK ? 1 : 4;
        int lane_e; asm volatile("v_mbcnt_lo_u32_b32 %0, -1, 0\n\tv_mbcnt_hi_u32_b32 %0, -1, %0" : "=v"(lane_e));
        const int fr = lane_e & 15, fq = lane_e >> 4;
        const int colt = u.pn * BM, t = colt >> 10;
        bf16_t* base = Q + (size_t)t * (ROWB1024 / 2) + (colt & 1023) + wc * 32 + 8 * fq;
        const bool rot = (t < 2) && ((wc & 1) == 0);
        const float sgn = fq == 0 ? -1.f : 1.f; const bool mine = fq < 2;
#pragma unroll
        for (int ai = 0; ai < NAI; ++ai)
#pragma unroll
            for (int m = 0; m < NM; ++m) {
                const int row = u.pm * BM + ai * HALF + wr * 64 + m * 16 + fr;
                const float rs = rstdf(rss, row, 1.0f / 1024.0f);
                f32x4 cs[4];
                if (rot) { const f32x4* tp = (const f32x4*)(TA + (size_t)row_pos(row) * 16);
#pragma unroll
                    for (int k = 0; k < 4; ++k) cs[k] = tp[k]; }
#pragma unroll
                for (int bj = 0; bj < 2; ++bj) {
                    f32x4 v0 = acc[ai][bj][m][0] * rs, v1 = acc[ai][bj][m][1] * rs;
                    if (rot) {
                        f32x4 r0, r1;
#pragma unroll
                        for (int e = 0; e < 4; ++e) { const float o0 = __shfl_xor(v0[e], 16), o1 = __shfl_xor(v1[e], 16);
                            r0[e] = v0[e] * cs[e >> 1][(e & 1) * 2] + sgn * o0 * cs[e >> 1][(e & 1) * 2 + 1];
                            r1[e] = v1[e] * cs[2 + (e >> 1)][(e & 1) * 2] + sgn * o1 * cs[2 + (e >> 1)][(e & 1) * 2 + 1]; }
                        if (mine) { v0 = r0; v1 = r1; }
                    }
                    *(u32x4*)(base + (size_t)row * 1024 + bj * HALF) = pack8(v0, v1);
                }
            }
    }
};
struct FEpiRes {
    static constexpr bool PERM = true, AFTER_DRAIN = false;
    float* out; float* hmeta; bf16_t* HB; float* rss;
    __device__ __forceinline__ void operator()(const f32x4 (&acc)[2][2][4][2], const Unit& u, int wr, int wc, int, int) const { apply<false>(acc, u, wr, wc); }
    template <bool SK> __device__ __forceinline__ void apply(const f32x4 (&acc)[2][2][4][2], const Unit& u, int wr, int wc) const {
        constexpr int NAI = SK ? 1 : 2, NM = SK ? 1 : 4;
        int lane_e; asm volatile("v_mbcnt_lo_u32_b32 %0, -1, 0\n\tv_mbcnt_hi_u32_b32 %0, -1, %0" : "=v"(lane_e));
        const int fr = lane_e & 15, fq = lane_e >> 4;
        float* hb_ = u.pm < 64 ? out + (size_t)u.pm * BM * 1024 : hmeta;
        const int col0 = u.pn * BM + wc * 32 + 8 * fq;
#pragma unroll
        for (int ai = 0; ai < NAI; ++ai)
#pragma unroll
            for (int m = 0; m < NM; ++m) {
                const int rl = ai * HALF + wr * 64 + m * 16 + fr, row = u.pm * BM + rl; float* hp = hb_ + (size_t)rl * 1024 + col0;
                float ss = 0.f;
#pragma unroll
                for (int bj = 0; bj < 2; ++bj) {
                    const f32x4 h0 = *(const f32x4*)(hp + bj * HALF) + acc[ai][bj][m][0], h1 = *(const f32x4*)(hp + bj * HALF + 4) + acc[ai][bj][m][1];
                    *(f32x4*)(hp + bj * HALF) = h0; *(f32x4*)(hp + bj * HALF + 4) = h1;
                    ss += (h0[0] * h0[0] + h0[1] * h0[1]) + (h0[2] * h0[2] + h0[3] * h0[3]) + (h1[0] * h1[0] + h1[1] * h1[1]) + (h1[2] * h1[2] + h1[3] * h1[3]);
                    if (HB) *(u32x4*)(HB + (size_t)row * 1024 + col0 + bj * HALF) = pack8(h0, h1);
                    asm volatile("" ::: "memory");
                }
                ss += __shfl_xor(ss, 16); ss += __shfl_xor(ss, 32);
                if (fq == 0) atomicAdd(rss + row, ss);
                asm volatile("" ::: "memory");
            }
    }
};
struct FEpiFFN {
    static constexpr bool PERM = true, AFTER_DRAIN = false;
    const float* rss; const float* cw; const float* cb; bf16_t* G; float* SA; float* SB; PG8_LAS float* X;
    __device__ __forceinline__ void operator()(const f32x4 (&acc)[2][2][4][2], const Unit& u, int wr, int wc, int, int) const { apply<false>(acc, u, wr, wc); }
    template <bool SK> __device__ __forceinline__ void apply(const f32x4 (&acc)[2][2][4][2], const Unit& u, int wr, int wc) const {
        constexpr int NAI = SK ? 1 : 2, NM = SK ? 1 : 4;
        int lane_e; asm volatile("v_mbcnt_lo_u32_b32 %0, -1, 0\n\tv_mbcnt_hi_u32_b32 %0, -1, %0" : "=v"(lane_e));
        const int fr = lane_e & 15, fq = lane_e >> 4;
        const int lane = fr + 16 * fq;
        const int cc0 = u.pn * HALF + wc * 32 + 8 * fq;
        f32x4 w0[2], w1[2], w2[2], bs[2];
#pragma unroll
        for (int n = 0; n < 2; ++n) { w0[n] = *(const f32x4*)(cw + cc0 + 4 * n); w1[n] = *(const f32x4*)(cw + DFF + cc0 + 4 * n); w2[n] = *(const f32x4*)(cw + 2 * DFF + cc0 + 4 * n); bs[n] = *(const f32x4*)(cb + cc0 + 4 * n); }
        if (!SK) {
#pragma unroll
            for (int ai = 0; ai < 2; ++ai) { const int row = u.pm * BM + ai * HALF + wr * 64 + 48 + fr; const float rsl = rstdf(rss, row, 1.0f / 1024.0f);
                if (fr >= 14) { PG8_LAS float* xp = X + (((2 * ai + wr) * 4 + wc) * 2 + (fr - 14)) * 32 + 8 * fq;
                    *(PG8_LAS f32x4*)xp = acc[ai][0][3][0] * rsl; *(PG8_LAS f32x4*)(xp + 4) = acc[ai][0][3][1] * rsl; } }
            asm volatile("s_waitcnt lgkmcnt(0)" ::: "memory"); __builtin_amdgcn_s_barrier(); asm volatile("" ::: "memory");
        }
        const int src1 = (lane & 48) | ((fr - 1) & 15), src2 = (lane & 48) | ((fr - 2) & 15);
#pragma unroll
        for (int ai = 0; ai < NAI; ++ai) {
            const int strip = 2 * ai + wr;
            f32x4 pa[2] = {(f32x4){0.f, 0.f, 0.f, 0.f}, (f32x4){0.f, 0.f, 0.f, 0.f}};
#pragma unroll
            for (int m = 0; m < NM; ++m) {
                const int rl = ai * HALF + wr * 64 + m * 16 + fr, row = u.pm * BM + rl;
                const float rs = rstdf(rss, row, 1.0f / 1024.0f);
                f32x4 a[2], b[2], p1[2], p2[2];
#pragma unroll
                for (int n = 0; n < 2; ++n) { a[n] = acc[ai][0][m][n] * rs; b[n] = acc[ai][1][m][n] * rs; }
#pragma unroll
                for (int n = 0; n < 2; ++n)
#pragma unroll
                    for (int e = 0; e < 4; ++e) { const float s1 = (m > 0 && fr == 15) ? pa[n][e] : a[n][e], s2 = (m > 0 && fr >= 14) ? pa[n][e] : a[n][e];
                        p1[n][e] = __shfl(s1, src1); p2[n][e] = __shfl(s2, src2); }
                if (m == 0 && strip > 0) {
                    const PG8_LAS float* xp = X + (((strip - 1) * 4 + wc) * 2) * 32 + 8 * fq;
#pragma unroll
                    for (int n = 0; n < 2; ++n) { const f32x4 h62 = *(const PG8_LAS f32x4*)(xp + 4 * n), h63 = *(const PG8_LAS f32x4*)(xp + 32 + 4 * n);
                        if (fr == 0) { p1[n] = h63; p2[n] = h62; } else if (fr == 1) { p2[n] = h63; } }
                }
                f32x4 g[2];
#pragma unroll
                for (int n = 0; n < 2; ++n)
#pragma unroll
                    for (int e = 0; e < 4; ++e) { const float ac = bs[n][e] + w0[n][e] * p2[n][e] + w1[n][e] * p1[n][e] + w2[n][e] * a[n][e];
                        g[n][e] = ac * __builtin_amdgcn_rcpf(1.0f + __builtin_amdgcn_exp2f(-LOG2E * ac)) * b[n][e]; }
                const bool head = (strip == 0 && m == 0 && fr < 2);
                if (!head) *(u32x4*)(G + (size_t)row * DFF + cc0) = pack8(g[0], g[1]);
                else { float* sa = SA + ((size_t)u.pm * 4 + fr) * DFF + cc0; float* sb = SB + ((size_t)u.pm * 2 + fr) * DFF + cc0;
                    *(f32x4*)sa = a[0]; *(f32x4*)(sa + 4) = a[1]; *(f32x4*)sb = b[0]; *(f32x4*)(sb + 4) = b[1]; }
                const bool tail = (u.pm < 64) ? (strip == 3 && m == 3 && fr >= 14) : (strip == 0 && m == 0 && fr >= 14);
                if (tail) { float* sa = SA + ((size_t)u.pm * 4 + 2 + (fr - 14)) * DFF + cc0; *(f32x4*)sa = a[0]; *(f32x4*)(sa + 4) = a[1]; }
                pa[0] = a[0]; pa[1] = a[1];
            }
        }
    }
};
__device__ __forceinline__ void rope32(f32x4& v0, f32x4& v1, const float* TB, int pos, int fq) {
    const f32x4* tp = (const f32x4*)(TB + (size_t)pos * 32 + 16 * (fq & 1)); const float sgn = fq < 2 ? -1.f : 1.f;
    f32x4 cs[4];
#pragma unroll
    for (int k = 0; k < 4; ++k) cs[k] = tp[k];
#pragma unroll
    for (int e = 0; e < 4; ++e) { const float o0 = __shfl_xor(v0[e], 32), o1 = __shfl_xor(v1[e], 32);
        v0[e] = v0[e] * cs[e >> 1][(e & 1) * 2] + sgn * o0 * cs[e >> 1][(e & 1) * 2 + 1];
        v1[e] = v1[e] * cs[2 + (e >> 1)][(e & 1) * 2] + sgn * o1 * cs[2 + (e >> 1)][(e & 1) * 2 + 1]; }
}
struct FEpiD {
    static constexpr bool PERM = true, AFTER_DRAIN = false;
    const float* rss; bf16_t* CQ; bf16_t* CKV; bf16_t* KR; float* rssq; float* rsskv; const float* TB;
    __device__ __forceinline__ void operator()(const f32x4 (&acc)[2][2][4][2], const Unit& u, int wr, int wc, int, int) const { apply<false>(acc, u, wr, wc); }
    template <bool SK> __device__ __forceinline__ void apply(const f32x4 (&acc)[2][2][4][2], const Unit& u, int wr, int wc) const {
        constexpr int NAI = SK ? 1 : 2, NM = SK ? 1 : 4;
        int lane_e; asm volatile("v_mbcnt_lo_u32_b32 %0, -1, 0\n\tv_mbcnt_hi_u32_b32 %0, -1, %0" : "=v"(lane_e));
        const int fr = lane_e & 15, fq = lane_e >> 4;
#pragma unroll
        for (int ai = 0; ai < NAI; ++ai)
#pragma unroll
            for (int m = 0; m < NM; ++m) {
                const int row = u.pm * BM + ai * HALF + wr * 64 + m * 16 + fr; const float rs = rstdf(rss, row, 1.0f / 1024.0f);
                float sq = 0.f, skv = 0.f;
#pragma unroll
                for (int bj = 0; bj < 2; ++bj) {
                    const int g128 = u.pn * 2 + bj, c = wc * 32 + 8 * fq;
                    f32x4 v0 = acc[ai][bj][m][0] * rs, v1 = acc[ai][bj][m][1] * rs;
                    const float s = (v0[0] * v0[0] + v0[1] * v0[1]) + (v0[2] * v0[2] + v0[3] * v0[3]) + (v1[0] * v1[0] + v1[1] * v1[1]) + (v1[2] * v1[2] + v1[3] * v1[3]);
                    if (g128 < 3) { sq += s; *(u32x4*)(CQ + (size_t)row * 384 + g128 * 128 + c) = pack8(v0, v1); }
                    else if (g128 < 5) { skv += s; *(u32x4*)(CKV + (size_t)row * 256 + (g128 - 3) * 128 + c) = pack8(v0, v1); }
                    else if (wc == 0) { rope32(v0, v1, TB, row_pos(row), fq); *(u32x4*)(KR + (size_t)row * 32 + c) = pack8(v0, v1); }
                }
                if (u.pn < 2) { sq += __shfl_xor(sq, 16); sq += __shfl_xor(sq, 32); if (fq == 0) atomicAdd(rssq + row, sq); }
                if (u.pn > 0) { skv += __shfl_xor(skv, 16); skv += __shfl_xor(skv, 32); if (fq == 0) atomicAdd(rsskv + row, skv); }
            }
    }
};
template <bool ROPE> struct FEpiUp {
    static constexpr bool PERM = true, AFTER_DRAIN = false;
    const float* rss; float invk; bf16_t* O; int ldo; const float* TB;
    __device__ __forceinline__ void operator()(const f32x4 (&acc)[2][2][4][2], const Unit& u, int wr, int wc, int, int) const { apply<false>(acc, u, wr, wc); }
    template <bool SK> __device__ __forceinline__ void apply(const f32x4 (&acc)[2][2][4][2], const Unit& u, int wr, int wc) const {
        constexpr int NAI = SK ? 1 : 2, NM = SK ? 1 : 4;
        int lane_e; asm volatile("v_mbcnt_lo_u32_b32 %0, -1, 0\n\tv_mbcnt_hi_u32_b32 %0, -1, %0" : "=v"(lane_e));
        const int fr = lane_e & 15, fq = lane_e >> 4;
#pragma unroll
        for (int ai = 0; ai < NAI; ++ai)
#pragma unroll
            for (int m = 0; m < NM; ++m) {
                const int row = u.pm * BM + ai * HALF + wr * 64 + m * 16 + fr; const float rs = rstdf(rss, row, invk);
#pragma unroll
                for (int bj = 0; bj < 2; ++bj) {
                    f32x4 v0 = acc[ai][bj][m][0] * rs, v1 = acc[ai][bj][m][1] * rs;
                    if (ROPE) { const int g32 = 8 * u.pn + 4 * bj + wc; if (g32 % 3 == 2) rope32(v0, v1, TB, row_pos(row), fq); }
                    *(u32x4*)(O + (size_t)row * ldo + u.pn * BM + bj * HALF + wc * 32 + 8 * fq) = pack8(v0, v1);
                    asm volatile("" ::: "memory");
                }
            }
    }
};

template <class Epi>
__device__ __forceinline__ void skinny_gemm(PG8_LAS unsigned char* lds, const bf16_t* A, const bf16_t* Bt, int N, int K, const Epi& E, int vcu, int G, int wave, int lane) {
    const int njobs = (N / BM) * 4, fr = lane & 15, fq = lane >> 4, nks = K / 32;
    for (int j = vcu; j < njobs; j += G) {
        const int pn = j >> 2, wc = j & 3;
        f32x4 pacc[2][2];
#pragma unroll
        for (int bj = 0; bj < 2; ++bj)
#pragma unroll
            for (int n = 0; n < 2; ++n) pacc[bj][n] = (f32x4){0.f, 0.f, 0.f, 0.f};
        const bf16_t* ap = A + (size_t)(64 * BM + fr) * K + 8 * fq;
        const bf16_t* bp[2][2];
#pragma unroll
        for (int bj = 0; bj < 2; ++bj)
#pragma unroll
            for (int n = 0; n < 2; ++n) bp[bj][n] = Bt + (size_t)(pn * BM + bj * HALF + wc * 32 + perm32(16 * n + fr)) * K + 8 * fq;
#pragma nounroll
        for (int ks0 = wave * 4; ks0 < nks; ks0 += 32) {
            bf16x8 a[4], b[4][2][2];
#pragma unroll
            for (int s = 0; s < 4; ++s) { a[s] = *(const bf16x8*)(ap + (ks0 + s) * 32);
#pragma unroll
                for (int bj = 0; bj < 2; ++bj)
#pragma unroll
                    for (int n = 0; n < 2; ++n) b[s][bj][n] = *(const bf16x8*)(bp[bj][n] + (ks0 + s) * 32); }
#pragma unroll
            for (int s = 0; s < 4; ++s)
#pragma unroll
                for (int bj = 0; bj < 2; ++bj)
#pragma unroll
                    for (int n = 0; n < 2; ++n) pacc[bj][n] = __builtin_amdgcn_mfma_f32_16x16x32_bf16(b[s][bj][n], a[s], pacc[bj][n], 0, 0, 0);
        }
        PG8_LAS f32x4* P = (PG8_LAS f32x4*)lds + (wave * 64 + lane) * 4;
        P[0] = pacc[0][0]; P[1] = pacc[0][1]; P[2] = pacc[1][0]; P[3] = pacc[1][1];
        __syncthreads();
        if (wave == 0) {
            f32x4 acc[2][2][4][2];
#pragma unroll
            for (int w = 1; w < 8; ++w) { const PG8_LAS f32x4* Q = (const PG8_LAS f32x4*)lds + (w * 64 + lane) * 4;
                pacc[0][0] += Q[0]; pacc[0][1] += Q[1]; pacc[1][0] += Q[2]; pacc[1][1] += Q[3]; }
            acc[0][0][0][0] = pacc[0][0]; acc[0][0][0][1] = pacc[0][1]; acc[0][1][0][0] = pacc[1][0]; acc[0][1][0][1] = pacc[1][1];
            Unit u; u.pm = 64; u.pn = pn;
            E.template apply<true>(acc, u, 0, wc);
        }
        __syncthreads();
    }
}
}

__device__ __forceinline__ void ph_rot_a(const Params& p, const Ctx& c) {
    const float2* TA = (const float2*)(p.ws + WS_ROPE);
    const int gt = c.gw * 64 + c.lane, ngt = c.ngw * 64;
    for (int t = gt; t < RV * 256; t += ngt) {
        const int i = t & 7, sh = (t >> 3) & 15, which = (t >> 7) & 1, row = t >> 8;
        bf16_t* buf = (bf16_t*)(p.ws + (which ? WS_K : WS_Q)) + (size_t)row * 1024 + sh * 64;
        const float x1 = bf2f(buf[i]), x2 = bf2f(buf[8 + i]); const float2 cs = TA[row_pos(row) * 8 + i];
        buf[i] = (bf16_t)f2bf(x1 * cs.x - x2 * cs.y); buf[8 + i] = (bf16_t)f2bf(x2 * cs.x + x1 * cs.y);
    }
}
__device__ __forceinline__ void ph_dpost(const Params& p, const Ctx& c) {
    const float2* TB = (const float2*)(p.ws + WS_ROPE) + 2064 * 8;
    const int gt = c.gw * 64 + c.lane, ngt = c.ngw * 64;
    for (int t = gt; t < RV * 16; t += ngt) {
        const int i = t & 15, row = t >> 4; bf16_t* buf = (bf16_t*)(p.ws + WS_KR) + (size_t)row * 32;
        const float x1 = bf2f(buf[i]), x2 = bf2f(buf[16 + i]); const float2 cs = TB[row_pos(row) * 16 + i];
        buf[i] = (bf16_t)f2bf(x1 * cs.x - x2 * cs.y); buf[16 + i] = (bf16_t)f2bf(x2 * cs.x + x1 * cs.y);
    }
    float* rq = rss_ptr(p, 5); float* rkv = rss_ptr(p, 6);
    for (int r = c.gw; r < RT; r += c.ngw) {
        const bf16_t* cq = (const bf16_t*)(p.ws + WS_CQ) + (size_t)r * 384; const bf16_t* ckv = (const bf16_t*)(p.ws + WS_CKV) + (size_t)r * 256;
        float s1 = 0.f, s2 = 0.f;
        for (int k = c.lane; k < 384; k += 64) { const float v = bf2f(cq[k]); s1 += v * v; }
        for (int k = c.lane; k < 256; k += 64) { const float v = bf2f(ckv[k]); s2 += v * v; }
        s1 = wave_sum(s1); s2 = wave_sum(s2);
        if (c.lane == 0) { rq[r] = s1; rkv[r] = s2; }
    }
}
__device__ __forceinline__ void ph_rot_b(const Params& p, const Ctx& c) {
    const float2* TB = (const float2*)(p.ws + WS_ROPE) + 2064 * 8;
    const int gt = c.gw * 64 + c.lane, ngt = c.ngw * 64;
    for (int t = gt; t < RV * 256; t += ngt) {
        const int i = t & 15, h = (t >> 4) & 15, row = t >> 8; bf16_t* buf = (bf16_t*)(p.ws + WS_Q2) + (size_t)row * 1536 + h * 96 + 64;
        const float x1 = bf2f(buf[i]), x2 = bf2f(buf[16 + i]); const float2 cs = TB[row_pos(row) * 16 + i];
        buf[i] = (bf16_t)f2bf(x1 * cs.x - x2 * cs.y); buf[16 + i] = (bf16_t)f2bf(x2 * cs.x + x1 * cs.y);
    }
}

__device__ __forceinline__ int prev_row(int r, int d, bool& has) {
    has = true;
    if (r < RR) { const int t = r & (SEQ - 1); if (t >= d) return r - d; return RV - d + t; }
    if (r < RV) { const int i = r - RR; if (i >= d) return r - d; has = false; return r; }
    has = false; return r;
}
__device__ __forceinline__ void ph_ffn_in(const Params& p, const Ctx& c, int layer, int site) {
    const bf16_t* A = (const bf16_t*)(p.ws + WS_HB); const bf16_t* Wt = (const bf16_t*)(p.ws + (layer ? W_IN1 : W_IN0));
    bf16_t* G = (bf16_t*)(p.ws + WS_G); const float* rss = rss_ptr(p, site);
    const float* cw = p.in[I_FFN_CW] + (size_t)layer * 3 * DFF; const float* cb = p.in[I_FFN_CB] + (size_t)layer * DFF;
    const int nct = DFF / 64, nrt = (RV + 15) / 16, items = nrt * nct;
    const int l15 = c.lane & 15, q4 = c.lane >> 4;
    for (int it = c.gw; it < items; it += c.ngw) {
        const int rt = it / nct, ct = it % nct;
        f32x4 a0[4], a1[4], a2[4], bb[4];
#pragma unroll
        for (int n = 0; n < 4; ++n) { a0[n] = a1[n] = a2[n] = bb[n] = (f32x4){0.f, 0.f, 0.f, 0.f}; }
        const int ra = rt * 16 + l15; bool h1, h2; const int r1 = prev_row(ra, 1, h1), r2 = prev_row(ra, 2, h2);
        const bf16_t* ap0 = A + (size_t)ra * D + 8 * q4; const bf16_t* ap1 = A + (size_t)r1 * D + 8 * q4; const bf16_t* ap2 = A + (size_t)r2 * D + 8 * q4;
        const bf16_t* bpa[4]; const bf16_t* bpb[4];
#pragma unroll
        for (int n = 0; n < 4; ++n) { const int cc = ct * 64 + 16 * n + l15; const int wr = 256 * (cc >> 7) + (cc & 127); bpa[n] = Wt + (size_t)wr * D + 8 * q4; bpb[n] = bpa[n] + (size_t)128 * D; }
        for (int k0 = 0; k0 < D; k0 += 32) {
            const bf16x8 x0 = *(const bf16x8*)(ap0 + k0), x1 = *(const bf16x8*)(ap1 + k0), x2 = *(const bf16x8*)(ap2 + k0);
#pragma unroll
            for (int n = 0; n < 4; ++n) { const bf16x8 wa = *(const bf16x8*)(bpa[n] + k0), wb = *(const bf16x8*)(bpb[n] + k0);
                a0[n] = __builtin_amdgcn_mfma_f32_16x16x32_bf16(x0, wa, a0[n], 0, 0, 0);
                a1[n] = __builtin_amdgcn_mfma_f32_16x16x32_bf16(x1, wa, a1[n], 0, 0, 0);
                a2[n] = __builtin_amdgcn_mfma_f32_16x16x32_bf16(x2, wa, a2[n], 0, 0, 0);
                bb[n] = __builtin_amdgcn_mfma_f32_16x16x32_bf16(x0, wb, bb[n], 0, 0, 0); }
        }
#pragma unroll
        for (int i = 0; i < 4; ++i) {
            const int row = rt * 16 + 4 * q4 + i; bool g1, g2; const int p1 = prev_row(row, 1, g1), p2 = prev_row(row, 2, g2);
            const float s0 = 1.0f / sqrtf(rss[row] * (1.0f / D) + EPS);
            const float s1 = g1 ? 1.0f / sqrtf(rss[p1] * (1.0f / D) + EPS) : 0.f, s2 = g2 ? 1.0f / sqrtf(rss[p2] * (1.0f / D) + EPS) : 0.f;
#pragma unroll
            for (int n = 0; n < 4; ++n) { const int cc = ct * 64 + 16 * n + l15;
                const float ac = cb[cc] + cw[cc] * (a2[n][i] * s2) + cw[DFF + cc] * (a1[n][i] * s1) + cw[2 * DFF + cc] * (a0[n][i] * s0);
                const float bv = bb[n][i] * s0; const float g = ac / (1.0f + __expf(-ac)) * bv;
                G[(size_t)row * DFF + cc] = (bf16_t)f2bf(g); }
        }
    }
}

__device__ __forceinline__ s16x4 vtr(const LAS unsigned char* p) { typedef short v4i16_t __attribute__((ext_vector_type(4)));
    return __builtin_bit_cast(s16x4, __builtin_amdgcn_ds_read_tr16_b64_v4i16((LAS v4i16_t*)p)); }
__device__ __forceinline__ unsigned cvtpk(float lo, float hi) { typedef float f32x2_t __attribute__((ext_vector_type(2))); typedef __bf16 bf16x2_t __attribute__((ext_vector_type(2)));
    f32x2_t v = {lo, hi}; bf16x2_t b = __builtin_convertvector(v, bf16x2_t); return __builtin_bit_cast(unsigned, b); }

struct SrcA { const bf16_t* K; const bf16_t* V; int h, s;
    __device__ __forceinline__ const bf16_t* kptr(int krow, int ch) const { return K + (size_t)krow * 1024 + h * 128 + s * 64 + ch * 8; }
    __device__ __forceinline__ const bf16_t* vptr(int krow, int ch) const { return V + (size_t)krow * 1024 + h * 128 + ch * 8; } };
struct SrcB { const bf16_t* KV; const bf16_t* KR; int h;
    __device__ __forceinline__ const bf16_t* kptr(int krow, int ch) const { return ch < 8 ? KV + (size_t)krow * 2048 + h * 128 + ch * 8 : KR + (size_t)krow * 32 + (ch - 8) * 8; }
    __device__ __forceinline__ const bf16_t* vptr(int krow, int ch) const { return KV + (size_t)krow * 2048 + h * 128 + 64 + ch * 8; } };

template <int DQK, int DV> struct ACfg { static constexpr int KS = DQK * 2 + 16, VS = DV * 2 + 64, KOFF = 0, VOFF = 64 * KS, SCR = VOFF + 64 * VS; };

template <int DQK, int DV, bool META>
__device__ __forceinline__ void attn_tile(const LAS unsigned char* Kt, const LAS unsigned char* Vt, LAS float* scr, const bf16x8 (&qf)[DQK / 16], f32x16 (&o)[DV / 32], float& m, float& lsum, int lane) {
    constexpr int KS = ACfg<DQK, DV>::KS, VS = ACfg<DQK, DV>::VS;
    const int r32 = lane & 31, hi = lane >> 5;
    f32x16 p0, p1;
#pragma unroll
    for (int r = 0; r < 16; ++r) { p0[r] = 0.f; p1[r] = 0.f; }
#pragma unroll
    for (int kk = 0; kk < DQK / 16; ++kk) {
        const bf16x8 k0 = *(const LAS bf16x8*)(Kt + r32 * KS + (16 * kk + 8 * hi) * 2);
        p0 = __builtin_amdgcn_mfma_f32_32x32x16_bf16(k0, qf[kk], p0, 0, 0, 0);
        if (!META) { const bf16x8 k1 = *(const LAS bf16x8*)(Kt + (32 + r32) * KS + (16 * kk + 8 * hi) * 2);
            p1 = __builtin_amdgcn_mfma_f32_32x32x16_bf16(k1, qf[kk], p1, 0, 0, 0); }
        if (kk & 1) __builtin_amdgcn_sched_barrier(0);
    }
    float mx = -INFINITY;
    if (META) {
#pragma unroll
        for (int r = 0; r < 8; ++r) mx = fmaxf(mx, p0[r]);
    } else {
#pragma unroll
        for (int r = 0; r < 16; ++r) mx = fmaxf(mx, fmaxf(p0[r], p1[r]));
    }
    mx = fmaxf(mx, __shfl_xor(mx, 32));
    const float mn = fmaxf(m, mx); const float alpha = __builtin_amdgcn_exp2f(m - mn); m = mn;
    float ps = 0.f;
    if (META) {
#pragma unroll
        for (int r = 0; r < 8; ++r) { p0[r] = __builtin_amdgcn_exp2f(p0[r] - mn); ps += p0[r]; }
    } else {
#pragma unroll
        for (int r = 0; r < 16; ++r) { p0[r] = __builtin_amdgcn_exp2f(p0[r] - mn); p1[r] = __builtin_amdgcn_exp2f(p1[r] - mn); ps += p0[r] + p1[r]; }
    }
    lsum = lsum * alpha + ps;
    if (__any(alpha != 1.0f)) {
        if (hi == 0) scr[r32] = alpha;
        asm volatile("s_waitcnt lgkmcnt(0)" ::: "memory");
#pragma unroll
        for (int r = 0; r < 16; ++r) { const float a = scr[crow(r, hi)];
#pragma unroll
            for (int d0 = 0; d0 < DV / 32; ++d0) o[d0][r] *= a; }
    }
    bf16x8 pa[4];
    { u32x4 w; w.x = cvtpk(p0[0], p0[1]); w.y = cvtpk(p0[2], p0[3]); w.z = cvtpk(p0[4], p0[5]); w.w = cvtpk(p0[6], p0[7]); pa[0] = __builtin_bit_cast(bf16x8, w); }
    if (!META) {
        { u32x4 w; w.x = cvtpk(p0[8], p0[9]); w.y = cvtpk(p0[10], p0[11]); w.z = cvtpk(p0[12], p0[13]); w.w = cvtpk(p0[14], p0[15]); pa[1] = __builtin_bit_cast(bf16x8, w); }
        { u32x4 w; w.x = cvtpk(p1[0], p1[1]); w.y = cvtpk(p1[2], p1[3]); w.z = cvtpk(p1[4], p1[5]); w.w = cvtpk(p1[6], p1[7]); pa[2] = __builtin_bit_cast(bf16x8, w); }
        { u32x4 w; w.x = cvtpk(p1[8], p1[9]); w.y = cvtpk(p1[10], p1[11]); w.z = cvtpk(p1[12], p1[13]); w.w = cvtpk(p1[14], p1[15]); pa[3] = __builtin_bit_cast(bf16x8, w); }
    }
    const LAS unsigned char* vb = Vt + (4 * hi + ((lane & 15) >> 2)) * VS + (16 * ((lane >> 4) & 1) + 4 * (lane & 3)) * 2;
#pragma unroll
    for (int ks = 0; ks < (META ? 1 : 4); ++ks) {
#pragma unroll
        for (int d0 = 0; d0 < DV / 32; ++d0) {
            const s16x4 lo = vtr(vb + (16 * ks) * VS + 64 * d0), hh = vtr(vb + (16 * ks + 8) * VS + 64 * d0);
            const bf16x8 vf = (bf16x8){lo[0], lo[1], lo[2], lo[3], hh[0], hh[1], hh[2], hh[3]};
            o[d0] = __builtin_amdgcn_mfma_f32_32x32x16_bf16(pa[ks], vf, o[d0], 0, 0, 0);
        }
        __builtin_amdgcn_sched_barrier(0);
    }
}

template <int DQK, int DV, class Src>
__device__ __forceinline__ void attn_pass(const Ctx& c, const Src& src, int b, int qb, const bf16x8 (&qf)[DQK / 16], f32x16 (&o)[DV / 32]) {
    typedef ACfg<DQK, DV> C;
    constexpr int KCH = DQK / 8, VCH = DV / 8;
    constexpr int NKL = (64 * KCH + NTHREADS - 1) / NTHREADS, NVL = (64 * VCH + NTHREADS - 1) / NTHREADS;
    LAS float* scr = (LAS float*)(c.lds + 2 * C::SCR) + c.wave * 64;
    const int hi = c.lane >> 5, r32 = c.lane & 31;
    float m = -INFINITY, lsum = 0.f;
#pragma unroll
    for (int d0 = 0; d0 < DV / 32; ++d0)
#pragma unroll
        for (int r = 0; r < 16; ++r) o[d0][r] = 0.f;
    const int NT = qb < 0 ? 0 : 4 * (qb + 1);
    const int myc = qb < 0 ? -1 : 4 * qb + (c.wave >> 1);
    const bool active = qb >= 0 || c.wave == 0;
    u32x4 kreg[NKL], vreg[NVL];
#define ATT_LOAD(jt_) do { int krow0_ = (jt_) < 0 ? RR : b * SEQ + 64 * (jt_); int tl_ = c.tid; asm volatile("" : "+s"(krow0_), "+v"(tl_));     \
        const int nk_ = (jt_) < 0 ? 32 : 64, nv_ = (jt_) < 0 ? 16 : 64; \
        _Pragma("unroll") for (int i_ = 0; i_ < NKL; ++i_) { const int idx_ = tl_ + i_ * NTHREADS; const int key_ = idx_ / KCH, ch_ = idx_ % KCH; if (key_ < nk_) kreg[i_] = *(const u32x4*)src.kptr(krow0_ + key_, ch_); } \
        _Pragma("unroll") for (int i_ = 0; i_ < NVL; ++i_) { const int idx_ = tl_ + i_ * NTHREADS; const int key_ = idx_ / VCH, ch_ = idx_ % VCH; if (key_ < nv_) vreg[i_] = *(const u32x4*)src.vptr(krow0_ + key_, ch_); } } while (0)
#define ATT_STORE(jt_, buf_) do { const int nk_ = (jt_) < 0 ? 32 : 64, nv_ = (jt_) < 0 ? 16 : 64; int ts_ = c.tid; asm volatile("" : "+v"(ts_)); LAS unsigned char* kt_ = c.lds + (buf_) * C::SCR + C::KOFF; LAS unsigned char* vt_ = c.lds + (buf_) * C::SCR + C::VOFF; \
        _Pragma("unroll") for (int i_ = 0; i_ < NKL; ++i_) { const int idx_ = ts_ + i_ * NTHREADS; const int key_ = idx_ / KCH, ch_ = idx_ % KCH; if (key_ < nk_) *(LAS u32x4*)(kt_ + key_ * C::KS + ch_ * 16) = kreg[i_]; } \
        _Pragma("unroll") for (int i_ = 0; i_ < NVL; ++i_) { const int idx_ = ts_ + i_ * NTHREADS; const int key_ = idx_ / VCH, ch_ = idx_ % VCH; if (key_ < nv_) *(LAS u32x4*)(vt_ + key_ * C::VS + ch_ * 16) = vreg[i_]; } } while (0)
    ATT_LOAD(-1); ATT_STORE(-1, 0);
    __syncthreads();
#pragma nounroll
    for (int jt = -1; jt < NT; ++jt) {
        const int cur = (jt + 1) & 1;
        if (jt + 1 < NT) ATT_LOAD(jt + 1);
        if (active && jt <= myc) {
            const LAS unsigned char* Kt = c.lds + cur * C::SCR + C::KOFF; const LAS unsigned char* Vt = c.lds + cur * C::SCR + C::VOFF;
            if (jt < 0) attn_tile<DQK, DV, true>(Kt, Vt, scr, qf, o, m, lsum, c.lane);
            else attn_tile<DQK, DV, false>(Kt, Vt, scr, qf, o, m, lsum, c.lane);
        }
        if (jt + 1 < NT) ATT_STORE(jt + 1, cur ^ 1);
        __syncthreads();
    }
#undef ATT_LOAD
#undef ATT_STORE
    const float lt = lsum + __shfl_xor(lsum, 32);
    if (hi == 0) scr[32 + r32] = 1.0f / lt;
    asm volatile("s_waitcnt lgkmcnt(0)" ::: "memory");
#pragma unroll
    for (int r = 0; r < 16; ++r) { const float a = scr[32 + crow(r, hi)];
#pragma unroll
        for (int d0 = 0; d0 < DV / 32; ++d0) o[d0][r] *= a; }
}

__device__ __forceinline__ void attn_unit_a(const Params& p, const Ctx& c, int b, int h, int qb, float lam) {
    const int q0 = qb < 0 ? RR : b * SEQ + 256 * qb; const int hi = c.lane >> 5, r32 = c.lane & 31;
    bf16_t* Qb = (bf16_t*)(p.ws + WS_Q); bf16_t* O1 = (bf16_t*)(p.ws + WS_OB2);
    const bool active = qb >= 0 || c.wave == 0;
    f32x16 o[4];
#pragma nounroll
    for (int s = 0; s < 2; ++s) {
        const bf16_t* qrow = Qb + (size_t)(q0 + 32 * c.wave + r32) * 1024 + h * 128 + s * 64;
        bf16x8 qf[4];
#pragma unroll
        for (int kk = 0; kk < 4; ++kk) qf[kk] = *(const bf16x8*)(qrow + 16 * kk + 8 * hi);
        SrcA src{(const bf16_t*)(p.ws + WS_K), (const bf16_t*)(p.ws + WS_V), h, s};
        attn_pass<64, 128, SrcA>(c, src, b, qb, qf, o);
        if (s == 0 && active) {
            int rb = q0 + 32 * c.wave; asm volatile("" : "+s"(rb));
#pragma unroll
            for (int r = 0; r < 16; ++r) { bf16_t* orow = O1 + (size_t)(rb + crow(r, hi)) * 1024 + h * 128 + r32;
                orow[0] = (bf16_t)f2bf(o[0][r]); orow[32] = (bf16_t)f2bf(o[1][r]); orow[64] = (bf16_t)f2bf(o[2][r]); orow[96] = (bf16_t)f2bf(o[3][r]); }
        }
    }
    if (!active) return;
    int rb = q0 + 32 * c.wave; asm volatile("" : "+s"(rb));
#pragma unroll
    for (int r = 0; r < 16; ++r) {
        const size_t off = (size_t)(rb + crow(r, hi)) * 1024 + h * 128 + r32;
        const float v0 = bf2f(O1[off]) - lam * o[0][r], v1 = bf2f(O1[off + 32]) - lam * o[1][r], v2 = bf2f(O1[off + 64]) - lam * o[2][r], v3 = bf2f(O1[off + 96]) - lam * o[3][r];
        float ss = v0 * v0 + v1 * v1 + v2 * v2 + v3 * v3;
#pragma unroll
        for (int sh = 1; sh < 32; sh <<= 1) ss += __shfl_xor(ss, sh);
        const float rs = 1.0f / sqrtf(ss * (1.0f / 128.0f) + EPS);
        bf16_t* orow = Qb + off;
        orow[0] = (bf16_t)f2bf(v0 * rs); orow[32] = (bf16_t)f2bf(v1 * rs); orow[64] = (bf16_t)f2bf(v2 * rs); orow[96] = (bf16_t)f2bf(v3 * rs);
        if ((r & 3) == 3) asm volatile("" ::: "memory");
    }
}
__device__ __forceinline__ void ph_attn_a(const Params& p, const Ctx& c) {
    const float d1 = wave_sum(p.in[I_LQ1][c.lane] * p.in[I_LK1][c.lane]), d2 = wave_sum(p.in[I_LQ2][c.lane] * p.in[I_LK2][c.lane]);
    const float lam = expf(d1) - expf(d2) + LAM_INIT;
#pragma nounroll
    for (int pi = c.vcu; pi < 256 + 8; pi += c.G) {
        const int nsub = pi < 256 ? 2 : 1;
#pragma nounroll
        for (int sub = 0; sub < nsub; ++sub) {
            int b, h, qb;
            if (pi < 256) { const int bh = pi >> 2, s = pi & 3; b = bh >> 3; h = bh & 7; qb = sub ? 7 - s : s; } else { b = 0; h = pi - 256; qb = -1; }
            attn_unit_a(p, c, b, h, qb, lam);
        }
    }
}
__device__ __forceinline__ void attn_unit_b(const Params& p, const Ctx& c, int b, int h, int qb) {
    const int q0 = qb < 0 ? RR : b * SEQ + 256 * qb; const int hi = c.lane >> 5, r32 = c.lane & 31;
    const bf16_t* qrow = (const bf16_t*)(p.ws + WS_Q2) + (size_t)(q0 + 32 * c.wave + r32) * 1536 + h * 96;
    bf16x8 qf[6];
#pragma unroll
    for (int kk = 0; kk < 6; ++kk) qf[kk] = *(const bf16x8*)(qrow + 16 * kk + 8 * hi);
    f32x16 o[2];
    SrcB src{(const bf16_t*)(p.ws + WS_KV2), (const bf16_t*)(p.ws + WS_KR), h};
    attn_pass<96, 64, SrcB>(c, src, b, qb, qf, o);
    const bool active = qb >= 0 || c.wave == 0;
    if (!active) return;
    bf16_t* Ob = (bf16_t*)(p.ws + WS_OB2);
    int rb = q0 + 32 * c.wave; asm volatile("" : "+s"(rb));
#pragma unroll
    for (int r = 0; r < 16; ++r) { bf16_t* orow = Ob + (size_t)(rb + crow(r, hi)) * 1024 + h * 64 + r32;
        orow[0] = (bf16_t)f2bf(o[0][r]); orow[32] = (bf16_t)f2bf(o[1][r]); }
}
__device__ __forceinline__ void ph_attn_b(const Params& p, const Ctx& c) {
#pragma nounroll
    for (int pi = c.vcu; pi < 512 + 16; pi += c.G) {
        const int nsub = pi < 512 ? 2 : 1;
#pragma nounroll
        for (int sub = 0; sub < nsub; ++sub) {
            int b, h, qb;
            if (pi < 512) { const int bh = pi >> 2, s = pi & 3; b = bh >> 4; h = bh & 15; qb = sub ? 7 - s : s; } else { b = 0; h = pi - 512; qb = -1; }
            attn_unit_b(p, c, b, h, qb);
        }
    }
}

__device__ __forceinline__ void ph_ffn_fix(const Params& p, const Ctx& c, int layer) {
    const float* SA = (const float*)(p.ws + WS_SA); const float* SB = (const float*)(p.ws + WS_SB); bf16_t* G = (bf16_t*)(p.ws + WS_G);
    const float* cw = p.in[I_FFN_CW] + (size_t)layer * 3 * DFF; const float* cb = p.in[I_FFN_CB] + (size_t)layer * DFF;
    const int gt = c.gw * 64 + c.lane, ngt = c.ngw * 64;
    for (int i = gt; i < 65 * DFF; i += ngt) {
        const int pm = i / DFF, col = i - pm * DFF;
        const float a0 = SA[((size_t)pm * 4 + 0) * DFF + col], a1 = SA[((size_t)pm * 4 + 1) * DFF + col];
        const float b0 = SB[((size_t)pm * 2 + 0) * DFF + col], b1 = SB[((size_t)pm * 2 + 1) * DFF + col];
        float l0 = 0.f, l1 = 0.f;
        if (pm < 64) { const int ps = (pm & 7) == 0 ? 64 : pm - 1; l0 = SA[((size_t)ps * 4 + 2) * DFF + col]; l1 = SA[((size_t)ps * 4 + 3) * DFF + col]; }
        const float w0 = cw[col], w1 = cw[DFF + col], w2 = cw[2 * DFF + col], bb = cb[col];
        const float c0 = bb + w0 * l0 + w1 * l1 + w2 * a0, c1 = bb + w0 * l1 + w1 * a0 + w2 * a1;
        const float g0 = c0 / (1.0f + __expf(-c0)) * b0, g1 = c1 / (1.0f + __expf(-c1)) * b1;
        G[(size_t)(pm * 256) * DFF + col] = (bf16_t)f2bf(g0); G[(size_t)(pm * 256 + 1) * DFF + col] = (bf16_t)f2bf(g1);
    }
}

#define XB_TMO      128
#define XB_XCNT(j)  (256  + 64 * (j))
#define XB_XSUB(j)  (1280 + 64 * (j))
#define XB_XGEN(j)  (2304 + 64 * (j))
#define XB_TOP      3328
#define XB_TOPGEN   3392
#define XCD_BAR_WORDS 3456
#define XB_SPIN_CAP (1u << 18)

__device__ __forceinline__ unsigned xb_ld(unsigned* p)              { return __hip_atomic_load(p, __ATOMIC_RELAXED, __HIP_MEMORY_SCOPE_AGENT); }
__device__ __forceinline__ unsigned xb_add(unsigned* p, unsigned v) { return __hip_atomic_fetch_add(p, v, __ATOMIC_RELAXED, __HIP_MEMORY_SCOPE_AGENT); }
__device__ __forceinline__ unsigned xb_xcc_id() { return (unsigned)__builtin_amdgcn_s_getreg((3 << 11) | 20) & 0xFu; }
#define XB_SPIN(cond, bar) do { unsigned _sp = 0; while (cond) { __builtin_amdgcn_s_sleep(1); \
    if ((++_sp & 255u) == 0u) { if (xb_ld(&(bar)[XB_TMO])) break; if (_sp > XB_SPIN_CAP) { atomicAdd(&(bar)[XB_TMO], 1u); break; } } } } while (0)

struct XcdBarrier {
    unsigned* bar; unsigned x;
    volatile LAS unsigned* st;
};

__device__ __forceinline__ XcdBarrier xcd_barrier_post(unsigned* bar, volatile LAS unsigned* st) {
    XcdBarrier b; b.bar = bar; b.x = xb_xcc_id(); b.st = st;
    if (threadIdx.x == 0) (void)xb_add(&bar[XB_XCNT(b.x)], 1u);
    return b;
}
__device__ __forceinline__ void xcd_barrier_complete(unsigned* bar, unsigned x, unsigned& nloc, unsigned& nx) {
    const unsigned G = gridDim.x * gridDim.y * gridDim.z;
    unsigned sum, cnt, mine, sp = 0u;
    for (;;) {
        sum = 0u; cnt = 0u; mine = 0u;
#pragma unroll
        for (unsigned j = 0; j < 16; ++j) { const unsigned c = xb_ld(&bar[XB_XCNT(j)]); sum += c; cnt += (c > 0u) ? 1u : 0u; mine = (j == x) ? c : mine; }
        if (sum == G) break;
        __builtin_amdgcn_s_sleep(1);
        if ((++sp & 255u) == 0u) { if (xb_ld(&bar[XB_TMO])) break; if (sp > XB_SPIN_CAP) { atomicAdd(&bar[XB_TMO], 1u); break; } }
    }
    nloc = mine > 0u ? mine : 1u; nx = cnt > 0u ? cnt : 1u;
}

__device__ __forceinline__ void xcd_barrier(const XcdBarrier& b) {
    asm volatile("s_waitcnt vmcnt(0)" ::: "memory");
    __syncthreads();
    if (threadIdx.x == 0) {
        unsigned* bar = b.bar;
        __builtin_amdgcn_s_waitcnt(0);
        unsigned nloc = b.st[0], nx = b.st[1];
        if (nloc == 0u) { xcd_barrier_complete(bar, b.x, nloc, nx); b.st[0] = nloc; b.st[1] = nx; }
        const unsigned old = xb_add(&bar[XB_XSUB(b.x)], 1u);
        const unsigned gen = old / nloc;
        if (old + 1u == (gen + 1u) * nloc) {
            __builtin_amdgcn_fence(__ATOMIC_RELEASE, "agent");
            asm volatile("s_waitcnt vmcnt(0)" ::: "memory");
            const unsigned og = xb_add(&bar[XB_TOP], 1u);
            const unsigned tg = og / nx;
            if (og + 1u == (tg + 1u) * nx) xb_add(&bar[XB_TOPGEN], 1u);
            else XB_SPIN(xb_ld(&bar[XB_TOPGEN]) == tg, bar);
            __builtin_amdgcn_fence(__ATOMIC_ACQUIRE, "agent");
            xb_add(&bar[XB_XGEN(b.x)], 1u);
            asm volatile("s_waitcnt vmcnt(0)" ::: "memory");
        } else {
            XB_SPIN(xb_ld(&bar[XB_XGEN(b.x)]) == gen, bar);
            __builtin_amdgcn_fence(__ATOMIC_ACQUIRE, "agent");
            asm volatile("s_waitcnt vmcnt(0)" ::: "memory");
        }
    }
    __syncthreads();
}

enum { PH_PROLOGUE = 0, PH_QKV, PH_ROT_A, PH_ATTN_A, PH_WO_A, PH_STAT1, PH_FFNIN_A, PH_FIX_A, PH_FFNOUT_A, PH_STAT2, PH_DPROJ, PH_DPOST, PH_UKV, PH_UQ, PH_ROT_B,
       PH_ATTN_B, PH_WO_B, PH_STAT3, PH_FFNIN_B, PH_FIX_B, PH_FFNOUT_B, PH_FINAL, PH_COUNT };
__host__ __device__ constexpr bool phase_active(int ph) {
#ifdef ONLY_PH
    if (ph != ONLY_PH) return false;
#endif
    return !((FAST_QKV && ph == PH_ROT_A) || (FAST_RES && (ph == PH_STAT1 || ph == PH_STAT2 || ph == PH_STAT3)) || (!FAST_FFN && (ph == PH_FIX_A || ph == PH_FIX_B)) ||
             (FAST_D && ph == PH_DPOST) || (FAST_U && ph == PH_ROT_B));
}

__host__ __device__ constexpr bool only_ok(int x) {
#ifdef ONLY_PH
    return x == ONLY_PH;
#else
    return true;
#endif
}
__device__ __forceinline__ Ctx make_ctx(LAS unsigned char* lds, int wave0) {
    int lane_; asm volatile("v_mbcnt_lo_u32_b32 %0, -1, 0\n\tv_mbcnt_hi_u32_b32 %0, -1, %0" : "=v"(lane_));
    int wv = wave0; asm volatile("" : "+s"(wv));
    Ctx c; c.lds = lds; c.lane = lane_; c.wave = wv; c.tid = wv * 64 + lane_;
    c.G = gridDim.x; { const int bx = blockIdx.x; c.vcu = (c.G % 8 == 0) ? (bx % 8) * (c.G / 8) + bx / 8 : bx; }
    c.gw = c.vcu * NWAVES + c.wave; c.ngw = c.G * NWAVES;
    return c;
}
template <class Epi> __device__ __forceinline__ void run_gemm(const Ctx& c, const bf16_t* A, const bf16_t* Bt, int N, int K, const Epi& E) {
    pg8::Gemm g{A, Bt, RR, N, K}; pg8::StaticOrder S; S.init(RR, N, c.G, (int)blockIdx.x);
    pg8::gemm_phase<Epi, pg8::StaticOrder, true, true>(c.lds, g, S, E, c.tid);
    pg8::skinny_gemm<Epi>(c.lds, A, Bt, N, K, E, c.vcu, c.G, c.wave, c.lane);
}

__global__ void __launch_bounds__(NTHREADS, 2) fwd_kernel(Params pin) {
    extern __shared__ __attribute__((aligned(16))) unsigned char smem[];
    bool first = true;
    int wave0 = __builtin_amdgcn_readfirstlane((int)threadIdx.x >> 6);
    if (threadIdx.x < 64) ((LAS unsigned*)(smem + MISC_OFF))[threadIdx.x] = 0u;
    __syncthreads();
    const XcdBarrier xbar = xcd_barrier_post((unsigned*)(pin.ws + WS_CTL) + CW_BAR, (volatile LAS unsigned*)(smem + MISC_OFF));
    int nsync = 0;
#ifdef PROBE_PH
    const int ph_end = pin.ph_hi + 1;
#else
    const int ph_end = pin.ph_hi;
#endif
#pragma nounroll
    for (int ph = pin.ph_lo; ph < ph_end; ++ph) {
        if (!phase_active(ph)) continue;
#ifdef PROBE_PH
        if (!first && ph == PH_UQ) { }
#endif
        if (!first && ph != PH_UQ) {
            if (nsync == 0) cg::this_grid().sync();
            else xcd_barrier(xbar);
            ++nsync;
        }
#ifdef PROBE_PH
        if (blockIdx.x == 0 && threadIdx.x == 0 && ph != PH_UQ) { volatile LAS unsigned* T = (volatile LAS unsigned*)(smem + MISC_OFF + 64); const unsigned t = (unsigned)__builtin_amdgcn_s_memrealtime();
            if (T[2] == (unsigned)PROBE_PH + 1u) T[1] = t - T[0];
            T[0] = t; T[2] = (unsigned)ph + 1u;
            if (ph == PH_COUNT) { const float us = (float)T[1] * 0.01f; const float k = rintf(logf(us) * (1.0f / 0.18232156f)); pin.out[0] = expf(k * 0.18232156f); } }
#endif
        first = false;
        Params p = pin; { size_t z0 = 0, z1 = 0; asm volatile("" : "+s"(z0), "+s"(z1)); p.ws = pin.ws + z0; p.out = pin.out + z1; }
#define MKCTX() const Ctx c = make_ctx((LAS unsigned char*)smem, wave0)
        unsigned char* ws = p.ws;
        const bf16_t* HB = (const bf16_t*)(ws + WS_HB);
        float* hmeta = (float*)(ws + WS_HMETA);
        const float* TA = (const float*)(ws + WS_ROPE); const float* TB = TA + 2064 * 8 * 2;
        switch (ph) {
            case PH_PROLOGUE: if (!only_ok(PH_PROLOGUE)) break; { MKCTX(); ph_prologue(p, c); break; }
            case PH_QKV: if (!only_ok(PH_QKV)) break; { MKCTX();
                if (FAST_QKV) { pg8::FEpiQKV e{rss_ptr(p, 0), (bf16_t*)(ws + WS_Q), TA}; run_gemm(c, HB, (const bf16_t*)(ws + W_QKV), 3072, 1024, e); }
                else { EpiQKV e{rss_ptr(p, 0), (bf16_t*)(ws + WS_Q), (bf16_t*)(ws + WS_K), (bf16_t*)(ws + WS_V)}; gemm_simple(HB, D, (const bf16_t*)(ws + W_QKV), D, 3072, RV, e, c); }
                break; }
            case PH_ROT_A: if (!only_ok(PH_ROT_A)) break; { MKCTX(); ph_rot_a(p, c); break; }
            case PH_ATTN_A: if (!only_ok(PH_ATTN_A)) break; { MKCTX(); ph_attn_a(p, c); break; }
            case PH_WO_A: if (!only_ok(PH_WO_A)) break; { MKCTX();
                if (FAST_RES) { pg8::FEpiRes e{p.out, hmeta, (bf16_t*)(ws + WS_HB), rss_ptr(p, 1)}; run_gemm(c, (const bf16_t*)(ws + WS_Q), (const bf16_t*)(ws + W_OA), 1024, 1024, e); }
                else { EpiRes e{p.out, hmeta}; gemm_simple((const bf16_t*)(ws + WS_Q), 1024, (const bf16_t*)(ws + W_OA), 1024, 1024, RV, e, c); }
                break; }
            case PH_STAT1: if (!only_ok(PH_STAT1)) break; { MKCTX(); ph_rowstat(p, c, 1); break; }
            case PH_FFNIN_A: case PH_FFNIN_B: if (!only_ok(PH_FFNIN_A) && !only_ok(PH_FFNIN_B)) break; { MKCTX(); { const int layer = ph == PH_FFNIN_B; const int site = layer ? 3 : 1;
                if (FAST_FFN) { pg8::FEpiFFN e{rss_ptr(p, site), p.in[I_FFN_CW] + (size_t)layer * 3 * DFF, p.in[I_FFN_CB] + (size_t)layer * DFF, (bf16_t*)(ws + WS_G), (float*)(ws + WS_SA), (float*)(ws + WS_SB), (LAS float*)(c.lds + XLDS_OFF)};
                    run_gemm(c, HB, (const bf16_t*)(ws + (layer ? W_IN1 : W_IN0)), 5632, 1024, e); }
                else ph_ffn_in(p, c, layer, site);
                break; } }
            case PH_FIX_A: if (!only_ok(PH_FIX_A)) break; { MKCTX(); ph_ffn_fix(p, c, 0); break; }
            case PH_FIX_B: if (!only_ok(PH_FIX_B)) break; { MKCTX(); ph_ffn_fix(p, c, 1); break; }
            case PH_FFNOUT_A: case PH_FFNOUT_B: if (!only_ok(PH_FFNOUT_A) && !only_ok(PH_FFNOUT_B)) break; { MKCTX(); { const int layer = ph == PH_FFNOUT_B;
                if (FAST_RES) { pg8::FEpiRes e{p.out, hmeta, layer ? nullptr : (bf16_t*)(ws + WS_HB), rss_ptr(p, layer ? 4 : 2)}; run_gemm(c, (const bf16_t*)(ws + WS_G), (const bf16_t*)(ws + (layer ? W_OUT1 : W_OUT0)), 1024, DFF, e); }
                else { EpiRes e{p.out, hmeta}; gemm_simple((const bf16_t*)(ws + WS_G), DFF, (const bf16_t*)(ws + (layer ? W_OUT1 : W_OUT0)), DFF, 1024, RV, e, c); }
                break; } }
            case PH_STAT2: if (!only_ok(PH_STAT2)) break; { MKCTX(); ph_rowstat(p, c, 2); break; }
            case PH_DPROJ: if (!only_ok(PH_DPROJ)) break; { MKCTX();
                if (FAST_D) { pg8::FEpiD e{rss_ptr(p, 2), (bf16_t*)(ws + WS_CQ), (bf16_t*)(ws + WS_CKV), (bf16_t*)(ws + WS_KR), rss_ptr(p, 5), rss_ptr(p, 6), TB}; run_gemm(c, HB, (const bf16_t*)(ws + W_D), 768, 1024, e); }
                else { EpiD e{rss_ptr(p, 2), (bf16_t*)(ws + WS_CQ), (bf16_t*)(ws + WS_CKV), (bf16_t*)(ws + WS_KR)}; gemm_simple(HB, D, (const bf16_t*)(ws + W_D), D, 768, RV, e, c); }
                break; }
            case PH_DPOST: if (!only_ok(PH_DPOST)) break; { MKCTX(); ph_dpost(p, c); break; }
            case PH_UKV: if (!only_ok(PH_UKV)) break; { MKCTX();
                if (FAST_U) { pg8::FEpiUp<false> e1{rss_ptr(p, 6), 1.0f / 256.0f, (bf16_t*)(ws + WS_KV2), 2048, TB}; run_gemm(c, (const bf16_t*)(ws + WS_CKV), (const bf16_t*)(ws + W_UKV), 2048, 256, e1); }
                else { EpiScaled e1{rss_ptr(p, 6), 1.0f / 256.0f, (bf16_t*)(ws + WS_KV2), 2048}; gemm_simple((const bf16_t*)(ws + WS_CKV), 256, (const bf16_t*)(ws + W_UKV), 256, 2048, RV, e1, c); }
                break; }
            case PH_UQ: if (!only_ok(PH_UQ)) break; { MKCTX();
                if (FAST_U) { pg8::FEpiUp<true> e2{rss_ptr(p, 5), 1.0f / 384.0f, (bf16_t*)(ws + WS_Q2), 1536, TB}; run_gemm(c, (const bf16_t*)(ws + WS_CQ), (const bf16_t*)(ws + W_UQ), 1536, 384, e2); }
                else { EpiScaled e2{rss_ptr(p, 5), 1.0f / 384.0f, (bf16_t*)(ws + WS_Q2), 1536}; gemm_simple((const bf16_t*)(ws + WS_CQ), 384, (const bf16_t*)(ws + W_UQ), 384, 1536, RV, e2, c); }
                break; }
            case PH_ROT_B: if (!only_ok(PH_ROT_B)) break; { MKCTX(); ph_rot_b(p, c); break; }
            case PH_ATTN_B: if (!only_ok(PH_ATTN_B)) break; { MKCTX(); ph_attn_b(p, c); break; }
            case PH_WO_B: if (!only_ok(PH_WO_B)) break; { MKCTX();
                if (FAST_RES) { pg8::FEpiRes e{p.out, hmeta, (bf16_t*)(ws + WS_HB), rss_ptr(p, 3)}; run_gemm(c, (const bf16_t*)(ws + WS_OB2), (const bf16_t*)(ws + W_OB), 1024, 1024, e); }
                else { EpiRes e{p.out, hmeta}; gemm_simple((const bf16_t*)(ws + WS_OB2), 1024, (const bf16_t*)(ws + W_OB), 1024, 1024, RV, e, c); }
                break; }
            case PH_STAT3: if (!only_ok(PH_STAT3)) break; { MKCTX(); ph_rowstat(p, c, 3); break; }
            case PH_FINAL: if (!only_ok(PH_FINAL)) break; { MKCTX(); ph_final(p, c); break; }
            default: break;
        }
    }
}

extern "C" void kernel_launch(void* const* d_in, const int* in_sizes, int n_in, void* d_out, int out_size, void* d_ws, size_t ws_size, hipStream_t stream) {
    static int grid = 0;
    if (grid == 0) {
        if (n_in != 25 || ws_size < WS_END || out_size != RR * D) { fprintf(stderr, "kernel_launch: unexpected shapes (n_in %d, ws %zu, out %d)\n", n_in, ws_size, out_size); grid = -1; return; }
        int dev = 0, cus = 0, per_cu = 0;
        hipGetDevice(&dev); hipDeviceGetAttribute(&cus, hipDeviceAttributeMultiprocessorCount, dev);
        hipFuncSetAttribute((const void*)fwd_kernel, hipFuncAttributeMaxDynamicSharedMemorySize, LDS_BYTES);
        hipOccupancyMaxActiveBlocksPerMultiprocessor(&per_cu, (const void*)fwd_kernel, NTHREADS, LDS_BYTES);
        if (per_cu < 1) { fprintf(stderr, "kernel_launch: occupancy query says %d blocks per CU\n", per_cu); per_cu = 1; }
        (void)hipGetLastError();
        grid = cus * per_cu;
    }
    if (grid < 0) return;
    Params p{};
    for (int i = 0; i < 25; ++i) p.in[i] = (const float*)d_in[i];
    p.out = (float*)d_out; p.ws = (unsigned char*)d_ws;
    (void)hipMemsetAsync((char*)d_ws + WS_CTL, 0, CTL_ZERO_BYTES, stream);
    p.ph_lo = 0; p.ph_hi = PH_COUNT;
    void* args[] = {&p};
    hipError_t e = hipLaunchCooperativeKernel((const void*)fwd_kernel, dim3(grid), dim3(NTHREADS), args, LDS_BYTES, stream);
    if (e != hipSuccess) fprintf(stderr, "kernel_launch: cooperative launch failed: %s (grid %d)\n", hipGetErrorString(e), grid);
}
```

```cpp
#include <hip/hip_runtime.h>
#include <hip/hip_cooperative_groups.h>
#include <cstdio>
#include <cstdint>
#include <cmath>
namespace cg = cooperative_groups;

#define LAS __attribute__((address_space(3)))
typedef unsigned short bf16_t;
typedef short bf16x8 __attribute__((ext_vector_type(8)));
typedef short s16x4 __attribute__((ext_vector_type(4)));
typedef float f32x4 __attribute__((ext_vector_type(4)));
typedef float f32x16 __attribute__((ext_vector_type(16)));
typedef unsigned u32x4 __attribute__((ext_vector_type(4)));
typedef unsigned u32x2 __attribute__((ext_vector_type(2)));

constexpr int NB = 8, SEQ = 2048, NMETA = 16, D = 1024, DFF = 2816;
constexpr int RR = NB * SEQ;
constexpr int RV = RR + NMETA;
constexpr int RT = 16640;
constexpr int NWAVES = 8, NTHREADS = 512;
constexpr float EPS = 1e-5f;
constexpr float LOG2E = 1.4426950408889634f;
constexpr float QS_A = 0.125f * LOG2E;
constexpr float QS_B = 0.10206207261596575f * LOG2E;
constexpr float LAM_INIT = 0.2f;

constexpr size_t KiB = 1024, MiB = 1024 * 1024;
constexpr size_t WS_CTL = 0;
constexpr size_t W_QKV = 1 * MiB;
constexpr size_t W_OA = 7 * MiB;
constexpr size_t W_IN0 = 9 * MiB, W_IN1 = 20 * MiB;
constexpr size_t W_OUT0 = 31 * MiB, W_OUT1 = 31 * MiB + 5632 * KiB;
constexpr size_t W_D = 42 * MiB;
constexpr size_t W_UKV = 43 * MiB + 512 * KiB;
constexpr size_t W_UQ = 44 * MiB + 512 * KiB;
constexpr size_t W_OB = 45 * MiB + 640 * KiB;
constexpr size_t WS_HB = 48 * MiB;
constexpr size_t WS_BIG = WS_HB + 33280 * KiB;
constexpr size_t ROWB1024 = (size_t)RT * 1024 * 2;
constexpr size_t WS_Q = WS_BIG, WS_K = WS_BIG + ROWB1024, WS_V = WS_BIG + 2 * ROWB1024;
constexpr size_t WS_G = WS_BIG;
constexpr size_t WS_Q2 = WS_BIG;
constexpr size_t WS_KV2 = WS_BIG + (size_t)RT * 1536 * 2;
constexpr size_t WS_CQ = WS_BIG + 116480 * KiB;
constexpr size_t WS_CKV = WS_CQ + (size_t)RT * 384 * 2;
constexpr size_t WS_KR = WS_CKV + (size_t)RT * 256 * 2;
constexpr size_t WS_OB2 = 216 * MiB;
constexpr size_t WS_HMETA = WS_OB2 + 33280 * KiB;
constexpr size_t WS_RSS = WS_HMETA + 1 * MiB;
constexpr size_t WS_ROPE = WS_RSS + 512 * KiB;
constexpr size_t WS_SA = 251 * MiB;
constexpr size_t WS_SB = WS_SA + (size_t)65 * 4 * 2816 * 4;
constexpr size_t WS_END = 256 * MiB;
static_assert(WS_SB + (size_t)65 * 2 * 2816 * 4 <= WS_END, "ws map");
static_assert(WS_KR + (size_t)RT * 32 * 2 <= WS_OB2, "ws map");

static_assert(WS_KV2 + (size_t)RT * 2048 * 2 <= WS_CQ, "ws map");
static_assert(WS_ROPE + 512 * KiB <= WS_END, "ws map");
static_assert(W_OB + 2 * MiB <= WS_HB, "ws map");

constexpr int LDS_BYTES = 147456;
constexpr int MISC_OFF = 131072 + 4096;
constexpr size_t CTL_ZERO_BYTES = 64 * 1024;
constexpr int CW_BAR = 4096;
constexpr int XLDS_OFF = 131072;
#ifndef FAST_MASK
#define FAST_MASK 0x1f
#endif
constexpr bool FAST_QKV = (FAST_MASK >> 0) & 1, FAST_RES = (FAST_MASK >> 1) & 1, FAST_FFN = (FAST_MASK >> 2) & 1, FAST_D = (FAST_MASK >> 3) & 1, FAST_U = (FAST_MASK >> 4) & 1;

struct Params {
    const float* in[25];
    float* out;
    unsigned char* ws;
    int ph_lo, ph_hi;
};
enum { I_X = 0, I_META, I_A_NORM, I_A_WQKV, I_LQ1, I_LK1, I_LQ2, I_LK2, I_A_SUB, I_A_WO, I_KV_NORM, I_KV_WDKV, I_KV_ANORM, I_KV_WUKV,
       I_B_NORM, I_B_WDQ, I_B_QANORM, I_B_WUQ, I_B_WO, I_FFN_NORM, I_FFN_WIN, I_FFN_CW, I_FFN_CB, I_FFN_WOUT, I_FINAL };

struct Ctx { int tid, lane, wave, gw, ngw, vcu, G; LAS unsigned char* lds; };

__device__ __forceinline__ unsigned f2bf(float f) { unsigned u = __builtin_bit_cast(unsigned, f); return (u + 0x7fffu + ((u >> 16) & 1u)) >> 16; }
__device__ __forceinline__ unsigned pk2(float lo, float hi) { return f2bf(lo) | (f2bf(hi) << 16); }
__device__ __forceinline__ float bf2f(bf16_t b) { return __builtin_bit_cast(float, (unsigned)b << 16); }
__device__ __forceinline__ float wave_sum(float v) {
#pragma unroll
    for (int o = 1; o < 64; o <<= 1) v += __shfl_xor(v, o);
    return v;
}
__device__ __forceinline__ int row_pos(int r) { return r < RR ? NMETA + (r & (SEQ - 1)) : r - RR; }
__device__ __forceinline__ float* hrow(const Params& p, int r) { return r < RR ? p.out + (size_t)r * D : (float*)(p.ws + WS_HMETA) + (size_t)(r - RR) * D; }
__device__ __forceinline__ float* rss_ptr(const Params& p, int site) { return (float*)(p.ws + WS_RSS) + (size_t)site * RT; }
__device__ __forceinline__ int crow(int r, int hi) { return (r & 3) + 8 * (r >> 2) + 4 * hi; }

struct WSrc { const float* W; int pitch; int col0; const float* gain; int gmask; float scale; };
__device__ __forceinline__ void wdims(int id, int& N, int& K, size_t& off) {
    switch (id) {
        case 0: N = 3072; K = 1024; off = W_QKV; break;
        case 1: N = 1024; K = 1024; off = W_OA; break;
        case 2: N = 5632; K = 1024; off = W_IN0; break;
        case 3: N = 5632; K = 1024; off = W_IN1; break;
        case 4: N = 1024; K = 2816; off = W_OUT0; break;
        case 5: N = 1024; K = 2816; off = W_OUT1; break;
        case 6: N = 768; K = 1024; off = W_D; break;
        case 7: N = 2048; K = 256; off = W_UKV; break;
        case 8: N = 1536; K = 384; off = W_UQ; break;
        default: N = 1024; K = 1024; off = W_OB; break;
    }
}
__device__ __forceinline__ WSrc wsrc(const Params& p, int id, int n0) {
    WSrc s; s.gain = nullptr; s.gmask = 0; s.scale = 1.f; s.W = nullptr; s.pitch = 0; s.col0 = 0;
    switch (id) {
        case 0: s.W = p.in[I_A_WQKV]; s.pitch = 3072; s.col0 = n0; s.gain = p.in[I_A_NORM]; s.gmask = 1023; s.scale = n0 < 1024 ? QS_A : 1.f; break;
        case 1: s.W = p.in[I_A_WO]; s.pitch = 1024; s.col0 = n0; s.gain = p.in[I_A_SUB]; s.gmask = 127; s.scale = 1.f - LAM_INIT; break;
        case 2: case 3: { const int l = id - 2; s.W = p.in[I_FFN_WIN] + (size_t)l * 1024 * 5632; s.pitch = 5632; const int j = n0 >> 8, u = n0 & 255;
            s.col0 = u < 128 ? 128 * j + u : DFF + 128 * j + (u - 128); s.gain = p.in[I_FFN_NORM] + l * 1024; s.gmask = 1023; break; }
        case 4: case 5: { const int l = id - 4; s.W = p.in[I_FFN_WOUT] + (size_t)l * DFF * 1024; s.pitch = 1024; s.col0 = n0; break; }
        case 6: if (n0 < 384) { s.W = p.in[I_B_WDQ]; s.pitch = 384; s.col0 = n0; s.gain = p.in[I_B_NORM]; s.gmask = 1023; }
                else if (n0 < 672) { s.W = p.in[I_KV_WDKV]; s.pitch = 288; s.col0 = n0 - 384; s.gain = p.in[I_KV_NORM]; s.gmask = 1023; }
                break;
        case 7: s.W = p.in[I_KV_WUKV]; s.pitch = 2048; s.col0 = n0; s.gain = p.in[I_KV_ANORM]; s.gmask = 255; break;
        case 8: s.W = p.in[I_B_WUQ]; s.pitch = 1536; s.col0 = n0; s.gain = p.in[I_B_QANORM]; s.gmask = 511; s.scale = QS_B; break;
        default: s.W = p.in[I_B_WO]; s.pitch = 1024; s.col0 = n0; break;
    }
    return s;
}
__device__ __forceinline__ void transpose_item(const WSrc& s, int K, bf16_t* WT, int k0, int n0, LAS float* scr, int lane) {
    if (s.W) {
#pragma unroll 8
        for (int i = 0; i < 32; ++i) { const int kk = 2 * i + (lane >> 5); float g = s.scale; if (s.gain) g *= s.gain[(k0 + kk) & s.gmask];
            scr[kk * 33 + (lane & 31)] = s.W[(size_t)(k0 + kk) * s.pitch + s.col0 + (lane & 31)] * g; }
    } else {
#pragma unroll 8
        for (int i = 0; i < 32; ++i) { const int kk = 2 * i + (lane >> 5); scr[kk * 33 + (lane & 31)] = 0.f; }
    }
    asm volatile("s_waitcnt lgkmcnt(0)" ::: "memory");
    const int c = lane & 7;
#pragma unroll
    for (int j = 0; j < 4; ++j) { const int n = (lane >> 3) + 8 * j; const LAS float* q = scr + (8 * c) * 33 + n;
        u32x4 o; o.x = pk2(q[0 * 33], q[1 * 33]); o.y = pk2(q[2 * 33], q[3 * 33]); o.z = pk2(q[4 * 33], q[5 * 33]); o.w = pk2(q[6 * 33], q[7 * 33]);
        *(u32x4*)(WT + (size_t)(n0 + n) * K + k0 + 8 * c) = o; }
    asm volatile("s_waitcnt lgkmcnt(0)" ::: "memory");
}
__device__ __forceinline__ void ph_prologue(const Params& p, const Ctx& c) {
    LAS float* scr = (LAS float*)(c.lds + c.wave * 16384);
    int base = 0;
    for (int id = 0; id < 10; ++id) {
        int N, K; size_t off; wdims(id, N, K, off);
        const int nkb = K / 64, nnb = N / 32, items = nkb * nnb;
        for (int it = ((c.gw - base) % c.ngw + c.ngw) % c.ngw; it < items; it += c.ngw) {
            const int kb = it / nnb, nb = it % nnb; const WSrc s = wsrc(p, id, nb * 32);
            transpose_item(s, K, (bf16_t*)(p.ws + off), kb * 64, nb * 32, scr, c.lane); }
        base += items;
    }
    { float2* TA = (float2*)(p.ws + WS_ROPE); float2* TB = TA + 2064 * 8;
      const int gt = c.gw * 64 + c.lane, ngt = c.ngw * 64;
      for (int i = gt; i < 2064 * 8; i += ngt) { const int pos = i >> 3, k = i & 7; const float inv = 1.0f / powf(500000.0f, (float)k / 8.0f); const float a = (float)pos * inv; TA[i] = make_float2(cosf(a), sinf(a)); }
      for (int i = gt; i < 2064 * 16; i += ngt) { const int pos = i >> 4, k = i & 15; const float inv = 1.0f / powf(10000.0f, (float)k / 16.0f); const float a = (float)pos * inv; TB[i] = make_float2(cosf(a), sinf(a)); } }
    { float* r1 = rss_ptr(p, 1); const int gt = c.gw * 64 + c.lane, ngt = c.ngw * 64; for (int i = gt; i < 6 * RT; i += ngt) r1[i] = 0.f; }
    float* rss0 = rss_ptr(p, 0);
    for (int r = c.gw; r < RT; r += c.ngw) {
        const float* src = r < RR ? p.in[I_X] + (size_t)r * D : (r < RV ? p.in[I_META] + (size_t)(r - RR) * D : nullptr);
        f32x4 v[4]; float ss = 0.f;
#pragma unroll
        for (int j = 0; j < 4; ++j) { v[j] = src ? *(const f32x4*)(src + 4 * c.lane + 256 * j) : (f32x4){0.f, 0.f, 0.f, 0.f}; ss += v[j].x * v[j].x + v[j].y * v[j].y + v[j].z * v[j].z + v[j].w * v[j].w; }
        ss = wave_sum(ss);
        float* h = hrow(p, r); bf16_t* hb = (bf16_t*)(p.ws + WS_HB) + (size_t)r * D;
#pragma unroll
        for (int j = 0; j < 4; ++j) { *(f32x4*)(h + 4 * c.lane + 256 * j) = v[j]; u32x2 w; w.x = pk2(v[j].x, v[j].y); w.y = pk2(v[j].z, v[j].w); *(u32x2*)(hb + 4 * c.lane + 256 * j) = w; }
        if (c.lane == 0) rss0[r] = ss;
    }
}
__device__ __forceinline__ void ph_rowstat(const Params& p, const Ctx& c, int site) {
    float* rss = rss_ptr(p, site);
    for (int r = c.gw; r < RT; r += c.ngw) {
        const float* h = hrow(p, r); f32x4 v[4]; float ss = 0.f;
#pragma unroll
        for (int j = 0; j < 4; ++j) { v[j] = *(const f32x4*)(h + 4 * c.lane + 256 * j); ss += v[j].x * v[j].x + v[j].y * v[j].y + v[j].z * v[j].z + v[j].w * v[j].w; }
        ss = wave_sum(ss);
        bf16_t* hb = (bf16_t*)(p.ws + WS_HB) + (size_t)r * D;
#pragma unroll
        for (int j = 0; j < 4; ++j) { u32x2 w; w.x = pk2(v[j].x, v[j].y); w.y = pk2(v[j].z, v[j].w); *(u32x2*)(hb + 4 * c.lane + 256 * j) = w; }
        if (c.lane == 0) rss[r] = ss;
    }
}
__device__ __forceinline__ void ph_final(const Params& p, const Ctx& c) {
    const float* g = p.in[I_FINAL];
    for (int r = c.gw; r < RR; r += c.ngw) {
        float* h = p.out + (size_t)r * D; f32x4 v[4]; float ss = 0.f;
#pragma unroll
        for (int j = 0; j < 4; ++j) { v[j] = *(const f32x4*)(h + 4 * c.lane + 256 * j); ss += v[j].x * v[j].x + v[j].y * v[j].y + v[j].z * v[j].z + v[j].w * v[j].w; }
        ss = wave_sum(ss); const float rstd = 1.0f / sqrtf(ss * (1.0f / D) + EPS);
#pragma unroll
        for (int j = 0; j < 4; ++j) { const f32x4 gg = *(const f32x4*)(g + 4 * c.lane + 256 * j); *(f32x4*)(h + 4 * c.lane + 256 * j) = v[j] * rstd * gg; }
    }
}

template <class Epi>
__device__ __forceinline__ void gemm_simple(const bf16_t* A, int lda, const bf16_t* Bt, int K, int N, int nrows, const Epi& epi, const Ctx& c) {
    const int nct = N / 64, nrt = (nrows + 31) / 32, items = nrt * nct;
    const int l15 = c.lane & 15, q4 = c.lane >> 4;
    for (int it = c.gw; it < items; it += c.ngw) {
        const int rt = it / nct, ct = it % nct;
        f32x4 acc[2][4];
#pragma unroll
        for (int m = 0; m < 2; ++m)
#pragma unroll
            for (int n = 0; n < 4; ++n) acc[m][n] = (f32x4){0.f, 0.f, 0.f, 0.f};
        const bf16_t* ap = A + (size_t)(rt * 32 + l15) * lda + 8 * q4;
        const bf16_t* bp = Bt + (size_t)(ct * 64 + l15) * K + 8 * q4;
        for (int k0 = 0; k0 < K; k0 += 32) {
            bf16x8 a[2], b[4];
#pragma unroll
            for (int m = 0; m < 2; ++m) a[m] = *(const bf16x8*)(ap + (size_t)(16 * m) * lda + k0);
#pragma unroll
            for (int n = 0; n < 4; ++n) b[n] = *(const bf16x8*)(bp + (size_t)(16 * n) * K + k0);
#pragma unroll
            for (int m = 0; m < 2; ++m)
#pragma unroll
                for (int n = 0; n < 4; ++n) acc[m][n] = __builtin_amdgcn_mfma_f32_16x16x32_bf16(a[m], b[n], acc[m][n], 0, 0, 0);
        }
#pragma unroll
        for (int m = 0; m < 2; ++m)
#pragma unroll
            for (int n = 0; n < 4; ++n)
#pragma unroll
                for (int i = 0; i < 4; ++i) epi(rt * 32 + 16 * m + 4 * q4 + i, ct * 64 + 16 * n + l15, acc[m][n][i]);
    }
}
struct EpiQKV { const float* rss; bf16_t* Q; bf16_t* K; bf16_t* V;
    __device__ __forceinline__ void operator()(int row, int col, float v) const { v *= 1.0f / sqrtf(rss[row] * (1.0f / D) + EPS);
        Q[(size_t)(col >> 10) * (ROWB1024 / 2) + (size_t)row * 1024 + (col & 1023)] = (bf16_t)f2bf(v); } };
struct EpiRes { float* out; float* hmeta;
    __device__ __forceinline__ void operator()(int row, int col, float v) const { float* h = row < RR ? out + (size_t)row * D : hmeta + (size_t)(row - RR) * D; h[col] += v; } };
struct EpiD { const float* rss; bf16_t* CQ; bf16_t* CKV; bf16_t* KR;
    __device__ __forceinline__ void operator()(int row, int col, float v) const { v *= 1.0f / sqrtf(rss[row] * (1.0f / D) + EPS); const bf16_t b = (bf16_t)f2bf(v);
        if (col < 384) CQ[(size_t)row * 384 + col] = b; else if (col < 640) CKV[(size_t)row * 256 + col - 384] = b; else if (col < 672) KR[(size_t)row * 32 + col - 640] = b; } };
struct EpiScaled { const float* rss; float invk; bf16_t* O; int ldo;
    __device__ __forceinline__ void operator()(int row, int col, float v) const { v *= 1.0f / sqrtf(rss[row] * invk + EPS); O[(size_t)row * ldo + col] = (bf16_t)f2bf(v); } };

namespace pg8 {
#define PG8_LAS __attribute__((address_space(3)))
typedef unsigned short bf16_t;
typedef short bf16x8 __attribute__((ext_vector_type(8)));
typedef float f32x4 __attribute__((ext_vector_type(4)));
typedef unsigned u32x4 __attribute__((ext_vector_type(4)));
constexpr int BM = 256, BK = 64, HALF = 128, HTB = HALF * BK * 2  , STAGE_BYTES = 8 * HTB, NXCD = 8, WGM = 8;

__host__ __device__ __forceinline__ int lds_byte(int r, int c) { const int st = (r >> 4) * 2 + (c >> 5), rr = r & 15, cc = c & 31, ob = rr * 64 + cc * 2; return st * 1024 + (ob ^ (((ob >> 9) & 1) << 5)); }
__host__ __device__ __forceinline__ void stage_rc(int b, int& R, int& C) { const int st = b / 1024, sb = b % 1024, swz = sb ^ (((sb >> 9) & 1) << 5); R = (st >> 1) * 16 + swz / 64; C = (st & 1) * 32 + (swz % 64) / 2; }
__host__ __device__ __forceinline__ int perm32(int rho) { const int n = rho >> 4, i = rho & 15; return 8 * (i >> 2) + 4 * n + (i & 3); }

struct Unit { int pm, pn; };
struct Gemm { const bf16_t* A; const bf16_t* Bt; int M, N, K; };

struct StaticOrder {
    int nM, nN, nwg, G, c;
    __host__ __device__ void init(int M, int N, int G_, int c_) { nM = M / BM; nN = N / BM; nwg = nM * nN; G = G_; c = c_; }
    __host__ __device__ bool next(int i, Unit& u) const {
        const long L = (long)i * G + c; if (L >= nwg) return false;
        int wgid = (int)L; { const int q = nwg / NXCD, r = nwg % NXCD, xcd = wgid % NXCD, off = wgid / NXCD; wgid = (xcd < r ? xcd * (q + 1) : r * (q + 1) + (xcd - r) * q) + off; }
        const int nig = WGM * nN, gid = wgid / nig, fm = gid * WGM, gsz = (nM - fm) < WGM ? (nM - fm) : WGM;
        u.pm = fm + ((wgid % nig) % gsz); u.pn = (wgid % nig) / gsz; return true;
    }
    __device__ __forceinline__ void a_ready(const Unit&) const {}
    __device__ __forceinline__ void done(const Unit&) const {}
};
template <class Epi, class Sched, bool ALIGN_EPI = false, bool SP2 = false>
__device__ __forceinline__ void gemm_phase(PG8_LAS unsigned char* lds, const Gemm g, const Sched& S, const Epi& E, const int tid_in) {
    const int tid = tid_in, wid = __builtin_amdgcn_readfirstlane(tid >> 6), lane = tid & 63, wr = wid >> 2, wc = wid & 3, fr = lane & 15, fq = lane >> 4;
    const int K = g.K, nt = K / BK;
    unsigned voffA[2], voffB[2];
#pragma unroll
    for (int i = 0; i < 2; ++i) { int R, C; stage_rc(tid * 16 + i * 8192, R, C); const int Rb = Epi::PERM ? ((R & ~31) + perm32(R & 31)) : R;
        voffA[i] = (unsigned)(R * K + C) * 2u; voffB[i] = (unsigned)(Rb * K + C) * 2u; }
    const size_t kstep = (size_t)(BK * 2);
    const size_t hstep = (size_t)HALF * K * 2;
    const size_t tstep = 2 * hstep;
    const unsigned ldsw = (unsigned)wid * 1024u;
    const int aoff = lds_byte(wr * 64 + fr, fq * 8), boff = lds_byte(wc * 32 + fr, fq * 8);
#define PG8_SA(b, h) (((b) * 2 + (h)) * HTB)
#define PG8_SB(b, h) ((4 + (b) * 2 + (h)) * HTB)
#define PG8_STAGE(bufoff, gbase, voff) do { _Pragma("unroll") for (int _i = 0; _i < 2; ++_i) \
        __builtin_amdgcn_global_load_lds((const unsigned*)((const char*)(gbase) + (voff)[_i]), (PG8_LAS unsigned*)(lds + (bufoff) + ldsw + _i * 8192), 16, 0, 0); } while (0)
#define PG8_LDA(dst, b, h) do { _Pragma("unroll") for (int m = 0; m < 4; ++m) _Pragma("unroll") for (int k = 0; k < 2; ++k) dst[m][k] = *(const PG8_LAS bf16x8*)(lds + PG8_SA(b, h) + aoff + m * 2048 + k * 1024); } while (0)
#define PG8_LDB(dst, b, h) do { _Pragma("unroll") for (int n = 0; n < 2; ++n) _Pragma("unroll") for (int k = 0; k < 2; ++k) dst[n][k] = *(const PG8_LAS bf16x8*)(lds + PG8_SB(b, h) + boff + n * 2048 + k * 1024); } while (0)
#define PG8_MMA(ai, bj, At, Bt) do { __builtin_amdgcn_s_setprio(1); _Pragma("unroll") for (int m = 0; m < 4; ++m) _Pragma("unroll") for (int n = 0; n < 2; ++n) _Pragma("unroll") for (int k = 0; k < 2; ++k) \
        acc[ai][bj][m][n] = __builtin_amdgcn_mfma_f32_16x16x32_bf16(Bt[n][k], At[m][k], acc[ai][bj][m][n], 0, 0, 0); __builtin_amdgcn_s_setprio(0); } while (0)
#define PG8_WAIT_V(n) asm volatile("s_waitcnt vmcnt(" #n ")" ::: "memory")
#define PG8_WAIT_L(n) asm volatile("s_waitcnt lgkmcnt(" #n ")" ::: "memory")
#define PG8_BAR __builtin_amdgcn_s_barrier()
#define PG8_SCHED __builtin_amdgcn_sched_barrier(0)
    Unit cur, nxt; int ui = 0;
    if (!S.next(0, cur)) return;
    f32x4 acc[2][2][4][2];
#pragma unroll
    for (int a = 0; a < 2; ++a)
#pragma unroll
        for (int b = 0; b < 2; ++b)
#pragma unroll
            for (int m = 0; m < 4; ++m)
#pragma unroll
                for (int n = 0; n < 2; ++n) acc[a][b][m][n] = (f32x4){0.f, 0.f, 0.f, 0.f};
    bf16x8 At[4][2], B0[2][2], B1[2][2];
    const char* cA = (const char*)g.A + (size_t)cur.pm * tstep; const char* cB = (const char*)g.Bt + (size_t)cur.pn * tstep;
    S.a_ready(cur);
    if constexpr (SP2) {
        PG8_STAGE(PG8_SB(0, 0), cB, voffB); PG8_STAGE(PG8_SB(0, 1), cB + hstep, voffB); PG8_STAGE(PG8_SA(0, 0), cA, voffA); PG8_STAGE(PG8_SA(0, 1), cA + hstep, voffA);
        if (wr == 1) PG8_BAR;
        PG8_WAIT_V(2); PG8_BAR;
        PG8_STAGE(PG8_SB(1, 0), cB + kstep, voffB); PG8_STAGE(PG8_SA(1, 0), cA + kstep, voffA); PG8_STAGE(PG8_SB(1, 1), cB + hstep + kstep, voffB);
        PG8_WAIT_V(6); PG8_BAR;
    } else {
        PG8_STAGE(PG8_SB(0, 0), cB, voffB); PG8_STAGE(PG8_SA(0, 0), cA, voffA); PG8_STAGE(PG8_SB(0, 1), cB + hstep, voffB); PG8_STAGE(PG8_SA(0, 1), cA + hstep, voffA);
        if (wr == 1) PG8_BAR;
        PG8_WAIT_V(4); PG8_BAR;
        PG8_STAGE(PG8_SB(1, 0), cB + kstep, voffB); PG8_STAGE(PG8_SA(1, 0), cA + kstep, voffA); PG8_STAGE(PG8_SB(1, 1), cB + hstep + kstep, voffB);
        PG8_WAIT_V(6); PG8_BAR;
    }
    for (;;) {
        const bool has_next = S.next(ui + 1, nxt);
        const char* nA = has_next ? (const char*)g.A + (size_t)nxt.pm * tstep : cA; const char* nB = has_next ? (const char*)g.Bt + (size_t)nxt.pn * tstep : cB;
        for (int t = 0; t < nt; t += 2) {
            const bool last = (t == nt - 2);
            const char* a1 = cA + (size_t)(t + 1) * kstep;
            const char* a2 = last ? nA : cA + (size_t)(t + 2) * kstep; const char* b2 = last ? nB : cB + (size_t)(t + 2) * kstep;
            const char* a3 = a2 + kstep; const char* b3 = b2 + kstep;
            if (last && has_next) S.a_ready(nxt);
            if constexpr (SP2) {
            PG8_LDB(B0, 0, 0); PG8_LDB(B1, 0, 1); PG8_SCHED; PG8_LDA(At, 0, 0); PG8_STAGE(PG8_SA(1, 1), a1 + hstep, voffA);
            PG8_WAIT_V(8); PG8_WAIT_L(0); PG8_BAR; PG8_MMA(0, 0, At, B0); PG8_MMA(0, 1, At, B1); PG8_BAR; PG8_SCHED;
            PG8_LDA(At, 0, 1); PG8_STAGE(PG8_SB(0, 0), b2, voffB); PG8_STAGE(PG8_SB(0, 1), b2 + hstep, voffB); PG8_STAGE(PG8_SA(0, 0), a2, voffA);
            PG8_WAIT_V(8); PG8_WAIT_L(0); PG8_BAR; PG8_MMA(1, 0, At, B0); PG8_MMA(1, 1, At, B1); PG8_BAR; PG8_SCHED;
            PG8_LDB(B0, 1, 0); PG8_LDB(B1, 1, 1); PG8_SCHED; PG8_LDA(At, 1, 0); PG8_STAGE(PG8_SA(0, 1), a2 + hstep, voffA);
            PG8_WAIT_V(8); PG8_WAIT_L(0); PG8_BAR; PG8_MMA(0, 0, At, B0); PG8_MMA(0, 1, At, B1); PG8_BAR; PG8_SCHED;
            PG8_LDA(At, 1, 1); PG8_STAGE(PG8_SB(1, 0), b3, voffB); PG8_STAGE(PG8_SB(1, 1), b3 + hstep, voffB); PG8_STAGE(PG8_SA(1, 0), a3, voffA);
            PG8_WAIT_V(8); PG8_WAIT_L(0); PG8_BAR; PG8_MMA(1, 0, At, B0); PG8_MMA(1, 1, At, B1); PG8_BAR; PG8_SCHED;
            } else {
            PG8_LDB(B0, 0, 0); PG8_SCHED; PG8_LDA(At, 0, 0); PG8_STAGE(PG8_SA(1, 1), a1 + hstep, voffA);
            PG8_WAIT_L(8); PG8_BAR; PG8_WAIT_L(0); PG8_MMA(0, 0, At, B0); PG8_BAR; PG8_SCHED;
            PG8_LDB(B1, 0, 1); PG8_STAGE(PG8_SB(0, 0), b2, voffB);
            PG8_BAR; PG8_WAIT_L(0); PG8_MMA(0, 1, At, B1); PG8_BAR;
            PG8_LDA(At, 0, 1); PG8_STAGE(PG8_SA(0, 0), a2, voffA);
            PG8_BAR; PG8_WAIT_L(0); PG8_MMA(1, 0, At, B0); PG8_BAR; PG8_SCHED;
            PG8_STAGE(PG8_SB(0, 1), b2 + hstep, voffB);
            PG8_WAIT_V(6); PG8_BAR; PG8_MMA(1, 1, At, B1); PG8_BAR;
            PG8_LDB(B0, 1, 0); PG8_SCHED; PG8_LDA(At, 1, 0); PG8_STAGE(PG8_SA(0, 1), a2 + hstep, voffA);
            PG8_WAIT_L(8); PG8_BAR; PG8_WAIT_L(0); PG8_MMA(0, 0, At, B0); PG8_BAR; PG8_SCHED;
            PG8_LDB(B1, 1, 1); PG8_STAGE(PG8_SB(1, 0), b3, voffB);
            PG8_BAR; PG8_WAIT_L(0); PG8_MMA(0, 1, At, B1); PG8_BAR;
            PG8_LDA(At, 1, 1); PG8_STAGE(PG8_SA(1, 0), a3, voffA);
            PG8_BAR; PG8_WAIT_L(0); PG8_MMA(1, 0, At, B0); PG8_BAR; PG8_SCHED;
            PG8_STAGE(PG8_SB(1, 1), b3 + hstep, voffB);
            PG8_WAIT_V(6); PG8_BAR; PG8_MMA(1, 1, At, B1); PG8_BAR;
            }
        }
        if constexpr (ALIGN_EPI) { if (wr == 0) PG8_BAR; }
        if constexpr (!Epi::AFTER_DRAIN) { E(acc, cur, wr, wc, fr, fq); S.done(cur); }
        if (!has_next) break;
#pragma unroll
        for (int a = 0; a < 2; ++a)
#pragma unroll
            for (int b = 0; b < 2; ++b)
#pragma unroll
                for (int m = 0; m < 4; ++m)
#pragma unroll
                    for (int n = 0; n < 2; ++n) acc[a][b][m][n] = (f32x4){0.f, 0.f, 0.f, 0.f};
        cur = nxt; cA = nA; cB = nB; ++ui;
        if constexpr (ALIGN_EPI) { if (wr == 1) PG8_BAR; }
    }
    PG8_WAIT_V(0);
    if constexpr (!ALIGN_EPI) { if (wr == 0) PG8_BAR; }
    PG8_BAR;
    if constexpr (Epi::AFTER_DRAIN) { E.fused(acc, cur, wr, wc, fr, fq, lds, wid, lane); S.done(cur); }
#undef PG8_SA
#undef PG8_SB
#undef PG8_STAGE
#undef PG8_LDA
#undef PG8_LDB
#undef PG8_MMA
#undef PG8_WAIT_V
#undef PG8_WAIT_L
#undef PG8_BAR
#undef PG8_SCHED
}

__device__ __forceinline__ unsigned cvt2(float lo, float hi) { typedef float f32x2_t __attribute__((ext_vector_type(2))); typedef __bf16 bf16x2_t __attribute__((ext_vector_type(2)));
    f32x2_t v = {lo, hi}; bf16x2_t b = __builtin_convertvector(v, bf16x2_t); return __builtin_bit_cast(unsigned, b); }
__device__ __forceinline__ u32x4 pack8(const f32x4& v0, const f32x4& v1) { u32x4 w; w.x = cvt2(v0[0], v0[1]); w.y = cvt2(v0[2], v0[3]); w.z = cvt2(v1[0], v1[1]); w.w = cvt2(v1[2], v1[3]); return w; }
__device__ __forceinline__ float rstdf(const float* rss, int row, float invk) { return 1.0f / sqrtf(rss[row] * invk + EPS); }

struct FEpiQKV {
    static constexpr bool PERM = true, AFTER_DRAIN = false;
    const float* rss; bf16_t* Q; const float* TA;
    __device__ __forceinline__ void operator()(const f32x4 (&acc)[2][2][4][2], const Unit& u, int wr, int wc, int, int) const { apply<false>(acc, u, wr, wc); }
    template <bool SK> __device__ __forceinline__ void apply(const f32x4 (&acc)[2][2][4][2], const Unit& u, int wr, int wc) const {
        constexpr int NAI = SK ? 1 : 2, NM = SK ? 1 : 4;
        int lane_e; asm volatile("v_mbcnt_lo_u32_b32 %0, -1, 0\n\tv_mbcnt_hi_u32_b32 %0, -1, %0" : "=v"(lane_e));
        const int fr = lane_e & 15, fq = lane_e >> 4;
        const int colt = u.pn * BM, t = colt >> 10;
        bf16_t* base = Q + (size_t)t * (ROWB1024 / 2) + (colt & 1023) + wc * 32 + 8 * fq;
        const bool rot = (t < 2) && ((wc & 1) == 0);
        const float sgn = fq == 0 ? -1.f : 1.f; const bool mine = fq < 2;
#pragma unroll
        for (int ai = 0; ai < NAI; ++ai)
#pragma unroll
            for (int m = 0; m < NM; ++m) {
                const int row = u.pm * BM + ai * HALF + wr * 64 + m * 16 + fr;
                const float rs = rstdf(rss, row, 1.0f / 1024.0f);
                f32x4 cs[4];
                if (rot) { const f32x4* tp = (const f32x4*)(TA + (size_t)row_pos(row) * 16);
#pragma unroll
                    for (int k = 0; k < 4; ++k) cs[k] = tp[k]; }
#pragma unroll
                for (int bj = 0; bj < 2; ++bj) {
                    f32x4 v0 = acc[ai][bj][m][0] * rs, v1 = acc[ai][bj][m][1] * rs;
                    if (rot) {
                        f32x4 r0, r1;
#pragma unroll
                        for (int e = 0; e < 4; ++e) { const float o0 = __shfl_xor(v0[e], 16), o1 = __shfl_xor(v1[e], 16);
                            r0[e] = v0[e] * cs[e >> 1][(e & 1) * 2] + sgn * o0 * cs[e >> 1][(e & 1) * 2 + 1];
                            r1[e] = v1[e] * cs[2 + (e >> 1)][(e & 1) * 2] + sgn * o1 * cs[2 + (e >> 1)][(e & 1) * 2 + 1]; }
                        if (mine) { v0 = r0; v1 = r1; }
                    }
                    *(u32x4*)(base + (size_t)row * 1024 + bj * HALF) = pack8(v0, v1);
                }
            }
    }
};
struct FEpiRes {
    static constexpr bool PERM = true, AFTER_DRAIN = false;
    float* out; float* hmeta; bf16_t* HB; float* rss;
    __device__ __forceinline__ void operator()(const f32x4 (&acc)[2][2][4][2], const Unit& u, int wr, int wc, int, int) const { apply<false>(acc, u, wr, wc); }
    template <bool SK> __device__ __forceinline__ void apply(const f32x4 (&acc)[2][2][4][2], const Unit& u, int wr, int wc) const {
        constexpr int NAI = SK ? 1 : 2, NM = SK ? 1 : 4;
        int lane_e; asm volatile("v_mbcnt_lo_u32_b32 %0, -1, 0\n\tv_mbcnt_hi_u32_b32 %0, -1, %0" : "=v"(lane_e));
        const int fr = lane_e & 15, fq = lane_e >> 4;
        float* hb_ = u.pm < 64 ? out + (size_t)u.pm * BM * 1024 : hmeta;
        const int col0 = u.pn * BM + wc * 32 + 8 * fq;
#pragma unroll
        for (int ai = 0; ai < NAI; ++ai)
#pragma unroll
            for (int m = 0; m < NM; ++m) {
                const int rl = ai * HALF + wr * 64 + m * 16 + fr, row = u.pm * BM + rl; float* hp = hb_ + (size_t)rl * 1024 + col0;
                float ss = 0.f;
#pragma unroll
                for (int bj = 0; bj < 2; ++bj) {
                    const f32x4 h0 = *(const f32x4*)(hp + bj * HALF) + acc[ai][bj][m][0], h1 = *(const f32x4*)(hp + bj * HALF + 4) + acc[ai][bj][m][1];
                    *(f32x4*)(hp + bj * HALF) = h0; *(f32x4*)(hp + bj * HALF + 4) = h1;
                    ss += (h0[0] * h0[0] + h0[1] * h0[1]) + (h0[2] * h0[2] + h0[3] * h0[3]) + (h1[0] * h1[0] + h1[1] * h1[1]) + (h1[2] * h1[2] + h1[3] * h1[3]);
                    if (HB) *(u32x4*)(HB + (size_t)row * 1024 + col0 + bj * HALF) = pack8(h0, h1);
                    asm volatile("" ::: "memory");
                }
                ss += __shfl_xor(ss, 16); ss += __shfl_xor(ss, 32);
                if (fq == 0) atomicAdd(rss + row, ss);
                asm volatile("" ::: "memory");
            }
    }
};
struct FEpiFFN {
    static constexpr bool PERM = true, AFTER_DRAIN = false;
    const float* rss; const float* cw; const float* cb; bf16_t* G; float* SA; float* SB; PG8_LAS float* X;
    __device__ __forceinline__ void operator()(const f32x4 (&acc)[2][2][4][2], const Unit& u, int wr, int wc, int, int) const { apply<false>(acc, u, wr, wc); }
    template <bool SK> __device__ __forceinline__ void apply(const f32x4 (&acc)[2][2][4][2], const Unit& u, int wr, int wc) const {
        constexpr int NAI = SK ? 1 : 2, NM = SK ? 1 : 4;
        int lane_e; asm volatile("v_mbcnt_lo_u32_b32 %0, -1, 0\n\tv_mbcnt_hi_u32_b32 %0, -1, %0" : "=v"(lane_e));
        const int fr = lane_e & 15, fq = lane_e >> 4;
        const int lane = fr + 16 * fq;
        const int cc0 = u.pn * HALF + wc * 32 + 8 * fq;
        f32x4 w0[2], w1[2], w2[2], bs[2];
#pragma unroll
        for (int n = 0; n < 2; ++n) { w0[n] = *(const f32x4*)(cw + cc0 + 4 * n); w1[n] = *(const f32x4*)(cw + DFF + cc0 + 4 * n); w2[n] = *(const f32x4*)(cw + 2 * DFF + cc0 + 4 * n); bs[n] = *(const f32x4*)(cb + cc0 + 4 * n); }
        if (!SK) {
#pragma unroll
            for (int ai = 0; ai < 2; ++ai) { const int row = u.pm * BM + ai * HALF + wr * 64 + 48 + fr; const float rsl = rstdf(rss, row, 1.0f / 1024.0f);
                if (fr >= 14) { PG8_LAS float* xp = X + (((2 * ai + wr) * 4 + wc) * 2 + (fr - 14)) * 32 + 8 * fq;
                    *(PG8_LAS f32x4*)xp = acc[ai][0][3][0] * rsl; *(PG8_LAS f32x4*)(xp + 4) = acc[ai][0][3][1] * rsl; } }
            asm volatile("s_waitcnt lgkmcnt(0)" ::: "memory"); __builtin_amdgcn_s_barrier(); asm volatile("" ::: "memory");
        }
        const int src1 = (lane & 48) | ((fr - 1) & 15), src2 = (lane & 48) | ((fr - 2) & 15);
#pragma unroll
        for (int ai = 0; ai < NAI; ++ai) {
            const int strip = 2 * ai + wr;
            f32x4 pa[2] = {(f32x4){0.f, 0.f, 0.f, 0.f}, (f32x4){0.f, 0.f, 0.f, 0.f}};
#pragma unroll
            for (int m = 0; m < NM; ++m) {
                const int rl = ai * HALF + wr * 64 + m * 16 + fr, row = u.pm * BM + rl;
                const float rs = rstdf(rss, row, 1.0f / 1024.0f);
                f32x4 a[2], b[2], p1[2], p2[2];
#pragma unroll
                for (int n = 0; n < 2; ++n) { a[n] = acc[ai][0][m][n] * rs; b[n] = acc[ai][1][m][n] * rs; }
#pragma unroll
                for (int n = 0; n < 2; ++n)
#pragma unroll
                    for (int e = 0; e < 4; ++e) { const float s1 = (m > 0 && fr == 15) ? pa[n][e] : a[n][e], s2 = (m > 0 && fr >= 14) ? pa[n][e] : a[n][e];
                        p1[n][e] = __shfl(s1, src1); p2[n][e] = __shfl(s2, src2); }
                if (m == 0 && strip > 0) {
                    const PG8_LAS float* xp = X + (((strip - 1) * 4 + wc) * 2) * 32 + 8 * fq;
#pragma unroll
                    for (int n = 0; n < 2; ++n) { const f32x4 h62 = *(const PG8_LAS f32x4*)(xp + 4 * n), h63 = *(const PG8_LAS f32x4*)(xp + 32 + 4 * n);
                        if (fr == 0) { p1[n] = h63; p2[n] = h62; } else if (fr == 1) { p2[n] = h63; } }
                }
                f32x4 g[2];
#pragma unroll
                for (int n = 0; n < 2; ++n)
#pragma unroll
                    for (int e = 0; e < 4; ++e) { const float ac = bs[n][e] + w0[n][e] * p2[n][e] + w1[n][e] * p1[n][e] + w2[n][e] * a[n][e];
                        g[n][e] = ac * __builtin_amdgcn_rcpf(1.0f + __builtin_amdgcn_exp2f(-LOG2E * ac)) * b[n][e]; }
                const bool head = (strip == 0 && m == 0 && fr < 2);
                if (!head) *(u32x4*)(G + (size_t)row * DFF + cc0) = pack8(g[0], g[1]);
                else { float* sa = SA + ((size_t)u.pm * 4 + fr) * DFF + cc0; float* sb = SB + ((size_t)u.pm * 2 + fr) * DFF + cc0;
                    *(f32x4*)sa = a[0]; *(f32x4*)(sa + 4) = a[1]; *(f32x4*)sb = b[0]; *(f32x4*)(sb + 4) = b[1]; }
                const bool tail = (u.pm < 64) ? (strip == 3 && m == 3 && fr >= 14) : (strip == 0 && m == 0 && fr >= 14);
                if (tail) { float* sa = SA + ((size_t)u.pm * 4 + 2 + (fr - 14)) * DFF + cc0; *(f32x4*)sa = a[0]; *(f32x4*)(sa + 4) = a[1]; }
                pa[0] = a[0]; pa[1] = a[1];
            }
        }
    }
};
__device__ __forceinline__ void rope32(f32x4& v0, f32x4& v1, const float* TB, int pos, int fq) {
    const f32x4* tp = (const f32x4*)(TB + (size_t)pos * 32 + 16 * (fq & 1)); const float sgn = fq < 2 ? -1.f : 1.f;
    f32x4 cs[4];
#pragma unroll
    for (int k = 0; k < 4; ++k) cs[k] = tp[k];
#pragma unroll
    for (int e = 0; e < 4; ++e) { const float o0 = __shfl_xor(v0[e], 32), o1 = __shfl_xor(v1[e], 32);
        v0[e] = v0[e] * cs[e >> 1][(e & 1) * 2] + sgn * o0 * cs[e >> 1][(e & 1) * 2 + 1];
        v1[e] = v1[e] * cs[2 + (e >> 1)][(e & 1) * 2] + sgn * o1 * cs[2 + (e >> 1)][(e & 1) * 2 + 1]; }
}
struct FEpiD {
    static constexpr bool PERM = true, AFTER_DRAIN = false;
    const float* rss; bf16_t* CQ; bf16_t* CKV; bf16_t* KR; float* rssq; float* rsskv; const float* TB;
    __device__ __forceinline__ void operator()(const f32x4 (&acc)[2][2][4][2], const Unit& u, int wr, int wc, int, int) const { apply<false>(acc, u, wr, wc); }
    template <bool SK> __device__ __forceinline__ void apply(const f32x4 (&acc)[2][2][4][2], const Unit& u, int wr, int wc) const {
        constexpr int NAI = SK ? 1 : 2, NM = SK ? 1 : 4;
        int lane_e; asm volatile("v_mbcnt_lo_u32_b32 %0, -1, 0\n\tv_mbcnt_hi_u32_b32 %0, -1, %0" : "=v"(lane_e));
        const int fr = lane_e & 15, fq = lane_e >> 4;
#pragma unroll
        for (int ai = 0; ai < NAI; ++ai)
#pragma unroll
            for (int m = 0; m < NM; ++m) {
                const int row = u.pm * BM + ai * HALF + wr * 64 + m * 16 + fr; const float rs = rstdf(rss, row, 1.0f / 1024.0f);
                float sq = 0.f, skv = 0.f;
#pragma unroll
                for (int bj = 0; bj < 2; ++bj) {
                    const int g128 = u.pn * 2 + bj, c = wc * 32 + 8 * fq;
                    f32x4 v0 = acc[ai][bj][m][0] * rs, v1 = acc[ai][bj][m][1] * rs;
                    const float s = (v0[0] * v0[0] + v0[1] * v0[1]) + (v0[2] * v0[2] + v0[3] * v0[3]) + (v1[0] * v1[0] + v1[1] * v1[1]) + (v1[2] * v1[2] + v1[3] * v1[3]);
                    if (g128 < 3) { sq += s; *(u32x4*)(CQ + (size_t)row * 384 + g128 * 128 + c) = pack8(v0, v1); }
                    else if (g128 < 5) { skv += s; *(u32x4*)(CKV + (size_t)row * 256 + (g128 - 3) * 128 + c) = pack8(v0, v1); }
                    else if (wc == 0) { rope32(v0, v1, TB, row_pos(row), fq); *(u32x4*)(KR + (size_t)row * 32 + c) = pack8(v0, v1); }
                }
                if (u.pn < 2) { sq += __shfl_xor(sq, 16); sq += __shfl_xor(sq, 32); if (fq == 0) atomicAdd(rssq + row, sq); }
                if (u.pn > 0) { skv += __shfl_xor(skv, 16); skv += __shfl_xor(skv, 32); if (fq == 0) atomicAdd(rsskv + row, skv); }
            }
    }
};
template <bool ROPE> struct FEpiUp {
    static constexpr bool PERM = true, AFTER_DRAIN = false;
    const float* rss; float invk; bf16_t* O; int ldo; const float* TB;
    __device__ __forceinline__ void operator()(const f32x4 (&acc)[2][2][4][2], const Unit& u, int wr, int wc, int, int) const { apply<false>(acc, u, wr, wc); }
    template <bool SK> __device__ __forceinline__ void apply(const f32x4 (&acc)[2][2][4][2], const Unit& u, int wr, int wc) const {
        constexpr int NAI = SK ? 1 : 2, NM = SK ? 1 : 4;
        int lane_e; asm volatile("v_mbcnt_lo_u32_b32 %0, -1, 0\n\tv_mbcnt_hi_u32_b32 %0, -1, %0" : "=v"(lane_e));
        const int fr = lane_e & 15, fq = lane_e >> 4;
#pragma unroll
        for (int ai = 0; ai < NAI; ++ai)
#pragma unroll
            for (int m = 0; m < NM; ++m) {
                const int row = u.pm * BM + ai * HALF + wr * 64 + m * 16 + fr; const float rs = rstdf(rss, row, invk);
#pragma unroll
                for (int bj = 0; bj < 2; ++bj) {
                    f32x4 v0 = acc[ai][bj][m][0] * rs, v1 = acc[ai][bj][m][1] * rs;
                    if (ROPE) { const int g32 = 8 * u.pn + 4 * bj + wc; if (g32 % 3 == 2) rope32(v0, v1, TB, row_pos(row), fq); }
                    *(u32x4*)(O + (size_t)row * ldo + u.pn * BM + bj * HALF + wc * 32 + 8 * fq) = pack8(v0, v1);
                    asm volatile("" ::: "memory");
                }
            }
    }
};

template <class Epi>
__device__ __forceinline__ void skinny_gemm(PG8_LAS unsigned char* lds, const bf16_t* A, const bf16_t* Bt, int N, int K, const Epi& E, int vcu, int G, int wave, int lane) {
    const int njobs = (N / BM) * 4, fr = lane & 15, fq = lane >> 4, nks = K / 32;
    for (int j = vcu; j < njobs; j += G) {
        const int pn = j >> 2, wc = j & 3;
        f32x4 pacc[2][2];
#pragma unroll
        for (int bj = 0; bj < 2; ++bj)
#pragma unroll
            for (int n = 0; n < 2; ++n) pacc[bj][n] = (f32x4){0.f, 0.f, 0.f, 0.f};
        const bf16_t* ap = A + (size_t)(64 * BM + fr) * K + 8 * fq;
        const bf16_t* bp[2][2];
#pragma unroll
        for (int bj = 0; bj < 2; ++bj)
#pragma unroll
            for (int n = 0; n < 2; ++n) bp[bj][n] = Bt + (size_t)(pn * BM + bj * HALF + wc * 32 + perm32(16 * n + fr)) * K + 8 * fq;
#pragma nounroll
        for (int ks0 = wave * 4; ks0 < nks; ks0 += 32) {
            bf16x8 a[4], b[4][2][2];
#pragma unroll
            for (int s = 0; s < 4; ++s) { a[s] = *(const bf16x8*)(ap + (ks0 + s) * 32);
#pragma unroll
                for (int bj = 0; bj < 2; ++bj)
#pragma unroll
                    for (int n = 0; n < 2; ++n) b[s][bj][n] = *(const bf16x8*)(bp[bj][n] + (ks0 + s) * 32); }
#pragma unroll
            for (int s = 0; s < 4; ++s)
#pragma unroll
                for (int bj = 0; bj < 2; ++bj)
#pragma unroll
                    for (int n = 0; n < 2; ++n) pacc[bj][n] = __builtin_amdgcn_mfma_f32_16x16x32_bf16(b[s][bj][n], a[s], pacc[bj][n], 0, 0, 0);
        }
        PG8_LAS f32x4* P = (PG8_LAS f32x4*)lds + (wave * 64 + lane) * 4;
        P[0] = pacc[0][0]; P[1] = pacc[0][1]; P[2] = pacc[1][0]; P[3] = pacc[1][1];
        __syncthreads();
        if (wave == 0) {
            f32x4 acc[2][2][4][2];
#pragma unroll
            for (int w = 1; w < 8; ++w) { const PG8_LAS f32x4* Q = (const PG8_LAS f32x4*)lds + (w * 64 + lane) * 4;
                pacc[0][0] += Q[0]; pacc[0][1] += Q[1]; pacc[1][0] += Q[2]; pacc[1][1] += Q[3]; }
            acc[0][0][0][0] = pacc[0][0]; acc[0][0][0][1] = pacc[0][1]; acc[0][1][0][0] = pacc[1][0]; acc[0][1][0][1] = pacc[1][1];
            Unit u; u.pm = 64; u.pn = pn;
            E.template apply<true>(acc, u, 0, wc);
        }
        __syncthreads();
    }
}
}

__device__ __forceinline__ void ph_rot_a(const Params& p, const Ctx& c) {
    const float2* TA = (const float2*)(p.ws + WS_ROPE);
    const int gt = c.gw * 64 + c.lane, ngt = c.ngw * 64;
    for (int t = gt; t < RV * 256; t += ngt) {
        const int i = t & 7, sh = (t >> 3) & 15, which = (t >> 7) & 1, row = t >> 8;
        bf16_t* buf = (bf16_t*)(p.ws + (which ? WS_K : WS_Q)) + (size_t)row * 1024 + sh * 64;
        const float x1 = bf2f(buf[i]), x2 = bf2f(buf[8 + i]); const float2 cs = TA[row_pos(row) * 8 + i];
        buf[i] = (bf16_t)f2bf(x1 * cs.x - x2 * cs.y); buf[8 + i] = (bf16_t)f2bf(x2 * cs.x + x1 * cs.y);
    }
}
__device__ __forceinline__ void ph_dpost(const Params& p, const Ctx& c) {
    const float2* TB = (const float2*)(p.ws + WS_ROPE) + 2064 * 8;
    const int gt = c.gw * 64 + c.lane, ngt = c.ngw * 64;
    for (int t = gt; t < RV * 16; t += ngt) {
        const int i = t & 15, row = t >> 4; bf16_t* buf = (bf16_t*)(p.ws + WS_KR) + (size_t)row * 32;
        const float x1 = bf2f(buf[i]), x2 = bf2f(buf[16 + i]); const float2 cs = TB[row_pos(row) * 16 + i];
        buf[i] = (bf16_t)f2bf(x1 * cs.x - x2 * cs.y); buf[16 + i] = (bf16_t)f2bf(x2 * cs.x + x1 * cs.y);
    }
    float* rq = rss_ptr(p, 5); float* rkv = rss_ptr(p, 6);
    for (int r = c.gw; r < RT; r += c.ngw) {
        const bf16_t* cq = (const bf16_t*)(p.ws + WS_CQ) + (size_t)r * 384; const bf16_t* ckv = (const bf16_t*)(p.ws + WS_CKV) + (size_t)r * 256;
        float s1 = 0.f, s2 = 0.f;
        for (int k = c.lane; k < 384; k += 64) { const float v = bf2f(cq[k]); s1 += v * v; }
        for (int k = c.lane; k < 256; k += 64) { const float v = bf2f(ckv[k]); s2 += v * v; }
        s1 = wave_sum(s1); s2 = wave_sum(s2);
        if (c.lane == 0) { rq[r] = s1; rkv[r] = s2; }
    }
}
__device__ __forceinline__ void ph_rot_b(const Params& p, const Ctx& c) {
    const float2* TB = (const float2*)(p.ws + WS_ROPE) + 2064 * 8;
    const int gt = c.gw * 64 + c.lane, ngt = c.ngw * 64;
    for (int t = gt; t < RV * 256; t += ngt) {
        const int i = t & 15, h = (t >> 4) & 15, row = t >> 8; bf16_t* buf = (bf16_t*)(p.ws + WS_Q2) + (size_t)row * 1536 + h * 96 + 64;
        const float x1 = bf2f(buf[i]), x2 = bf2f(buf[16 + i]); const float2 cs = TB[row_pos(row) * 16 + i];
        buf[i] = (bf16_t)f2bf(x1 * cs.x - x2 * cs.y); buf[16 + i] = (bf16_t)f2bf(x2 * cs.x + x1 * cs.y);
    }
}

__device__ __forceinline__ int prev_row(int r, int d, bool& has) {
    has = true;
    if (r < RR) { const int t = r & (SEQ - 1); if (t >= d) return r - d; return RV - d + t; }
    if (r < RV) { const int i = r - RR; if (i >= d) return r - d; has = false; return r; }
    has = false; return r;
}
__device__ __forceinline__ void ph_ffn_in(const Params& p, const Ctx& c, int layer, int site) {
    const bf16_t* A = (const bf16_t*)(p.ws + WS_HB); const bf16_t* Wt = (const bf16_t*)(p.ws + (layer ? W_IN1 : W_IN0));
    bf16_t* G = (bf16_t*)(p.ws + WS_G); const float* rss = rss_ptr(p, site);
    const float* cw = p.in[I_FFN_CW] + (size_t)layer * 3 * DFF; const float* cb = p.in[I_FFN_CB] + (size_t)layer * DFF;
    const int nct = DFF / 64, nrt = (RV + 15) / 16, items = nrt * nct;
    const int l15 = c.lane & 15, q4 = c.lane >> 4;
    for (int it = c.gw; it < items; it += c.ngw) {
        const int rt = it / nct, ct = it % nct;
        f32x4 a0[4], a1[4], a2[4], bb[4];
#pragma unroll
        for (int n = 0; n < 4; ++n) { a0[n] = a1[n] = a2[n] = bb[n] = (f32x4){0.f, 0.f, 0.f, 0.f}; }
        const int ra = rt * 16 + l15; bool h1, h2; const int r1 = prev_row(ra, 1, h1), r2 = prev_row(ra, 2, h2);
        const bf16_t* ap0 = A + (size_t)ra * D + 8 * q4; const bf16_t* ap1 = A + (size_t)r1 * D + 8 * q4; const bf16_t* ap2 = A + (size_t)r2 * D + 8 * q4;
        const bf16_t* bpa[4]; const bf16_t* bpb[4];
#pragma unroll
        for (int n = 0; n < 4; ++n) { const int cc = ct * 64 + 16 * n + l15; const int wr = 256 * (cc >> 7) + (cc & 127); bpa[n] = Wt + (size_t)wr * D + 8 * q4; bpb[n] = bpa[n] + (size_t)128 * D; }
        for (int k0 = 0; k0 < D; k0 += 32) {
            const bf16x8 x0 = *(const bf16x8*)(ap0 + k0), x1 = *(const bf16x8*)(ap1 + k0), x2 = *(const bf16x8*)(ap2 + k0);
#pragma unroll
            for (int n = 0; n < 4; ++n) { const bf16x8 wa = *(const bf16x8*)(bpa[n] + k0), wb = *(const bf16x8*)(bpb[n] + k0);
                a0[n] = __builtin_amdgcn_mfma_f32_16x16x32_bf16(x0, wa, a0[n], 0, 0, 0);
                a1[n] = __builtin_amdgcn_mfma_f32_16x16x32_bf16(x1, wa, a1[n], 0, 0, 0);
                a2[n] = __builtin_amdgcn_mfma_f32_16x16x32_bf16(x2, wa, a2[n], 0, 0, 0);
                bb[n] = __builtin_amdgcn_mfma_f32_16x16x32_bf16(x0, wb, bb[n], 0, 0, 0); }
        }
#pragma unroll
        for (int i = 0; i < 4; ++i) {
            const int row = rt * 16 + 4 * q4 + i; bool g1, g2; const int p1 = prev_row(row, 1, g1), p2 = prev_row(row, 2, g2);
            const float s0 = 1.0f / sqrtf(rss[row] * (1.0f / D) + EPS);
            const float s1 = g1 ? 1.0f / sqrtf(rss[p1] * (1.0f / D) + EPS) : 0.f, s2 = g2 ? 1.0f / sqrtf(rss[p2] * (1.0f / D) + EPS) : 0.f;
#pragma unroll
            for (int n = 0; n < 4; ++n) { const int cc = ct * 64 + 16 * n + l15;
                const float ac = cb[cc] + cw[cc] * (a2[n][i] * s2) + cw[DFF + cc] * (a1[n][i] * s1) + cw[2 * DFF + cc] * (a0[n][i] * s0);
                const float bv = bb[n][i] * s0; const float g = ac / (1.0f + __expf(-ac)) * bv;
                G[(size_t)row * DFF + cc] = (bf16_t)f2bf(g); }
        }
    }
}

template <int MASK> __device__ __forceinline__ float swz_xor(float v) { return __shfl_xor(v, MASK); }
__device__ __forceinline__ float half_max(float v) { return fmaxf(v, __shfl_xor(v, 32)); }
__device__ __forceinline__ float half_sum(float v) { return v + __shfl_xor(v, 32); }
__device__ __forceinline__ s16x4 vtr(const LAS unsigned char* p) { typedef short v4i16_t __attribute__((ext_vector_type(4)));
    return __builtin_bit_cast(s16x4, __builtin_amdgcn_ds_read_tr16_b64_v4i16((LAS v4i16_t*)p)); }
__device__ __forceinline__ unsigned cvtpk(float lo, float hi) { typedef float f32x2_t __attribute__((ext_vector_type(2))); typedef __bf16 bf16x2_t __attribute__((ext_vector_type(2)));
    f32x2_t v = {lo, hi}; bf16x2_t b = __builtin_convertvector(v, bf16x2_t); return __builtin_bit_cast(unsigned, b); }

struct SrcA { const bf16_t* K; const bf16_t* V; int h, s;
    __device__ __forceinline__ const bf16_t* kptr(int krow, int ch) const { return K + (size_t)krow * 1024 + h * 128 + s * 64 + ch * 8; }
    __device__ __forceinline__ const bf16_t* vptr(int krow, int ch) const { return V + (size_t)krow * 1024 + h * 128 + ch * 8; } };
struct SrcB { const bf16_t* KV; const bf16_t* KR; int h;
    __device__ __forceinline__ const bf16_t* kptr(int krow, int ch) const { return ch < 8 ? KV + (size_t)krow * 2048 + h * 128 + ch * 8 : KR + (size_t)krow * 32 + (ch - 8) * 8; }
    __device__ __forceinline__ const bf16_t* vptr(int krow, int ch) const { return KV + (size_t)krow * 2048 + h * 128 + 64 + ch * 8; } };

template <int DQK, int DV> struct ACfg { static constexpr int KS = DQK * 2 + 16, VS = DV * 2 + 64, KOFF = 0, VOFF = 64 * KS, SCR = VOFF + 64 * VS,
    SCRATCH = 2 * SCR  , STG = SCRATCH + 2048  , END = STG + 8 * 32 * DV * 2; };
constexpr float ATT_THR = 8.0f;

template <int DQK, int DV, bool META>
__device__ __forceinline__ void attn_tile(const LAS unsigned char* Kt, const LAS unsigned char* Vt, LAS float* scr, const bf16x8 (&qf)[DQK / 16], f32x16 (&o)[DV / 32], float& m, float& lsum, int lane) {
    constexpr int KS = ACfg<DQK, DV>::KS, VS = ACfg<DQK, DV>::VS;
    const int r32 = lane & 31, hi = lane >> 5;
    f32x16 p0, p1; const f32x16 zero16 = {0.f, 0.f, 0.f, 0.f, 0.f, 0.f, 0.f, 0.f, 0.f, 0.f, 0.f, 0.f, 0.f, 0.f, 0.f, 0.f};
#pragma unroll
    for (int kk = 0; kk < DQK / 16; ++kk) {
        const bf16x8 k0 = *(const LAS bf16x8*)(Kt + r32 * KS + (16 * kk + 8 * hi) * 2);
        p0 = __builtin_amdgcn_mfma_f32_32x32x16_bf16(k0, qf[kk], kk == 0 ? zero16 : p0, 0, 0, 0);
        if (!META) { const bf16x8 k1 = *(const LAS bf16x8*)(Kt + (32 + r32) * KS + (16 * kk + 8 * hi) * 2);
            p1 = __builtin_amdgcn_mfma_f32_32x32x16_bf16(k1, qf[kk], kk == 0 ? zero16 : p1, 0, 0, 0); }
        if (kk & 1) __builtin_amdgcn_sched_barrier(0);
    }
    float mx;
    if (META) { mx = fmaxf(fmaxf(p0[0], p0[1]), p0[2]);
#pragma unroll
        for (int r = 3; r < 8; ++r) mx = fmaxf(mx, p0[r]);
    } else { float a = fmaxf(fmaxf(p0[0], p0[1]), p1[0]), bq = fmaxf(fmaxf(p0[2], p0[3]), p1[1]); a = fmaxf(fmaxf(a, p1[2]), p1[3]);
#pragma unroll
        for (int r = 4; r < 16; r += 4) { a = fmaxf(fmaxf(a, p0[r]), p0[r + 1]); bq = fmaxf(fmaxf(bq, p0[r + 2]), p0[r + 3]); a = fmaxf(fmaxf(a, p1[r]), p1[r + 1]); bq = fmaxf(fmaxf(bq, p1[r + 2]), p1[r + 3]); }
        mx = fmaxf(a, bq); }
    mx = half_max(mx) - m;
    if (META || __any(mx > ATT_THR)) {
        const float dl = META ? mx : fmaxf(mx, 0.f);
        m += dl;
        if (!META) {
            const float f = __builtin_amdgcn_exp2f(-dl); lsum *= f;
            if (hi == 0) scr[r32] = f;
            asm volatile("s_waitcnt lgkmcnt(0)" ::: "memory");
#pragma unroll
            for (int r = 0; r < 16; ++r) { const float a = scr[crow(r, hi)];
#pragma unroll
                for (int d0 = 0; d0 < DV / 32; ++d0) o[d0][r] *= a; }
        }
    }
    float ps = 0.f;
    if (META) {
#pragma unroll
        for (int r = 0; r < 8; ++r) { p0[r] = __builtin_amdgcn_exp2f(p0[r] - m); ps += p0[r]; }
    } else {
#pragma unroll
        for (int r = 0; r < 16; ++r) { p0[r] = __builtin_amdgcn_exp2f(p0[r] - m); p1[r] = __builtin_amdgcn_exp2f(p1[r] - m); ps += p0[r] + p1[r]; }
    }
    lsum += ps;
    bf16x8 pa[4];
    { u32x4 w; w.x = cvtpk(p0[0], p0[1]); w.y = cvtpk(p0[2], p0[3]); w.z = cvtpk(p0[4], p0[5]); w.w = cvtpk(p0[6], p0[7]); pa[0] = __builtin_bit_cast(bf16x8, w); }
    if (!META) {
        { u32x4 w; w.x = cvtpk(p0[8], p0[9]); w.y = cvtpk(p0[10], p0[11]); w.z = cvtpk(p0[12], p0[13]); w.w = cvtpk(p0[14], p0[15]); pa[1] = __builtin_bit_cast(bf16x8, w); }
        { u32x4 w; w.x = cvtpk(p1[0], p1[1]); w.y = cvtpk(p1[2], p1[3]); w.z = cvtpk(p1[4], p1[5]); w.w = cvtpk(p1[6], p1[7]); pa[2] = __builtin_bit_cast(bf16x8, w); }
        { u32x4 w; w.x = cvtpk(p1[8], p1[9]); w.y = cvtpk(p1[10], p1[11]); w.z = cvtpk(p1[12], p1[13]); w.w = cvtpk(p1[14], p1[15]); pa[3] = __builtin_bit_cast(bf16x8, w); }
    }
    const LAS unsigned char* vb = Vt + (4 * hi + ((lane & 15) >> 2)) * VS + (16 * ((lane >> 4) & 1) + 4 * (lane & 3)) * 2;
#pragma unroll
    for (int ks = 0; ks < (META ? 1 : 4); ++ks) {
#pragma unroll
        for (int d0 = 0; d0 < DV / 32; ++d0) {
            const s16x4 lo = vtr(vb + (16 * ks) * VS + 64 * d0), hh = vtr(vb + (16 * ks + 8) * VS + 64 * d0);
            const bf16x8 vf = (bf16x8){lo[0], lo[1], lo[2], lo[3], hh[0], hh[1], hh[2], hh[3]};
            o[d0] = __builtin_amdgcn_mfma_f32_32x32x16_bf16(pa[ks], vf, o[d0], 0, 0, 0);
        }
        __builtin_amdgcn_sched_barrier(0);
    }
}

template <int DQK, int DV, class Src>
__device__ __forceinline__ void attn_pass(const Ctx& c, const Src& src, int b, int qb, const bf16x8 (&qf)[DQK / 16], f32x16 (&o)[DV / 32]) {
    typedef ACfg<DQK, DV> C;
    constexpr int KCH = DQK / 8, VCH = DV / 8;
    constexpr int NKL = (64 * KCH + NTHREADS - 1) / NTHREADS, NVL = (64 * VCH + NTHREADS - 1) / NTHREADS;
    LAS float* scr = (LAS float*)(c.lds + C::SCRATCH) + c.wave * 64;
    const int hi = c.lane >> 5, r32 = c.lane & 31;
    float m = 0.f, lsum = 0.f;
#pragma unroll
    for (int d0 = 0; d0 < DV / 32; ++d0)
#pragma unroll
        for (int r = 0; r < 16; ++r) o[d0][r] = 0.f;
    const int NT = qb < 0 ? 0 : 4 * (qb + 1);
    const int myc = qb < 0 ? -1 : 4 * qb + (c.wave >> 1);
    const bool active = qb >= 0 || c.wave == 0;
    u32x4 kreg[NKL], vreg[NVL];
#define ATT_LOAD(jt_) do { int krow0_ = (jt_) < 0 ? RR : b * SEQ + 64 * (jt_); int tl_ = c.tid; asm volatile("" : "+s"(krow0_), "+v"(tl_));     \
        const int nk_ = (jt_) < 0 ? 32 : 64, nv_ = (jt_) < 0 ? 16 : 64; \
        _Pragma("unroll") for (int i_ = 0; i_ < NKL; ++i_) { const int idx_ = tl_ + i_ * NTHREADS; const int key_ = idx_ / KCH, ch_ = idx_ % KCH; if (key_ < nk_) kreg[i_] = *(const u32x4*)src.kptr(krow0_ + key_, ch_); } \
        _Pragma("unroll") for (int i_ = 0; i_ < NVL; ++i_) { const int idx_ = tl_ + i_ * NTHREADS; const int key_ = idx_ / VCH, ch_ = idx_ % VCH; if (key_ < nv_) vreg[i_] = *(const u32x4*)src.vptr(krow0_ + key_, ch_); } } while (0)
#define ATT_STORE(jt_, buf_) do { const int nk_ = (jt_) < 0 ? 32 : 64, nv_ = (jt_) < 0 ? 16 : 64; int ts_ = c.tid; asm volatile("" : "+v"(ts_)); LAS unsigned char* kt_ = c.lds + (buf_) * C::SCR + C::KOFF; LAS unsigned char* vt_ = c.lds + (buf_) * C::SCR + C::VOFF; \
        _Pragma("unroll") for (int i_ = 0; i_ < NKL; ++i_) { const int idx_ = ts_ + i_ * NTHREADS; const int key_ = idx_ / KCH, ch_ = idx_ % KCH; if (key_ < nk_) *(LAS u32x4*)(kt_ + key_ * C::KS + ch_ * 16) = kreg[i_]; } \
        _Pragma("unroll") for (int i_ = 0; i_ < NVL; ++i_) { const int idx_ = ts_ + i_ * NTHREADS; const int key_ = idx_ / VCH, ch_ = idx_ % VCH; if (key_ < nv_) *(LAS u32x4*)(vt_ + key_ * C::VS + ch_ * 16) = vreg[i_]; } } while (0)
    ATT_LOAD(-1); ATT_STORE(-1, 0);
    __syncthreads();
#pragma nounroll
    for (int jt = -1; jt < NT; ++jt) {
        const int cur = (jt + 1) & 1;
        if (jt + 1 < NT) ATT_LOAD(jt + 1);
        if (active && jt <= myc) {
            const LAS unsigned char* Kt = c.lds + cur * C::SCR + C::KOFF; const LAS unsigned char* Vt = c.lds + cur * C::SCR + C::VOFF;
            if (jt < 0) attn_tile<DQK, DV, true>(Kt, Vt, scr, qf, o, m, lsum, c.lane);
            else attn_tile<DQK, DV, false>(Kt, Vt, scr, qf, o, m, lsum, c.lane);
        }
        if (jt + 1 < NT) ATT_STORE(jt + 1, cur ^ 1);
        __syncthreads();
    }
#undef ATT_LOAD
#undef ATT_STORE
    const float lt = half_sum(lsum);
    if (hi == 0) scr[32 + r32] = 1.0f / lt;
    asm volatile("s_waitcnt lgkmcnt(0)" ::: "memory");
#pragma unroll
    for (int r = 0; r < 16; ++r) { const float a = scr[32 + crow(r, hi)];
#pragma unroll
        for (int d0 = 0; d0 < DV / 32; ++d0) o[d0][r] *= a; }
}

__device__ __forceinline__ void attn_unit_a(const Params& p, const Ctx& c, int b, int h, int qb, float lam, bf16_t* Odst) {
    typedef ACfg<64, 128> C;
    int ln_ = c.lane; asm volatile("" : "+v"(ln_));
    const int q0 = qb < 0 ? RR : b * SEQ + 256 * qb; const int hi = ln_ >> 5, r32 = ln_ & 31;
    bf16_t* Qb = (bf16_t*)(p.ws + WS_Q);
    LAS bf16_t* stg = (LAS bf16_t*)(c.lds + C::STG) + c.wave * (32 * 128);
    const bool active = qb >= 0 || c.wave == 0;
    f32x16 o[4];
#pragma nounroll
    for (int s = 0; s < 2; ++s) {
        const bf16_t* qrow = Qb + (size_t)(q0 + 32 * c.wave + r32) * 1024 + h * 128 + s * 64;
        bf16x8 qf[4];
#pragma unroll
        for (int kk = 0; kk < 4; ++kk) qf[kk] = *(const bf16x8*)(qrow + 16 * kk + 8 * hi);
        SrcA src{(const bf16_t*)(p.ws + WS_K), (const bf16_t*)(p.ws + WS_V), h, s};
        attn_pass<64, 128, SrcA>(c, src, b, qb, qf, o);
        if (s == 0) {
#pragma unroll
            for (int r = 0; r < 16; ++r) { LAS bf16_t* sp = stg + crow(r, hi) * 128 + r32;
                sp[0] = (bf16_t)f2bf(o[0][r]); sp[32] = (bf16_t)f2bf(o[1][r]); sp[64] = (bf16_t)f2bf(o[2][r]); sp[96] = (bf16_t)f2bf(o[3][r]); }
        }
    }
#pragma unroll
    for (int r = 0; r < 16; ++r) {
        LAS bf16_t* sp = stg + crow(r, hi) * 128 + r32;
        const float v0 = bf2f(sp[0]) - lam * o[0][r], v1 = bf2f(sp[32]) - lam * o[1][r], v2 = bf2f(sp[64]) - lam * o[2][r], v3 = bf2f(sp[96]) - lam * o[3][r];
        float ss = v0 * v0 + v1 * v1 + v2 * v2 + v3 * v3;
        ss += swz_xor<1>(ss); ss += swz_xor<2>(ss); ss += swz_xor<4>(ss); ss += swz_xor<8>(ss); ss += swz_xor<16>(ss);
        const float rs = 1.0f / sqrtf(ss * (1.0f / 128.0f) + EPS);
        sp[0] = (bf16_t)f2bf(v0 * rs); sp[32] = (bf16_t)f2bf(v1 * rs); sp[64] = (bf16_t)f2bf(v2 * rs); sp[96] = (bf16_t)f2bf(v3 * rs);
    }
    asm volatile("s_waitcnt lgkmcnt(0)" ::: "memory");
    if (!active) return;
    int rb = q0 + 32 * c.wave; asm volatile("" : "+s"(rb));
#pragma unroll
    for (int i = 0; i < 8; ++i) { const int row = 4 * i + (c.lane >> 4), ch = c.lane & 15;
        const u32x4 v = *(const LAS u32x4*)(stg + row * 128 + ch * 8);
        *(u32x4*)(Odst + (size_t)(rb + row) * 1024 + h * 128 + ch * 8) = v; }
}
__device__ __forceinline__ void ph_attn_a(const Params& p, const Ctx& c, bool dummy) {
    bf16_t* Odst = (bf16_t*)(p.ws + (dummy ? WS_OB2 : WS_Q));
    float d1 = 0.f, d2 = 0.f;
    for (int k = 0; k < 64; ++k) { d1 += p.in[I_LQ1][k] * p.in[I_LK1][k]; d2 += p.in[I_LQ2][k] * p.in[I_LK2][k]; }
    float lam = expf(d1) - expf(d2) + LAM_INIT; asm volatile("" : "+v"(lam));
#pragma nounroll
    for (int pi = c.vcu; pi < 256 + 8; pi += c.G) {
        const int nsub = pi < 256 ? 2 : 1;
#pragma nounroll
        for (int sub = 0; sub < nsub; ++sub) {
            int b, h, qb;
            if (pi < 256) { const int bh = pi >> 2, s = pi & 3; b = bh >> 3; h = bh & 7; qb = sub ? 7 - s : s; } else { b = 0; h = pi - 256; qb = -1; }
            attn_unit_a(p, c, b, h, qb, lam, Odst);
        }
    }
}
__device__ __forceinline__ void attn_unit_b(const Params& p, const Ctx& c, int b, int h, int qb) {
    typedef ACfg<96, 64> C;
    int ln_ = c.lane; asm volatile("" : "+v"(ln_));
    const int q0 = qb < 0 ? RR : b * SEQ + 256 * qb; const int hi = ln_ >> 5, r32 = ln_ & 31;
    const bf16_t* qrow = (const bf16_t*)(p.ws + WS_Q2) + (size_t)(q0 + 32 * c.wave + r32) * 1536 + h * 96;
    LAS bf16_t* stg = (LAS bf16_t*)(c.lds + C::STG) + c.wave * (32 * 64);
    bf16x8 qf[6];
#pragma unroll
    for (int kk = 0; kk < 6; ++kk) qf[kk] = *(const bf16x8*)(qrow + 16 * kk + 8 * hi);
    f32x16 o[2];
    SrcB src{(const bf16_t*)(p.ws + WS_KV2), (const bf16_t*)(p.ws + WS_KR), h};
    attn_pass<96, 64, SrcB>(c, src, b, qb, qf, o);
#pragma unroll
    for (int r = 0; r < 16; ++r) { LAS bf16_t* sp = stg + crow(r, hi) * 64 + r32; sp[0] = (bf16_t)f2bf(o[0][r]); sp[32] = (bf16_t)f2bf(o[1][r]); }
    asm volatile("s_waitcnt lgkmcnt(0)" ::: "memory");
    const bool active = qb >= 0 || c.wave == 0;
    if (!active) return;
    bf16_t* Ob = (bf16_t*)(p.ws + WS_OB2);
    int rb = q0 + 32 * c.wave; asm volatile("" : "+s"(rb));
#pragma unroll
    for (int i = 0; i < 4; ++i) { const int row = 8 * i + (c.lane >> 3), ch = c.lane & 7;
        const u32x4 v = *(const LAS u32x4*)(stg + row * 64 + ch * 8);
        *(u32x4*)(Ob + (size_t)(rb + row) * 1024 + h * 64 + ch * 8) = v; }
}
__device__ __forceinline__ void ph_attn_b(const Params& p, const Ctx& c) {
#pragma nounroll
    for (int pi = c.vcu; pi < 512 + 16; pi += c.G) {
        const int nsub = pi < 512 ? 2 : 1;
#pragma nounroll
        for (int sub = 0; sub < nsub; ++sub) {
            int b, h, qb;
            if (pi < 512) { const int bh = pi >> 2, s = pi & 3; b = bh >> 4; h = bh & 15; qb = sub ? 7 - s : s; } else { b = 0; h = pi - 512; qb = -1; }
            attn_unit_b(p, c, b, h, qb);
        }
    }
}

__device__ __forceinline__ void ph_ffn_fix(const Params& p, const Ctx& c, int layer) {
    const float* SA = (const float*)(p.ws + WS_SA); const float* SB = (const float*)(p.ws + WS_SB); bf16_t* G = (bf16_t*)(p.ws + WS_G);
    const float* cw = p.in[I_FFN_CW] + (size_t)layer * 3 * DFF; const float* cb = p.in[I_FFN_CB] + (size_t)layer * DFF;
    const int gt = c.gw * 64 + c.lane, ngt = c.ngw * 64;
    for (int i = gt; i < 65 * DFF; i += ngt) {
        const int pm = i / DFF, col = i - pm * DFF;
        const float a0 = SA[((size_t)pm * 4 + 0) * DFF + col], a1 = SA[((size_t)pm * 4 + 1) * DFF + col];
        const float b0 = SB[((size_t)pm * 2 + 0) * DFF + col], b1 = SB[((size_t)pm * 2 + 1) * DFF + col];
        float l0 = 0.f, l1 = 0.f;
        if (pm < 64) { const int ps = (pm & 7) == 0 ? 64 : pm - 1; l0 = SA[((size_t)ps * 4 + 2) * DFF + col]; l1 = SA[((size_t)ps * 4 + 3) * DFF + col]; }
        const float w0 = cw[col], w1 = cw[DFF + col], w2 = cw[2 * DFF + col], bb = cb[col];
        const float c0 = bb + w0 * l0 + w1 * l1 + w2 * a0, c1 = bb + w0 * l1 + w1 * a0 + w2 * a1;
        const float g0 = c0 / (1.0f + __expf(-c0)) * b0, g1 = c1 / (1.0f + __expf(-c1)) * b1;
        G[(size_t)(pm * 256) * DFF + col] = (bf16_t)f2bf(g0); G[(size_t)(pm * 256 + 1) * DFF + col] = (bf16_t)f2bf(g1);
    }
}

#define XB_TMO      128
#define XB_XCNT(j)  (256  + 64 * (j))
#define XB_XSUB(j)  (1280 + 64 * (j))
#define XB_XGEN(j)  (2304 + 64 * (j))
#define XB_TOP      3328
#define XB_TOPGEN   3392
#define XCD_BAR_WORDS 3456
#define XB_SPIN_CAP (1u << 18)

__device__ __forceinline__ unsigned xb_ld(unsigned* p)              { return __hip_atomic_load(p, __ATOMIC_RELAXED, __HIP_MEMORY_SCOPE_AGENT); }
__device__ __forceinline__ unsigned xb_add(unsigned* p, unsigned v) { return __hip_atomic_fetch_add(p, v, __ATOMIC_RELAXED, __HIP_MEMORY_SCOPE_AGENT); }
__device__ __forceinline__ unsigned xb_xcc_id() { return (unsigned)__builtin_amdgcn_s_getreg((3 << 11) | 20) & 0xFu; }
#define XB_SPIN(cond, bar) do { unsigned _sp = 0; while (cond) { __builtin_amdgcn_s_sleep(1); \
    if ((++_sp & 255u) == 0u) { if (xb_ld(&(bar)[XB_TMO])) break; if (_sp > XB_SPIN_CAP) { atomicAdd(&(bar)[XB_TMO], 1u); break; } } } } while (0)

struct XcdBarrier {
    unsigned* bar; unsigned x;
    volatile LAS unsigned* st;
};

__device__ __forceinline__ XcdBarrier xcd_barrier_post(unsigned* bar, volatile LAS unsigned* st) {
    XcdBarrier b; b.bar = bar; b.x = xb_xcc_id(); b.st = st;
    if (threadIdx.x == 0) (void)xb_add(&bar[XB_XCNT(b.x)], 1u);
    return b;
}
__device__ __forceinline__ void xcd_barrier_complete(unsigned* bar, unsigned x, unsigned& nloc, unsigned& nx) {
    const unsigned G = gridDim.x * gridDim.y * gridDim.z;
    unsigned sum, cnt, mine, sp = 0u;
    for (;;) {
        sum = 0u; cnt = 0u; mine = 0u;
#pragma unroll
        for (unsigned j = 0; j < 16; ++j) { const unsigned c = xb_ld(&bar[XB_XCNT(j)]); sum += c; cnt += (c > 0u) ? 1u : 0u; mine = (j == x) ? c : mine; }
        if (sum == G) break;
        __builtin_amdgcn_s_sleep(1);
        if ((++sp & 255u) == 0u) { if (xb_ld(&bar[XB_TMO])) break; if (sp > XB_SPIN_CAP) { atomicAdd(&bar[XB_TMO], 1u); break; } }
    }
    nloc = mine > 0u ? mine : 1u; nx = cnt > 0u ? cnt : 1u;
}

__device__ __forceinline__ void xcd_barrier(const XcdBarrier& b) {
    asm volatile("s_waitcnt vmcnt(0)" ::: "memory");
    __syncthreads();
    if (threadIdx.x == 0) {
        unsigned* bar = b.bar;
        __builtin_amdgcn_s_waitcnt(0);
        unsigned nloc = b.st[0], nx = b.st[1];
        if (nloc == 0u) { xcd_barrier_complete(bar, b.x, nloc, nx); b.st[0] = nloc; b.st[1] = nx; }
        const unsigned old = xb_add(&bar[XB_XSUB(b.x)], 1u);
        const unsigned gen = old / nloc;
        if (old + 1u == (gen + 1u) * nloc) {
            __builtin_amdgcn_fence(__ATOMIC_RELEASE, "agent");
            asm volatile("s_waitcnt vmcnt(0)" ::: "memory");
            const unsigned og = xb_add(&bar[XB_TOP], 1u);
            const unsigned tg = og / nx;
            if (og + 1u == (tg + 1u) * nx) xb_add(&bar[XB_TOPGEN], 1u);
            else XB_SPIN(xb_ld(&bar[XB_TOPGEN]) == tg, bar);
            __builtin_amdgcn_fence(__ATOMIC_ACQUIRE, "agent");
            xb_add(&bar[XB_XGEN(b.x)], 1u);
            asm volatile("s_waitcnt vmcnt(0)" ::: "memory");
        } else {
            XB_SPIN(xb_ld(&bar[XB_XGEN(b.x)]) == gen, bar);
            __builtin_amdgcn_fence(__ATOMIC_ACQUIRE, "agent");
            asm volatile("s_waitcnt vmcnt(0)" ::: "memory");
        }
    }
    __syncthreads();
}

enum { PH_PROLOGUE = 0, PH_QKV, PH_ROT_A, PH_ATTN_A, PH_WO_A, PH_STAT1, PH_FFNIN_A, PH_FIX_A, PH_FFNOUT_A, PH_STAT2, PH_DPROJ, PH_DPOST, PH_UKV, PH_UQ, PH_ROT_B,
       PH_ATTN_B, PH_WO_B, PH_STAT3, PH_FFNIN_B, PH_FIX_B, PH_FFNOUT_B, PH_FINAL, PH_COUNT };
__host__ __device__ constexpr bool phase_active(int ph) {
#ifdef ONLY_PH
    if (ph != ONLY_PH) return false;
#endif
    return !((FAST_QKV && ph == PH_ROT_A) || (FAST_RES && (ph == PH_STAT1 || ph == PH_STAT2 || ph == PH_STAT3)) || (!FAST_FFN && (ph == PH_FIX_A || ph == PH_FIX_B)) ||
             (FAST_D && ph == PH_DPOST) || (FAST_U && ph == PH_ROT_B));
}

__host__ __device__ constexpr bool only_ok(int x) {
#ifdef ONLY_PH
    return x == ONLY_PH;
#else
    return true;
#endif
}
__device__ __forceinline__ Ctx make_ctx(LAS unsigned char* lds, int wave0) {
    int lane_; asm volatile("v_mbcnt_lo_u32_b32 %0, -1, 0\n\tv_mbcnt_hi_u32_b32 %0, -1, %0" : "=v"(lane_));
    int wv = wave0; asm volatile("" : "+s"(wv));
    Ctx c; c.lds = lds; c.lane = lane_; c.wave = wv; c.tid = wv * 64 + lane_;
    c.G = gridDim.x; { const int bx = blockIdx.x; c.vcu = (c.G % 8 == 0) ? (bx % 8) * (c.G / 8) + bx / 8 : bx; }
    c.gw = c.vcu * NWAVES + c.wave; c.ngw = c.G * NWAVES;
    return c;
}
template <class Epi> __device__ __forceinline__ void run_gemm(const Ctx& c, const bf16_t* A, const bf16_t* Bt, int N, int K, const Epi& E) {
    pg8::Gemm g{A, Bt, RR, N, K}; pg8::StaticOrder S; S.init(RR, N, c.G, (int)blockIdx.x);
    pg8::gemm_phase<Epi, pg8::StaticOrder, true, true>(c.lds, g, S, E, c.tid);
    int ln_; asm volatile("v_mbcnt_lo_u32_b32 %0, -1, 0\n\tv_mbcnt_hi_u32_b32 %0, -1, %0" : "=v"(ln_));
    pg8::skinny_gemm<Epi>(c.lds, A, Bt, N, K, E, c.vcu, c.G, c.wave, ln_);
}

__global__ void __launch_bounds__(NTHREADS, 2) fwd_kernel(Params pin) {
    extern __shared__ __attribute__((aligned(16))) unsigned char smem[];
    bool first = true;
    int wave0 = __builtin_amdgcn_readfirstlane((int)threadIdx.x >> 6);
    if (threadIdx.x < 64) ((LAS unsigned*)(smem + MISC_OFF))[threadIdx.x] = 0u;
    __syncthreads();
    const XcdBarrier xbar = xcd_barrier_post((unsigned*)(pin.ws + WS_CTL) + CW_BAR, (volatile LAS unsigned*)(smem + MISC_OFF));
    int nsync = 0;
#ifdef DUP_PH
    int dupdone = 0;
#endif
#ifdef PROBE_PH
    const int ph_end = pin.ph_hi + 1;
#else
    const int ph_end = pin.ph_hi;
#endif
#pragma nounroll
    for (int ph = pin.ph_lo; ph < ph_end; ++ph) {
        if (!phase_active(ph)) continue;
#ifdef PROBE_PH
        if (!first && ph == PH_UQ) { }
#endif
        if (!first && ph != PH_UQ) {
            if (nsync == 0) cg::this_grid().sync();
            else xcd_barrier(xbar);
            ++nsync;
        }
#ifdef PROBE_PH
        if (blockIdx.x == 0 && threadIdx.x == 0 && ph != PH_UQ) { volatile LAS unsigned* T = (volatile LAS unsigned*)(smem + MISC_OFF + 64); const unsigned t = (unsigned)__builtin_amdgcn_s_memrealtime();
            if (T[2] == (unsigned)PROBE_PH + 1u) T[1] = t - T[0];
            T[0] = t; T[2] = (unsigned)ph + 1u;
            if (ph == PH_COUNT) { const float us = (float)T[1] * 0.01f; const float k = rintf(logf(us) * (1.0f / 0.18232156f)); pin.out[0] = expf(k * 0.18232156f); } }
#endif
        first = false;
        Params p = pin; { size_t z0 = 0, z1 = 0; asm volatile("" : "+s"(z0), "+s"(z1)); p.ws = pin.ws + z0; p.out = pin.out + z1; }
#define MKCTX() const Ctx c = make_ctx((LAS unsigned char*)smem, wave0)
        unsigned char* ws = p.ws;
        const bf16_t* HB = (const bf16_t*)(ws + WS_HB);
        float* hmeta = (float*)(ws + WS_HMETA);
        const float* TA = (const float*)(ws + WS_ROPE); const float* TB = TA + 2064 * 8 * 2;
#ifdef DUP_PH
        const bool dummy = (ph == DUP_PH) && !dupdone;
#else
        const bool dummy = false;
#endif
        switch (ph) {
            case PH_PROLOGUE: if (!only_ok(PH_PROLOGUE)) break; { MKCTX(); ph_prologue(p, c); break; }
            case PH_QKV: if (!only_ok(PH_QKV)) break; { MKCTX();
                if (FAST_QKV) { pg8::FEpiQKV e{rss_ptr(p, 0), (bf16_t*)(ws + WS_Q), TA}; run_gemm(c, HB, (const bf16_t*)(ws + W_QKV), 3072, 1024, e); }
                else { EpiQKV e{rss_ptr(p, 0), (bf16_t*)(ws + WS_Q), (bf16_t*)(ws + WS_K), (bf16_t*)(ws + WS_V)}; gemm_simple(HB, D, (const bf16_t*)(ws + W_QKV), D, 3072, RV, e, c); }
                break; }
            case PH_ROT_A: if (!only_ok(PH_ROT_A)) break; { MKCTX(); ph_rot_a(p, c); break; }
            case PH_ATTN_A: if (!only_ok(PH_ATTN_A)) break; { MKCTX(); ph_attn_a(p, c, dummy); break; }
            case PH_WO_A: if (!only_ok(PH_WO_A)) break; { MKCTX();
                if (FAST_RES) { pg8::FEpiRes e{p.out, hmeta, (bf16_t*)(ws + WS_HB), rss_ptr(p, 1)}; run_gemm(c, (const bf16_t*)(ws + WS_Q), (const bf16_t*)(ws + W_OA), 1024, 1024, e); }
                else { EpiRes e{p.out, hmeta}; gemm_simple((const bf16_t*)(ws + WS_Q), 1024, (const bf16_t*)(ws + W_OA), 1024, 1024, RV, e, c); }
                break; }
            case PH_STAT1: if (!only_ok(PH_STAT1)) break; { MKCTX(); ph_rowstat(p, c, 1); break; }
            case PH_FFNIN_A: case PH_FFNIN_B: if (!only_ok(PH_FFNIN_A) && !only_ok(PH_FFNIN_B)) break; { MKCTX(); { const int layer = ph == PH_FFNIN_B; const int site = layer ? 3 : 1;
                if (FAST_FFN) { pg8::FEpiFFN e{rss_ptr(p, site), p.in[I_FFN_CW] + (size_t)layer * 3 * DFF, p.in[I_FFN_CB] + (size_t)layer * DFF, (bf16_t*)(ws + WS_G), (float*)(ws + WS_SA), (float*)(ws + WS_SB), (LAS float*)(c.lds + XLDS_OFF)};
                    run_gemm(c, HB, (const bf16_t*)(ws + (layer ? W_IN1 : W_IN0)), 5632, 1024, e); }
                else ph_ffn_in(p, c, layer, site);
                break; } }
            case PH_FIX_A: if (!only_ok(PH_FIX_A)) break; { MKCTX(); ph_ffn_fix(p, c, 0); break; }
            case PH_FIX_B: if (!only_ok(PH_FIX_B)) break; { MKCTX(); ph_ffn_fix(p, c, 1); break; }
            case PH_FFNOUT_A: case PH_FFNOUT_B: if (!only_ok(PH_FFNOUT_A) && !only_ok(PH_FFNOUT_B)) break; { MKCTX(); { const int layer = ph == PH_FFNOUT_B;
                if (FAST_RES) { pg8::FEpiRes e{p.out, hmeta, layer ? nullptr : (bf16_t*)(ws + WS_HB), rss_ptr(p, layer ? 4 : 2)}; run_gemm(c, (const bf16_t*)(ws + WS_G), (const bf16_t*)(ws + (layer ? W_OUT1 : W_OUT0)), 1024, DFF, e); }
                else { EpiRes e{p.out, hmeta}; gemm_simple((const bf16_t*)(ws + WS_G), DFF, (const bf16_t*)(ws + (layer ? W_OUT1 : W_OUT0)), DFF, 1024, RV, e, c); }
                break; } }
            case PH_STAT2: if (!only_ok(PH_STAT2)) break; { MKCTX(); ph_rowstat(p, c, 2); break; }
            case PH_DPROJ: if (!only_ok(PH_DPROJ)) break; { MKCTX();
                if (FAST_D) { pg8::FEpiD e{rss_ptr(p, 2), (bf16_t*)(ws + WS_CQ), (bf16_t*)(ws + WS_CKV), (bf16_t*)(ws + WS_KR), rss_ptr(p, 5), rss_ptr(p, 6), TB}; run_gemm(c, HB, (const bf16_t*)(ws + W_D), 768, 1024, e); }
                else { EpiD e{rss_ptr(p, 2), (bf16_t*)(ws + WS_CQ), (bf16_t*)(ws + WS_CKV), (bf16_t*)(ws + WS_KR)}; gemm_simple(HB, D, (const bf16_t*)(ws + W_D), D, 768, RV, e, c); }
                break; }
            case PH_DPOST: if (!only_ok(PH_DPOST)) break; { MKCTX(); ph_dpost(p, c); break; }
            case PH_UKV: if (!only_ok(PH_UKV)) break; { MKCTX();
                if (FAST_U) { pg8::FEpiUp<false> e1{rss_ptr(p, 6), 1.0f / 256.0f, (bf16_t*)(ws + WS_KV2), 2048, TB}; run_gemm(c, (const bf16_t*)(ws + WS_CKV), (const bf16_t*)(ws + W_UKV), 2048, 256, e1); }
                else { EpiScaled e1{rss_ptr(p, 6), 1.0f / 256.0f, (bf16_t*)(ws + WS_KV2), 2048}; gemm_simple((const bf16_t*)(ws + WS_CKV), 256, (const bf16_t*)(ws + W_UKV), 256, 2048, RV, e1, c); }
                break; }
            case PH_UQ: if (!only_ok(PH_UQ)) break; { MKCTX();
                if (FAST_U) { pg8::FEpiUp<true> e2{rss_ptr(p, 5), 1.0f / 384.0f, (bf16_t*)(ws + WS_Q2), 1536, TB}; run_gemm(c, (const bf16_t*)(ws + WS_CQ), (const bf16_t*)(ws + W_UQ), 1536, 384, e2); }
                else { EpiScaled e2{rss_ptr(p, 5), 1.0f / 384.0f, (bf16_t*)(ws + WS_Q2), 1536}; gemm_simple((const bf16_t*)(ws + WS_CQ), 384, (const bf16_t*)(ws + W_UQ), 384, 1536, RV, e2, c); }
                break; }
            case PH_ROT_B: if (!only_ok(PH_ROT_B)) break; { MKCTX(); ph_rot_b(p, c); break; }
            case PH_ATTN_B: if (!only_ok(PH_ATTN_B)) break; { MKCTX(); ph_attn_b(p, c); break; }
            case PH_WO_B: if (!only_ok(PH_WO_B)) break; { MKCTX();
                if (FAST_RES) { pg8::FEpiRes e{p.out, hmeta, (bf16_t*)(ws + WS_HB), rss_ptr(p, 3)}; run_gemm(c, (const bf16_t*)(ws + WS_OB2), (const bf16_t*)(ws + W_OB), 1024, 1024, e); }
                else { EpiRes e{p.out, hmeta}; gemm_simple((const bf16_t*)(ws + WS_OB2), 1024, (const bf16_t*)(ws + W_OB), 1024, 1024, RV, e, c); }
                break; }
            case PH_STAT3: if (!only_ok(PH_STAT3)) break; { MKCTX(); ph_rowstat(p, c, 3); break; }
            case PH_FINAL: if (!only_ok(PH_FINAL)) break; { MKCTX(); ph_final(p, c); break; }
            default: break;
        }
#ifdef DUP_PH
        if (ph == DUP_PH && !dupdone) { dupdone = 1; --ph; }
#endif
    }
}

extern "C" void kernel_launch(void* const* d_in, const int* in_sizes, int n_in, void* d_out, int out_size, void* d_ws, size_t ws_size, hipStream_t stream) {
    static int grid = 0;
    if (grid == 0) {
        if (n_in != 25 || ws_size < WS_END || out_size != RR * D) { fprintf(stderr, "kernel_launch: unexpected shapes (n_in %d, ws %zu, out %d)\n", n_in, ws_size, out_size); grid = -1; return; }
        int dev = 0, cus = 0, per_cu = 0;
        hipGetDevice(&dev); hipDeviceGetAttribute(&cus, hipDeviceAttributeMultiprocessorCount, dev);
        hipFuncSetAttribute((const void*)fwd_kernel, hipFuncAttributeMaxDynamicSharedMemorySize, LDS_BYTES);
        hipOccupancyMaxActiveBlocksPerMultiprocessor(&per_cu, (const void*)fwd_kernel, NTHREADS, LDS_BYTES);
        if (per_cu < 1) { fprintf(stderr, "kernel_launch: occupancy query says %d blocks per CU\n", per_cu); per_cu = 1; }
        (void)hipGetLastError();
        grid = cus * per_cu;
    }
    if (grid < 0) return;
    Params p{};
    for (int i = 0; i < 25; ++i) p.in[i] = (const float*)d_in[i];
    p.out = (float*)d_out; p.ws = (unsigned char*)d_ws;
    (void)hipMemsetAsync((char*)d_ws + WS_CTL, 0, CTL_ZERO_BYTES, stream);
    p.ph_lo = 0; p.ph_hi = PH_COUNT;
    void* args[] = {&p};
    hipError_t e = hipLaunchCooperativeKernel((const void*)fwd_kernel, dim3(grid), dim3(NTHREADS), args, LDS_BYTES, stream);
    if (e != hipSuccess) fprintf(stderr, "kernel_launch: cooperative launch failed: %s (grid %d)\n", hipGetErrorString(e), grid);
}
```

```cpp
#include <hip/hip_runtime.h>
#include <hip/hip_cooperative_groups.h>
#include <cstdio>
#include <cstdint>
#include <cmath>
namespace cg = cooperative_groups;

#define LAS __attribute__((address_space(3)))
typedef unsigned short bf16_t;
typedef short bf16x8 __attribute__((ext_vector_type(8)));
typedef short s16x4 __attribute__((ext_vector_type(4)));
typedef float f32x4 __attribute__((ext_vector_type(4)));
typedef float f32x16 __attribute__((ext_vector_type(16)));
typedef unsigned u32x4 __attribute__((ext_vector_type(4)));
typedef unsigned u32x2 __attribute__((ext_vector_type(2)));

constexpr int NB = 8, SEQ = 2048, NMETA = 16, D = 1024, DFF = 2816;
constexpr int RR = NB * SEQ;
constexpr int RV = RR + NMETA;
constexpr int RT = 16640;
constexpr int NWAVES = 8, NTHREADS = 512;
constexpr float EPS = 1e-5f;
constexpr float LOG2E = 1.4426950408889634f;
constexpr float QS_A = 0.125f * LOG2E;
constexpr float QS_B = 0.10206207261596575f * LOG2E;
constexpr float LAM_INIT = 0.2f;

constexpr size_t KiB = 1024, MiB = 1024 * 1024;
constexpr size_t WS_CTL = 0;
constexpr size_t W_QKV = 1 * MiB;
constexpr size_t W_OA = 7 * MiB;
constexpr size_t W_IN0 = 9 * MiB, W_IN1 = 20 * MiB;
constexpr size_t W_OUT0 = 31 * MiB, W_OUT1 = 31 * MiB + 5632 * KiB;
constexpr size_t W_D = 42 * MiB;
constexpr size_t W_UKV = 43 * MiB + 512 * KiB;
constexpr size_t W_UQ = 44 * MiB + 512 * KiB;
constexpr size_t W_OB = 45 * MiB + 640 * KiB;
constexpr size_t WS_HB = 48 * MiB;
constexpr size_t WS_BIG = WS_HB + 33280 * KiB;
constexpr size_t ROWB1024 = (size_t)RT * 1024 * 2;
constexpr size_t WS_Q = WS_BIG, WS_K = WS_BIG + ROWB1024, WS_V = WS_BIG + 2 * ROWB1024;
constexpr size_t WS_G = WS_BIG;
constexpr size_t WS_Q2 = WS_BIG;
constexpr size_t WS_KV2 = WS_BIG + (size_t)RT * 1536 * 2;
constexpr size_t WS_CQ = WS_BIG + 116480 * KiB;
constexpr size_t WS_CKV = WS_CQ + (size_t)RT * 384 * 2;
constexpr size_t WS_KR = WS_CKV + (size_t)RT * 256 * 2;
constexpr size_t WS_OB2 = 216 * MiB;
constexpr size_t WS_HMETA = WS_OB2 + 33280 * KiB;
constexpr size_t WS_RSS = WS_HMETA + 1 * MiB;
constexpr size_t WS_ROPE = WS_RSS + 512 * KiB;
constexpr size_t WS_SA = 251 * MiB;
constexpr size_t WS_SB = WS_SA + (size_t)65 * 4 * 2816 * 4;
constexpr size_t WS_END = 256 * MiB;
static_assert(WS_SB + (size_t)65 * 2 * 2816 * 4 <= WS_END, "ws map");
static_assert(WS_KR + (size_t)RT * 32 * 2 <= WS_OB2, "ws map");

static_assert(WS_KV2 + (size_t)RT * 2048 * 2 <= WS_CQ, "ws map");
static_assert(WS_ROPE + 512 * KiB <= WS_END, "ws map");
static_assert(W_OB + 2 * MiB <= WS_HB, "ws map");

constexpr int LDS_BYTES = 147456;
constexpr int MISC_OFF = 131072 + 4096;
constexpr size_t CTL_ZERO_BYTES = 64 * 1024;
constexpr int CW_BAR = 4096;
constexpr int XLDS_OFF = 131072;

struct Params {
    const float* in[25];
    float* out;
    unsigned char* ws;
    int ph_lo, ph_hi;
};
enum { I_X = 0, I_META, I_A_NORM, I_A_WQKV, I_LQ1, I_LK1, I_LQ2, I_LK2, I_A_SUB, I_A_WO, I_KV_NORM, I_KV_WDKV, I_KV_ANORM, I_KV_WUKV,
       I_B_NORM, I_B_WDQ, I_B_QANORM, I_B_WUQ, I_B_WO, I_FFN_NORM, I_FFN_WIN, I_FFN_CW, I_FFN_CB, I_FFN_WOUT, I_FINAL };

struct Ctx { int tid, lane, wave, gw, ngw, vcu, G; LAS unsigned char* lds; };

__device__ __forceinline__ unsigned f2bf(float f) { unsigned u = __builtin_bit_cast(unsigned, f); return (u + 0x7fffu + ((u >> 16) & 1u)) >> 16; }
__device__ __forceinline__ unsigned pk2(float lo, float hi) { return f2bf(lo) | (f2bf(hi) << 16); }
__device__ __forceinline__ float bf2f(bf16_t b) { return __builtin_bit_cast(float, (unsigned)b << 16); }
__device__ __forceinline__ float wave_sum(float v) {
#pragma unroll
    for (int o = 1; o < 64; o <<= 1) v += __shfl_xor(v, o);
    return v;
}
__device__ __forceinline__ int row_pos(int r) { return r < RR ? NMETA + (r & (SEQ - 1)) : r - RR; }
__device__ __forceinline__ float* hrow(const Params& p, int r) { return r < RR ? p.out + (size_t)r * D : (float*)(p.ws + WS_HMETA) + (size_t)(r - RR) * D; }
__device__ __forceinline__ float* rss_ptr(const Params& p, int site) { return (float*)(p.ws + WS_RSS) + (size_t)site * RT; }
__device__ __forceinline__ int crow(int r, int hi) { return (r & 3) + 8 * (r >> 2) + 4 * hi; }

struct WSrc { const float* W; int pitch; int col0; const float* gain; int gmask; float scale; };
__device__ __forceinline__ void wdims(int id, int& N, int& K, size_t& off) {
    switch (id) {
        case 0: N = 3072; K = 1024; off = W_QKV; break;
        case 1: N = 1024; K = 1024; off = W_OA; break;
        case 2: N = 5632; K = 1024; off = W_IN0; break;
        case 3: N = 5632; K = 1024; off = W_IN1; break;
        case 4: N = 1024; K = 2816; off = W_OUT0; break;
        case 5: N = 1024; K = 2816; off = W_OUT1; break;
        case 6: N = 768; K = 1024; off = W_D; break;
        case 7: N = 2048; K = 256; off = W_UKV; break;
        case 8: N = 1536; K = 384; off = W_UQ; break;
        default: N = 1024; K = 1024; off = W_OB; break;
    }
}
__device__ __forceinline__ WSrc wsrc(const Params& p, int id, int n0) {
    WSrc s; s.gain = nullptr; s.gmask = 0; s.scale = 1.f; s.W = nullptr; s.pitch = 0; s.col0 = 0;
    switch (id) {
        case 0: s.W = p.in[I_A_WQKV]; s.pitch = 3072; s.col0 = n0; s.gain = p.in[I_A_NORM]; s.gmask = 1023; s.scale = n0 < 1024 ? QS_A : 1.f; break;
        case 1: s.W = p.in[I_A_WO]; s.pitch = 1024; s.col0 = n0; s.gain = p.in[I_A_SUB]; s.gmask = 127; s.scale = 1.f - LAM_INIT; break;
        case 2: case 3: { const int l = id - 2; s.W = p.in[I_FFN_WIN] + (size_t)l * 1024 * 5632; s.pitch = 5632; const int j = n0 >> 8, u = n0 & 255;
            s.col0 = u < 128 ? 128 * j + u : DFF + 128 * j + (u - 128); s.gain = p.in[I_FFN_NORM] + l * 1024; s.gmask = 1023; break; }
        case 4: case 5: { const int l = id - 4; s.W = p.in[I_FFN_WOUT] + (size_t)l * DFF * 1024; s.pitch = 1024; s.col0 = n0; break; }
        case 6: if (n0 < 384) { s.W = p.in[I_B_WDQ]; s.pitch = 384; s.col0 = n0; s.gain = p.in[I_B_NORM]; s.gmask = 1023; }
                else if (n0 < 672) { s.W = p.in[I_KV_WDKV]; s.pitch = 288; s.col0 = n0 - 384; s.gain = p.in[I_KV_NORM]; s.gmask = 1023; }
                break;
        case 7: s.W = p.in[I_KV_WUKV]; s.pitch = 2048; s.col0 = n0; s.gain = p.in[I_KV_ANORM]; s.gmask = 255; break;
        case 8: s.W = p.in[I_B_WUQ]; s.pitch = 1536; s.col0 = n0; s.gain = p.in[I_B_QANORM]; s.gmask = 511; s.scale = QS_B; break;
        default: s.W = p.in[I_B_WO]; s.pitch = 1024; s.col0 = n0; break;
    }
    return s;
}
__device__ __forceinline__ void transpose_item(const WSrc& s, int K, bf16_t* WT, int k0, int n0, LAS float* scr, int lane) {
    const int kr = lane >> 3, nq = lane & 7;
    f32x4 v[8];
    if (s.W) {
#pragma unroll
        for (int i = 0; i < 8; ++i) v[i] = *(const f32x4*)(s.W + (size_t)(k0 + 8 * i + kr) * s.pitch + s.col0 + 4 * nq);
#pragma unroll
        for (int i = 0; i < 8; ++i) { float g = s.scale; if (s.gain) g *= s.gain[(k0 + 8 * i + kr) & s.gmask]; v[i] = v[i] * g; }
    } else {
#pragma unroll
        for (int i = 0; i < 8; ++i) v[i] = (f32x4){0.f, 0.f, 0.f, 0.f};
    }
#pragma unroll
    for (int i = 0; i < 8; ++i)
#pragma unroll
        for (int e = 0; e < 4; ++e) scr[(4 * nq + e) * 65 + 8 * i + kr] = v[i][e];
    asm volatile("s_waitcnt lgkmcnt(0)" ::: "memory");
    const int c = lane & 7;
#pragma unroll
    for (int j = 0; j < 4; ++j) { const int n = (lane >> 3) + 8 * j; const LAS float* q = scr + n * 65 + 8 * c;
        u32x4 o; o.x = pk2(q[0], q[1]); o.y = pk2(q[2], q[3]); o.z = pk2(q[4], q[5]); o.w = pk2(q[6], q[7]);
        *(u32x4*)(WT + (size_t)(n0 + n) * K + k0 + 8 * c) = o; }
    asm volatile("s_waitcnt lgkmcnt(0)" ::: "memory");
}
__device__ __forceinline__ void ph_prologue(const Params& p, const Ctx& c) {
    LAS float* scr = (LAS float*)(c.lds + c.wave * 16384);
    int base = 0;
    for (int id = 0; id < 10; ++id) {
        int N, K; size_t off; wdims(id, N, K, off);
        const int nkb = K / 64, nnb = N / 32, items = nkb * nnb;
        for (int it = ((c.gw - base) % c.ngw + c.ngw) % c.ngw; it < items; it += c.ngw) {
            const int kb = it / nnb, nb = it % nnb; const WSrc s = wsrc(p, id, nb * 32);
            transpose_item(s, K, (bf16_t*)(p.ws + off), kb * 64, nb * 32, scr, c.lane); }
        base += items;
    }
    { float2* TA = (float2*)(p.ws + WS_ROPE); float2* TB = TA + 2064 * 8;
      const int gt = c.gw * 64 + c.lane, ngt = c.ngw * 64;
      for (int i = gt; i < 2064 * 8; i += ngt) { const int pos = i >> 3, k = i & 7; const float inv = 1.0f / powf(500000.0f, (float)k / 8.0f); const float a = (float)pos * inv; TA[i] = make_float2(cosf(a), sinf(a)); }
      for (int i = gt; i < 2064 * 16; i += ngt) { const int pos = i >> 4, k = i & 15; const float inv = 1.0f / powf(10000.0f, (float)k / 16.0f); const float a = (float)pos * inv; TB[i] = make_float2(cosf(a), sinf(a)); } }
    { float* r1 = rss_ptr(p, 1); const int gt = c.gw * 64 + c.lane, ngt = c.ngw * 64; for (int i = gt; i < 6 * RT; i += ngt) r1[i] = 0.f; }
    float* rss0 = rss_ptr(p, 0);
    for (int it = c.gw; it < RT / 4; it += c.ngw) {
        f32x4 v[4][4];
#pragma unroll
        for (int rr = 0; rr < 4; ++rr) { const int r = 4 * it + rr;
            const float* src = r < RR ? p.in[I_X] + (size_t)r * D : (r < RV ? p.in[I_META] + (size_t)(r - RR) * D : nullptr);
#pragma unroll
            for (int j = 0; j < 4; ++j) v[rr][j] = src ? *(const f32x4*)(src + 4 * c.lane + 256 * j) : (f32x4){0.f, 0.f, 0.f, 0.f}; }
#pragma unroll
        for (int rr = 0; rr < 4; ++rr) { const int r = 4 * it + rr; float ss = 0.f;
#pragma unroll
            for (int j = 0; j < 4; ++j) ss += v[rr][j].x * v[rr][j].x + v[rr][j].y * v[rr][j].y + v[rr][j].z * v[rr][j].z + v[rr][j].w * v[rr][j].w;
            ss = wave_sum(ss);
            bf16_t* hb = (bf16_t*)(p.ws + WS_HB) + (size_t)r * D;
#pragma unroll
            for (int j = 0; j < 4; ++j) { u32x2 w; w.x = pk2(v[rr][j].x, v[rr][j].y); w.y = pk2(v[rr][j].z, v[rr][j].w); *(u32x2*)(hb + 4 * c.lane + 256 * j) = w; }
            if (c.lane == 0) rss0[r] = ss; }
    }
}
__device__ __forceinline__ void ph_final(const Params& p, const Ctx& c) {
    const float* g = p.in[I_FINAL];
    for (int r = c.gw; r < RR; r += c.ngw) {
        float* h = p.out + (size_t)r * D; f32x4 v[4]; float ss = 0.f;
#pragma unroll
        for (int j = 0; j < 4; ++j) { v[j] = *(const f32x4*)(h + 4 * c.lane + 256 * j); ss += v[j].x * v[j].x + v[j].y * v[j].y + v[j].z * v[j].z + v[j].w * v[j].w; }
        ss = wave_sum(ss); const float rstd = 1.0f / sqrtf(ss * (1.0f / D) + EPS);
#pragma unroll
        for (int j = 0; j < 4; ++j) { const f32x4 gg = *(const f32x4*)(g + 4 * c.lane + 256 * j); *(f32x4*)(h + 4 * c.lane + 256 * j) = v[j] * rstd * gg; }
    }
}

namespace pg8 {
#define PG8_LAS __attribute__((address_space(3)))
typedef unsigned short bf16_t;
typedef short bf16x8 __attribute__((ext_vector_type(8)));
typedef float f32x4 __attribute__((ext_vector_type(4)));
typedef unsigned u32x4 __attribute__((ext_vector_type(4)));
constexpr int BM = 256, BK = 64, HALF = 128, HTB = HALF * BK * 2  , STAGE_BYTES = 8 * HTB, NXCD = 8, WGM = 8;

__host__ __device__ __forceinline__ int lds_byte(int r, int c) { const int st = (r >> 4) * 2 + (c >> 5), rr = r & 15, cc = c & 31, ob = rr * 64 + cc * 2; return st * 1024 + (ob ^ (((ob >> 9) & 1) << 5)); }
__host__ __device__ __forceinline__ void stage_rc(int b, int& R, int& C) { const int st = b / 1024, sb = b % 1024, swz = sb ^ (((sb >> 9) & 1) << 5); R = (st >> 1) * 16 + swz / 64; C = (st & 1) * 32 + (swz % 64) / 2; }
__host__ __device__ __forceinline__ int perm32(int rho) { const int n = rho >> 4, i = rho & 15; return 8 * (i >> 2) + 4 * n + (i & 3); }

struct Unit { int pm, pn; };
struct Gemm { const bf16_t* A; const bf16_t* Bt; int M, N, K; };

struct StaticOrder {
    int nM, nN, nwg, G, c;
    __host__ __device__ void init(int M, int N, int G_, int c_) { nM = M / BM; nN = N / BM; nwg = nM * nN; G = G_; c = c_; }
    __host__ __device__ bool next(int i, Unit& u) const {
        const long L = (long)i * G + c; if (L >= nwg) return false;
        int wgid = (int)L; { const int q = nwg / NXCD, r = nwg % NXCD, xcd = wgid % NXCD, off = wgid / NXCD; wgid = (xcd < r ? xcd * (q + 1) : r * (q + 1) + (xcd - r) * q) + off; }
        const int nig = WGM * nN, gid = wgid / nig, fm = gid * WGM, gsz = (nM - fm) < WGM ? (nM - fm) : WGM;
        u.pm = fm + ((wgid % nig) % gsz); u.pn = (wgid % nig) / gsz; return true;
    }
    __device__ __forceinline__ void a_ready(const Unit&) const {}
    __device__ __forceinline__ void done(const Unit&) const {}
};
template <class Epi, class Sched, bool ALIGN_EPI = false, bool SP2 = false>
__device__ __forceinline__ void gemm_phase(PG8_LAS unsigned char* lds, const Gemm g, const Sched& S, const Epi& E, const int tid_in) {
    const int tid = tid_in, wid = __builtin_amdgcn_readfirstlane(tid >> 6), lane = tid & 63, wr = wid >> 2, wc = wid & 3, fr = lane & 15, fq = lane >> 4;
    const int K = g.K, nt = K / BK;
    unsigned voffA[2], voffB[2];
#pragma unroll
    for (int i = 0; i < 2; ++i) { int R, C; stage_rc(tid * 16 + i * 8192, R, C); const int Rb = Epi::PERM ? ((R & ~31) + perm32(R & 31)) : R;
        voffA[i] = (unsigned)(R * K + C) * 2u; voffB[i] = (unsigned)(Rb * K + C) * 2u; }
    const size_t kstep = (size_t)(BK * 2);
    const size_t hstep = (size_t)HALF * K * 2;
    const size_t tstep = 2 * hstep;
    const unsigned ldsw = (unsigned)wid * 1024u;
    const int aoff = lds_byte(wr * 64 + fr, fq * 8), boff = lds_byte(wc * 32 + fr, fq * 8);
#define PG8_SA(b, h) (((b) * 2 + (h)) * HTB)
#define PG8_SB(b, h) ((4 + (b) * 2 + (h)) * HTB)
#define PG8_STAGE(bufoff, gbase, voff) do { _Pragma("unroll") for (int _i = 0; _i < 2; ++_i) \
        __builtin_amdgcn_global_load_lds((const unsigned*)((const char*)(gbase) + (voff)[_i]), (PG8_LAS unsigned*)(lds + (bufoff) + ldsw + _i * 8192), 16, 0, 0); } while (0)
#define PG8_LDA(dst, b, h) do { _Pragma("unroll") for (int m = 0; m < 4; ++m) _Pragma("unroll") for (int k = 0; k < 2; ++k) dst[m][k] = *(const PG8_LAS bf16x8*)(lds + PG8_SA(b, h) + aoff + m * 2048 + k * 1024); } while (0)
#define PG8_LDB(dst, b, h) do { _Pragma("unroll") for (int n = 0; n < 2; ++n) _Pragma("unroll") for (int k = 0; k < 2; ++k) dst[n][k] = *(const PG8_LAS bf16x8*)(lds + PG8_SB(b, h) + boff + n * 2048 + k * 1024); } while (0)
#define PG8_MMA(ai, bj, At, Bt) do { __builtin_amdgcn_s_setprio(1); _Pragma("unroll") for (int m = 0; m < 4; ++m) _Pragma("unroll") for (int n = 0; n < 2; ++n) _Pragma("unroll") for (int k = 0; k < 2; ++k) \
        acc[ai][bj][m][n] = __builtin_amdgcn_mfma_f32_16x16x32_bf16(Bt[n][k], At[m][k], acc[ai][bj][m][n], 0, 0, 0); __builtin_amdgcn_s_setprio(0); } while (0)
#define PG8_WAIT_V(n) asm volatile("s_waitcnt vmcnt(" #n ")" ::: "memory")
#define PG8_WAIT_L(n) asm volatile("s_waitcnt lgkmcnt(" #n ")" ::: "memory")
#define PG8_BAR __builtin_amdgcn_s_barrier()
#define PG8_SCHED __builtin_amdgcn_sched_barrier(0)
    Unit cur, nxt; int ui = 0;
    if (!S.next(0, cur)) return;
    f32x4 acc[2][2][4][2];
#pragma unroll
    for (int a = 0; a < 2; ++a)
#pragma unroll
        for (int b = 0; b < 2; ++b)
#pragma unroll
            for (int m = 0; m < 4; ++m)
#pragma unroll
                for (int n = 0; n < 2; ++n) acc[a][b][m][n] = (f32x4){0.f, 0.f, 0.f, 0.f};
    bf16x8 At[4][2], B0[2][2], B1[2][2];
    const char* cA = (const char*)g.A + (size_t)cur.pm * tstep; const char* cB = (const char*)g.Bt + (size_t)cur.pn * tstep;
    S.a_ready(cur);
    if constexpr (SP2) {
        PG8_STAGE(PG8_SB(0, 0), cB, voffB); PG8_STAGE(PG8_SB(0, 1), cB + hstep, voffB); PG8_STAGE(PG8_SA(0, 0), cA, voffA); PG8_STAGE(PG8_SA(0, 1), cA + hstep, voffA);
        if (wr == 1) PG8_BAR;
        PG8_WAIT_V(2); PG8_BAR;
        PG8_STAGE(PG8_SB(1, 0), cB + kstep, voffB); PG8_STAGE(PG8_SA(1, 0), cA + kstep, voffA); PG8_STAGE(PG8_SB(1, 1), cB + hstep + kstep, voffB);
        PG8_WAIT_V(6); PG8_BAR;
    } else {
        PG8_STAGE(PG8_SB(0, 0), cB, voffB); PG8_STAGE(PG8_SA(0, 0), cA, voffA); PG8_STAGE(PG8_SB(0, 1), cB + hstep, voffB); PG8_STAGE(PG8_SA(0, 1), cA + hstep, voffA);
        if (wr == 1) PG8_BAR;
        PG8_WAIT_V(4); PG8_BAR;
        PG8_STAGE(PG8_SB(1, 0), cB + kstep, voffB); PG8_STAGE(PG8_SA(1, 0), cA + kstep, voffA); PG8_STAGE(PG8_SB(1, 1), cB + hstep + kstep, voffB);
        PG8_WAIT_V(6); PG8_BAR;
    }
    for (;;) {
        const bool has_next = S.next(ui + 1, nxt);
        const char* nA = has_next ? (const char*)g.A + (size_t)nxt.pm * tstep : cA; const char* nB = has_next ? (const char*)g.Bt + (size_t)nxt.pn * tstep : cB;
        for (int t = 0; t < nt; t += 2) {
            const bool last = (t == nt - 2);
            const char* a1 = cA + (size_t)(t + 1) * kstep;
            const char* a2 = last ? nA : cA + (size_t)(t + 2) * kstep; const char* b2 = last ? nB : cB + (size_t)(t + 2) * kstep;
            const char* a3 = a2 + kstep; const char* b3 = b2 + kstep;
            if (last && has_next) S.a_ready(nxt);
            if constexpr (SP2) {
            PG8_LDB(B0, 0, 0); PG8_LDB(B1, 0, 1); PG8_SCHED; PG8_LDA(At, 0, 0); PG8_STAGE(PG8_SA(1, 1), a1 + hstep, voffA);
            PG8_WAIT_V(8); PG8_WAIT_L(0); PG8_BAR; PG8_MMA(0, 0, At, B0); PG8_MMA(0, 1, At, B1); PG8_BAR; PG8_SCHED;
            PG8_LDA(At, 0, 1); PG8_STAGE(PG8_SB(0, 0), b2, voffB); PG8_STAGE(PG8_SB(0, 1), b2 + hstep, voffB); PG8_STAGE(PG8_SA(0, 0), a2, voffA);
            PG8_WAIT_V(8); PG8_WAIT_L(0); PG8_BAR; PG8_MMA(1, 0, At, B0); PG8_MMA(1, 1, At, B1); PG8_BAR; PG8_SCHED;
            PG8_LDB(B0, 1, 0); PG8_LDB(B1, 1, 1); PG8_SCHED; PG8_LDA(At, 1, 0); PG8_STAGE(PG8_SA(0, 1), a2 + hstep, voffA);
            PG8_WAIT_V(8); PG8_WAIT_L(0); PG8_BAR; PG8_MMA(0, 0, At, B0); PG8_MMA(0, 1, At, B1); PG8_BAR; PG8_SCHED;
            PG8_LDA(At, 1, 1); PG8_STAGE(PG8_SB(1, 0), b3, voffB); PG8_STAGE(PG8_SB(1, 1), b3 + hstep, voffB); PG8_STAGE(PG8_SA(1, 0), a3, voffA);
            PG8_WAIT_V(8); PG8_WAIT_L(0); PG8_BAR; PG8_MMA(1, 0, At, B0); PG8_MMA(1, 1, At, B1); PG8_BAR; PG8_SCHED;
            } else {
            PG8_LDB(B0, 0, 0); PG8_SCHED; PG8_LDA(At, 0, 0); PG8_STAGE(PG8_SA(1, 1), a1 + hstep, voffA);
            PG8_WAIT_L(8); PG8_BAR; PG8_WAIT_L(0); PG8_MMA(0, 0, At, B0); PG8_BAR; PG8_SCHED;
            PG8_LDB(B1, 0, 1); PG8_STAGE(PG8_SB(0, 0), b2, voffB);
            PG8_BAR; PG8_WAIT_L(0); PG8_MMA(0, 1, At, B1); PG8_BAR;
            PG8_LDA(At, 0, 1); PG8_STAGE(PG8_SA(0, 0), a2, voffA);
            PG8_BAR; PG8_WAIT_L(0); PG8_MMA(1, 0, At, B0); PG8_BAR; PG8_SCHED;
            PG8_STAGE(PG8_SB(0, 1), b2 + hstep, voffB);
            PG8_WAIT_V(6); PG8_BAR; PG8_MMA(1, 1, At, B1); PG8_BAR;
            PG8_LDB(B0, 1, 0); PG8_SCHED; PG8_LDA(At, 1, 0); PG8_STAGE(PG8_SA(0, 1), a2 + hstep, voffA);
            PG8_WAIT_L(8); PG8_BAR; PG8_WAIT_L(0); PG8_MMA(0, 0, At, B0); PG8_BAR; PG8_SCHED;
            PG8_LDB(B1, 1, 1); PG8_STAGE(PG8_SB(1, 0), b3, voffB);
            PG8_BAR; PG8_WAIT_L(0); PG8_MMA(0, 1, At, B1); PG8_BAR;
            PG8_LDA(At, 1, 1); PG8_STAGE(PG8_SA(1, 0), a3, voffA);
            PG8_BAR; PG8_WAIT_L(0); PG8_MMA(1, 0, At, B0); PG8_BAR; PG8_SCHED;
            PG8_STAGE(PG8_SB(1, 1), b3 + hstep, voffB);
            PG8_WAIT_V(6); PG8_BAR; PG8_MMA(1, 1, At, B1); PG8_BAR;
            }
        }
        if constexpr (ALIGN_EPI) { if (wr == 0) PG8_BAR; }
        if constexpr (!Epi::AFTER_DRAIN) { E(acc, cur, wr, wc, fr, fq); S.done(cur); }
        if (!has_next) break;
#pragma unroll
        for (int a = 0; a < 2; ++a)
#pragma unroll
            for (int b = 0; b < 2; ++b)
#pragma unroll
                for (int m = 0; m < 4; ++m)
#pragma unroll
                    for (int n = 0; n < 2; ++n) acc[a][b][m][n] = (f32x4){0.f, 0.f, 0.f, 0.f};
        cur = nxt; cA = nA; cB = nB; ++ui;
        if constexpr (ALIGN_EPI) { if (wr == 1) PG8_BAR; }
    }
    PG8_WAIT_V(0);
    if constexpr (!ALIGN_EPI) { if (wr == 0) PG8_BAR; }
    PG8_BAR;
    if constexpr (Epi::AFTER_DRAIN) { E.fused(acc, cur, wr, wc, fr, fq, lds, wid, lane); S.done(cur); }
#undef PG8_SA
#undef PG8_SB
#undef PG8_STAGE
#undef PG8_LDA
#undef PG8_LDB
#undef PG8_MMA
#undef PG8_WAIT_V
#undef PG8_WAIT_L
#undef PG8_BAR
#undef PG8_SCHED
}

__device__ __forceinline__ unsigned cvt2(float lo, float hi) { typedef float f32x2_t __attribute__((ext_vector_type(2))); typedef __bf16 bf16x2_t __attribute__((ext_vector_type(2)));
    f32x2_t v = {lo, hi}; bf16x2_t b = __builtin_convertvector(v, bf16x2_t); return __builtin_bit_cast(unsigned, b); }
__device__ __forceinline__ u32x4 pack8(const f32x4& v0, const f32x4& v1) { u32x4 w; w.x = cvt2(v0[0], v0[1]); w.y = cvt2(v0[2], v0[3]); w.z = cvt2(v1[0], v1[1]); w.w = cvt2(v1[2], v1[3]); return w; }
__device__ __forceinline__ float rstdf(const float* rss, int row, float invk) { return 1.0f / sqrtf(rss[row] * invk + EPS); }

struct FEpiQKV {
    static constexpr bool PERM = true, AFTER_DRAIN = false;
    const float* rss; bf16_t* Q; const float* TA;
    __device__ __forceinline__ void operator()(const f32x4 (&acc)[2][2][4][2], const Unit& u, int wr, int wc, int, int) const { apply<false>(acc, u, wr, wc); }
    template <bool SK> __device__ __forceinline__ void apply(const f32x4 (&acc)[2][2][4][2], const Unit& u, int wr, int wc) const {
        constexpr int NAI = SK ? 1 : 2, NM = SK ? 1 : 4;
        int lane_e; asm volatile("v_mbcnt_lo_u32_b32 %0, -1, 0\n\tv_mbcnt_hi_u32_b32 %0, -1, %0" : "=v"(lane_e));
        const int fr = lane_e & 15, fq = lane_e >> 4;
        const int colt = u.pn * BM, t = colt >> 10;
        bf16_t* base = Q + (size_t)t * (ROWB1024 / 2) + (colt & 1023) + wc * 32 + 8 * fq;
        const bool rot = (t < 2) && ((wc & 1) == 0);
        const float sgn = fq == 0 ? -1.f : 1.f; const bool mine = fq < 2;
#pragma unroll
        for (int ai = 0; ai < NAI; ++ai)
#pragma unroll
            for (int m = 0; m < NM; ++m) {
                const int row = u.pm * BM + ai * HALF + wr * 64 + m * 16 + fr;
                const float rs = rstdf(rss, row, 1.0f / 1024.0f);
                f32x4 cs[4];
                if (rot) { const f32x4* tp = (const f32x4*)(TA + (size_t)row_pos(row) * 16);
#pragma unroll
                    for (int k = 0; k < 4; ++k) cs[k] = tp[k]; }
#pragma unroll
                for (int bj = 0; bj < 2; ++bj) {
                    f32x4 v0 = acc[ai][bj][m][0] * rs, v1 = acc[ai][bj][m][1] * rs;
                    if (rot) {
                        f32x4 r0, r1;
#pragma unroll
                        for (int e = 0; e < 4; ++e) { const float o0 = __shfl_xor(v0[e], 16), o1 = __shfl_xor(v1[e], 16);
                            r0[e] = v0[e] * cs[e >> 1][(e & 1) * 2] + sgn * o0 * cs[e >> 1][(e & 1) * 2 + 1];
                            r1[e] = v1[e] * cs[2 + (e >> 1)][(e & 1) * 2] + sgn * o1 * cs[2 + (e >> 1)][(e & 1) * 2 + 1]; }
                        if (mine) { v0 = r0; v1 = r1; }
                    }
                    *(u32x4*)(base + (size_t)row * 1024 + bj * HALF) = pack8(v0, v1);
                }
            }
    }
};
struct FEpiRes {
    static constexpr bool PERM = true, AFTER_DRAIN = false;
    const float* bin; const float* bin_meta; float* out; float* hmeta; bf16_t* HB; float* rss;
    __device__ __forceinline__ void operator()(const f32x4 (&acc)[2][2][4][2], const Unit& u, int wr, int wc, int, int) const { apply<false>(acc, u, wr, wc); }
    template <bool SK> __device__ __forceinline__ void apply(const f32x4 (&acc)[2][2][4][2], const Unit& u, int wr, int wc) const {
        constexpr int NAI = SK ? 1 : 2, NM = SK ? 1 : 4;
        int lane_e; asm volatile("v_mbcnt_lo_u32_b32 %0, -1, 0\n\tv_mbcnt_hi_u32_b32 %0, -1, %0" : "=v"(lane_e));
        const int fr = lane_e & 15, fq = lane_e >> 4;
        float* hb_ = u.pm < 64 ? out + (size_t)u.pm * BM * 1024 : hmeta; const float* rb_ = u.pm < 64 ? bin + (size_t)u.pm * BM * 1024 : bin_meta;
        const int col0 = u.pn * BM + wc * 32 + 8 * fq;
#pragma unroll
        for (int ai = 0; ai < NAI; ++ai)
#pragma unroll
            for (int m = 0; m < NM; ++m) {
                const int rl = ai * HALF + wr * 64 + m * 16 + fr, row = u.pm * BM + rl; float* hp = hb_ + (size_t)rl * 1024 + col0; const float* rp = rb_ + (size_t)rl * 1024 + col0;
                float ss = 0.f;
#pragma unroll
                for (int bj = 0; bj < 2; ++bj) {
                    const f32x4 h0 = *(const f32x4*)(rp + bj * HALF) + acc[ai][bj][m][0], h1 = *(const f32x4*)(rp + bj * HALF + 4) + acc[ai][bj][m][1];
                    *(f32x4*)(hp + bj * HALF) = h0; *(f32x4*)(hp + bj * HALF + 4) = h1;
                    ss += (h0[0] * h0[0] + h0[1] * h0[1]) + (h0[2] * h0[2] + h0[3] * h0[3]) + (h1[0] * h1[0] + h1[1] * h1[1]) + (h1[2] * h1[2] + h1[3] * h1[3]);
                    if (HB) *(u32x4*)(HB + (size_t)row * 1024 + col0 + bj * HALF) = pack8(h0, h1);
                    asm volatile("" ::: "memory");
                }
                ss += __shfl_xor(ss, 16); ss += __shfl_xor(ss, 32);
                if (fq == 0) atomicAdd(rss + row, ss);
                asm volatile("" ::: "memory");
            }
    }
};
struct FEpiFFN {
    static constexpr bool PERM = true, AFTER_DRAIN = false;
    const float* rss; const float* cw; const float* cb; bf16_t* G; float* SA; float* SB; PG8_LAS float* X;
    __device__ __forceinline__ void operator()(const f32x4 (&acc)[2][2][4][2], const Unit& u, int wr, int wc, int, int) const { apply<false>(acc, u, wr, wc); }
    template <bool SK> __device__ __forceinline__ void apply(const f32x4 (&acc)[2][2][4][2], const Unit& u, int wr, int wc) const {
        constexpr int NAI = SK ? 1 : 2, NM = SK ? 1 : 4;
        int lane_e; asm volatile("v_mbcnt_lo_u32_b32 %0, -1, 0\n\tv_mbcnt_hi_u32_b32 %0, -1, %0" : "=v"(lane_e));
        const int fr = lane_e & 15, fq = lane_e >> 4;
        const int lane = fr + 16 * fq;
        const int cc0 = u.pn * HALF + wc * 32 + 8 * fq;
        f32x4 w0[2], w1[2], w2[2], bs[2];
#pragma unroll
        for (int n = 0; n < 2; ++n) { w0[n] = *(const f32x4*)(cw + cc0 + 4 * n); w1[n] = *(const f32x4*)(cw + DFF + cc0 + 4 * n); w2[n] = *(const f32x4*)(cw + 2 * DFF + cc0 + 4 * n); bs[n] = *(const f32x4*)(cb + cc0 + 4 * n); }
        if (!SK) {
#pragma unroll
            for (int ai = 0; ai < 2; ++ai) { const int row = u.pm * BM + ai * HALF + wr * 64 + 48 + fr; const float rsl = rstdf(rss, row, 1.0f / 1024.0f);
                if (fr >= 14) { PG8_LAS float* xp = X + (((2 * ai + wr) * 4 + wc) * 2 + (fr - 14)) * 32 + 8 * fq;
                    *(PG8_LAS f32x4*)xp = acc[ai][0][3][0] * rsl; *(PG8_LAS f32x4*)(xp + 4) = acc[ai][0][3][1] * rsl; } }
            asm volatile("s_waitcnt lgkmcnt(0)" ::: "memory"); __builtin_amdgcn_s_barrier(); asm volatile("" ::: "memory");
        }
        const int src1 = (lane & 48) | ((fr - 1) & 15), src2 = (lane & 48) | ((fr - 2) & 15);
#pragma unroll
        for (int ai = 0; ai < NAI; ++ai) {
            const int strip = 2 * ai + wr;
            f32x4 pa[2] = {(f32x4){0.f, 0.f, 0.f, 0.f}, (f32x4){0.f, 0.f, 0.f, 0.f}};
#pragma unroll
            for (int m = 0; m < NM; ++m) {
                const int rl = ai * HALF + wr * 64 + m * 16 + fr, row = u.pm * BM + rl;
                const float rs = rstdf(rss, row, 1.0f / 1024.0f);
                f32x4 a[2], b[2], p1[2], p2[2];
#pragma unroll
                for (int n = 0; n < 2; ++n) { a[n] = acc[ai][0][m][n] * rs; b[n] = acc[ai][1][m][n] * rs; }
#pragma unroll
                for (int n = 0; n < 2; ++n)
#pragma unroll
                    for (int e = 0; e < 4; ++e) { const float s1 = (m > 0 && fr == 15) ? pa[n][e] : a[n][e], s2 = (m > 0 && fr >= 14) ? pa[n][e] : a[n][e];
                        p1[n][e] = __shfl(s1, src1); p2[n][e] = __shfl(s2, src2); }
                if (m == 0 && strip > 0) {
                    const PG8_LAS float* xp = X + (((strip - 1) * 4 + wc) * 2) * 32 + 8 * fq;
#pragma unroll
                    for (int n = 0; n < 2; ++n) { const f32x4 h62 = *(const PG8_LAS f32x4*)(xp + 4 * n), h63 = *(const PG8_LAS f32x4*)(xp + 32 + 4 * n);
                        if (fr == 0) { p1[n] = h63; p2[n] = h62; } else if (fr == 1) { p2[n] = h63; } }
                }
                f32x4 g[2];
#pragma unroll
                for (int n = 0; n < 2; ++n)
#pragma unroll
                    for (int e = 0; e < 4; ++e) { const float ac = bs[n][e] + w0[n][e] * p2[n][e] + w1[n][e] * p1[n][e] + w2[n][e] * a[n][e];
                        g[n][e] = ac * __builtin_amdgcn_rcpf(1.0f + __builtin_amdgcn_exp2f(-LOG2E * ac)) * b[n][e]; }
                const bool head = (strip == 0 && m == 0 && fr < 2);
                if (!head) *(u32x4*)(G + (size_t)row * DFF + cc0) = pack8(g[0], g[1]);
                else { float* sa = SA + ((size_t)u.pm * 4 + fr) * DFF + cc0; float* sb = SB + ((size_t)u.pm * 2 + fr) * DFF + cc0;
                    *(f32x4*)sa = a[0]; *(f32x4*)(sa + 4) = a[1]; *(f32x4*)sb = b[0]; *(f32x4*)(sb + 4) = b[1]; }
                const bool tail = (u.pm < 64) ? (strip == 3 && m == 3 && fr >= 14) : (strip == 0 && m == 0 && fr >= 14);
                if (tail) { float* sa = SA + ((size_t)u.pm * 4 + 2 + (fr - 14)) * DFF + cc0; *(f32x4*)sa = a[0]; *(f32x4*)(sa + 4) = a[1]; }
                pa[0] = a[0]; pa[1] = a[1];
            }
        }
    }
};
__device__ __forceinline__ void rope32(f32x4& v0, f32x4& v1, const float* TB, int pos, int fq) {
    const f32x4* tp = (const f32x4*)(TB + (size_t)pos * 32 + 16 * (fq & 1)); const float sgn = fq < 2 ? -1.f : 1.f;
    f32x4 cs[4];
#pragma unroll
    for (int k = 0; k < 4; ++k) cs[k] = tp[k];
#pragma unroll
    for (int e = 0; e < 4; ++e) { const float o0 = __shfl_xor(v0[e], 32), o1 = __shfl_xor(v1[e], 32);
        v0[e] = v0[e] * cs[e >> 1][(e & 1) * 2] + sgn * o0 * cs[e >> 1][(e & 1) * 2 + 1];
        v1[e] = v1[e] * cs[2 + (e >> 1)][(e & 1) * 2] + sgn * o1 * cs[2 + (e >> 1)][(e & 1) * 2 + 1]; }
}
struct FEpiD {
    static constexpr bool PERM = true, AFTER_DRAIN = false;
    const float* rss; bf16_t* CQ; bf16_t* CKV; bf16_t* KR; float* rssq; float* rsskv; const float* TB;
    __device__ __forceinline__ void operator()(const f32x4 (&acc)[2][2][4][2], const Unit& u, int wr, int wc, int, int) const { apply<false>(acc, u, wr, wc); }
    template <bool SK> __device__ __forceinline__ void apply(const f32x4 (&acc)[2][2][4][2], const Unit& u, int wr, int wc) const {
        constexpr int NAI = SK ? 1 : 2, NM = SK ? 1 : 4;
        int lane_e; asm volatile("v_mbcnt_lo_u32_b32 %0, -1, 0\n\tv_mbcnt_hi_u32_b32 %0, -1, %0" : "=v"(lane_e));
        const int fr = lane_e & 15, fq = lane_e >> 4;
#pragma unroll
        for (int ai = 0; ai < NAI; ++ai)
#pragma unroll
            for (int m = 0; m < NM; ++m) {
                const int row = u.pm * BM + ai * HALF + wr * 64 + m * 16 + fr; const float rs = rstdf(rss, row, 1.0f / 1024.0f);
                float sq = 0.f, skv = 0.f;
#pragma unroll
                for (int bj = 0; bj < 2; ++bj) {
                    const int g128 = u.pn * 2 + bj, c = wc * 32 + 8 * fq;
                    f32x4 v0 = acc[ai][bj][m][0] * rs, v1 = acc[ai][bj][m][1] * rs;
                    const float s = (v0[0] * v0[0] + v0[1] * v0[1]) + (v0[2] * v0[2] + v0[3] * v0[3]) + (v1[0] * v1[0] + v1[1] * v1[1]) + (v1[2] * v1[2] + v1[3] * v1[3]);
                    if (g128 < 3) { sq += s; *(u32x4*)(CQ + (size_t)row * 384 + g128 * 128 + c) = pack8(v0, v1); }
                    else if (g128 < 5) { skv += s; *(u32x4*)(CKV + (size_t)row * 256 + (g128 - 3) * 128 + c) = pack8(v0, v1); }
                    else if (wc == 0) { rope32(v0, v1, TB, row_pos(row), fq); *(u32x4*)(KR + (size_t)row * 32 + c) = pack8(v0, v1); }
                }
                if (u.pn < 2) { sq += __shfl_xor(sq, 16); sq += __shfl_xor(sq, 32); if (fq == 0) atomicAdd(rssq + row, sq); }
                if (u.pn > 0) { skv += __shfl_xor(skv, 16); skv += __shfl_xor(skv, 32); if (fq == 0) atomicAdd(rsskv + row, skv); }
            }
    }
};
template <bool ROPE> struct FEpiUp {
    static constexpr bool PERM = true, AFTER_DRAIN = false;
    const float* rss; float invk; bf16_t* O; int ldo; const float* TB;
    __device__ __forceinline__ void operator()(const f32x4 (&acc)[2][2][4][2], const Unit& u, int wr, int wc, int, int) const { apply<false>(acc, u, wr, wc); }
    template <bool SK> __device__ __forceinline__ void apply(const f32x4 (&acc)[2][2][4][2], const Unit& u, int wr, int wc) const {
        constexpr int NAI = SK ? 1 : 2, NM = SK ? 1 : 4;
        int lane_e; asm volatile("v_mbcnt_lo_u32_b32 %0, -1, 0\n\tv_mbcnt_hi_u32_b32 %0, -1, %0" : "=v"(lane_e));
        const int fr = lane_e & 15, fq = lane_e >> 4;
#pragma unroll
        for (int ai = 0; ai < NAI; ++ai)
#pragma unroll
            for (int m = 0; m < NM; ++m) {
                const int row = u.pm * BM + ai * HALF + wr * 64 + m * 16 + fr; const float rs = rstdf(rss, row, invk);
#pragma unroll
                for (int bj = 0; bj < 2; ++bj) {
                    f32x4 v0 = acc[ai][bj][m][0] * rs, v1 = acc[ai][bj][m][1] * rs;
                    if (ROPE) { const int g32 = 8 * u.pn + 4 * bj + wc; if (g32 % 3 == 2) rope32(v0, v1, TB, row_pos(row), fq); }
                    *(u32x4*)(O + (size_t)row * ldo + u.pn * BM + bj * HALF + wc * 32 + 8 * fq) = pack8(v0, v1);
                    asm volatile("" ::: "memory");
                }
            }
    }
};

template <class Epi>
__device__ __forceinline__ void skinny_gemm(PG8_LAS unsigned char* lds, const bf16_t* A, const bf16_t* Bt, int N, int K, const Epi& E, int vcu, int G, int wave, int lane) {
    const int njobs = (N / BM) * 4, fr = lane & 15, fq = lane >> 4, nks = K / 32;
    for (int j = vcu; j < njobs; j += G) {
        const int pn = j >> 2, wc = j & 3;
        f32x4 pacc[2][2];
#pragma unroll
        for (int bj = 0; bj < 2; ++bj)
#pragma unroll
            for (int n = 0; n < 2; ++n) pacc[bj][n] = (f32x4){0.f, 0.f, 0.f, 0.f};
        const bf16_t* ap = A + (size_t)(64 * BM + fr) * K + 8 * fq;
        const bf16_t* bp[2][2];
#pragma unroll
        for (int bj = 0; bj < 2; ++bj)
#pragma unroll
            for (int n = 0; n < 2; ++n) bp[bj][n] = Bt + (size_t)(pn * BM + bj * HALF + wc * 32 + perm32(16 * n + fr)) * K + 8 * fq;
#pragma nounroll
        for (int ks0 = wave * 4; ks0 < nks; ks0 += 32) {
            bf16x8 a[4], b[4][2][2];
#pragma unroll
            for (int s = 0; s < 4; ++s) { a[s] = *(const bf16x8*)(ap + (ks0 + s) * 32);
#pragma unroll
                for (int bj = 0; bj < 2; ++bj)
#pragma unroll
                    for (int n = 0; n < 2; ++n) b[s][bj][n] = *(const bf16x8*)(bp[bj][n] + (ks0 + s) * 32); }
#pragma unroll
            for (int s = 0; s < 4; ++s)
#pragma unroll
                for (int bj = 0; bj < 2; ++bj)
#pragma unroll
                    for (int n = 0; n < 2; ++n) pacc[bj][n] = __builtin_amdgcn_mfma_f32_16x16x32_bf16(b[s][bj][n], a[s], pacc[bj][n], 0, 0, 0);
        }
        PG8_LAS f32x4* P = (PG8_LAS f32x4*)lds + (wave * 64 + lane) * 4;
        P[0] = pacc[0][0]; P[1] = pacc[0][1]; P[2] = pacc[1][0]; P[3] = pacc[1][1];
        __syncthreads();
        if (wave == 0) {
            f32x4 acc[2][2][4][2];
#pragma unroll
            for (int w = 1; w < 8; ++w) { const PG8_LAS f32x4* Q = (const PG8_LAS f32x4*)lds + (w * 64 + lane) * 4;
                pacc[0][0] += Q[0]; pacc[0][1] += Q[1]; pacc[1][0] += Q[2]; pacc[1][1] += Q[3]; }
            acc[0][0][0][0] = pacc[0][0]; acc[0][0][0][1] = pacc[0][1]; acc[0][1][0][0] = pacc[1][0]; acc[0][1][0][1] = pacc[1][1];
            Unit u; u.pm = 64; u.pn = pn;
            E.template apply<true>(acc, u, 0, wc);
        }
        __syncthreads();
    }
}
}

template <int MASK> __device__ __forceinline__ float swz_xor(float v) { return __shfl_xor(v, MASK); }
__device__ __forceinline__ float half_max(float v) { return fmaxf(v, __shfl_xor(v, 32)); }
__device__ __forceinline__ float half_sum(float v) { return v + __shfl_xor(v, 32); }
__device__ __forceinline__ s16x4 vtr(const LAS unsigned char* p) { typedef short v4i16_t __attribute__((ext_vector_type(4)));
    return __builtin_bit_cast(s16x4, __builtin_amdgcn_ds_read_tr16_b64_v4i16((LAS v4i16_t*)p)); }
__device__ __forceinline__ unsigned cvtpk(float lo, float hi) { typedef float f32x2_t __attribute__((ext_vector_type(2))); typedef __bf16 bf16x2_t __attribute__((ext_vector_type(2)));
    f32x2_t v = {lo, hi}; bf16x2_t b = __builtin_convertvector(v, bf16x2_t); return __builtin_bit_cast(unsigned, b); }

struct SrcA { const bf16_t* K; const bf16_t* V; int h, s;
    __device__ __forceinline__ const bf16_t* kptr(int krow, int ch) const { return K + (size_t)krow * 1024 + h * 128 + s * 64 + ch * 8; }
    __device__ __forceinline__ const bf16_t* vptr(int krow, int ch) const { return V + (size_t)krow * 1024 + h * 128 + ch * 8; } };
struct SrcB { const bf16_t* KV; const bf16_t* KR; int h;
    __device__ __forceinline__ const bf16_t* kptr(int krow, int ch) const { return ch < 8 ? KV + (size_t)krow * 2048 + h * 128 + ch * 8 : KR + (size_t)krow * 32 + (ch - 8) * 8; }
    __device__ __forceinline__ const bf16_t* vptr(int krow, int ch) const { return KV + (size_t)krow * 2048 + h * 128 + 64 + ch * 8; } };

template <int DQK, int DV> struct ACfg { static constexpr int KS = DQK * 2 + 16, VS = DV * 2 + 64, KOFF = 0, VOFF = 64 * KS, SCR = VOFF + 64 * VS,
    SCRATCH = 2 * SCR  , STG = SCRATCH + 2048  , END = STG + 8 * 32 * DV * 2; };
constexpr float ATT_THR = 8.0f;

template <int DQK, int DV, bool META>
__device__ __forceinline__ void attn_tile(const LAS unsigned char* Kt, const LAS unsigned char* Vt, LAS float* scr, const bf16x8 (&qf)[DQK / 16], f32x16 (&o)[DV / 32], float& m, float& lsum, int lane) {
    constexpr int KS = ACfg<DQK, DV>::KS, VS = ACfg<DQK, DV>::VS;
    const int r32 = lane & 31, hi = lane >> 5;
    f32x16 p0, p1; const f32x16 zero16 = {0.f, 0.f, 0.f, 0.f, 0.f, 0.f, 0.f, 0.f, 0.f, 0.f, 0.f, 0.f, 0.f, 0.f, 0.f, 0.f};
#pragma unroll
    for (int kk = 0; kk < DQK / 16; ++kk) {
        const bf16x8 k0 = *(const LAS bf16x8*)(Kt + r32 * KS + (16 * kk + 8 * hi) * 2);
        p0 = __builtin_amdgcn_mfma_f32_32x32x16_bf16(k0, qf[kk], kk == 0 ? zero16 : p0, 0, 0, 0);
        if (!META) { const bf16x8 k1 = *(const LAS bf16x8*)(Kt + (32 + r32) * KS + (16 * kk + 8 * hi) * 2);
            p1 = __builtin_amdgcn_mfma_f32_32x32x16_bf16(k1, qf[kk], kk == 0 ? zero16 : p1, 0, 0, 0); }
        if (kk & 1) __builtin_amdgcn_sched_barrier(0);
    }
    float mx;
    if (META) { mx = fmaxf(fmaxf(p0[0], p0[1]), p0[2]);
#pragma unroll
        for (int r = 3; r < 8; ++r) mx = fmaxf(mx, p0[r]);
    } else { float a = fmaxf(fmaxf(p0[0], p0[1]), p1[0]), bq = fmaxf(fmaxf(p0[2], p0[3]), p1[1]); a = fmaxf(fmaxf(a, p1[2]), p1[3]);
#pragma unroll
        for (int r = 4; r < 16; r += 4) { a = fmaxf(fmaxf(a, p0[r]), p0[r + 1]); bq = fmaxf(fmaxf(bq, p0[r + 2]), p0[r + 3]); a = fmaxf(fmaxf(a, p1[r]), p1[r + 1]); bq = fmaxf(fmaxf(bq, p1[r + 2]), p1[r + 3]); }
        mx = fmaxf(a, bq); }
    mx = half_max(mx) - m;
    if (META || __any(mx > ATT_THR)) {
        const float dl = META ? mx : fmaxf(mx, 0.f);
        m += dl;
        if (!META) {
            const float f = __builtin_amdgcn_exp2f(-dl); lsum *= f;
            if (hi == 0) scr[r32] = f;
            asm volatile("s_waitcnt lgkmcnt(0)" ::: "memory");
#pragma unroll
            for (int r = 0; r < 16; ++r) { const float a = scr[crow(r, hi)];
#pragma unroll
                for (int d0 = 0; d0 < DV / 32; ++d0) o[d0][r] *= a; }
        }
    }
    float ps = 0.f;
    if (META) {
#pragma unroll
        for (int r = 0; r < 8; ++r) { p0[r] = __builtin_amdgcn_exp2f(p0[r] - m); ps += p0[r]; }
    } else {
#pragma unroll
        for (int r = 0; r < 16; ++r) { p0[r] = __builtin_amdgcn_exp2f(p0[r] - m); p1[r] = __builtin_amdgcn_exp2f(p1[r] - m); ps += p0[r] + p1[r]; }
    }
    lsum += ps;
    bf16x8 pa[4];
    { u32x4 w; w.x = cvtpk(p0[0], p0[1]); w.y = cvtpk(p0[2], p0[3]); w.z = cvtpk(p0[4], p0[5]); w.w = cvtpk(p0[6], p0[7]); pa[0] = __builtin_bit_cast(bf16x8, w); }
    if (!META) {
        { u32x4 w; w.x = cvtpk(p0[8], p0[9]); w.y = cvtpk(p0[10], p0[11]); w.z = cvtpk(p0[12], p0[13]); w.w = cvtpk(p0[14], p0[15]); pa[1] = __builtin_bit_cast(bf16x8, w); }
        { u32x4 w; w.x = cvtpk(p1[0], p1[1]); w.y = cvtpk(p1[2], p1[3]); w.z = cvtpk(p1[4], p1[5]); w.w = cvtpk(p1[6], p1[7]); pa[2] = __builtin_bit_cast(bf16x8, w); }
        { u32x4 w; w.x = cvtpk(p1[8], p1[9]); w.y = cvtpk(p1[10], p1[11]); w.z = cvtpk(p1[12], p1[13]); w.w = cvtpk(p1[14], p1[15]); pa[3] = __builtin_bit_cast(bf16x8, w); }
    }
    const LAS unsigned char* vb = Vt + (4 * hi + ((lane & 15) >> 2)) * VS + (16 * ((lane >> 4) & 1) + 4 * (lane & 3)) * 2;
#pragma unroll
    for (int ks = 0; ks < (META ? 1 : 4); ++ks) {
#pragma unroll
        for (int d0 = 0; d0 < DV / 32; ++d0) {
            const s16x4 lo = vtr(vb + (16 * ks) * VS + 64 * d0), hh = vtr(vb + (16 * ks + 8) * VS + 64 * d0);
            const bf16x8 vf = (bf16x8){lo[0], lo[1], lo[2], lo[3], hh[0], hh[1], hh[2], hh[3]};
            o[d0] = __builtin_amdgcn_mfma_f32_32x32x16_bf16(pa[ks], vf, o[d0], 0, 0, 0);
        }
        __builtin_amdgcn_sched_barrier(0);
    }
}

template <int DQK, int DV, class Src>
__device__ __forceinline__ void attn_pass(const Ctx& c, const Src& src, int b, int qb, const bf16x8 (&qf)[DQK / 16], f32x16 (&o)[DV / 32]) {
    typedef ACfg<DQK, DV> C;
    constexpr int KCH = DQK / 8, VCH = DV / 8;
    constexpr int NKL = (64 * KCH + NTHREADS - 1) / NTHREADS, NVL = (64 * VCH + NTHREADS - 1) / NTHREADS;
    LAS float* scr = (LAS float*)(c.lds + C::SCRATCH) + c.wave * 64;
    const int hi = c.lane >> 5, r32 = c.lane & 31;
    float m = 0.f, lsum = 0.f;
#pragma unroll
    for (int d0 = 0; d0 < DV / 32; ++d0)
#pragma unroll
        for (int r = 0; r < 16; ++r) o[d0][r] = 0.f;
    const int NT = qb < 0 ? 0 : 4 * (qb + 1);
    const int myc = qb < 0 ? -1 : 4 * qb + (c.wave >> 1);
    const bool active = qb >= 0 || c.wave == 0;
    u32x4 kreg[NKL], vreg[NVL];
#define ATT_LOAD(jt_) do { int krow0_ = (jt_) < 0 ? RR : b * SEQ + 64 * (jt_); int tl_ = c.tid; asm volatile("" : "+s"(krow0_), "+v"(tl_));     \
        const int nk_ = (jt_) < 0 ? 32 : 64, nv_ = (jt_) < 0 ? 16 : 64; \
        _Pragma("unroll") for (int i_ = 0; i_ < NKL; ++i_) { const int idx_ = tl_ + i_ * NTHREADS; const int key_ = idx_ / KCH, ch_ = idx_ % KCH; if (key_ < nk_) kreg[i_] = *(const u32x4*)src.kptr(krow0_ + key_, ch_); } \
        _Pragma("unroll") for (int i_ = 0; i_ < NVL; ++i_) { const int idx_ = tl_ + i_ * NTHREADS; const int key_ = idx_ / VCH, ch_ = idx_ % VCH; if (key_ < nv_) vreg[i_] = *(const u32x4*)src.vptr(krow0_ + key_, ch_); } } while (0)
#define ATT_STORE(jt_, buf_) do { const int nk_ = (jt_) < 0 ? 32 : 64, nv_ = (jt_) < 0 ? 16 : 64; int ts_ = c.tid; asm volatile("" : "+v"(ts_)); LAS unsigned char* kt_ = c.lds + (buf_) * C::SCR + C::KOFF; LAS unsigned char* vt_ = c.lds + (buf_) * C::SCR + C::VOFF; \
        _Pragma("unroll") for (int i_ = 0; i_ < NKL; ++i_) { const int idx_ = ts_ + i_ * NTHREADS; const int key_ = idx_ / KCH, ch_ = idx_ % KCH; if (key_ < nk_) *(LAS u32x4*)(kt_ + key_ * C::KS + ch_ * 16) = kreg[i_]; } \
        _Pragma("unroll") for (int i_ = 0; i_ < NVL; ++i_) { const int idx_ = ts_ + i_ * NTHREADS; const int key_ = idx_ / VCH, ch_ = idx_ % VCH; if (key_ < nv_) *(LAS u32x4*)(vt_ + key_ * C::VS + ch_ * 16) = vreg[i_]; } } while (0)
    ATT_LOAD(-1); ATT_STORE(-1, 0);
    __syncthreads();
#pragma nounroll
    for (int jt = -1; jt < NT; ++jt) {
        const int cur = (jt + 1) & 1;
        if (jt + 1 < NT) ATT_LOAD(jt + 1);
        if (active && jt <= myc) {
            const LAS unsigned char* Kt = c.lds + cur * C::SCR + C::KOFF; const LAS unsigned char* Vt = c.lds + cur * C::SCR + C::VOFF;
            if (jt < 0) attn_tile<DQK, DV, true>(Kt, Vt, scr, qf, o, m, lsum, c.lane);
            else attn_tile<DQK, DV, false>(Kt, Vt, scr, qf, o, m, lsum, c.lane);
        }
        if (jt + 1 < NT) ATT_STORE(jt + 1, cur ^ 1);
        __syncthreads();
    }
#undef ATT_LOAD
#undef ATT_STORE
    const float lt = half_sum(lsum);
    if (hi == 0) scr[32 + r32] = 1.0f / lt;
    asm volatile("s_waitcnt lgkmcnt(0)" ::: "memory");
#pragma unroll
    for (int r = 0; r < 16; ++r) { const float a = scr[32 + crow(r, hi)];
#pragma unroll
        for (int d0 = 0; d0 < DV / 32; ++d0) o[d0][r] *= a; }
}

__device__ __forceinline__ void attn_unit_a(const Params& p, const Ctx& c, int b, int h, int qb, float lam, bf16_t* Odst) {
    typedef ACfg<64, 128> C;
    int ln_ = c.lane; asm volatile("" : "+v"(ln_));
    const int q0 = qb < 0 ? RR : b * SEQ + 256 * qb; const int hi = ln_ >> 5, r32 = ln_ & 31;
    bf16_t* Qb = (bf16_t*)(p.ws + WS_Q);
    LAS bf16_t* stg = (LAS bf16_t*)(c.lds + C::STG) + c.wave * (32 * 128);
    const bool active = qb >= 0 || c.wave == 0;
    f32x16 o[4];
#pragma nounroll
    for (int s = 0; s < 2; ++s) {
        const bf16_t* qrow = Qb + (size_t)(q0 + 32 * c.wave + r32) * 1024 + h * 128 + s * 64;
        bf16x8 qf[4];
#pragma unroll
        for (int kk = 0; kk < 4; ++kk) qf[kk] = *(const bf16x8*)(qrow + 16 * kk + 8 * hi);
        SrcA src{(const bf16_t*)(p.ws + WS_K), (const bf16_t*)(p.ws + WS_V), h, s};
        attn_pass<64, 128, SrcA>(c, src, b, qb, qf, o);
        if (s == 0) {
#pragma unroll
            for (int r = 0; r < 16; ++r) { LAS bf16_t* sp = stg + crow(r, hi) * 128 + r32;
                sp[0] = (bf16_t)f2bf(o[0][r]); sp[32] = (bf16_t)f2bf(o[1][r]); sp[64] = (bf16_t)f2bf(o[2][r]); sp[96] = (bf16_t)f2bf(o[3][r]); }
        }
    }
#pragma unroll
    for (int r = 0; r < 16; ++r) {
        LAS bf16_t* sp = stg + crow(r, hi) * 128 + r32;
        const float v0 = bf2f(sp[0]) - lam * o[0][r], v1 = bf2f(sp[32]) - lam * o[1][r], v2 = bf2f(sp[64]) - lam * o[2][r], v3 = bf2f(sp[96]) - lam * o[3][r];
        float ss = v0 * v0 + v1 * v1 + v2 * v2 + v3 * v3;
        ss += swz_xor<1>(ss); ss += swz_xor<2>(ss); ss += swz_xor<4>(ss); ss += swz_xor<8>(ss); ss += swz_xor<16>(ss);
        const float rs = 1.0f / sqrtf(ss * (1.0f / 128.0f) + EPS);
        sp[0] = (bf16_t)f2bf(v0 * rs); sp[32] = (bf16_t)f2bf(v1 * rs); sp[64] = (bf16_t)f2bf(v2 * rs); sp[96] = (bf16_t)f2bf(v3 * rs);
    }
    asm volatile("s_waitcnt lgkmcnt(0)" ::: "memory");
    if (!active) return;
    int rb = q0 + 32 * c.wave; asm volatile("" : "+s"(rb));
#pragma unroll
    for (int i = 0; i < 8; ++i) { const int row = 4 * i + (c.lane >> 4), ch = c.lane & 15;
        const u32x4 v = *(const LAS u32x4*)(stg + row * 128 + ch * 8);
        *(u32x4*)(Odst + (size_t)(rb + row) * 1024 + h * 128 + ch * 8) = v; }
}
__device__ __forceinline__ void ph_attn_a(const Params& p, const Ctx& c, bool dummy) {
    bf16_t* Odst = (bf16_t*)(p.ws + (dummy ? WS_OB2 : WS_Q));
    float d1 = 0.f, d2 = 0.f;
    for (int k = 0; k < 64; ++k) { d1 += p.in[I_LQ1][k] * p.in[I_LK1][k]; d2 += p.in[I_LQ2][k] * p.in[I_LK2][k]; }
    float lam = expf(d1) - expf(d2) + LAM_INIT; asm volatile("" : "+v"(lam));
#pragma nounroll
    for (int pi = c.vcu; pi < 256 + 8; pi += c.G) {
        const int nsub = pi < 256 ? 2 : 1;
#pragma nounroll
        for (int sub = 0; sub < nsub; ++sub) {
            int b, h, qb;
            if (pi < 256) { const int bh = pi >> 2, s = pi & 3; b = bh >> 3; h = bh & 7; qb = sub ? 7 - s : s; } else { b = 0; h = pi - 256; qb = -1; }
            attn_unit_a(p, c, b, h, qb, lam, Odst);
        }
    }
}
__device__ __forceinline__ void attn_unit_b(const Params& p, const Ctx& c, int b, int h, int qb) {
    typedef ACfg<96, 64> C;
    int ln_ = c.lane; asm volatile("" : "+v"(ln_));
    const int q0 = qb < 0 ? RR : b * SEQ + 256 * qb; const int hi = ln_ >> 5, r32 = ln_ & 31;
    const bf16_t* qrow = (const bf16_t*)(p.ws + WS_Q2) + (size_t)(q0 + 32 * c.wave + r32) * 1536 + h * 96;
    LAS bf16_t* stg = (LAS bf16_t*)(c.lds + C::STG) + c.wave * (32 * 64);
    bf16x8 qf[6];
#pragma unroll
    for (int kk = 0; kk < 6; ++kk) qf[kk] = *(const bf16x8*)(qrow + 16 * kk + 8 * hi);
    f32x16 o[2];
    SrcB src{(const bf16_t*)(p.ws + WS_KV2), (const bf16_t*)(p.ws + WS_KR), h};
    attn_pass<96, 64, SrcB>(c, src, b, qb, qf, o);
#pragma unroll
    for (int r = 0; r < 16; ++r) { LAS bf16_t* sp = stg + crow(r, hi) * 64 + r32; sp[0] = (bf16_t)f2bf(o[0][r]); sp[32] = (bf16_t)f2bf(o[1][r]); }
    asm volatile("s_waitcnt lgkmcnt(0)" ::: "memory");
    const bool active = qb >= 0 || c.wave == 0;
    if (!active) return;
    bf16_t* Ob = (bf16_t*)(p.ws + WS_OB2);
    int rb = q0 + 32 * c.wave; asm volatile("" : "+s"(rb));
#pragma unroll
    for (int i = 0; i < 4; ++i) { const int row = 8 * i + (c.lane >> 3), ch = c.lane & 7;
        const u32x4 v = *(const LAS u32x4*)(stg + row * 64 + ch * 8);
        *(u32x4*)(Ob + (size_t)(rb + row) * 1024 + h * 64 + ch * 8) = v; }
}
__device__ __forceinline__ void ph_attn_b(const Params& p, const Ctx& c) {
#pragma nounroll
    for (int pi = c.vcu; pi < 512 + 16; pi += c.G) {
        const int nsub = pi < 512 ? 2 : 1;
#pragma nounroll
        for (int sub = 0; sub < nsub; ++sub) {
            int b, h, qb;
            if (pi < 512) { const int bh = pi >> 2, s = pi & 3; b = bh >> 4; h = bh & 15; qb = sub ? 7 - s : s; } else { b = 0; h = pi - 512; qb = -1; }
            attn_unit_b(p, c, b, h, qb);
        }
    }
}

__device__ __forceinline__ void ph_ffn_fix(const Params& p, const Ctx& c, int layer) {
    const float* SA = (const float*)(p.ws + WS_SA); const float* SB = (const float*)(p.ws + WS_SB); bf16_t* G = (bf16_t*)(p.ws + WS_G);
    const float* cw = p.in[I_FFN_CW] + (size_t)layer * 3 * DFF; const float* cb = p.in[I_FFN_CB] + (size_t)layer * DFF;
    const int gt = c.gw * 64 + c.lane, ngt = c.ngw * 64;
    for (int i = gt; i < 65 * DFF; i += ngt) {
        const int pm = i / DFF, col = i - pm * DFF;
        const float a0 = SA[((size_t)pm * 4 + 0) * DFF + col], a1 = SA[((size_t)pm * 4 + 1) * DFF + col];
        const float b0 = SB[((size_t)pm * 2 + 0) * DFF + col], b1 = SB[((size_t)pm * 2 + 1) * DFF + col];
        float l0 = 0.f, l1 = 0.f;
        if (pm < 64) { const int ps = (pm & 7) == 0 ? 64 : pm - 1; l0 = SA[((size_t)ps * 4 + 2) * DFF + col]; l1 = SA[((size_t)ps * 4 + 3) * DFF + col]; }
        const float w0 = cw[col], w1 = cw[DFF + col], w2 = cw[2 * DFF + col], bb = cb[col];
        const float c0 = bb + w0 * l0 + w1 * l1 + w2 * a0, c1 = bb + w0 * l1 + w1 * a0 + w2 * a1;
        const float g0 = c0 / (1.0f + __expf(-c0)) * b0, g1 = c1 / (1.0f + __expf(-c1)) * b1;
        G[(size_t)(pm * 256) * DFF + col] = (bf16_t)f2bf(g0); G[(size_t)(pm * 256 + 1) * DFF + col] = (bf16_t)f2bf(g1);
    }
}

#define XB_TMO      128
#define XB_XCNT(j)  (256  + 64 * (j))
#define XB_XSUB(j)  (1280 + 64 * (j))
#define XB_XGEN(j)  (2304 + 64 * (j))
#define XB_TOP      3328
#define XB_TOPGEN   3392
#define XCD_BAR_WORDS 3456
#define XB_SPIN_CAP (1u << 18)

__device__ __forceinline__ unsigned xb_ld(unsigned* p)              { return __hip_atomic_load(p, __ATOMIC_RELAXED, __HIP_MEMORY_SCOPE_AGENT); }
__device__ __forceinline__ unsigned xb_add(unsigned* p, unsigned v) { return __hip_atomic_fetch_add(p, v, __ATOMIC_RELAXED, __HIP_MEMORY_SCOPE_AGENT); }
__device__ __forceinline__ unsigned xb_xcc_id() { return (unsigned)__builtin_amdgcn_s_getreg((3 << 11) | 20) & 0xFu; }
#define XB_SPIN(cond, bar) do { unsigned _sp = 0; while (cond) { __builtin_amdgcn_s_sleep(1); \
    if ((++_sp & 255u) == 0u) { if (xb_ld(&(bar)[XB_TMO])) break; if (_sp > XB_SPIN_CAP) { atomicAdd(&(bar)[XB_TMO], 1u); break; } } } } while (0)

struct XcdBarrier {
    unsigned* bar; unsigned x;
    volatile LAS unsigned* st;
};

__device__ __forceinline__ XcdBarrier xcd_barrier_post(unsigned* bar, volatile LAS unsigned* st) {
    XcdBarrier b; b.bar = bar; b.x = xb_xcc_id(); b.st = st;
    if (threadIdx.x == 0) (void)xb_add(&bar[XB_XCNT(b.x)], 1u);
    return b;
}
__device__ __forceinline__ void xcd_barrier_complete(unsigned* bar, unsigned x, unsigned& nloc, unsigned& nx) {
    const unsigned G = gridDim.x * gridDim.y * gridDim.z;
    unsigned sum, cnt, mine, sp = 0u;
    for (;;) {
        sum = 0u; cnt = 0u; mine = 0u;
#pragma unroll
        for (unsigned j = 0; j < 16; ++j) { const unsigned c = xb_ld(&bar[XB_XCNT(j)]); sum += c; cnt += (c > 0u) ? 1u : 0u; mine = (j == x) ? c : mine; }
        if (sum == G) break;
        __builtin_amdgcn_s_sleep(1);
        if ((++sp & 255u) == 0u) { if (xb_ld(&bar[XB_TMO])) break; if (sp > XB_SPIN_CAP) { atomicAdd(&bar[XB_TMO], 1u); break; } }
    }
    nloc = mine > 0u ? mine : 1u; nx = cnt > 0u ? cnt : 1u;
}

__device__ __forceinline__ void xcd_barrier(const XcdBarrier& b) {
    asm volatile("s_waitcnt vmcnt(0)" ::: "memory");
    __syncthreads();
    if (threadIdx.x == 0) {
        unsigned* bar = b.bar;
        __builtin_amdgcn_s_waitcnt(0);
        unsigned nloc = b.st[0], nx = b.st[1];
        if (nloc == 0u) { xcd_barrier_complete(bar, b.x, nloc, nx); b.st[0] = nloc; b.st[1] = nx; }
        const unsigned old = xb_add(&bar[XB_XSUB(b.x)], 1u);
        const unsigned gen = old / nloc;
        if (old + 1u == (gen + 1u) * nloc) {
            __builtin_amdgcn_fence(__ATOMIC_RELEASE, "agent");
            asm volatile("s_waitcnt vmcnt(0)" ::: "memory");
            const unsigned og = xb_add(&bar[XB_TOP], 1u);
            const unsigned tg = og / nx;
            if (og + 1u == (tg + 1u) * nx) xb_add(&bar[XB_TOPGEN], 1u);
            else XB_SPIN(xb_ld(&bar[XB_TOPGEN]) == tg, bar);
            __builtin_amdgcn_fence(__ATOMIC_ACQUIRE, "agent");
            xb_add(&bar[XB_XGEN(b.x)], 1u);
            asm volatile("s_waitcnt vmcnt(0)" ::: "memory");
        } else {
            XB_SPIN(xb_ld(&bar[XB_XGEN(b.x)]) == gen, bar);
            __builtin_amdgcn_fence(__ATOMIC_ACQUIRE, "agent");
            asm volatile("s_waitcnt vmcnt(0)" ::: "memory");
        }
    }
    __syncthreads();
}

enum { PH_PROLOGUE = 0, PH_QKV, PH_ATTN_A, PH_WO_A, PH_FFNIN_A, PH_FIX_A, PH_FFNOUT_A, PH_DPROJ, PH_UKV, PH_UQ, PH_ATTN_B, PH_WO_B, PH_FFNIN_B, PH_FIX_B, PH_FFNOUT_B, PH_FINAL, PH_COUNT };
__host__ __device__ constexpr bool phase_active(int ph) {
#ifdef ONLY_PH
    if (ph != ONLY_PH) return false;
#endif
    return true;
}
__host__ __device__ constexpr bool only_ok(int x) {
#ifdef ONLY_PH
    return x == ONLY_PH;
#else
    return true;
#endif
}
__device__ __forceinline__ Ctx make_ctx(LAS unsigned char* lds, int wave0) {
    int lane_; asm volatile("v_mbcnt_lo_u32_b32 %0, -1, 0\n\tv_mbcnt_hi_u32_b32 %0, -1, %0" : "=v"(lane_));
    int wv = wave0; asm volatile("" : "+s"(wv));
    Ctx c; c.lds = lds; c.lane = lane_; c.wave = wv; c.tid = wv * 64 + lane_;
    c.G = gridDim.x; { const int bx = blockIdx.x; c.vcu = (c.G % 8 == 0) ? (bx % 8) * (c.G / 8) + bx / 8 : bx; }
    c.gw = c.vcu * NWAVES + c.wave; c.ngw = c.G * NWAVES;
    return c;
}
template <class Epi> __device__ __forceinline__ void run_gemm(const Ctx& c, const bf16_t* A, const bf16_t* Bt, int N, int K, const Epi& E) {
    pg8::Gemm g{A, Bt, RR, N, K}; pg8::StaticOrder S; S.init(RR, N, c.G, (int)blockIdx.x);
    pg8::gemm_phase<Epi, pg8::StaticOrder, true, true>(c.lds, g, S, E, c.tid);
    int ln_; asm volatile("v_mbcnt_lo_u32_b32 %0, -1, 0\n\tv_mbcnt_hi_u32_b32 %0, -1, %0" : "=v"(ln_));
    pg8::skinny_gemm<Epi>(c.lds, A, Bt, N, K, E, c.vcu, c.G, c.wave, ln_);
}

__global__ void __launch_bounds__(NTHREADS, 2) fwd_kernel(Params pin) {
    extern __shared__ __attribute__((aligned(16))) unsigned char smem[];
    bool first = true;
    int wave0 = __builtin_amdgcn_readfirstlane((int)threadIdx.x >> 6);
    if (threadIdx.x < 64) ((LAS unsigned*)(smem + MISC_OFF))[threadIdx.x] = 0u;
    __syncthreads();
    const XcdBarrier xbar = xcd_barrier_post((unsigned*)(pin.ws + WS_CTL) + CW_BAR, (volatile LAS unsigned*)(smem + MISC_OFF));
    int nsync = 0;
#ifdef DUP_PH
    int dupdone = 0;
#endif
#ifdef PROBE_PH
    const int ph_end = pin.ph_hi + 1;
#else
    const int ph_end = pin.ph_hi;
#endif
#pragma nounroll
    for (int ph = pin.ph_lo; ph < ph_end; ++ph) {
        if (!phase_active(ph)) continue;
#ifdef PROBE_PH
        if (!first && ph == PH_UQ) { }
#endif
        if (!first && ph != PH_UQ) {
            if (nsync == 0) cg::this_grid().sync();
            else xcd_barrier(xbar);
            ++nsync;
        }
#ifdef PROBE_PH
        if (blockIdx.x == 0 && threadIdx.x == 0 && ph != PH_UQ) { volatile LAS unsigned* T = (volatile LAS unsigned*)(smem + MISC_OFF + 64); const unsigned t = (unsigned)__builtin_amdgcn_s_memrealtime();
            if (T[2] == (unsigned)PROBE_PH + 1u) T[1] = t - T[0];
            T[0] = t; T[2] = (unsigned)ph + 1u;
            if (ph == PH_COUNT) { const float us = (float)T[1] * 0.01f; const float k = rintf(logf(us) * (1.0f / 0.18232156f)); pin.out[0] = expf(k * 0.18232156f); } }
#endif
        first = false;
        Params p = pin; { size_t z0 = 0, z1 = 0; asm volatile("" : "+s"(z0), "+s"(z1)); p.ws = pin.ws + z0; p.out = pin.out + z1; }
#define MKCTX() const Ctx c = make_ctx((LAS unsigned char*)smem, wave0)
        unsigned char* ws = p.ws;
        const bf16_t* HB = (const bf16_t*)(ws + WS_HB);
        float* hmeta = (float*)(ws + WS_HMETA);
        const float* TA = (const float*)(ws + WS_ROPE); const float* TB = TA + 2064 * 8 * 2;
#ifdef DUP_PH
        const bool dummy = (ph == DUP_PH) && !dupdone;
#else
        const bool dummy = false;
#endif
        switch (ph) {
            case PH_PROLOGUE: if (!only_ok(PH_PROLOGUE)) break; { MKCTX(); ph_prologue(p, c); break; }
            case PH_QKV: if (!only_ok(PH_QKV)) break; { MKCTX();
                pg8::FEpiQKV e{rss_ptr(p, 0), (bf16_t*)(ws + WS_Q), TA}; run_gemm(c, HB, (const bf16_t*)(ws + W_QKV), 3072, 1024, e); break; }
            case PH_ATTN_A: if (!only_ok(PH_ATTN_A)) break; { MKCTX(); ph_attn_a(p, c, dummy); break; }
            case PH_WO_A: if (!only_ok(PH_WO_A)) break; { MKCTX();
                pg8::FEpiRes e{p.in[I_X], p.in[I_META], p.out, hmeta, (bf16_t*)(ws + WS_HB), rss_ptr(p, 1)}; run_gemm(c, (const bf16_t*)(ws + WS_Q), (const bf16_t*)(ws + W_OA), 1024, 1024, e); break; }
            case PH_FFNIN_A: case PH_FFNIN_B: if (!only_ok(PH_FFNIN_A) && !only_ok(PH_FFNIN_B)) break; { MKCTX(); const int layer = ph == PH_FFNIN_B; const int site = layer ? 3 : 1;
                pg8::FEpiFFN e{rss_ptr(p, site), p.in[I_FFN_CW] + (size_t)layer * 3 * DFF, p.in[I_FFN_CB] + (size_t)layer * DFF, (bf16_t*)(ws + WS_G), (float*)(ws + WS_SA), (float*)(ws + WS_SB), (LAS float*)(c.lds + XLDS_OFF)};
                run_gemm(c, HB, (const bf16_t*)(ws + (layer ? W_IN1 : W_IN0)), 5632, 1024, e); break; }
            case PH_FIX_A: if (!only_ok(PH_FIX_A)) break; { MKCTX(); ph_ffn_fix(p, c, 0); break; }
            case PH_FIX_B: if (!only_ok(PH_FIX_B)) break; { MKCTX(); ph_ffn_fix(p, c, 1); break; }
            case PH_FFNOUT_A: case PH_FFNOUT_B: if (!only_ok(PH_FFNOUT_A) && !only_ok(PH_FFNOUT_B)) break; { MKCTX(); const int layer = ph == PH_FFNOUT_B;
                pg8::FEpiRes e{p.out, hmeta, p.out, hmeta, layer ? nullptr : (bf16_t*)(ws + WS_HB), rss_ptr(p, layer ? 4 : 2)}; run_gemm(c, (const bf16_t*)(ws + WS_G), (const bf16_t*)(ws + (layer ? W_OUT1 : W_OUT0)), 1024, DFF, e); break; }
            case PH_DPROJ: if (!only_ok(PH_DPROJ)) break; { MKCTX();
                pg8::FEpiD e{rss_ptr(p, 2), (bf16_t*)(ws + WS_CQ), (bf16_t*)(ws + WS_CKV), (bf16_t*)(ws + WS_KR), rss_ptr(p, 5), rss_ptr(p, 6), TB}; run_gemm(c, HB, (const bf16_t*)(ws + W_D), 768, 1024, e); break; }
            case PH_UKV: if (!only_ok(PH_UKV)) break; { MKCTX();
                pg8::FEpiUp<false> e1{rss_ptr(p, 6), 1.0f / 256.0f, (bf16_t*)(ws + WS_KV2), 2048, TB}; run_gemm(c, (const bf16_t*)(ws + WS_CKV), (const bf16_t*)(ws + W_UKV), 2048, 256, e1); break; }
            case PH_UQ: if (!only_ok(PH_UQ)) break; { MKCTX();
                pg8::FEpiUp<true> e2{rss_ptr(p, 5), 1.0f / 384.0f, (bf16_t*)(ws + WS_Q2), 1536, TB}; run_gemm(c, (const bf16_t*)(ws + WS_CQ), (const bf16_t*)(ws + W_UQ), 1536, 384, e2); break; }
            case PH_ATTN_B: if (!only_ok(PH_ATTN_B)) break; { MKCTX(); ph_attn_b(p, c); break; }
            case PH_WO_B: if (!only_ok(PH_WO_B)) break; { MKCTX();
                pg8::FEpiRes e{p.out, hmeta, p.out, hmeta, (bf16_t*)(ws + WS_HB), rss_ptr(p, 3)}; run_gemm(c, (const bf16_t*)(ws + WS_OB2), (const bf16_t*)(ws + W_OB), 1024, 1024, e); break; }
            case PH_FINAL: if (!only_ok(PH_FINAL)) break; { MKCTX(); ph_final(p, c); break; }
            default: break;
        }
#ifdef DUP_PH
        if (ph == DUP_PH && !dupdone) { dupdone = 1; --ph; }
#endif
    }
}

extern "C" void kernel_launch(void* const* d_in, const int* in_sizes, int n_in, void* d_out, int out_size, void* d_ws, size_t ws_size, hipStream_t stream) {
    static int grid = 0;
    if (grid == 0) {
        if (n_in != 25 || ws_size < WS_END || out_size != RR * D) { fprintf(stderr, "kernel_launch: unexpected shapes (n_in %d, ws %zu, out %d)\n", n_in, ws_size, out_size); grid = -1; return; }
        int dev = 0, cus = 0, per_cu = 0;
        hipGetDevice(&dev); hipDeviceGetAttribute(&cus, hipDeviceAttributeMultiprocessorCount, dev);
        hipFuncSetAttribute((const void*)fwd_kernel, hipFuncAttributeMaxDynamicSharedMemorySize, LDS_BYTES);
        hipOccupancyMaxActiveBlocksPerMultiprocessor(&per_cu, (const void*)fwd_kernel, NTHREADS, LDS_BYTES);
        if (per_cu < 1) { fprintf(stderr, "kernel_launch: occupancy query says %d blocks per CU\n", per_cu); per_cu = 1; }
        (void)hipGetLastError();
        grid = cus * per_cu;
    }
    if (grid < 0) return;
    Params p{};
    for (int i = 0; i < 25; ++i) p.in[i] = (const float*)d_in[i];
    p.out = (float*)d_out; p.ws = (unsigned char*)d_ws;
    (void)hipMemsetAsync((char*)d_ws + WS_CTL, 0, CTL_ZERO_BYTES, stream);
    p.ph_lo = 0; p.ph_hi = PH_COUNT;
    void* args[] = {&p};
    hipError_t e = hipLaunchCooperativeKernel((const void*)fwd_kernel, dim3(grid), dim3(NTHREADS), args, LDS_BYTES, stream);
    if (e != hipSuccess) fprintf(stderr, "kernel_launch: cooperative launch failed: %s (grid %d)\n", hipGetErrorString(e), grid);
}
```

```cpp
#include <hip/hip_runtime.h>
#include <hip/hip_cooperative_groups.h>
#include <cstdio>
#include <cstdint>
#include <cmath>
namespace cg = cooperative_groups;

#define LAS __attribute__((address_space(3)))
typedef unsigned short bf16_t;
typedef short bf16x8 __attribute__((ext_vector_type(8)));
typedef short s16x4 __attribute__((ext_vector_type(4)));
typedef float f32x4 __attribute__((ext_vector_type(4)));
typedef float f32x16 __attribute__((ext_vector_type(16)));
typedef unsigned u32x4 __attribute__((ext_vector_type(4)));
typedef unsigned u32x2 __attribute__((ext_vector_type(2)));

constexpr int NB = 8, SEQ = 2048, NMETA = 16, D = 1024, DFF = 2816;
constexpr int RR = NB * SEQ;
constexpr int RV = RR + NMETA;
constexpr int RT = 16640;
constexpr int NWAVES = 8, NTHREADS = 512;
constexpr float EPS = 1e-5f;
constexpr float LOG2E = 1.4426950408889634f;
constexpr float QS_A = 0.125f * LOG2E;
constexpr float QS_B = 0.10206207261596575f * LOG2E;
constexpr float LAM_INIT = 0.2f;

constexpr size_t KiB = 1024, MiB = 1024 * 1024;
constexpr size_t WS_CTL = 0;
constexpr size_t W_QKV = 1 * MiB;
constexpr size_t W_OA = 7 * MiB;
constexpr size_t W_IN0 = 9 * MiB, W_IN1 = 20 * MiB;
constexpr size_t W_OUT0 = 31 * MiB, W_OUT1 = 31 * MiB + 5632 * KiB;
constexpr size_t W_D = 42 * MiB;
constexpr size_t W_UKV = 43 * MiB + 512 * KiB;
constexpr size_t W_UQ = 44 * MiB + 512 * KiB;
constexpr size_t W_OB = 45 * MiB + 640 * KiB;
constexpr size_t WS_HB = 48 * MiB;
constexpr size_t WS_BIG = WS_HB + 33280 * KiB;
constexpr size_t ROWB1024 = (size_t)RT * 1024 * 2;
constexpr size_t WS_Q = WS_BIG, WS_K = WS_BIG + ROWB1024, WS_V = WS_BIG + 2 * ROWB1024;
constexpr size_t WS_G = WS_BIG;
constexpr size_t WS_Q2 = WS_BIG;
constexpr size_t WS_KV2 = WS_BIG + (size_t)RT * 1536 * 2;
constexpr size_t WS_CQ = WS_BIG + 116480 * KiB;
constexpr size_t WS_CKV = WS_CQ + (size_t)RT * 384 * 2;
constexpr size_t WS_KR = WS_CKV + (size_t)RT * 256 * 2;
constexpr size_t WS_OB2 = 216 * MiB;
constexpr size_t WS_HMETA = WS_OB2 + 33280 * KiB;
constexpr size_t WS_RSS = WS_HMETA + 1 * MiB;
constexpr size_t WS_ROPE = WS_RSS + 512 * KiB;
constexpr size_t WS_SA = 251 * MiB;
constexpr size_t WS_SB = WS_SA + (size_t)65 * 4 * 2816 * 4;
constexpr size_t WS_END = 256 * MiB;
static_assert(WS_SB + (size_t)65 * 2 * 2816 * 4 <= WS_END, "ws map");
static_assert(WS_KR + (size_t)RT * 32 * 2 <= WS_OB2, "ws map");

static_assert(WS_KV2 + (size_t)RT * 2048 * 2 <= WS_CQ, "ws map");
static_assert(WS_ROPE + 512 * KiB <= WS_END, "ws map");
static_assert(W_OB + 2 * MiB <= WS_HB, "ws map");

constexpr int LDS_BYTES = 147456;
constexpr int MISC_OFF = 131072 + 4096;
constexpr size_t CTL_ZERO_BYTES = 64 * 1024;
constexpr int CW_BAR = 4096;
constexpr int XLDS_OFF = 131072;

struct Params {
    const float* in[25];
    float* out;
    unsigned char* ws;
    int ph_lo, ph_hi;
};
enum { I_X = 0, I_META, I_A_NORM, I_A_WQKV, I_LQ1, I_LK1, I_LQ2, I_LK2, I_A_SUB, I_A_WO, I_KV_NORM, I_KV_WDKV, I_KV_ANORM, I_KV_WUKV,
       I_B_NORM, I_B_WDQ, I_B_QANORM, I_B_WUQ, I_B_WO, I_FFN_NORM, I_FFN_WIN, I_FFN_CW, I_FFN_CB, I_FFN_WOUT, I_FINAL };

struct Ctx { int tid, lane, wave, gw, ngw, vcu, G; LAS unsigned char* lds; };

__device__ __forceinline__ unsigned f2bf(float f) { unsigned u = __builtin_bit_cast(unsigned, f); return (u + 0x7fffu + ((u >> 16) & 1u)) >> 16; }
__device__ __forceinline__ unsigned pk2(float lo, float hi) { return f2bf(lo) | (f2bf(hi) << 16); }
__device__ __forceinline__ float bf2f(bf16_t b) { return __builtin_bit_cast(float, (unsigned)b << 16); }
__device__ __forceinline__ float wave_sum(float v) {
#pragma unroll
    for (int o = 1; o < 64; o <<= 1) v += __shfl_xor(v, o);
    return v;
}
__device__ __forceinline__ int row_pos(int r) { return r < RR ? NMETA + (r & (SEQ - 1)) : r - RR; }
__device__ __forceinline__ float* hrow(const Params& p, int r) { return r < RR ? p.out + (size_t)r * D : (float*)(p.ws + WS_HMETA) + (size_t)(r - RR) * D; }
__device__ __forceinline__ float* rss_ptr(const Params& p, int site) { return (float*)(p.ws + WS_RSS) + (size_t)site * RT; }
__device__ __forceinline__ int crow(int r, int hi) { return (r & 3) + 8 * (r >> 2) + 4 * hi; }

struct WSrc { const float* W; int pitch; int col0; const float* gain; int gmask; float scale; };
__device__ __forceinline__ void wdims(int id, int& N, int& K, size_t& off) {
    switch (id) {
        case 0: N = 3072; K = 1024; off = W_QKV; break;
        case 1: N = 1024; K = 1024; off = W_OA; break;
        case 2: N = 5632; K = 1024; off = W_IN0; break;
        case 3: N = 5632; K = 1024; off = W_IN1; break;
        case 4: N = 1024; K = 2816; off = W_OUT0; break;
        case 5: N = 1024; K = 2816; off = W_OUT1; break;
        case 6: N = 768; K = 1024; off = W_D; break;
        case 7: N = 2048; K = 256; off = W_UKV; break;
        case 8: N = 1536; K = 384; off = W_UQ; break;
        default: N = 1024; K = 1024; off = W_OB; break;
    }
}
__device__ __forceinline__ WSrc wsrc(const Params& p, int id, int n0) {
    WSrc s; s.gain = nullptr; s.gmask = 0; s.scale = 1.f; s.W = nullptr; s.pitch = 0; s.col0 = 0;
    switch (id) {
        case 0: s.W = p.in[I_A_WQKV]; s.pitch = 3072; s.col0 = n0; s.gain = p.in[I_A_NORM]; s.gmask = 1023; s.scale = n0 < 1024 ? QS_A : 1.f; break;
        case 1: s.W = p.in[I_A_WO]; s.pitch = 1024; s.col0 = n0; s.gain = p.in[I_A_SUB]; s.gmask = 127; s.scale = 1.f - LAM_INIT; break;
        case 2: case 3: { const int l = id - 2; s.W = p.in[I_FFN_WIN] + (size_t)l * 1024 * 5632; s.pitch = 5632; const int j = n0 >> 8, u = n0 & 255;
            s.col0 = u < 128 ? 128 * j + u : DFF + 128 * j + (u - 128); s.gain = p.in[I_FFN_NORM] + l * 1024; s.gmask = 1023; break; }
        case 4: case 5: { const int l = id - 4; s.W = p.in[I_FFN_WOUT] + (size_t)l * DFF * 1024; s.pitch = 1024; s.col0 = n0; break; }
        case 6: if (n0 < 384) { s.W = p.in[I_B_WDQ]; s.pitch = 384; s.col0 = n0; s.gain = p.in[I_B_NORM]; s.gmask = 1023; }
                else if (n0 < 672) { s.W = p.in[I_KV_WDKV]; s.pitch = 288; s.col0 = n0 - 384; s.gain = p.in[I_KV_NORM]; s.gmask = 1023; }
                break;
        case 7: s.W = p.in[I_KV_WUKV]; s.pitch = 2048; s.col0 = n0; s.gain = p.in[I_KV_ANORM]; s.gmask = 255; break;
        case 8: s.W = p.in[I_B_WUQ]; s.pitch = 1536; s.col0 = n0; s.gain = p.in[I_B_QANORM]; s.gmask = 511; s.scale = QS_B; break;
        default: s.W = p.in[I_B_WO]; s.pitch = 1024; s.col0 = n0; break;
    }
    return s;
}
__device__ __forceinline__ void transpose_item(const WSrc& s, int K, bf16_t* WT, int k0, int n0, LAS float* scr, int lane) {
    const int kr = lane >> 3, nq = lane & 7;
    f32x4 v[8];
    if (s.W) {
#pragma unroll
        for (int i = 0; i < 8; ++i) v[i] = *(const f32x4*)(s.W + (size_t)(k0 + 8 * i + kr) * s.pitch + s.col0 + 4 * nq);
#pragma unroll
        for (int i = 0; i < 8; ++i) { float g = s.scale; if (s.gain) g *= s.gain[(k0 + 8 * i + kr) & s.gmask]; v[i] = v[i] * g; }
    } else {
#pragma unroll
        for (int i = 0; i < 8; ++i) v[i] = (f32x4){0.f, 0.f, 0.f, 0.f};
    }
#pragma unroll
    for (int i = 0; i < 8; ++i)
#pragma unroll
        for (int e = 0; e < 4; ++e) scr[(4 * nq + e) * 65 + 8 * i + kr] = v[i][e];
    asm volatile("s_waitcnt lgkmcnt(0)" ::: "memory");
    const int c = lane & 7;
#pragma unroll
    for (int j = 0; j < 4; ++j) { const int n = (lane >> 3) + 8 * j; const LAS float* q = scr + n * 65 + 8 * c;
        u32x4 o; o.x = pk2(q[0], q[1]); o.y = pk2(q[2], q[3]); o.z = pk2(q[4], q[5]); o.w = pk2(q[6], q[7]);
        *(u32x4*)(WT + (size_t)(n0 + n) * K + k0 + 8 * c) = o; }
    asm volatile("s_waitcnt lgkmcnt(0)" ::: "memory");
}
__device__ __forceinline__ void ph_prologue(const Params& p, const Ctx& c) {
    LAS float* scr = (LAS float*)(c.lds + c.wave * 16384);
    int base = 0;
    for (int id = 0; id < 10; ++id) {
        int N, K; size_t off; wdims(id, N, K, off);
        const int nkb = K / 64, nnb = N / 32, items = nkb * nnb;
        for (int it = ((c.gw - base) % c.ngw + c.ngw) % c.ngw; it < items; it += c.ngw) {
            const int kb = it / nnb, nb = it % nnb; const WSrc s = wsrc(p, id, nb * 32);
            transpose_item(s, K, (bf16_t*)(p.ws + off), kb * 64, nb * 32, scr, c.lane); }
        base += items;
    }
    { float2* TA = (float2*)(p.ws + WS_ROPE); float2* TB = TA + 2064 * 8;
      const int gt = c.gw * 64 + c.lane, ngt = c.ngw * 64;
      for (int i = gt; i < 2064 * 8; i += ngt) { const int pos = i >> 3, k = i & 7; const float inv = 1.0f / powf(500000.0f, (float)k / 8.0f); const float a = (float)pos * inv; TA[i] = make_float2(cosf(a), sinf(a)); }
      for (int i = gt; i < 2064 * 16; i += ngt) { const int pos = i >> 4, k = i & 15; const float inv = 1.0f / powf(10000.0f, (float)k / 16.0f); const float a = (float)pos * inv; TB[i] = make_float2(cosf(a), sinf(a)); } }
    { float* r1 = rss_ptr(p, 1); const int gt = c.gw * 64 + c.lane, ngt = c.ngw * 64; for (int i = gt; i < 6 * RT; i += ngt) r1[i] = 0.f; }
    float* rss0 = rss_ptr(p, 0);
    for (int it = c.gw; it < RT / 4; it += c.ngw) {
        f32x4 v[4][4];
#pragma unroll
        for (int rr = 0; rr < 4; ++rr) { const int r = 4 * it + rr;
            const float* src = r < RR ? p.in[I_X] + (size_t)r * D : (r < RV ? p.in[I_META] + (size_t)(r - RR) * D : nullptr);
#pragma unroll
            for (int j = 0; j < 4; ++j) v[rr][j] = src ? *(const f32x4*)(src + 4 * c.lane + 256 * j) : (f32x4){0.f, 0.f, 0.f, 0.f}; }
#pragma unroll
        for (int rr = 0; rr < 4; ++rr) { const int r = 4 * it + rr; float ss = 0.f;
#pragma unroll
            for (int j = 0; j < 4; ++j) ss += v[rr][j].x * v[rr][j].x + v[rr][j].y * v[rr][j].y + v[rr][j].z * v[rr][j].z + v[rr][j].w * v[rr][j].w;
            ss = wave_sum(ss);
            bf16_t* hb = (bf16_t*)(p.ws + WS_HB) + (size_t)r * D;
#pragma unroll
            for (int j = 0; j < 4; ++j) { u32x2 w; w.x = pk2(v[rr][j].x, v[rr][j].y); w.y = pk2(v[rr][j].z, v[rr][j].w); *(u32x2*)(hb + 4 * c.lane + 256 * j) = w; }
            if (c.lane == 0) rss0[r] = ss; }
    }
}
__device__ __forceinline__ void ph_final(const Params& p, const Ctx& c) {
    const float* g = p.in[I_FINAL];
    for (int r = c.gw; r < RR; r += c.ngw) {
        float* h = p.out + (size_t)r * D; f32x4 v[4]; float ss = 0.f;
#pragma unroll
        for (int j = 0; j < 4; ++j) { v[j] = *(const f32x4*)(h + 4 * c.lane + 256 * j); ss += v[j].x * v[j].x + v[j].y * v[j].y + v[j].z * v[j].z + v[j].w * v[j].w; }
        ss = wave_sum(ss); const float rstd = 1.0f / sqrtf(ss * (1.0f / D) + EPS);
#pragma unroll
        for (int j = 0; j < 4; ++j) { const f32x4 gg = *(const f32x4*)(g + 4 * c.lane + 256 * j); *(f32x4*)(h + 4 * c.lane + 256 * j) = v[j] * rstd * gg; }
    }
}

namespace pg8 {
#define PG8_LAS __attribute__((address_space(3)))
typedef unsigned short bf16_t;
typedef short bf16x8 __attribute__((ext_vector_type(8)));
typedef float f32x4 __attribute__((ext_vector_type(4)));
typedef unsigned u32x4 __attribute__((ext_vector_type(4)));
constexpr int BM = 256, BK = 64, HALF = 128, HTB = HALF * BK * 2  , STAGE_BYTES = 8 * HTB, NXCD = 8, WGM = 8;

__host__ __device__ __forceinline__ int lds_byte(int r, int c) { const int st = (r >> 4) * 2 + (c >> 5), rr = r & 15, cc = c & 31, ob = rr * 64 + cc * 2; return st * 1024 + (ob ^ (((ob >> 9) & 1) << 5)); }
__host__ __device__ __forceinline__ void stage_rc(int b, int& R, int& C) { const int st = b / 1024, sb = b % 1024, swz = sb ^ (((sb >> 9) & 1) << 5); R = (st >> 1) * 16 + swz / 64; C = (st & 1) * 32 + (swz % 64) / 2; }
__host__ __device__ __forceinline__ int perm32(int rho) { const int n = rho >> 4, i = rho & 15; return 8 * (i >> 2) + 4 * n + (i & 3); }

struct Unit { int pm, pn; };
struct Gemm { const bf16_t* A; const bf16_t* Bt; int M, N, K; };

struct StaticOrder {
    int nM, nN, nwg, G, c;
    __host__ __device__ void init(int M, int N, int G_, int c_) { nM = M / BM; nN = N / BM; nwg = nM * nN; G = G_; c = c_; }
    __host__ __device__ bool next(int i, Unit& u) const {
        const long L = (long)i * G + c; if (L >= nwg) return false;
        int wgid = (int)L; { const int q = nwg / NXCD, r = nwg % NXCD, xcd = wgid % NXCD, off = wgid / NXCD; wgid = (xcd < r ? xcd * (q + 1) : r * (q + 1) + (xcd - r) * q) + off; }
        const int nig = WGM * nN, gid = wgid / nig, fm = gid * WGM, gsz = (nM - fm) < WGM ? (nM - fm) : WGM;
        u.pm = fm + ((wgid % nig) % gsz); u.pn = (wgid % nig) / gsz; return true;
    }
    __device__ __forceinline__ void a_ready(const Unit&) const {}
    __device__ __forceinline__ void done(const Unit&) const {}
};
template <class Epi, class Sched, bool ALIGN_EPI = false, bool SP2 = false>
__device__ __forceinline__ void gemm_phase(PG8_LAS unsigned char* lds, const Gemm g, const Sched& S, const Epi& E, const int tid_in) {
    const int tid = tid_in, wid = __builtin_amdgcn_readfirstlane(tid >> 6), lane = tid & 63, wr = wid >> 2, wc = wid & 3, fr = lane & 15, fq = lane >> 4;
    const int K = g.K, nt = K / BK;
    unsigned voffA[2], voffB[2]; int aoff, boff;
#define PG8_LANE_STATE() do { int l_; asm volatile("v_mbcnt_lo_u32_b32 %0, -1, 0\n\tv_mbcnt_hi_u32_b32 %0, -1, %0" : "=v"(l_)); const int t_ = wid * 64 + l_; \
        _Pragma("unroll") for (int i = 0; i < 2; ++i) { int R, C; stage_rc(t_ * 16 + i * 8192, R, C); const int Rb = Epi::PERM ? ((R & ~31) + perm32(R & 31)) : R; \
            voffA[i] = (unsigned)(R * K + C) * 2u; voffB[i] = (unsigned)(Rb * K + C) * 2u; } \
        aoff = lds_byte(wr * 64 + (l_ & 15), (l_ >> 4) * 8); boff = lds_byte(wc * 32 + (l_ & 15), (l_ >> 4) * 8); } while (0)
    PG8_LANE_STATE();
    const size_t kstep = (size_t)(BK * 2);
    const size_t hstep = (size_t)HALF * K * 2;
    const size_t tstep = 2 * hstep;
    const unsigned ldsw = (unsigned)wid * 1024u;

#define PG8_SA(b, h) (((b) * 2 + (h)) * HTB)
#define PG8_SB(b, h) ((4 + (b) * 2 + (h)) * HTB)
#define PG8_STAGE(bufoff, gbase, voff) do { _Pragma("unroll") for (int _i = 0; _i < 2; ++_i) \
        __builtin_amdgcn_global_load_lds((const unsigned*)((const char*)(gbase) + (voff)[_i]), (PG8_LAS unsigned*)(lds + (bufoff) + ldsw + _i * 8192), 16, 0, 0); } while (0)
#define PG8_LDA(dst, b, h) do { _Pragma("unroll") for (int m = 0; m < 4; ++m) _Pragma("unroll") for (int k = 0; k < 2; ++k) dst[m][k] = *(const PG8_LAS bf16x8*)(lds + PG8_SA(b, h) + aoff + m * 2048 + k * 1024); } while (0)
#define PG8_LDB(dst, b, h) do { _Pragma("unroll") for (int n = 0; n < 2; ++n) _Pragma("unroll") for (int k = 0; k < 2; ++k) dst[n][k] = *(const PG8_LAS bf16x8*)(lds + PG8_SB(b, h) + boff + n * 2048 + k * 1024); } while (0)
#define PG8_MMA(ai, bj, At, Bt) do { __builtin_amdgcn_s_setprio(1); _Pragma("unroll") for (int m = 0; m < 4; ++m) _Pragma("unroll") for (int n = 0; n < 2; ++n) _Pragma("unroll") for (int k = 0; k < 2; ++k) \
        acc[ai][bj][m][n] = __builtin_amdgcn_mfma_f32_16x16x32_bf16(Bt[n][k], At[m][k], acc[ai][bj][m][n], 0, 0, 0); __builtin_amdgcn_s_setprio(0); } while (0)
#define PG8_WAIT_V(n) asm volatile("s_waitcnt vmcnt(" #n ")" ::: "memory")
#define PG8_WAIT_L(n) asm volatile("s_waitcnt lgkmcnt(" #n ")" ::: "memory")
#define PG8_BAR __builtin_amdgcn_s_barrier()
#define PG8_SCHED __builtin_amdgcn_sched_barrier(0)
    Unit cur, nxt; int ui = 0;
    if (!S.next(0, cur)) return;
    f32x4 acc[2][2][4][2];
#pragma unroll
    for (int a = 0; a < 2; ++a)
#pragma unroll
        for (int b = 0; b < 2; ++b)
#pragma unroll
            for (int m = 0; m < 4; ++m)
#pragma unroll
                for (int n = 0; n < 2; ++n) acc[a][b][m][n] = (f32x4){0.f, 0.f, 0.f, 0.f};
    bf16x8 At[4][2], B0[2][2], B1[2][2];
    const char* cA = (const char*)g.A + (size_t)cur.pm * tstep; const char* cB = (const char*)g.Bt + (size_t)cur.pn * tstep;
    S.a_ready(cur);
    if constexpr (SP2) {
        PG8_STAGE(PG8_SB(0, 0), cB, voffB); PG8_STAGE(PG8_SB(0, 1), cB + hstep, voffB); PG8_STAGE(PG8_SA(0, 0), cA, voffA); PG8_STAGE(PG8_SA(0, 1), cA + hstep, voffA);
        if (wr == 1) PG8_BAR;
        PG8_WAIT_V(2); PG8_BAR;
        PG8_STAGE(PG8_SB(1, 0), cB + kstep, voffB); PG8_STAGE(PG8_SA(1, 0), cA + kstep, voffA); PG8_STAGE(PG8_SB(1, 1), cB + hstep + kstep, voffB);
        PG8_WAIT_V(6); PG8_BAR;
    } else {
        PG8_STAGE(PG8_SB(0, 0), cB, voffB); PG8_STAGE(PG8_SA(0, 0), cA, voffA); PG8_STAGE(PG8_SB(0, 1), cB + hstep, voffB); PG8_STAGE(PG8_SA(0, 1), cA + hstep, voffA);
        if (wr == 1) PG8_BAR;
        PG8_WAIT_V(4); PG8_BAR;
        PG8_STAGE(PG8_SB(1, 0), cB + kstep, voffB); PG8_STAGE(PG8_SA(1, 0), cA + kstep, voffA); PG8_STAGE(PG8_SB(1, 1), cB + hstep + kstep, voffB);
        PG8_WAIT_V(6); PG8_BAR;
    }
    for (;;) {
        const bool has_next = S.next(ui + 1, nxt);
        const char* nA = has_next ? (const char*)g.A + (size_t)nxt.pm * tstep : cA; const char* nB = has_next ? (const char*)g.Bt + (size_t)nxt.pn * tstep : cB;
        for (int t = 0; t < nt; t += 2) {
            const bool last = (t == nt - 2);
            const char* a1 = cA + (size_t)(t + 1) * kstep;
            const char* a2 = last ? nA : cA + (size_t)(t + 2) * kstep; const char* b2 = last ? nB : cB + (size_t)(t + 2) * kstep;
            const char* a3 = a2 + kstep; const char* b3 = b2 + kstep;
            if (last && has_next) S.a_ready(nxt);
            if constexpr (SP2) {
            PG8_LDB(B0, 0, 0); PG8_LDB(B1, 0, 1); PG8_SCHED; PG8_LDA(At, 0, 0); PG8_STAGE(PG8_SA(1, 1), a1 + hstep, voffA);
            PG8_WAIT_V(8); PG8_WAIT_L(0); PG8_BAR; PG8_MMA(0, 0, At, B0); PG8_MMA(0, 1, At, B1); PG8_BAR; PG8_SCHED;
            PG8_LDA(At, 0, 1); PG8_STAGE(PG8_SB(0, 0), b2, voffB); PG8_STAGE(PG8_SB(0, 1), b2 + hstep, voffB); PG8_STAGE(PG8_SA(0, 0), a2, voffA);
            PG8_WAIT_V(8); PG8_WAIT_L(0); PG8_BAR; PG8_MMA(1, 0, At, B0); PG8_MMA(1, 1, At, B1); PG8_BAR; PG8_SCHED;
            PG8_LDB(B0, 1, 0); PG8_LDB(B1, 1, 1); PG8_SCHED; PG8_LDA(At, 1, 0); PG8_STAGE(PG8_SA(0, 1), a2 + hstep, voffA);
            PG8_WAIT_V(8); PG8_WAIT_L(0); PG8_BAR; PG8_MMA(0, 0, At, B0); PG8_MMA(0, 1, At, B1); PG8_BAR; PG8_SCHED;
            PG8_LDA(At, 1, 1); PG8_STAGE(PG8_SB(1, 0), b3, voffB); PG8_STAGE(PG8_SB(1, 1), b3 + hstep, voffB); PG8_STAGE(PG8_SA(1, 0), a3, voffA);
            PG8_WAIT_V(8); PG8_WAIT_L(0); PG8_BAR; PG8_MMA(1, 0, At, B0); PG8_MMA(1, 1, At, B1); PG8_BAR; PG8_SCHED;
            } else {
            PG8_LDB(B0, 0, 0); PG8_SCHED; PG8_LDA(At, 0, 0); PG8_STAGE(PG8_SA(1, 1), a1 + hstep, voffA);
            PG8_WAIT_L(8); PG8_BAR; PG8_WAIT_L(0); PG8_MMA(0, 0, At, B0); PG8_BAR; PG8_SCHED;
            PG8_LDB(B1, 0, 1); PG8_STAGE(PG8_SB(0, 0), b2, voffB);
            PG8_BAR; PG8_WAIT_L(0); PG8_MMA(0, 1, At, B1); PG8_BAR;
            PG8_LDA(At, 0, 1); PG8_STAGE(PG8_SA(0, 0), a2, voffA);
            PG8_BAR; PG8_WAIT_L(0); PG8_MMA(1, 0, At, B0); PG8_BAR; PG8_SCHED;
            PG8_STAGE(PG8_SB(0, 1), b2 + hstep, voffB);
            PG8_WAIT_V(6); PG8_BAR; PG8_MMA(1, 1, At, B1); PG8_BAR;
            PG8_LDB(B0, 1, 0); PG8_SCHED; PG8_LDA(At, 1, 0); PG8_STAGE(PG8_SA(0, 1), a2 + hstep, voffA);
            PG8_WAIT_L(8); PG8_BAR; PG8_WAIT_L(0); PG8_MMA(0, 0, At, B0); PG8_BAR; PG8_SCHED;
            PG8_LDB(B1, 1, 1); PG8_STAGE(PG8_SB(1, 0), b3, voffB);
            PG8_BAR; PG8_WAIT_L(0); PG8_MMA(0, 1, At, B1); PG8_BAR;
            PG8_LDA(At, 1, 1); PG8_STAGE(PG8_SA(1, 0), a3, voffA);
            PG8_BAR; PG8_WAIT_L(0); PG8_MMA(1, 0, At, B0); PG8_BAR; PG8_SCHED;
            PG8_STAGE(PG8_SB(1, 1), b3 + hstep, voffB);
            PG8_WAIT_V(6); PG8_BAR; PG8_MMA(1, 1, At, B1); PG8_BAR;
            }
        }
        if constexpr (ALIGN_EPI) { if (wr == 0) PG8_BAR; }
        if constexpr (!Epi::AFTER_DRAIN) { E(acc, cur, wr, wc, fr, fq); S.done(cur); }
        if (!has_next) break;
#pragma unroll
        for (int a = 0; a < 2; ++a)
#pragma unroll
            for (int b = 0; b < 2; ++b)
#pragma unroll
                for (int m = 0; m < 4; ++m)
#pragma unroll
                    for (int n = 0; n < 2; ++n) acc[a][b][m][n] = (f32x4){0.f, 0.f, 0.f, 0.f};
        cur = nxt; cA = nA; cB = nB; ++ui;
        PG8_LANE_STATE();
        if constexpr (ALIGN_EPI) { if (wr == 1) PG8_BAR; }
    }
    PG8_WAIT_V(0);
    if constexpr (!ALIGN_EPI) { if (wr == 0) PG8_BAR; }
    PG8_BAR;
    if constexpr (Epi::AFTER_DRAIN) { E.fused(acc, cur, wr, wc, fr, fq, lds, wid, lane); S.done(cur); }
#undef PG8_LANE_STATE
#undef PG8_SA
#undef PG8_SB
#undef PG8_STAGE
#undef PG8_LDA
#undef PG8_LDB
#undef PG8_MMA
#undef PG8_WAIT_V
#undef PG8_WAIT_L
#undef PG8_BAR
#undef PG8_SCHED
}

__device__ __forceinline__ unsigned cvt2(float lo, float hi) { typedef float f32x2_t __attribute__((ext_vector_type(2))); typedef __bf16 bf16x2_t __attribute__((ext_vector_type(2)));
    f32x2_t v = {lo, hi}; bf16x2_t b = __builtin_convertvector(v, bf16x2_t); return __builtin_bit_cast(unsigned, b); }
__device__ __forceinline__ u32x4 pack8(const f32x4& v0, const f32x4& v1) { u32x4 w; w.x = cvt2(v0[0], v0[1]); w.y = cvt2(v0[2], v0[3]); w.z = cvt2(v1[0], v1[1]); w.w = cvt2(v1[2], v1[3]); return w; }
__device__ __forceinline__ float rstdf(const float* rss, int row, float invk) { return 1.0f / sqrtf(rss[row] * invk + EPS); }

struct FEpiQKV {
    static constexpr bool PERM = true, AFTER_DRAIN = false;
    const float* rss; bf16_t* Q; const float* TA;
    __device__ __forceinline__ void operator()(const f32x4 (&acc)[2][2][4][2], const Unit& u, int wr, int wc, int, int) const { apply<false>(acc, u, wr, wc); }
    template <bool SK> __device__ __forceinline__ void apply(const f32x4 (&acc)[2][2][4][2], const Unit& u, int wr, int wc) const {
        constexpr int NAI = SK ? 1 : 2, NM = SK ? 1 : 4;
        int lane_e; asm volatile("v_mbcnt_lo_u32_b32 %0, -1, 0\n\tv_mbcnt_hi_u32_b32 %0, -1, %0" : "=v"(lane_e));
        const int fr = lane_e & 15, fq = lane_e >> 4;
        const int colt = u.pn * BM, t = colt >> 10;
        bf16_t* base = Q + (size_t)t * (ROWB1024 / 2) + (colt & 1023) + wc * 32 + 8 * fq;
        const bool rot = (t < 2) && ((wc & 1) == 0);
        const float sgn = fq == 0 ? -1.f : 1.f; const bool mine = fq < 2;
#pragma unroll
        for (int ai = 0; ai < NAI; ++ai)
#pragma unroll
            for (int m = 0; m < NM; ++m) {
                const int row = u.pm * BM + ai * HALF + wr * 64 + m * 16 + fr;
                const float rs = rstdf(rss, row, 1.0f / 1024.0f);
                f32x4 cs[4];
                if (rot) { const f32x4* tp = (const f32x4*)(TA + (size_t)row_pos(row) * 16);
#pragma unroll
                    for (int k = 0; k < 4; ++k) cs[k] = tp[k]; }
#pragma unroll
                for (int bj = 0; bj < 2; ++bj) {
                    f32x4 v0 = acc[ai][bj][m][0] * rs, v1 = acc[ai][bj][m][1] * rs;
                    if (rot) {
                        f32x4 r0, r1;
#pragma unroll
                        for (int e = 0; e < 4; ++e) { const float o0 = __shfl_xor(v0[e], 16), o1 = __shfl_xor(v1[e], 16);
                            r0[e] = v0[e] * cs[e >> 1][(e & 1) * 2] + sgn * o0 * cs[e >> 1][(e & 1) * 2 + 1];
                            r1[e] = v1[e] * cs[2 + (e >> 1)][(e & 1) * 2] + sgn * o1 * cs[2 + (e >> 1)][(e & 1) * 2 + 1]; }
                        if (mine) { v0 = r0; v1 = r1; }
                    }
                    *(u32x4*)(base + (size_t)row * 1024 + bj * HALF) = pack8(v0, v1);
                }
            }
    }
};
struct FEpiRes {
    static constexpr bool PERM = true, AFTER_DRAIN = false;
    const float* bin; const float* bin_meta; float* out; float* hmeta; bf16_t* HB; float* rss;
    __device__ __forceinline__ void operator()(const f32x4 (&acc)[2][2][4][2], const Unit& u, int wr, int wc, int, int) const { apply<false>(acc, u, wr, wc); }
    template <bool SK> __device__ __forceinline__ void apply(const f32x4 (&acc)[2][2][4][2], const Unit& u, int wr, int wc) const {
        constexpr int NAI = SK ? 1 : 2, NM = SK ? 1 : 4;
        int lane_e; asm volatile("v_mbcnt_lo_u32_b32 %0, -1, 0\n\tv_mbcnt_hi_u32_b32 %0, -1, %0" : "=v"(lane_e));
        const int fr = lane_e & 15, fq = lane_e >> 4;
        float* hb_ = u.pm < 64 ? out + (size_t)u.pm * BM * 1024 : hmeta; const float* rb_ = u.pm < 64 ? bin + (size_t)u.pm * BM * 1024 : bin_meta;
        const int col0 = u.pn * BM + wc * 32 + 8 * fq;
#pragma unroll
        for (int ai = 0; ai < NAI; ++ai)
#pragma unroll
            for (int m = 0; m < NM; ++m) {
                const int rl = ai * HALF + wr * 64 + m * 16 + fr, row = u.pm * BM + rl; float* hp = hb_ + (size_t)rl * 1024 + col0; const float* rp = rb_ + (size_t)rl * 1024 + col0;
                float ss = 0.f;
#pragma unroll
                for (int bj = 0; bj < 2; ++bj) {
                    const f32x4 h0 = *(const f32x4*)(rp + bj * HALF) + acc[ai][bj][m][0], h1 = *(const f32x4*)(rp + bj * HALF + 4) + acc[ai][bj][m][1];
                    *(f32x4*)(hp + bj * HALF) = h0; *(f32x4*)(hp + bj * HALF + 4) = h1;
                    ss += (h0[0] * h0[0] + h0[1] * h0[1]) + (h0[2] * h0[2] + h0[3] * h0[3]) + (h1[0] * h1[0] + h1[1] * h1[1]) + (h1[2] * h1[2] + h1[3] * h1[3]);
                    if (HB) *(u32x4*)(HB + (size_t)row * 1024 + col0 + bj * HALF) = pack8(h0, h1);
                    asm volatile("" ::: "memory");
                }
                ss += __shfl_xor(ss, 16); ss += __shfl_xor(ss, 32);
                if (fq == 0) atomicAdd(rss + row, ss);
                asm volatile("" ::: "memory");
            }
    }
};
struct FEpiFFN {
    static constexpr bool PERM = true, AFTER_DRAIN = false;
    const float* rss; const float* cw; const float* cb; bf16_t* G; float* SA; float* SB; PG8_LAS float* X;
    __device__ __forceinline__ void operator()(const f32x4 (&acc)[2][2][4][2], const Unit& u, int wr, int wc, int, int) const { apply<false>(acc, u, wr, wc); }
    template <bool SK> __device__ __forceinline__ void apply(const f32x4 (&acc)[2][2][4][2], const Unit& u, int wr, int wc) const {
        constexpr int NAI = SK ? 1 : 2, NM = SK ? 1 : 4;
        int lane_e; asm volatile("v_mbcnt_lo_u32_b32 %0, -1, 0\n\tv_mbcnt_hi_u32_b32 %0, -1, %0" : "=v"(lane_e));
        const int fr = lane_e & 15, fq = lane_e >> 4;
        const int lane = fr + 16 * fq;
        const int cc0 = u.pn * HALF + wc * 32 + 8 * fq;
        f32x4 w0[2], w1[2], w2[2], bs[2];
#pragma unroll
        for (int n = 0; n < 2; ++n) { w0[n] = *(const f32x4*)(cw + cc0 + 4 * n); w1[n] = *(const f32x4*)(cw + DFF + cc0 + 4 * n); w2[n] = *(const f32x4*)(cw + 2 * DFF + cc0 + 4 * n); bs[n] = *(const f32x4*)(cb + cc0 + 4 * n); }
        if (!SK) {
#pragma unroll
            for (int ai = 0; ai < 2; ++ai) { const int row = u.pm * BM + ai * HALF + wr * 64 + 48 + fr; const float rsl = rstdf(rss, row, 1.0f / 1024.0f);
                if (fr >= 14) { PG8_LAS float* xp = X + (((2 * ai + wr) * 4 + wc) * 2 + (fr - 14)) * 32 + 8 * fq;
                    *(PG8_LAS f32x4*)xp = acc[ai][0][3][0] * rsl; *(PG8_LAS f32x4*)(xp + 4) = acc[ai][0][3][1] * rsl; } }
            asm volatile("s_waitcnt lgkmcnt(0)" ::: "memory"); __builtin_amdgcn_s_barrier(); asm volatile("" ::: "memory");
        }
        const int src1 = (lane & 48) | ((fr - 1) & 15), src2 = (lane & 48) | ((fr - 2) & 15);
#pragma unroll
        for (int ai = 0; ai < NAI; ++ai) {
            const int strip = 2 * ai + wr;
            f32x4 pa[2] = {(f32x4){0.f, 0.f, 0.f, 0.f}, (f32x4){0.f, 0.f, 0.f, 0.f}};
#pragma unroll
            for (int m = 0; m < NM; ++m) {
                const int rl = ai * HALF + wr * 64 + m * 16 + fr, row = u.pm * BM + rl;
                const float rs = rstdf(rss, row, 1.0f / 1024.0f);
                f32x4 a[2], b[2], p1[2], p2[2];
#pragma unroll
                for (int n = 0; n < 2; ++n) { a[n] = acc[ai][0][m][n] * rs; b[n] = acc[ai][1][m][n] * rs; }
#pragma unroll
                for (int n = 0; n < 2; ++n)
#pragma unroll
                    for (int e = 0; e < 4; ++e) { const float s1 = (m > 0 && fr == 15) ? pa[n][e] : a[n][e], s2 = (m > 0 && fr >= 14) ? pa[n][e] : a[n][e];
                        p1[n][e] = __shfl(s1, src1); p2[n][e] = __shfl(s2, src2); }
                if (m == 0 && strip > 0) {
                    const PG8_LAS float* xp = X + (((strip - 1) * 4 + wc) * 2) * 32 + 8 * fq;
#pragma unroll
                    for (int n = 0; n < 2; ++n) { const f32x4 h62 = *(const PG8_LAS f32x4*)(xp + 4 * n), h63 = *(const PG8_LAS f32x4*)(xp + 32 + 4 * n);
                        if (fr == 0) { p1[n] = h63; p2[n] = h62; } else if (fr == 1) { p2[n] = h63; } }
                }
                f32x4 g[2];
#pragma unroll
                for (int n = 0; n < 2; ++n)
#pragma unroll
                    for (int e = 0; e < 4; ++e) { const float ac = bs[n][e] + w0[n][e] * p2[n][e] + w1[n][e] * p1[n][e] + w2[n][e] * a[n][e];
                        g[n][e] = ac * __builtin_amdgcn_rcpf(1.0f + __builtin_amdgcn_exp2f(-LOG2E * ac)) * b[n][e]; }
                const bool head = (strip == 0 && m == 0 && fr < 2);
                if (!head) *(u32x4*)(G + (size_t)row * DFF + cc0) = pack8(g[0], g[1]);
                else { float* sa = SA + ((size_t)u.pm * 4 + fr) * DFF + cc0; float* sb = SB + ((size_t)u.pm * 2 + fr) * DFF + cc0;
                    *(f32x4*)sa = a[0]; *(f32x4*)(sa + 4) = a[1]; *(f32x4*)sb = b[0]; *(f32x4*)(sb + 4) = b[1]; }
                const bool tail = (u.pm < 64) ? (strip == 3 && m == 3 && fr >= 14) : (strip == 0 && m == 0 && fr >= 14);
                if (tail) { float* sa = SA + ((size_t)u.pm * 4 + 2 + (fr - 14)) * DFF + cc0; *(f32x4*)sa = a[0]; *(f32x4*)(sa + 4) = a[1]; }
                pa[0] = a[0]; pa[1] = a[1];
            }
        }
    }
};
__device__ __forceinline__ void rope32(f32x4& v0, f32x4& v1, const float* TB, int pos, int fq) {
    const f32x4* tp = (const f32x4*)(TB + (size_t)pos * 32 + 16 * (fq & 1)); const float sgn = fq < 2 ? -1.f : 1.f;
    f32x4 cs[4];
#pragma unroll
    for (int k = 0; k < 4; ++k) cs[k] = tp[k];
#pragma unroll
    for (int e = 0; e < 4; ++e) { const float o0 = __shfl_xor(v0[e], 32), o1 = __shfl_xor(v1[e], 32);
        v0[e] = v0[e] * cs[e >> 1][(e & 1) * 2] + sgn * o0 * cs[e >> 1][(e & 1) * 2 + 1];
        v1[e] = v1[e] * cs[2 + (e >> 1)][(e & 1) * 2] + sgn * o1 * cs[2 + (e >> 1)][(e & 1) * 2 + 1]; }
}
struct FEpiD {
    static constexpr bool PERM = true, AFTER_DRAIN = false;
    const float* rss; bf16_t* CQ; bf16_t* CKV; bf16_t* KR; float* rssq; float* rsskv; const float* TB;
    __device__ __forceinline__ void operator()(const f32x4 (&acc)[2][2][4][2], const Unit& u, int wr, int wc, int, int) const { apply<false>(acc, u, wr, wc); }
    template <bool SK> __device__ __forceinline__ void apply(const f32x4 (&acc)[2][2][4][2], const Unit& u, int wr, int wc) const {
        constexpr int NAI = SK ? 1 : 2, NM = SK ? 1 : 4;
        int lane_e; asm volatile("v_mbcnt_lo_u32_b32 %0, -1, 0\n\tv_mbcnt_hi_u32_b32 %0, -1, %0" : "=v"(lane_e));
        const int fr = lane_e & 15, fq = lane_e >> 4;
#pragma unroll
        for (int ai = 0; ai < NAI; ++ai)
#pragma unroll
            for (int m = 0; m < NM; ++m) {
                const int row = u.pm * BM + ai * HALF + wr * 64 + m * 16 + fr; const float rs = rstdf(rss, row, 1.0f / 1024.0f);
                float sq = 0.f, skv = 0.f;
#pragma unroll
                for (int bj = 0; bj < 2; ++bj) {
                    const int g128 = u.pn * 2 + bj, c = wc * 32 + 8 * fq;
                    f32x4 v0 = acc[ai][bj][m][0] * rs, v1 = acc[ai][bj][m][1] * rs;
                    const float s = (v0[0] * v0[0] + v0[1] * v0[1]) + (v0[2] * v0[2] + v0[3] * v0[3]) + (v1[0] * v1[0] + v1[1] * v1[1]) + (v1[2] * v1[2] + v1[3] * v1[3]);
                    if (g128 < 3) { sq += s; *(u32x4*)(CQ + (size_t)row * 384 + g128 * 128 + c) = pack8(v0, v1); }
                    else if (g128 < 5) { skv += s; *(u32x4*)(CKV + (size_t)row * 256 + (g128 - 3) * 128 + c) = pack8(v0, v1); }
                    else if (wc == 0) { rope32(v0, v1, TB, row_pos(row), fq); *(u32x4*)(KR + (size_t)row * 32 + c) = pack8(v0, v1); }
                }
                if (u.pn < 2) { sq += __shfl_xor(sq, 16); sq += __shfl_xor(sq, 32); if (fq == 0) atomicAdd(rssq + row, sq); }
                if (u.pn > 0) { skv += __shfl_xor(skv, 16); skv += __shfl_xor(skv, 32); if (fq == 0) atomicAdd(rsskv + row, skv); }
            }
    }
};
template <bool ROPE> struct FEpiUp {
    static constexpr bool PERM = true, AFTER_DRAIN = false;
    const float* rss; float invk; bf16_t* O; int ldo; const float* TB;
    __device__ __forceinline__ void operator()(const f32x4 (&acc)[2][2][4][2], const Unit& u, int wr, int wc, int, int) const { apply<false>(acc, u, wr, wc); }
    template <bool SK> __device__ __forceinline__ void apply(const f32x4 (&acc)[2][2][4][2], const Unit& u, int wr, int wc) const {
        constexpr int NAI = SK ? 1 : 2, NM = SK ? 1 : 4;
        int lane_e; asm volatile("v_mbcnt_lo_u32_b32 %0, -1, 0\n\tv_mbcnt_hi_u32_b32 %0, -1, %0" : "=v"(lane_e));
        const int fr = lane_e & 15, fq = lane_e >> 4;
#pragma unroll
        for (int ai = 0; ai < NAI; ++ai)
#pragma unroll
            for (int m = 0; m < NM; ++m) {
                const int row = u.pm * BM + ai * HALF + wr * 64 + m * 16 + fr; const float rs = rstdf(rss, row, invk);
#pragma unroll
                for (int bj = 0; bj < 2; ++bj) {
                    f32x4 v0 = acc[ai][bj][m][0] * rs, v1 = acc[ai][bj][m][1] * rs;
                    if (ROPE) { const int g32 = 8 * u.pn + 4 * bj + wc; if (g32 % 3 == 2) rope32(v0, v1, TB, row_pos(row), fq); }
                    *(u32x4*)(O + (size_t)row * ldo + u.pn * BM + bj * HALF + wc * 32 + 8 * fq) = pack8(v0, v1);
                    asm volatile("" ::: "memory");
                }
            }
    }
};

template <class Epi>
__device__ __forceinline__ void skinny_gemm(PG8_LAS unsigned char* lds, const bf16_t* A, const bf16_t* Bt, int N, int K, const Epi& E, int vcu, int G, int wave, int lane) {
    const int njobs = (N / BM) * 4, fr = lane & 15, fq = lane >> 4, nks = K / 32;
    for (int j = vcu; j < njobs; j += G) {
        const int pn = j >> 2, wc = j & 3;
        f32x4 pacc[2][2];
#pragma unroll
        for (int bj = 0; bj < 2; ++bj)
#pragma unroll
            for (int n = 0; n < 2; ++n) pacc[bj][n] = (f32x4){0.f, 0.f, 0.f, 0.f};
        const bf16_t* ap = A + (size_t)(64 * BM + fr) * K + 8 * fq;
        const bf16_t* bp[2][2];
#pragma unroll
        for (int bj = 0; bj < 2; ++bj)
#pragma unroll
            for (int n = 0; n < 2; ++n) bp[bj][n] = Bt + (size_t)(pn * BM + bj * HALF + wc * 32 + perm32(16 * n + fr)) * K + 8 * fq;
#pragma nounroll
        for (int ks0 = wave * 4; ks0 < nks; ks0 += 32) {
            bf16x8 a[4], b[4][2][2];
#pragma unroll
            for (int s = 0; s < 4; ++s) { a[s] = *(const bf16x8*)(ap + (ks0 + s) * 32);
#pragma unroll
                for (int bj = 0; bj < 2; ++bj)
#pragma unroll
                    for (int n = 0; n < 2; ++n) b[s][bj][n] = *(const bf16x8*)(bp[bj][n] + (ks0 + s) * 32); }
#pragma unroll
            for (int s = 0; s < 4; ++s)
#pragma unroll
                for (int bj = 0; bj < 2; ++bj)
#pragma unroll
                    for (int n = 0; n < 2; ++n) pacc[bj][n] = __builtin_amdgcn_mfma_f32_16x16x32_bf16(b[s][bj][n], a[s], pacc[bj][n], 0, 0, 0);
        }
        PG8_LAS f32x4* P = (PG8_LAS f32x4*)lds + (wave * 64 + lane) * 4;
        P[0] = pacc[0][0]; P[1] = pacc[0][1]; P[2] = pacc[1][0]; P[3] = pacc[1][1];
        __syncthreads();
        if (wave == 0) {
            f32x4 acc[2][2][4][2];
#pragma unroll
            for (int w = 1; w < 8; ++w) { const PG8_LAS f32x4* Q = (const PG8_LAS f32x4*)lds + (w * 64 + lane) * 4;
                pacc[0][0] += Q[0]; pacc[0][1] += Q[1]; pacc[1][0] += Q[2]; pacc[1][1] += Q[3]; }
            acc[0][0][0][0] = pacc[0][0]; acc[0][0][0][1] = pacc[0][1]; acc[0][1][0][0] = pacc[1][0]; acc[0][1][0][1] = pacc[1][1];
            Unit u; u.pm = 64; u.pn = pn;
            E.template apply<true>(acc, u, 0, wc);
        }
        __syncthreads();
    }
}
}

template <int MASK> __device__ __forceinline__ float swz_xor(float v) { return __shfl_xor(v, MASK); }
__device__ __forceinline__ float half_max(float v) { return fmaxf(v, __shfl_xor(v, 32)); }
__device__ __forceinline__ float half_sum(float v) { return v + __shfl_xor(v, 32); }
__device__ __forceinline__ s16x4 vtr(const LAS unsigned char* p) { typedef short v4i16_t __attribute__((ext_vector_type(4)));
    return __builtin_bit_cast(s16x4, __builtin_amdgcn_ds_read_tr16_b64_v4i16((LAS v4i16_t*)p)); }
__device__ __forceinline__ unsigned cvtpk(float lo, float hi) { typedef float f32x2_t __attribute__((ext_vector_type(2))); typedef __bf16 bf16x2_t __attribute__((ext_vector_type(2)));
    f32x2_t v = {lo, hi}; bf16x2_t b = __builtin_convertvector(v, bf16x2_t); return __builtin_bit_cast(unsigned, b); }

struct SrcA { const bf16_t* K; const bf16_t* V; int h, s;
    __device__ __forceinline__ const bf16_t* kptr(int krow, int ch) const { return K + (size_t)krow * 1024 + h * 128 + s * 64 + ch * 8; }
    __device__ __forceinline__ const bf16_t* vptr(int krow, int ch) const { return V + (size_t)krow * 1024 + h * 128 + ch * 8; }
    __device__ __forceinline__ unsigned kstep(int) const { return 64u * 1024u * 2u; }
    __device__ __forceinline__ unsigned vstep() const { return 64u * 1024u * 2u; } };
struct SrcB { const bf16_t* KV; const bf16_t* KR; int h;
    __device__ __forceinline__ const bf16_t* kptr(int krow, int ch) const { return ch < 8 ? KV + (size_t)krow * 2048 + h * 128 + ch * 8 : KR + (size_t)krow * 32 + (ch - 8) * 8; }
    __device__ __forceinline__ const bf16_t* vptr(int krow, int ch) const { return KV + (size_t)krow * 2048 + h * 128 + 64 + ch * 8; }
    __device__ __forceinline__ unsigned kstep(int ch) const { return ch < 8 ? 64u * 2048u * 2u : 64u * 32u * 2u; }
    __device__ __forceinline__ unsigned vstep() const { return 64u * 2048u * 2u; } };

template <int DQK, int DV> struct ACfg { static constexpr int KS = DQK * 2 + 16, VS = DV * 2 + 64, KOFF = 0, VOFF = 64 * KS, SCR = VOFF + 64 * VS,
    SCRATCH = 2 * SCR  , STG = SCRATCH + 2048  , END = STG + 8 * 32 * DV * 2; };
constexpr float ATT_THR = 8.0f;

template <int DQK, int DV, bool META>
__device__ __forceinline__ void attn_tile(const LAS unsigned char* Kt, const LAS unsigned char* Vt, LAS float* scr, const bf16x8 (&qf)[DQK / 16], f32x16 (&o)[DV / 32], float& m, float& lsum, int lane) {
    constexpr int KS = ACfg<DQK, DV>::KS, VS = ACfg<DQK, DV>::VS;
    const int r32 = lane & 31, hi = lane >> 5;
    f32x16 p0, p1; const f32x16 zero16 = {0.f, 0.f, 0.f, 0.f, 0.f, 0.f, 0.f, 0.f, 0.f, 0.f, 0.f, 0.f, 0.f, 0.f, 0.f, 0.f};
#pragma unroll
    for (int kk = 0; kk < DQK / 16; ++kk) {
        const bf16x8 k0 = *(const LAS bf16x8*)(Kt + r32 * KS + (16 * kk + 8 * hi) * 2);
        p0 = __builtin_amdgcn_mfma_f32_32x32x16_bf16(k0, qf[kk], kk == 0 ? zero16 : p0, 0, 0, 0);
        if (!META) { const bf16x8 k1 = *(const LAS bf16x8*)(Kt + (32 + r32) * KS + (16 * kk + 8 * hi) * 2);
            p1 = __builtin_amdgcn_mfma_f32_32x32x16_bf16(k1, qf[kk], kk == 0 ? zero16 : p1, 0, 0, 0); }
        if (kk & 1) __builtin_amdgcn_sched_barrier(0);
    }
    const LAS unsigned char* vb = Vt + (4 * hi + ((lane & 15) >> 2)) * VS + (16 * ((lane >> 4) & 1) + 4 * (lane & 3)) * 2;
    s16x4 vlo[DV / 32], vhi[DV / 32];
#pragma unroll
    for (int d0 = 0; d0 < DV / 32; ++d0) { vlo[d0] = vtr(vb + 64 * d0); vhi[d0] = vtr(vb + 8 * VS + 64 * d0); }
    __builtin_amdgcn_sched_barrier(0);
    float mx;
    if (META) { mx = fmaxf(fmaxf(p0[0], p0[1]), p0[2]);
#pragma unroll
        for (int r = 3; r < 8; ++r) mx = fmaxf(mx, p0[r]);
    } else { float a = fmaxf(fmaxf(p0[0], p0[1]), p1[0]), bq = fmaxf(fmaxf(p0[2], p0[3]), p1[1]); a = fmaxf(fmaxf(a, p1[2]), p1[3]);
#pragma unroll
        for (int r = 4; r < 16; r += 4) { a = fmaxf(fmaxf(a, p0[r]), p0[r + 1]); bq = fmaxf(fmaxf(bq, p0[r + 2]), p0[r + 3]); a = fmaxf(fmaxf(a, p1[r]), p1[r + 1]); bq = fmaxf(fmaxf(bq, p1[r + 2]), p1[r + 3]); }
        mx = fmaxf(a, bq); }
    mx = half_max(mx) - m;
    if (META || __any(mx > ATT_THR)) {
        const float dl = META ? mx : fmaxf(mx, 0.f);
        m += dl;
        if (!META) {
            const float f = __builtin_amdgcn_exp2f(-dl); lsum *= f;
            if (hi == 0) scr[r32] = f;
            asm volatile("s_waitcnt lgkmcnt(0)" ::: "memory");
#pragma unroll
            for (int r = 0; r < 16; ++r) { const float a = scr[crow(r, hi)];
#pragma unroll
                for (int d0 = 0; d0 < DV / 32; ++d0) o[d0][r] *= a; }
        }
    }
    float ps = 0.f;
    if (META) {
#pragma unroll
        for (int r = 0; r < 8; ++r) { p0[r] = __builtin_amdgcn_exp2f(p0[r] - m); ps += p0[r]; }
    } else {
#pragma unroll
        for (int r = 0; r < 16; ++r) { p0[r] = __builtin_amdgcn_exp2f(p0[r] - m); p1[r] = __builtin_amdgcn_exp2f(p1[r] - m); ps += p0[r] + p1[r]; }
    }
    lsum += ps;
    bf16x8 pa[4];
    { u32x4 w; w.x = cvtpk(p0[0], p0[1]); w.y = cvtpk(p0[2], p0[3]); w.z = cvtpk(p0[4], p0[5]); w.w = cvtpk(p0[6], p0[7]); pa[0] = __builtin_bit_cast(bf16x8, w); }
    if (!META) {
        { u32x4 w; w.x = cvtpk(p0[8], p0[9]); w.y = cvtpk(p0[10], p0[11]); w.z = cvtpk(p0[12], p0[13]); w.w = cvtpk(p0[14], p0[15]); pa[1] = __builtin_bit_cast(bf16x8, w); }
        { u32x4 w; w.x = cvtpk(p1[0], p1[1]); w.y = cvtpk(p1[2], p1[3]); w.z = cvtpk(p1[4], p1[5]); w.w = cvtpk(p1[6], p1[7]); pa[2] = __builtin_bit_cast(bf16x8, w); }
        { u32x4 w; w.x = cvtpk(p1[8], p1[9]); w.y = cvtpk(p1[10], p1[11]); w.z = cvtpk(p1[12], p1[13]); w.w = cvtpk(p1[14], p1[15]); pa[3] = __builtin_bit_cast(bf16x8, w); }
    }
    __builtin_amdgcn_sched_barrier(0);
#pragma unroll
    for (int ks = 0; ks < (META ? 1 : 4); ++ks) {
        s16x4 nlo[DV / 32], nhi[DV / 32];
        if (ks + 1 < (META ? 1 : 4)) {
#pragma unroll
            for (int d0 = 0; d0 < DV / 32; ++d0) { nlo[d0] = vtr(vb + (16 * (ks + 1)) * VS + 64 * d0); nhi[d0] = vtr(vb + (16 * (ks + 1) + 8) * VS + 64 * d0); }
        }
        __builtin_amdgcn_s_setprio(1);
#pragma unroll
        for (int d0 = 0; d0 < DV / 32; ++d0) { const bf16x8 vf = (bf16x8){vlo[d0][0], vlo[d0][1], vlo[d0][2], vlo[d0][3], vhi[d0][0], vhi[d0][1], vhi[d0][2], vhi[d0][3]};
            o[d0] = __builtin_amdgcn_mfma_f32_32x32x16_bf16(pa[ks], vf, o[d0], 0, 0, 0); }
        __builtin_amdgcn_s_setprio(0);
        if (ks + 1 < (META ? 1 : 4)) {
#pragma unroll
            for (int d0 = 0; d0 < DV / 32; ++d0) { vlo[d0] = nlo[d0]; vhi[d0] = nhi[d0]; }
        }
        __builtin_amdgcn_sched_barrier(0);
    }
}

template <int DQK, int DV, class Src>
__device__ __forceinline__ void attn_pass(const Ctx& c, const Src& src, int b, int qb, const bf16x8 (&qf)[DQK / 16], f32x16 (&o)[DV / 32]) {
    typedef ACfg<DQK, DV> C;
    constexpr int KCH = DQK / 8, VCH = DV / 8;
    constexpr int NKL = (64 * KCH + NTHREADS - 1) / NTHREADS, NVL = (64 * VCH + NTHREADS - 1) / NTHREADS;
    LAS float* scr = (LAS float*)(c.lds + C::SCRATCH) + c.wave * 64;
    const int hi = c.lane >> 5, r32 = c.lane & 31;
    float m = 0.f, lsum = 0.f;
#pragma unroll
    for (int d0 = 0; d0 < DV / 32; ++d0)
#pragma unroll
        for (int r = 0; r < 16; ++r) o[d0][r] = 0.f;
    const int NT = qb < 0 ? 0 : 4 * (qb + 1);
    const int myc = qb < 0 ? -1 : 4 * qb + (c.wave >> 1);
    const bool active = qb >= 0 || c.wave == 0;
    u32x4 kreg[NKL], vreg[NVL];
    {
        int tl_ = c.tid; asm volatile("" : "+v"(tl_));
#pragma unroll
        for (int i_ = 0; i_ < NKL; ++i_) { const int idx_ = tl_ + i_ * NTHREADS; const int key_ = min(idx_ / KCH, 31), ch_ = idx_ % KCH; kreg[i_] = *(const u32x4*)src.kptr(RR + key_, ch_); }
#pragma unroll
        for (int i_ = 0; i_ < NVL; ++i_) { const int idx_ = tl_ + i_ * NTHREADS; const int key_ = min(idx_ / VCH, 15), ch_ = idx_ % VCH; vreg[i_] = *(const u32x4*)src.vptr(RR + key_, ch_); }
#pragma unroll
        for (int i_ = 0; i_ < NKL; ++i_) { const int idx_ = tl_ + i_ * NTHREADS; const int key_ = min(idx_ / KCH, 31), ch_ = idx_ % KCH; *(LAS u32x4*)(c.lds + C::KOFF + key_ * C::KS + ch_ * 16) = kreg[i_]; }
#pragma unroll
        for (int i_ = 0; i_ < NVL; ++i_) { const int idx_ = tl_ + i_ * NTHREADS; const int key_ = min(idx_ / VCH, 15), ch_ = idx_ % VCH; *(LAS u32x4*)(c.lds + C::VOFF + key_ * C::VS + ch_ * 16) = vreg[i_]; }
    }
    const char* kp[NKL]; const char* vp[NVL]; unsigned kst[NKL], klds[NKL], vlds[NVL]; const unsigned vst = src.vstep();
    {
        int tl_ = c.tid; asm volatile("" : "+v"(tl_));
#pragma unroll
        for (int i_ = 0; i_ < NKL; ++i_) { const int idx_ = tl_ + i_ * NTHREADS; const int key_ = min(idx_ / KCH, 63), ch_ = idx_ % KCH;
            kp[i_] = (const char*)src.kptr(b * SEQ + key_, ch_); kst[i_] = src.kstep(ch_); klds[i_] = (unsigned)(C::KOFF + key_ * C::KS + ch_ * 16); }
#pragma unroll
        for (int i_ = 0; i_ < NVL; ++i_) { const int idx_ = tl_ + i_ * NTHREADS; const int key_ = min(idx_ / VCH, 63), ch_ = idx_ % VCH;
            vp[i_] = (const char*)src.vptr(b * SEQ + key_, ch_); vlds[i_] = (unsigned)(C::VOFF + key_ * C::VS + ch_ * 16); }
    }
    __syncthreads();
#define ATT_PREFETCH() do { _Pragma("unroll") for (int i_ = 0; i_ < NKL; ++i_) { kreg[i_] = *(const u32x4*)kp[i_]; kp[i_] += kst[i_]; } \
        _Pragma("unroll") for (int i_ = 0; i_ < NVL; ++i_) { vreg[i_] = *(const u32x4*)vp[i_]; vp[i_] += vst; } } while (0)
#define ATT_COMMIT(buf_) do { LAS unsigned char* nb_ = c.lds + (buf_) * C::SCR; \
        _Pragma("unroll") for (int i_ = 0; i_ < NKL; ++i_) *(LAS u32x4*)(nb_ + klds[i_]) = kreg[i_]; \
        _Pragma("unroll") for (int i_ = 0; i_ < NVL; ++i_) *(LAS u32x4*)(nb_ + vlds[i_]) = vreg[i_]; } while (0)
    if (NT > 0) ATT_PREFETCH();
    attn_tile<DQK, DV, true>(c.lds + C::KOFF, c.lds + C::VOFF, scr, qf, o, m, lsum, c.lane);
    if (NT > 0) ATT_COMMIT(1);
    __syncthreads();
    const int nfull = NT > 0 ? NT - 3 : 0;
#pragma nounroll
    for (int jt = 0; jt < nfull; ++jt) {
        const int cur = (jt + 1) & 1;
        ATT_PREFETCH();
        attn_tile<DQK, DV, false>(c.lds + cur * C::SCR + C::KOFF, c.lds + cur * C::SCR + C::VOFF, scr, qf, o, m, lsum, c.lane);
        ATT_COMMIT(cur ^ 1);
        __syncthreads();
    }
#pragma nounroll
    for (int jt = nfull; jt < NT; ++jt) {
        const int cur = (jt + 1) & 1;
        if (jt + 1 < NT) ATT_PREFETCH();
        if (jt <= myc) attn_tile<DQK, DV, false>(c.lds + cur * C::SCR + C::KOFF, c.lds + cur * C::SCR + C::VOFF, scr, qf, o, m, lsum, c.lane);
        if (jt + 1 < NT) ATT_COMMIT(cur ^ 1);
        __syncthreads();
    }
#undef ATT_PREFETCH
#undef ATT_COMMIT
    const float lt = half_sum(lsum);
    if (hi == 0) scr[32 + r32] = 1.0f / lt;
    asm volatile("s_waitcnt lgkmcnt(0)" ::: "memory");
#pragma unroll
    for (int r = 0; r < 16; ++r) { const float a = scr[32 + crow(r, hi)];
#pragma unroll
        for (int d0 = 0; d0 < DV / 32; ++d0) o[d0][r] *= a; }
}

__device__ __forceinline__ void attn_unit_a(const Params& p, const Ctx& c, int b, int h, int qb, float lam, bf16_t* Odst) {
    typedef ACfg<64, 128> C;
    int ln_ = c.lane; asm volatile("" : "+v"(ln_));
    const int q0 = qb < 0 ? RR : b * SEQ + 256 * qb; const int hi = ln_ >> 5, r32 = ln_ & 31;
    bf16_t* Qb = (bf16_t*)(p.ws + WS_Q);
    LAS bf16_t* stg = (LAS bf16_t*)(c.lds + C::STG) + c.wave * (32 * 128);
    const bool active = qb >= 0 || c.wave == 0;
    f32x16 o[4];
#pragma nounroll
    for (int s = 0; s < 2; ++s) {
        int lq_ = c.lane; asm volatile("" : "+v"(lq_));
        const bf16_t* qrow = Qb + (size_t)(q0 + 32 * c.wave + (lq_ & 31)) * 1024 + h * 128 + s * 64;
        bf16x8 qf[4];
#pragma unroll
        for (int kk = 0; kk < 4; ++kk) qf[kk] = *(const bf16x8*)(qrow + 16 * kk + 8 * hi);
        SrcA src{(const bf16_t*)(p.ws + WS_K), (const bf16_t*)(p.ws + WS_V), h, s};
        attn_pass<64, 128, SrcA>(c, src, b, qb, qf, o);
        if (s == 0) {
#pragma unroll
            for (int r = 0; r < 16; ++r) { LAS bf16_t* sp = stg + crow(r, hi) * 128 + r32;
                sp[0] = (bf16_t)f2bf(o[0][r]); sp[32] = (bf16_t)f2bf(o[1][r]); sp[64] = (bf16_t)f2bf(o[2][r]); sp[96] = (bf16_t)f2bf(o[3][r]); }
        }
    }
#pragma unroll
    for (int r = 0; r < 16; ++r) {
        LAS bf16_t* sp = stg + crow(r, hi) * 128 + r32;
        const float v0 = bf2f(sp[0]) - lam * o[0][r], v1 = bf2f(sp[32]) - lam * o[1][r], v2 = bf2f(sp[64]) - lam * o[2][r], v3 = bf2f(sp[96]) - lam * o[3][r];
        float ss = v0 * v0 + v1 * v1 + v2 * v2 + v3 * v3;
        ss += swz_xor<1>(ss); ss += swz_xor<2>(ss); ss += swz_xor<4>(ss); ss += swz_xor<8>(ss); ss += swz_xor<16>(ss);
        const float rs = 1.0f / sqrtf(ss * (1.0f / 128.0f) + EPS);
        sp[0] = (bf16_t)f2bf(v0 * rs); sp[32] = (bf16_t)f2bf(v1 * rs); sp[64] = (bf16_t)f2bf(v2 * rs); sp[96] = (bf16_t)f2bf(v3 * rs);
    }
    asm volatile("s_waitcnt lgkmcnt(0)" ::: "memory");
    if (!active) return;
    int rb = q0 + 32 * c.wave; asm volatile("" : "+s"(rb));
    int ls_ = c.lane; asm volatile("" : "+v"(ls_));
#pragma unroll
    for (int i = 0; i < 8; ++i) { const int row = 4 * i + (ls_ >> 4), ch = ls_ & 15;
        const u32x4 v = *(const LAS u32x4*)(stg + row * 128 + ch * 8);
        *(u32x4*)(Odst + (size_t)(rb + row) * 1024 + h * 128 + ch * 8) = v; }
}
__device__ __forceinline__ void ph_attn_a(const Params& p, const Ctx& c, bool dummy) {
    bf16_t* Odst = (bf16_t*)(p.ws + (dummy ? WS_OB2 : WS_Q));
    float d1 = 0.f, d2 = 0.f;
    for (int k = 0; k < 64; ++k) { d1 += p.in[I_LQ1][k] * p.in[I_LK1][k]; d2 += p.in[I_LQ2][k] * p.in[I_LK2][k]; }
    const float lamv = expf(d1) - expf(d2) + LAM_INIT;
    const int lami = __builtin_amdgcn_readfirstlane(__builtin_bit_cast(int, lamv));
    const float lam = __builtin_bit_cast(float, lami);
#pragma nounroll
    for (int pi = c.vcu; pi < 256 + 8; pi += c.G) {
        const int nsub = pi < 256 ? 2 : 1;
#pragma nounroll
        for (int sub = 0; sub < nsub; ++sub) {
            int b, h, qb;
            if (pi < 256) { const int bh = pi >> 2, s = pi & 3; b = bh >> 3; h = bh & 7; qb = sub ? 7 - s : s; } else { b = 0; h = pi - 256; qb = -1; }
            attn_unit_a(p, c, b, h, qb, lam, Odst);
        }
    }
}
__device__ __forceinline__ void attn_unit_b(const Params& p, const Ctx& c, int b, int h, int qb) {
    typedef ACfg<96, 64> C;
    int ln_ = c.lane; asm volatile("" : "+v"(ln_));
    const int q0 = qb < 0 ? RR : b * SEQ + 256 * qb; const int hi = ln_ >> 5, r32 = ln_ & 31;
    const bf16_t* qrow = (const bf16_t*)(p.ws + WS_Q2) + (size_t)(q0 + 32 * c.wave + r32) * 1536 + h * 96;
    LAS bf16_t* stg = (LAS bf16_t*)(c.lds + C::STG) + c.wave * (32 * 64);
    bf16x8 qf[6];
#pragma unroll
    for (int kk = 0; kk < 6; ++kk) qf[kk] = *(const bf16x8*)(qrow + 16 * kk + 8 * hi);
    f32x16 o[2];
    SrcB src{(const bf16_t*)(p.ws + WS_KV2), (const bf16_t*)(p.ws + WS_KR), h};
    attn_pass<96, 64, SrcB>(c, src, b, qb, qf, o);
#pragma unroll
    for (int r = 0; r < 16; ++r) { LAS bf16_t* sp = stg + crow(r, hi) * 64 + r32; sp[0] = (bf16_t)f2bf(o[0][r]); sp[32] = (bf16_t)f2bf(o[1][r]); }
    asm volatile("s_waitcnt lgkmcnt(0)" ::: "memory");
    const bool active = qb >= 0 || c.wave == 0;
    if (!active) return;
    bf16_t* Ob = (bf16_t*)(p.ws + WS_OB2);
    int rb = q0 + 32 * c.wave; asm volatile("" : "+s"(rb));
    int ls_ = c.lane; asm volatile("" : "+v"(ls_));
#pragma unroll
    for (int i = 0; i < 4; ++i) { const int row = 8 * i + (ls_ >> 3), ch = ls_ & 7;
        const u32x4 v = *(const LAS u32x4*)(stg + row * 64 + ch * 8);
        *(u32x4*)(Ob + (size_t)(rb + row) * 1024 + h * 64 + ch * 8) = v; }
}
__device__ __forceinline__ void ph_attn_b(const Params& p, const Ctx& c) {
#pragma nounroll
    for (int pi = c.vcu; pi < 512 + 16; pi += c.G) {
        const int nsub = pi < 512 ? 2 : 1;
#pragma nounroll
        for (int sub = 0; sub < nsub; ++sub) {
            int b, h, qb;
            if (pi < 512) { const int bh = pi >> 2, s = pi & 3; b = bh >> 4; h = bh & 15; qb = sub ? 7 - s : s; } else { b = 0; h = pi - 512; qb = -1; }
            attn_unit_b(p, c, b, h, qb);
        }
    }
}

__device__ __forceinline__ void ph_ffn_fix(const Params& p, const Ctx& c, int layer) {
    const float* SA = (const float*)(p.ws + WS_SA); const float* SB = (const float*)(p.ws + WS_SB); bf16_t* G = (bf16_t*)(p.ws + WS_G);
    const float* cw = p.in[I_FFN_CW] + (size_t)layer * 3 * DFF; const float* cb = p.in[I_FFN_CB] + (size_t)layer * DFF;
    const int gt = c.gw * 64 + c.lane, ngt = c.ngw * 64;
    for (int i = gt; i < 65 * DFF; i += ngt) {
        const int pm = i / DFF, col = i - pm * DFF;
        const float a0 = SA[((size_t)pm * 4 + 0) * DFF + col], a1 = SA[((size_t)pm * 4 + 1) * DFF + col];
        const float b0 = SB[((size_t)pm * 2 + 0) * DFF + col], b1 = SB[((size_t)pm * 2 + 1) * DFF + col];
        float l0 = 0.f, l1 = 0.f;
        if (pm < 64) { const int ps = (pm & 7) == 0 ? 64 : pm - 1; l0 = SA[((size_t)ps * 4 + 2) * DFF + col]; l1 = SA[((size_t)ps * 4 + 3) * DFF + col]; }
        const float w0 = cw[col], w1 = cw[DFF + col], w2 = cw[2 * DFF + col], bb = cb[col];
        const float c0 = bb + w0 * l0 + w1 * l1 + w2 * a0, c1 = bb + w0 * l1 + w1 * a0 + w2 * a1;
        const float g0 = c0 / (1.0f + __expf(-c0)) * b0, g1 = c1 / (1.0f + __expf(-c1)) * b1;
        G[(size_t)(pm * 256) * DFF + col] = (bf16_t)f2bf(g0); G[(size_t)(pm * 256 + 1) * DFF + col] = (bf16_t)f2bf(g1);
    }
}

#define XB_TMO      128
#define XB_XCNT(j)  (256  + 64 * (j))
#define XB_XSUB(j)  (1280 + 64 * (j))
#define XB_XGEN(j)  (2304 + 64 * (j))
#define XB_TOP      3328
#define XB_TOPGEN   3392
#define XCD_BAR_WORDS 3456
#define XB_SPIN_CAP (1u << 18)

__device__ __forceinline__ unsigned xb_ld(unsigned* p)              { return __hip_atomic_load(p, __ATOMIC_RELAXED, __HIP_MEMORY_SCOPE_AGENT); }
__device__ __forceinline__ unsigned xb_add(unsigned* p, unsigned v) { return __hip_atomic_fetch_add(p, v, __ATOMIC_RELAXED, __HIP_MEMORY_SCOPE_AGENT); }
__device__ __forceinline__ unsigned xb_xcc_id() { return (unsigned)__builtin_amdgcn_s_getreg((3 << 11) | 20) & 0xFu; }
#define XB_SPIN(cond, bar) do { unsigned _sp = 0; while (cond) { __builtin_amdgcn_s_sleep(1); \
    if ((++_sp & 255u) == 0u) { if (xb_ld(&(bar)[XB_TMO])) break; if (_sp > XB_SPIN_CAP) { atomicAdd(&(bar)[XB_TMO], 1u); break; } } } } while (0)

struct XcdBarrier {
    unsigned* bar; unsigned x;
    volatile LAS unsigned* st;
};

__device__ __forceinline__ XcdBarrier xcd_barrier_post(unsigned* bar, volatile LAS unsigned* st) {
    XcdBarrier b; b.bar = bar; b.x = xb_xcc_id(); b.st = st;
    if (threadIdx.x == 0) (void)xb_add(&bar[XB_XCNT(b.x)], 1u);
    return b;
}
__device__ __forceinline__ void xcd_barrier_complete(unsigned* bar, unsigned x, unsigned& nloc, unsigned& nx) {
    const unsigned G = gridDim.x * gridDim.y * gridDim.z;
    unsigned sum, cnt, mine, sp = 0u;
    for (;;) {
        sum = 0u; cnt = 0u; mine = 0u;
#pragma unroll
        for (unsigned j = 0; j < 16; ++j) { const unsigned c = xb_ld(&bar[XB_XCNT(j)]); sum += c; cnt += (c > 0u) ? 1u : 0u; mine = (j == x) ? c : mine; }
        if (sum == G) break;
        __builtin_amdgcn_s_sleep(1);
        if ((++sp & 255u) == 0u) { if (xb_ld(&bar[XB_TMO])) break; if (sp > XB_SPIN_CAP) { atomicAdd(&bar[XB_TMO], 1u); break; } }
    }
    nloc = mine > 0u ? mine : 1u; nx = cnt > 0u ? cnt : 1u;
}

__device__ __forceinline__ void xcd_barrier(const XcdBarrier& b) {
    asm volatile("s_waitcnt vmcnt(0)" ::: "memory");
    __syncthreads();
    if (threadIdx.x == 0) {
        unsigned* bar = b.bar;
        __builtin_amdgcn_s_waitcnt(0);
        unsigned nloc = b.st[0], nx = b.st[1];
        if (nloc == 0u) { xcd_barrier_complete(bar, b.x, nloc, nx); b.st[0] = nloc; b.st[1] = nx; }
        const unsigned old = xb_add(&bar[XB_XSUB(b.x)], 1u);
        const unsigned gen = old / nloc;
        if (old + 1u == (gen + 1u) * nloc) {
            __builtin_amdgcn_fence(__ATOMIC_RELEASE, "agent");
            asm volatile("s_waitcnt vmcnt(0)" ::: "memory");
            const unsigned og = xb_add(&bar[XB_TOP], 1u);
            const unsigned tg = og / nx;
            if (og + 1u == (tg + 1u) * nx) xb_add(&bar[XB_TOPGEN], 1u);
            else XB_SPIN(xb_ld(&bar[XB_TOPGEN]) == tg, bar);
            __builtin_amdgcn_fence(__ATOMIC_ACQUIRE, "agent");
            xb_add(&bar[XB_XGEN(b.x)], 1u);
            asm volatile("s_waitcnt vmcnt(0)" ::: "memory");
        } else {
            XB_SPIN(xb_ld(&bar[XB_XGEN(b.x)]) == gen, bar);
            __builtin_amdgcn_fence(__ATOMIC_ACQUIRE, "agent");
            asm volatile("s_waitcnt vmcnt(0)" ::: "memory");
        }
    }
    __syncthreads();
}

enum { PH_PROLOGUE = 0, PH_QKV, PH_ATTN_A, PH_WO_A, PH_FFNIN_A, PH_FIX_A, PH_FFNOUT_A, PH_DPROJ, PH_UKV, PH_UQ, PH_ATTN_B, PH_WO_B, PH_FFNIN_B, PH_FIX_B, PH_FFNOUT_B, PH_FINAL, PH_COUNT };
__host__ __device__ constexpr bool phase_active(int ph) {
#ifdef ONLY_PH
    if (ph != ONLY_PH) return false;
#endif
    return true;
}
__host__ __device__ constexpr bool only_ok(int x) {
#ifdef ONLY_PH
    return x == ONLY_PH;
#else
    return true;
#endif
}
__device__ __forceinline__ Ctx make_ctx(LAS unsigned char* lds, int wave0) {
    int lane_; asm volatile("v_mbcnt_lo_u32_b32 %0, -1, 0\n\tv_mbcnt_hi_u32_b32 %0, -1, %0" : "=v"(lane_));
    int wv = wave0; asm volatile("" : "+s"(wv));
    Ctx c; c.lds = lds; c.lane = lane_; c.wave = wv; c.tid = wv * 64 + lane_;
    c.G = gridDim.x; { const int bx = blockIdx.x; c.vcu = (c.G % 8 == 0) ? (bx % 8) * (c.G / 8) + bx / 8 : bx; }
    c.gw = c.vcu * NWAVES + c.wave; c.ngw = c.G * NWAVES;
    return c;
}
template <class Epi> __device__ __forceinline__ void run_gemm(const Ctx& c, const bf16_t* A, const bf16_t* Bt, int N, int K, const Epi& E) {
    pg8::Gemm g{A, Bt, RR, N, K}; pg8::StaticOrder S; S.init(RR, N, c.G, (int)blockIdx.x);
    pg8::gemm_phase<Epi, pg8::StaticOrder, true, true>(c.lds, g, S, E, c.tid);
    int ln_; asm volatile("v_mbcnt_lo_u32_b32 %0, -1, 0\n\tv_mbcnt_hi_u32_b32 %0, -1, %0" : "=v"(ln_));
    pg8::skinny_gemm<Epi>(c.lds, A, Bt, N, K, E, c.vcu, c.G, c.wave, ln_);
}

__global__ void __launch_bounds__(NTHREADS, 2) fwd_kernel(Params pin) {
    extern __shared__ __attribute__((aligned(16))) unsigned char smem[];
    bool first = true;
    int wave0 = __builtin_amdgcn_readfirstlane((int)threadIdx.x >> 6);
    if (threadIdx.x < 64) ((LAS unsigned*)(smem + MISC_OFF))[threadIdx.x] = 0u;
    __syncthreads();
    const XcdBarrier xbar = xcd_barrier_post((unsigned*)(pin.ws + WS_CTL) + CW_BAR, (volatile LAS unsigned*)(smem + MISC_OFF));
    int nsync = 0;
#ifdef DUP_PH
    int dupdone = 0;
#endif
#ifdef PROBE_PH
    const int ph_end = pin.ph_hi + 1;
#else
    const int ph_end = pin.ph_hi;
#endif
#pragma nounroll
    for (int ph = pin.ph_lo; ph < ph_end; ++ph) {
        if (!phase_active(ph)) continue;
#ifdef PROBE_PH
        if (!first && ph == PH_UQ) { }
#endif
        if (!first && ph != PH_UQ) {
            if (nsync == 0) cg::this_grid().sync();
            else xcd_barrier(xbar);
            ++nsync;
        }
#ifdef PROBE_PH
        if (blockIdx.x == 0 && threadIdx.x == 0 && ph != PH_UQ) { volatile LAS unsigned* T = (volatile LAS unsigned*)(smem + MISC_OFF + 64); const unsigned t = (unsigned)__builtin_amdgcn_s_memrealtime();
            if (T[2] == (unsigned)PROBE_PH + 1u) T[1] = t - T[0];
            T[0] = t; T[2] = (unsigned)ph + 1u;
            if (ph == PH_COUNT) { const float us = (float)T[1] * 0.01f; const float k = rintf(logf(us) * (1.0f / 0.18232156f)); pin.out[0] = expf(k * 0.18232156f); } }
#endif
        first = false;
        Params p = pin; { size_t z0 = 0, z1 = 0; asm volatile("" : "+s"(z0), "+s"(z1)); p.ws = pin.ws + z0; p.out = pin.out + z1; }
#define MKCTX() const Ctx c = make_ctx((LAS unsigned char*)smem, wave0)
        unsigned char* ws = p.ws;
        const bf16_t* HB = (const bf16_t*)(ws + WS_HB);
        float* hmeta = (float*)(ws + WS_HMETA);
        const float* TA = (const float*)(ws + WS_ROPE); const float* TB = TA + 2064 * 8 * 2;
#ifdef DUP_PH
        const bool dummy = (ph == DUP_PH) && !dupdone;
#else
        const bool dummy = false;
#endif
        switch (ph) {
            case PH_PROLOGUE: if (!only_ok(PH_PROLOGUE)) break; { MKCTX(); ph_prologue(p, c); break; }
            case PH_QKV: if (!only_ok(PH_QKV)) break; { MKCTX();
                pg8::FEpiQKV e{rss_ptr(p, 0), (bf16_t*)(ws + WS_Q), TA}; run_gemm(c, HB, (const bf16_t*)(ws + W_QKV), 3072, 1024, e); break; }
            case PH_ATTN_A: if (!only_ok(PH_ATTN_A)) break; { MKCTX(); ph_attn_a(p, c, dummy); break; }
            case PH_WO_A: if (!only_ok(PH_WO_A)) break; { MKCTX();
                pg8::FEpiRes e{p.in[I_X], p.in[I_META], p.out, hmeta, (bf16_t*)(ws + WS_HB), rss_ptr(p, 1)}; run_gemm(c, (const bf16_t*)(ws + WS_Q), (const bf16_t*)(ws + W_OA), 1024, 1024, e); break; }
            case PH_FFNIN_A: case PH_FFNIN_B: if (!only_ok(PH_FFNIN_A) && !only_ok(PH_FFNIN_B)) break; { MKCTX(); const int layer = ph == PH_FFNIN_B; const int site = layer ? 3 : 1;
                pg8::FEpiFFN e{rss_ptr(p, site), p.in[I_FFN_CW] + (size_t)layer * 3 * DFF, p.in[I_FFN_CB] + (size_t)layer * DFF, (bf16_t*)(ws + WS_G), (float*)(ws + WS_SA), (float*)(ws + WS_SB), (LAS float*)(c.lds + XLDS_OFF)};
                run_gemm(c, HB, (const bf16_t*)(ws + (layer ? W_IN1 : W_IN0)), 5632, 1024, e); break; }
            case PH_FIX_A: if (!only_ok(PH_FIX_A)) break; { MKCTX(); ph_ffn_fix(p, c, 0); break; }
            case PH_FIX_B: if (!only_ok(PH_FIX_B)) break; { MKCTX(); ph_ffn_fix(p, c, 1); break; }
            case PH_FFNOUT_A: case PH_FFNOUT_B: if (!only_ok(PH_FFNOUT_A) && !only_ok(PH_FFNOUT_B)) break; { MKCTX(); const int layer = ph == PH_FFNOUT_B;
                pg8::FEpiRes e{p.out, hmeta, p.out, hmeta, layer ? nullptr : (bf16_t*)(ws + WS_HB), rss_ptr(p, layer ? 4 : 2)}; run_gemm(c, (const bf16_t*)(ws + WS_G), (const bf16_t*)(ws + (layer ? W_OUT1 : W_OUT0)), 1024, DFF, e); break; }
            case PH_DPROJ: if (!only_ok(PH_DPROJ)) break; { MKCTX();
                pg8::FEpiD e{rss_ptr(p, 2), (bf16_t*)(ws + WS_CQ), (bf16_t*)(ws + WS_CKV), (bf16_t*)(ws + WS_KR), rss_ptr(p, 5), rss_ptr(p, 6), TB}; run_gemm(c, HB, (const bf16_t*)(ws + W_D), 768, 1024, e); break; }
            case PH_UKV: if (!only_ok(PH_UKV)) break; { MKCTX();
                pg8::FEpiUp<false> e1{rss_ptr(p, 6), 1.0f / 256.0f, (bf16_t*)(ws + WS_KV2), 2048, TB}; run_gemm(c, (const bf16_t*)(ws + WS_CKV), (const bf16_t*)(ws + W_UKV), 2048, 256, e1); break; }
            case PH_UQ: if (!only_ok(PH_UQ)) break; { MKCTX();
                pg8::FEpiUp<true> e2{rss_ptr(p, 5), 1.0f / 384.0f, (bf16_t*)(ws + WS_Q2), 1536, TB}; run_gemm(c, (const bf16_t*)(ws + WS_CQ), (const bf16_t*)(ws + W_UQ), 1536, 384, e2); break; }
            case PH_ATTN_B: if (!only_ok(PH_ATTN_B)) break; { MKCTX(); ph_attn_b(p, c); break; }
            case PH_WO_B: if (!only_ok(PH_WO_B)) break; { MKCTX();
                pg8::FEpiRes e{p.out, hmeta, p.out, hmeta, (bf16_t*)(ws + WS_HB), rss_ptr(p, 3)}; run_gemm(c, (const bf16_t*)(ws + WS_OB2), (const bf16_t*)(ws + W_OB), 1024, 1024, e); break; }
            case PH_FINAL: if (!only_ok(PH_FINAL)) break; { MKCTX(); ph_final(p, c); break; }
            default: break;
        }
#ifdef DUP_PH
        if (ph == DUP_PH && !dupdone) { dupdone = 1; --ph; }
#endif
    }
}

extern "C" void kernel_launch(void* const* d_in, const int* in_sizes, int n_in, void* d_out, int out_size, void* d_ws, size_t ws_size, hipStream_t stream) {
    static int grid = 0;
    if (grid == 0) {
        if (n_in != 25 || ws_size < WS_END || out_size != RR * D) { fprintf(stderr, "kernel_launch: unexpected shapes (n_in %d, ws %zu, out %d)\n", n_in, ws_size, out_size); grid = -1; return; }
        int dev = 0, cus = 0, per_cu = 0;
        hipGetDevice(&dev); hipDeviceGetAttribute(&cus, hipDeviceAttributeMultiprocessorCount, dev);
        hipFuncSetAttribute((const void*)fwd_kernel, hipFuncAttributeMaxDynamicSharedMemorySize, LDS_BYTES);
        hipOccupancyMaxActiveBlocksPerMultiprocessor(&per_cu, (const void*)fwd_kernel, NTHREADS, LDS_BYTES);
        if (per_cu < 1) { fprintf(stderr, "kernel_launch: occupancy query says %d blocks per CU\n", per_cu); per_cu = 1; }
        (void)hipGetLastError();
        grid = cus * per_cu;
    }
    if (grid < 0) return;
    Params p{};
    for (int i = 0; i < 25; ++i) p.in[i] = (const float*)d_in[i];
    p.out = (float*)d_out; p.ws = (unsigned char*)d_ws;
    (void)hipMemsetAsync((char*)d_ws + WS_CTL, 0, CTL_ZERO_BYTES, stream);
    p.ph_lo = 0; p.ph_hi = PH_COUNT;
    void* args[] = {&p};
    hipError_t e = hipLaunchCooperativeKernel((const void*)fwd_kernel, dim3(grid), dim3(NTHREADS), args, LDS_BYTES, stream);
    if (e != hipSuccess) fprintf(stderr, "kernel_launch: cooperative launch failed: %s (grid %d)\n", hipGetErrorString(e), grid);
}
```

```cpp
#include <hip/hip_runtime.h>
#include <hip/hip_cooperative_groups.h>
#include <cstdio>
#include <cstdint>
#include <cmath>
namespace cg = cooperative_groups;

#define LAS __attribute__((address_space(3)))
typedef unsigned short bf16_t;
typedef short bf16x8 __attribute__((ext_vector_type(8)));
typedef short s16x4 __attribute__((ext_vector_type(4)));
typedef float f32x4 __attribute__((ext_vector_type(4)));
typedef float f32x16 __attribute__((ext_vector_type(16)));
typedef unsigned u32x4 __attribute__((ext_vector_type(4)));
typedef unsigned u32x2 __attribute__((ext_vector_type(2)));

constexpr int NB = 8, SEQ = 2048, NMETA = 16, D = 1024, DFF = 2816;
constexpr int RR = NB * SEQ;
constexpr int RV = RR + NMETA;
constexpr int RT = 16640;
constexpr int NWAVES = 8, NTHREADS = 512;
constexpr float EPS = 1e-5f;
constexpr float LOG2E = 1.4426950408889634f;
constexpr float QS_A = 0.125f * LOG2E;
constexpr float QS_B = 0.10206207261596575f * LOG2E;
constexpr float LAM_INIT = 0.2f;

constexpr size_t KiB = 1024, MiB = 1024 * 1024;
constexpr size_t WS_CTL = 0;
constexpr size_t W_QKV = 1 * MiB;
constexpr size_t W_OA = 7 * MiB;
constexpr size_t W_IN0 = 9 * MiB, W_IN1 = 20 * MiB;
constexpr size_t W_OUT0 = 31 * MiB, W_OUT1 = 31 * MiB + 5632 * KiB;
constexpr size_t W_D = 42 * MiB;
constexpr size_t W_UKV = 43 * MiB + 512 * KiB;
constexpr size_t W_UQ = 44 * MiB + 512 * KiB;
constexpr size_t W_OB = 45 * MiB + 640 * KiB;
constexpr size_t WS_HB = 48 * MiB;
constexpr size_t WS_BIG = WS_HB + 33280 * KiB;
constexpr size_t ROWB1024 = (size_t)RT * 1024 * 2;
constexpr size_t WS_Q = WS_BIG, WS_K = WS_BIG + ROWB1024, WS_V = WS_BIG + 2 * ROWB1024;
constexpr size_t WS_G = WS_BIG;
constexpr size_t WS_Q2 = WS_BIG;
constexpr size_t WS_KV2 = WS_BIG + (size_t)RT * 1536 * 2;
constexpr size_t WS_CQ = WS_BIG + 116480 * KiB;
constexpr size_t WS_CKV = WS_CQ + (size_t)RT * 384 * 2;
constexpr size_t WS_KR = WS_CKV + (size_t)RT * 256 * 2;
constexpr size_t WS_OB2 = 216 * MiB;
constexpr size_t WS_HMETA = WS_OB2 + 33280 * KiB;
constexpr size_t WS_RSS = WS_HMETA + 1 * MiB;
constexpr size_t WS_ROPE = WS_RSS + 512 * KiB;
constexpr size_t WS_SA = 251 * MiB;
constexpr size_t WS_SB = WS_SA + (size_t)65 * 4 * 2816 * 4;
constexpr size_t WS_END = 256 * MiB;
static_assert(WS_SB + (size_t)65 * 2 * 2816 * 4 <= WS_END, "ws map");
static_assert(WS_KR + (size_t)RT * 32 * 2 <= WS_OB2, "ws map");

static_assert(WS_KV2 + (size_t)RT * 2048 * 2 <= WS_CQ, "ws map");
static_assert(WS_ROPE + 512 * KiB <= WS_END, "ws map");
static_assert(W_OB + 2 * MiB <= WS_HB, "ws map");

constexpr int LDS_BYTES = 147456;
constexpr int MISC_OFF = 131072 + 4096;
constexpr size_t CTL_ZERO_BYTES = 64 * 1024;
constexpr int CW_BAR = 4096;
constexpr int XLDS_OFF = 131072;

struct Params {
    const float* in[25];
    float* out;
    unsigned char* ws;
    int ph_lo, ph_hi;
};
enum { I_X = 0, I_META, I_A_NORM, I_A_WQKV, I_LQ1, I_LK1, I_LQ2, I_LK2, I_A_SUB, I_A_WO, I_KV_NORM, I_KV_WDKV, I_KV_ANORM, I_KV_WUKV,
       I_B_NORM, I_B_WDQ, I_B_QANORM, I_B_WUQ, I_B_WO, I_FFN_NORM, I_FFN_WIN, I_FFN_CW, I_FFN_CB, I_FFN_WOUT, I_FINAL };

struct Ctx { int tid, lane, wave, gw, ngw, vcu, G; LAS unsigned char* lds; };

__device__ __forceinline__ unsigned f2bf(float f) { unsigned u = __builtin_bit_cast(unsigned, f); return (u + 0x7fffu + ((u >> 16) & 1u)) >> 16; }
__device__ __forceinline__ unsigned pk2(float lo, float hi) { return f2bf(lo) | (f2bf(hi) << 16); }
__device__ __forceinline__ float bf2f(bf16_t b) { return __builtin_bit_cast(float, (unsigned)b << 16); }
__device__ __forceinline__ float wave_sum(float v) {
#pragma unroll
    for (int o = 1; o < 64; o <<= 1) v += __shfl_xor(v, o);
    return v;
}
__device__ __forceinline__ int row_pos(int r) { return r < RR ? NMETA + (r & (SEQ - 1)) : r - RR; }
__device__ __forceinline__ float* hrow(const Params& p, int r) { return r < RR ? p.out + (size_t)r * D : (float*)(p.ws + WS_HMETA) + (size_t)(r - RR) * D; }
__device__ __forceinline__ float* rss_ptr(const Params& p, int site) { return (float*)(p.ws + WS_RSS) + (size_t)site * RT; }
__device__ __forceinline__ int crow(int r, int hi) { return (r & 3) + 8 * (r >> 2) + 4 * hi; }

struct WSrc { const float* W; int pitch; int col0; const float* gain; int gmask; float scale; };
__device__ __forceinline__ void wdims(int id, int& N, int& K, size_t& off) {
    switch (id) {
        case 0: N = 3072; K = 1024; off = W_QKV; break;
        case 1: N = 1024; K = 1024; off = W_OA; break;
        case 2: N = 5632; K = 1024; off = W_IN0; break;
        case 3: N = 5632; K = 1024; off = W_IN1; break;
        case 4: N = 1024; K = 2816; off = W_OUT0; break;
        case 5: N = 1024; K = 2816; off = W_OUT1; break;
        case 6: N = 768; K = 1024; off = W_D; break;
        case 7: N = 2048; K = 256; off = W_UKV; break;
        case 8: N = 1536; K = 384; off = W_UQ; break;
        default: N = 1024; K = 1024; off = W_OB; break;
    }
}
__device__ __forceinline__ WSrc wsrc(const Params& p, int id, int n0) {
    WSrc s; s.gain = nullptr; s.gmask = 0; s.scale = 1.f; s.W = nullptr; s.pitch = 0; s.col0 = 0;
    switch (id) {
        case 0: s.W = p.in[I_A_WQKV]; s.pitch = 3072; s.col0 = n0; s.gain = p.in[I_A_NORM]; s.gmask = 1023; s.scale = n0 < 1024 ? QS_A : 1.f; break;
        case 1: s.W = p.in[I_A_WO]; s.pitch = 1024; s.col0 = n0; s.gain = p.in[I_A_SUB]; s.gmask = 127; s.scale = 1.f - LAM_INIT; break;
        case 2: case 3: { const int l = id - 2; s.W = p.in[I_FFN_WIN] + (size_t)l * 1024 * 5632; s.pitch = 5632; const int j = n0 >> 8, u = n0 & 255;
            s.col0 = u < 128 ? 128 * j + u : DFF + 128 * j + (u - 128); s.gain = p.in[I_FFN_NORM] + l * 1024; s.gmask = 1023; break; }
        case 4: case 5: { const int l = id - 4; s.W = p.in[I_FFN_WOUT] + (size_t)l * DFF * 1024; s.pitch = 1024; s.col0 = n0; break; }
        case 6: if (n0 < 384) { s.W = p.in[I_B_WDQ]; s.pitch = 384; s.col0 = n0; s.gain = p.in[I_B_NORM]; s.gmask = 1023; }
                else if (n0 < 672) { s.W = p.in[I_KV_WDKV]; s.pitch = 288; s.col0 = n0 - 384; s.gain = p.in[I_KV_NORM]; s.gmask = 1023; }
                break;
        case 7: s.W = p.in[I_KV_WUKV]; s.pitch = 2048; s.col0 = n0; s.gain = p.in[I_KV_ANORM]; s.gmask = 255; break;
        case 8: s.W = p.in[I_B_WUQ]; s.pitch = 1536; s.col0 = n0; s.gain = p.in[I_B_QANORM]; s.gmask = 511; s.scale = QS_B; break;
        default: s.W = p.in[I_B_WO]; s.pitch = 1024; s.col0 = n0; break;
    }
    return s;
}
__device__ __forceinline__ void transpose_item(const WSrc& s, int K, bf16_t* WT, int k0, int n0, LAS float* scr, int lane) {
    const int kr = lane >> 3, nq = lane & 7;
    f32x4 v[8];
    if (s.W) {
#pragma unroll
        for (int i = 0; i < 8; ++i) v[i] = *(const f32x4*)(s.W + (size_t)(k0 + 8 * i + kr) * s.pitch + s.col0 + 4 * nq);
#pragma unroll
        for (int i = 0; i < 8; ++i) { float g = s.scale; if (s.gain) g *= s.gain[(k0 + 8 * i + kr) & s.gmask]; v[i] = v[i] * g; }
    } else {
#pragma unroll
        for (int i = 0; i < 8; ++i) v[i] = (f32x4){0.f, 0.f, 0.f, 0.f};
    }
#pragma unroll
    for (int i = 0; i < 8; ++i)
#pragma unroll
        for (int e = 0; e < 4; ++e) scr[(4 * nq + e) * 65 + 8 * i + kr] = v[i][e];
    asm volatile("s_waitcnt lgkmcnt(0)" ::: "memory");
    const int c = lane & 7;
#pragma unroll
    for (int j = 0; j < 4; ++j) { const int n = (lane >> 3) + 8 * j; const LAS float* q = scr + n * 65 + 8 * c;
        u32x4 o; o.x = pk2(q[0], q[1]); o.y = pk2(q[2], q[3]); o.z = pk2(q[4], q[5]); o.w = pk2(q[6], q[7]);
        *(u32x4*)(WT + (size_t)(n0 + n) * K + k0 + 8 * c) = o; }
    asm volatile("s_waitcnt lgkmcnt(0)" ::: "memory");
}
__device__ __forceinline__ void ph_prologue(const Params& p, const Ctx& c) {
    LAS float* scr = (LAS float*)(c.lds + c.wave * 16384);
    int base = 0;
    for (int id = 0; id < 10; ++id) {
        int N, K; size_t off; wdims(id, N, K, off);
        const int nkb = K / 64, nnb = N / 32, items = nkb * nnb;
        for (int it = ((c.gw - base) % c.ngw + c.ngw) % c.ngw; it < items; it += c.ngw) {
            const int kb = it / nnb, nb = it % nnb; const WSrc s = wsrc(p, id, nb * 32);
            transpose_item(s, K, (bf16_t*)(p.ws + off), kb * 64, nb * 32, scr, c.lane); }
        base += items;
    }
    { float2* TA = (float2*)(p.ws + WS_ROPE); float2* TB = TA + 2064 * 8;
      const int gt = c.gw * 64 + c.lane, ngt = c.ngw * 64;
      for (int i = gt; i < 2064 * 8; i += ngt) { const int pos = i >> 3, k = i & 7; const float inv = 1.0f / powf(500000.0f, (float)k / 8.0f); const float a = (float)pos * inv; TA[i] = make_float2(cosf(a), sinf(a)); }
      for (int i = gt; i < 2064 * 16; i += ngt) { const int pos = i >> 4, k = i & 15; const float inv = 1.0f / powf(10000.0f, (float)k / 16.0f); const float a = (float)pos * inv; TB[i] = make_float2(cosf(a), sinf(a)); } }
    { float* r1 = rss_ptr(p, 1); const int gt = c.gw * 64 + c.lane, ngt = c.ngw * 64; for (int i = gt; i < 6 * RT; i += ngt) r1[i] = 0.f; }
    float* rss0 = rss_ptr(p, 0);
    for (int it = c.gw; it < RT / 4; it += c.ngw) {
        f32x4 v[4][4];
#pragma unroll
        for (int rr = 0; rr < 4; ++rr) { const int r = 4 * it + rr;
            const float* src = r < RR ? p.in[I_X] + (size_t)r * D : (r < RV ? p.in[I_META] + (size_t)(r - RR) * D : nullptr);
#pragma unroll
            for (int j = 0; j < 4; ++j) v[rr][j] = src ? *(const f32x4*)(src + 4 * c.lane + 256 * j) : (f32x4){0.f, 0.f, 0.f, 0.f}; }
#pragma unroll
        for (int rr = 0; rr < 4; ++rr) { const int r = 4 * it + rr; float ss = 0.f;
#pragma unroll
            for (int j = 0; j < 4; ++j) ss += v[rr][j].x * v[rr][j].x + v[rr][j].y * v[rr][j].y + v[rr][j].z * v[rr][j].z + v[rr][j].w * v[rr][j].w;
            ss = wave_sum(ss);
            bf16_t* hb = (bf16_t*)(p.ws + WS_HB) + (size_t)r * D;
#pragma unroll
            for (int j = 0; j < 4; ++j) { u32x2 w; w.x = pk2(v[rr][j].x, v[rr][j].y); w.y = pk2(v[rr][j].z, v[rr][j].w); *(u32x2*)(hb + 4 * c.lane + 256 * j) = w; }
            if (c.lane == 0) rss0[r] = ss; }
    }
}
__device__ __forceinline__ void ph_final(const Params& p, const Ctx& c) {
    const float* g = p.in[I_FINAL];
    for (int r = c.gw; r < RR; r += c.ngw) {
        float* h = p.out + (size_t)r * D; f32x4 v[4]; float ss = 0.f;
#pragma unroll
        for (int j = 0; j < 4; ++j) { v[j] = *(const f32x4*)(h + 4 * c.lane + 256 * j); ss += v[j].x * v[j].x + v[j].y * v[j].y + v[j].z * v[j].z + v[j].w * v[j].w; }
        ss = wave_sum(ss); const float rstd = 1.0f / sqrtf(ss * (1.0f / D) + EPS);
#pragma unroll
        for (int j = 0; j < 4; ++j) { const f32x4 gg = *(const f32x4*)(g + 4 * c.lane + 256 * j); *(f32x4*)(h + 4 * c.lane + 256 * j) = v[j] * rstd * gg; }
    }
}

namespace pg8 {
#define PG8_LAS __attribute__((address_space(3)))
typedef unsigned short bf16_t;
typedef short bf16x8 __attribute__((ext_vector_type(8)));
typedef float f32x4 __attribute__((ext_vector_type(4)));
typedef unsigned u32x4 __attribute__((ext_vector_type(4)));
constexpr int BM = 256, BK = 64, HALF = 128, HTB = HALF * BK * 2  , STAGE_BYTES = 8 * HTB, NXCD = 8, WGM = 8;

__host__ __device__ __forceinline__ int lds_byte(int r, int c) { const int st = (r >> 4) * 2 + (c >> 5), rr = r & 15, cc = c & 31, ob = rr * 64 + cc * 2; return st * 1024 + (ob ^ (((ob >> 9) & 1) << 5)); }
__host__ __device__ __forceinline__ void stage_rc(int b, int& R, int& C) { const int st = b / 1024, sb = b % 1024, swz = sb ^ (((sb >> 9) & 1) << 5); R = (st >> 1) * 16 + swz / 64; C = (st & 1) * 32 + (swz % 64) / 2; }
__host__ __device__ __forceinline__ int perm32(int rho) { const int n = rho >> 4, i = rho & 15; return 8 * (i >> 2) + 4 * n + (i & 3); }

struct Unit { int pm, pn; };
struct Gemm { const bf16_t* A; const bf16_t* Bt; int M, N, K; };

struct StaticOrder {
    int nM, nN, nwg, G, c;
    __host__ __device__ void init(int M, int N, int G_, int c_) { nM = M / BM; nN = N / BM; nwg = nM * nN; G = G_; c = c_; }
    __host__ __device__ bool next(int i, Unit& u) const {
        const long L = (long)i * G + c; if (L >= nwg) return false;
        int wgid = (int)L; { const int q = nwg / NXCD, r = nwg % NXCD, xcd = wgid % NXCD, off = wgid / NXCD; wgid = (xcd < r ? xcd * (q + 1) : r * (q + 1) + (xcd - r) * q) + off; }
        const int nig = WGM * nN, gid = wgid / nig, fm = gid * WGM, gsz = (nM - fm) < WGM ? (nM - fm) : WGM;
        u.pm = fm + ((wgid % nig) % gsz); u.pn = (wgid % nig) / gsz; return true;
    }
    __device__ __forceinline__ void a_ready(const Unit&) const {}
    __device__ __forceinline__ void done(const Unit&) const {}
};
template <class Epi, class Sched, bool ALIGN_EPI = false, bool SP2 = false>
__device__ __forceinline__ void gemm_phase(PG8_LAS unsigned char* lds, const Gemm g, const Sched& S, const Epi& E, const int tid_in) {
    const int tid = tid_in, wid = __builtin_amdgcn_readfirstlane(tid >> 6), lane = tid & 63, wr = wid >> 2, wc = wid & 3, fr = lane & 15, fq = lane >> 4;
    const int K = g.K, nt = K / BK;
    unsigned voffA[2], voffB[2]; int aoff, boff;
#define PG8_LANE_STATE() do { int l_; asm volatile("v_mbcnt_lo_u32_b32 %0, -1, 0\n\tv_mbcnt_hi_u32_b32 %0, -1, %0" : "=v"(l_)); const int t_ = wid * 64 + l_; \
        _Pragma("unroll") for (int i = 0; i < 2; ++i) { int R, C; stage_rc(t_ * 16 + i * 8192, R, C); const int Rb = Epi::PERM ? ((R & ~31) + perm32(R & 31)) : R; \
            voffA[i] = (unsigned)(R * K + C) * 2u; voffB[i] = (unsigned)(Rb * K + C) * 2u; } \
        aoff = lds_byte(wr * 64 + (l_ & 15), (l_ >> 4) * 8); boff = lds_byte(wc * 32 + (l_ & 15), (l_ >> 4) * 8); } while (0)
    PG8_LANE_STATE();
    const size_t kstep = (size_t)(BK * 2);
    const size_t hstep = (size_t)HALF * K * 2;
    const size_t tstep = 2 * hstep;
    const unsigned ldsw = (unsigned)wid * 1024u;

#define PG8_SA(b, h) (((b) * 2 + (h)) * HTB)
#define PG8_SB(b, h) ((4 + (b) * 2 + (h)) * HTB)
#define PG8_STAGE(bufoff, gbase, voff) do { _Pragma("unroll") for (int _i = 0; _i < 2; ++_i) \
        __builtin_amdgcn_global_load_lds((const unsigned*)((const char*)(gbase) + (voff)[_i]), (PG8_LAS unsigned*)(lds + (bufoff) + ldsw + _i * 8192), 16, 0, 0); } while (0)
#define PG8_LDA(dst, b, h) do { _Pragma("unroll") for (int m = 0; m < 4; ++m) _Pragma("unroll") for (int k = 0; k < 2; ++k) dst[m][k] = *(const PG8_LAS bf16x8*)(lds + PG8_SA(b, h) + aoff + m * 2048 + k * 1024); } while (0)
#define PG8_LDB(dst, b, h) do { _Pragma("unroll") for (int n = 0; n < 2; ++n) _Pragma("unroll") for (int k = 0; k < 2; ++k) dst[n][k] = *(const PG8_LAS bf16x8*)(lds + PG8_SB(b, h) + boff + n * 2048 + k * 1024); } while (0)
#define PG8_MMA(ai, bj, At, Bt) do { __builtin_amdgcn_s_setprio(1); _Pragma("unroll") for (int m = 0; m < 4; ++m) _Pragma("unroll") for (int n = 0; n < 2; ++n) _Pragma("unroll") for (int k = 0; k < 2; ++k) \
        acc[ai][bj][m][n] = __builtin_amdgcn_mfma_f32_16x16x32_bf16(Bt[n][k], At[m][k], acc[ai][bj][m][n], 0, 0, 0); __builtin_amdgcn_s_setprio(0); } while (0)
#define PG8_WAIT_V(n) asm volatile("s_waitcnt vmcnt(" #n ")" ::: "memory")
#define PG8_WAIT_L(n) asm volatile("s_waitcnt lgkmcnt(" #n ")" ::: "memory")
#define PG8_BAR __builtin_amdgcn_s_barrier()
#define PG8_SCHED __builtin_amdgcn_sched_barrier(0)
    Unit cur, nxt; int ui = 0;
    if (!S.next(0, cur)) return;
    f32x4 acc[2][2][4][2];
#pragma unroll
    for (int a = 0; a < 2; ++a)
#pragma unroll
        for (int b = 0; b < 2; ++b)
#pragma unroll
            for (int m = 0; m < 4; ++m)
#pragma unroll
                for (int n = 0; n < 2; ++n) acc[a][b][m][n] = (f32x4){0.f, 0.f, 0.f, 0.f};
    bf16x8 At[4][2], B0[2][2], B1[2][2];
    const char* cA = (const char*)g.A + (size_t)cur.pm * tstep; const char* cB = (const char*)g.Bt + (size_t)cur.pn * tstep;
    S.a_ready(cur);
    if constexpr (SP2) {
        PG8_STAGE(PG8_SB(0, 0), cB, voffB); PG8_STAGE(PG8_SB(0, 1), cB + hstep, voffB); PG8_STAGE(PG8_SA(0, 0), cA, voffA); PG8_STAGE(PG8_SA(0, 1), cA + hstep, voffA);
        if (wr == 1) PG8_BAR;
        PG8_WAIT_V(2); PG8_BAR;
        PG8_STAGE(PG8_SB(1, 0), cB + kstep, voffB); PG8_STAGE(PG8_SA(1, 0), cA + kstep, voffA); PG8_STAGE(PG8_SB(1, 1), cB + hstep + kstep, voffB);
        PG8_WAIT_V(6); PG8_BAR;
    } else {
        PG8_STAGE(PG8_SB(0, 0), cB, voffB); PG8_STAGE(PG8_SA(0, 0), cA, voffA); PG8_STAGE(PG8_SB(0, 1), cB + hstep, voffB); PG8_STAGE(PG8_SA(0, 1), cA + hstep, voffA);
        if (wr == 1) PG8_BAR;
        PG8_WAIT_V(4); PG8_BAR;
        PG8_STAGE(PG8_SB(1, 0), cB + kstep, voffB); PG8_STAGE(PG8_SA(1, 0), cA + kstep, voffA); PG8_STAGE(PG8_SB(1, 1), cB + hstep + kstep, voffB);
        PG8_WAIT_V(6); PG8_BAR;
    }
    for (;;) {
        const bool has_next = S.next(ui + 1, nxt);
        const char* nA = has_next ? (const char*)g.A + (size_t)nxt.pm * tstep : cA; const char* nB = has_next ? (const char*)g.Bt + (size_t)nxt.pn * tstep : cB;
        for (int t = 0; t < nt; t += 2) {
            const bool last = (t == nt - 2);
            const char* a1 = cA + (size_t)(t + 1) * kstep;
            const char* a2 = last ? nA : cA + (size_t)(t + 2) * kstep; const char* b2 = last ? nB : cB + (size_t)(t + 2) * kstep;
            const char* a3 = a2 + kstep; const char* b3 = b2 + kstep;
            if (last && has_next) S.a_ready(nxt);
            if constexpr (SP2) {
            PG8_LDB(B0, 0, 0); PG8_LDB(B1, 0, 1); PG8_SCHED; PG8_LDA(At, 0, 0); PG8_STAGE(PG8_SA(1, 1), a1 + hstep, voffA);
            PG8_WAIT_V(8); PG8_WAIT_L(0); PG8_BAR; PG8_MMA(0, 0, At, B0); PG8_MMA(0, 1, At, B1); PG8_BAR; PG8_SCHED;
            PG8_LDA(At, 0, 1); PG8_STAGE(PG8_SB(0, 0), b2, voffB); PG8_STAGE(PG8_SB(0, 1), b2 + hstep, voffB); PG8_STAGE(PG8_SA(0, 0), a2, voffA);
            PG8_WAIT_V(8); PG8_WAIT_L(0); PG8_BAR; PG8_MMA(1, 0, At, B0); PG8_MMA(1, 1, At, B1); PG8_BAR; PG8_SCHED;
            PG8_LDB(B0, 1, 0); PG8_LDB(B1, 1, 1); PG8_SCHED; PG8_LDA(At, 1, 0); PG8_STAGE(PG8_SA(0, 1), a2 + hstep, voffA);
            PG8_WAIT_V(8); PG8_WAIT_L(0); PG8_BAR; PG8_MMA(0, 0, At, B0); PG8_MMA(0, 1, At, B1); PG8_BAR; PG8_SCHED;
            PG8_LDA(At, 1, 1); PG8_STAGE(PG8_SB(1, 0), b3, voffB); PG8_STAGE(PG8_SB(1, 1), b3 + hstep, voffB); PG8_STAGE(PG8_SA(1, 0), a3, voffA);
            PG8_WAIT_V(8); PG8_WAIT_L(0); PG8_BAR; PG8_MMA(1, 0, At, B0); PG8_MMA(1, 1, At, B1); PG8_BAR; PG8_SCHED;
            } else {
            PG8_LDB(B0, 0, 0); PG8_SCHED; PG8_LDA(At, 0, 0); PG8_STAGE(PG8_SA(1, 1), a1 + hstep, voffA);
            PG8_WAIT_L(8); PG8_BAR; PG8_WAIT_L(0); PG8_MMA(0, 0, At, B0); PG8_BAR; PG8_SCHED;
            PG8_LDB(B1, 0, 1); PG8_STAGE(PG8_SB(0, 0), b2, voffB);
            PG8_BAR; PG8_WAIT_L(0); PG8_MMA(0, 1, At, B1); PG8_BAR;
            PG8_LDA(At, 0, 1); PG8_STAGE(PG8_SA(0, 0), a2, voffA);
            PG8_BAR; PG8_WAIT_L(0); PG8_MMA(1, 0, At, B0); PG8_BAR; PG8_SCHED;
            PG8_STAGE(PG8_SB(0, 1), b2 + hstep, voffB);
            PG8_WAIT_V(6); PG8_BAR; PG8_MMA(1, 1, At, B1); PG8_BAR;
            PG8_LDB(B0, 1, 0); PG8_SCHED; PG8_LDA(At, 1, 0); PG8_STAGE(PG8_SA(0, 1), a2 + hstep, voffA);
            PG8_WAIT_L(8); PG8_BAR; PG8_WAIT_L(0); PG8_MMA(0, 0, At, B0); PG8_BAR; PG8_SCHED;
            PG8_LDB(B1, 1, 1); PG8_STAGE(PG8_SB(1, 0), b3, voffB);
            PG8_BAR; PG8_WAIT_L(0); PG8_MMA(0, 1, At, B1); PG8_BAR;
            PG8_LDA(At, 1, 1); PG8_STAGE(PG8_SA(1, 0), a3, voffA);
            PG8_BAR; PG8_WAIT_L(0); PG8_MMA(1, 0, At, B0); PG8_BAR; PG8_SCHED;
            PG8_STAGE(PG8_SB(1, 1), b3 + hstep, voffB);
            PG8_WAIT_V(6); PG8_BAR; PG8_MMA(1, 1, At, B1); PG8_BAR;
            }
        }
        if constexpr (ALIGN_EPI) { if (wr == 0) PG8_BAR; }
        if constexpr (!Epi::AFTER_DRAIN) { E(acc, cur, wr, wc, fr, fq); S.done(cur); }
        if (!has_next) break;
#pragma unroll
        for (int a = 0; a < 2; ++a)
#pragma unroll
            for (int b = 0; b < 2; ++b)
#pragma unroll
                for (int m = 0; m < 4; ++m)
#pragma unroll
                    for (int n = 0; n < 2; ++n) acc[a][b][m][n] = (f32x4){0.f, 0.f, 0.f, 0.f};
        cur = nxt; cA = nA; cB = nB; ++ui;
        PG8_LANE_STATE();
        if constexpr (ALIGN_EPI) { if (wr == 1) PG8_BAR; }
    }
    PG8_WAIT_V(0);
    if constexpr (!ALIGN_EPI) { if (wr == 0) PG8_BAR; }
    PG8_BAR;
    if constexpr (Epi::AFTER_DRAIN) { E.fused(acc, cur, wr, wc, fr, fq, lds, wid, lane); S.done(cur); }
#undef PG8_LANE_STATE
#undef PG8_SA
#undef PG8_SB
#undef PG8_STAGE
#undef PG8_LDA
#undef PG8_LDB
#undef PG8_MMA
#undef PG8_WAIT_V
#undef PG8_WAIT_L
#undef PG8_BAR
#undef PG8_SCHED
}

__device__ __forceinline__ unsigned cvt2(float lo, float hi) { typedef float f32x2_t __attribute__((ext_vector_type(2))); typedef __bf16 bf16x2_t __attribute__((ext_vector_type(2)));
    f32x2_t v = {lo, hi}; bf16x2_t b = __builtin_convertvector(v, bf16x2_t); return __builtin_bit_cast(unsigned, b); }
__device__ __forceinline__ u32x4 pack8(const f32x4& v0, const f32x4& v1) { u32x4 w; w.x = cvt2(v0[0], v0[1]); w.y = cvt2(v0[2], v0[3]); w.z = cvt2(v1[0], v1[1]); w.w = cvt2(v1[2], v1[3]); return w; }
__device__ __forceinline__ float rstdf(const float* rss, int row, float invk) { return 1.0f / sqrtf(rss[row] * invk + EPS); }

struct FEpiQKV {
    static constexpr bool PERM = true, AFTER_DRAIN = false;
    const float* rss; bf16_t* Q; const float* TA;
    __device__ __forceinline__ void operator()(const f32x4 (&acc)[2][2][4][2], const Unit& u, int wr, int wc, int, int) const { apply<false>(acc, u, wr, wc); }
    template <bool SK> __device__ __forceinline__ void apply(const f32x4 (&acc)[2][2][4][2], const Unit& u, int wr, int wc) const {
        constexpr int NAI = SK ? 1 : 2, NM = SK ? 1 : 4;
        int lane_e; asm volatile("v_mbcnt_lo_u32_b32 %0, -1, 0\n\tv_mbcnt_hi_u32_b32 %0, -1, %0" : "=v"(lane_e));
        const int fr = lane_e & 15, fq = lane_e >> 4;
        const int colt = u.pn * BM, t = colt >> 10;
        bf16_t* base = Q + (size_t)t * (ROWB1024 / 2) + (colt & 1023) + wc * 32 + 8 * fq;
        const bool rot = (t < 2) && ((wc & 1) == 0);
        const float sgn = fq == 0 ? -1.f : 1.f; const bool mine = fq < 2;
#pragma unroll
        for (int ai = 0; ai < NAI; ++ai)
#pragma unroll
            for (int m = 0; m < NM; ++m) {
                const int row = u.pm * BM + ai * HALF + wr * 64 + m * 16 + fr;
                const float rs = rstdf(rss, row, 1.0f / 1024.0f);
                f32x4 cs[4];
                if (rot) { const f32x4* tp = (const f32x4*)(TA + (size_t)row_pos(row) * 16);
#pragma unroll
                    for (int k = 0; k < 4; ++k) cs[k] = tp[k]; }
#pragma unroll
                for (int bj = 0; bj < 2; ++bj) {
                    f32x4 v0 = acc[ai][bj][m][0] * rs, v1 = acc[ai][bj][m][1] * rs;
                    if (rot) {
                        f32x4 r0, r1;
#pragma unroll
                        for (int e = 0; e < 4; ++e) { const float o0 = __shfl_xor(v0[e], 16), o1 = __shfl_xor(v1[e], 16);
                            r0[e] = v0[e] * cs[e >> 1][(e & 1) * 2] + sgn * o0 * cs[e >> 1][(e & 1) * 2 + 1];
                            r1[e] = v1[e] * cs[2 + (e >> 1)][(e & 1) * 2] + sgn * o1 * cs[2 + (e >> 1)][(e & 1) * 2 + 1]; }
                        if (mine) { v0 = r0; v1 = r1; }
                    }
                    *(u32x4*)(base + (size_t)row * 1024 + bj * HALF) = pack8(v0, v1);
                }
            }
    }
};
struct FEpiRes {
    static constexpr bool PERM = true, AFTER_DRAIN = false;
    const float* fin; const float* fin_meta; float* fout; float* fout_meta; bf16_t* HB; float* rss;
    __device__ __forceinline__ void operator()(const f32x4 (&acc)[2][2][4][2], const Unit& u, int wr, int wc, int, int) const { apply<false>(acc, u, wr, wc); }
    template <bool SK> __device__ __forceinline__ void apply(const f32x4 (&acc)[2][2][4][2], const Unit& u, int wr, int wc) const {
        constexpr int NAI = SK ? 1 : 2, NM = SK ? 1 : 4;
        int lane_e; asm volatile("v_mbcnt_lo_u32_b32 %0, -1, 0\n\tv_mbcnt_hi_u32_b32 %0, -1, %0" : "=v"(lane_e));
        const int fr = lane_e & 15, fq = lane_e >> 4;
        const float* rb_ = fin ? (u.pm < 64 ? fin + (size_t)u.pm * BM * 1024 : fin_meta) : nullptr;
        float* wb_ = fout ? (u.pm < 64 ? fout + (size_t)u.pm * BM * 1024 : fout_meta) : nullptr;
        const int col0 = u.pn * BM + wc * 32 + 8 * fq;
#pragma unroll
        for (int ai = 0; ai < NAI; ++ai)
#pragma unroll
            for (int m = 0; m < NM; ++m) {
                const int rl = ai * HALF + wr * 64 + m * 16 + fr, row = u.pm * BM + rl;
                float ss = 0.f;
#pragma unroll
                for (int bj = 0; bj < 2; ++bj) {
                    bf16_t* hbp = HB + (size_t)row * 1024 + col0 + bj * HALF;
                    f32x4 h0, h1;
                    if (fin) { const float* rp = rb_ + (size_t)rl * 1024 + col0 + bj * HALF; h0 = *(const f32x4*)rp; h1 = *(const f32x4*)(rp + 4); }
                    else { const u32x4 w = *(const u32x4*)hbp;
                        h0 = (f32x4){__builtin_bit_cast(float, w.x << 16), __builtin_bit_cast(float, w.x & 0xffff0000u), __builtin_bit_cast(float, w.y << 16), __builtin_bit_cast(float, w.y & 0xffff0000u)};
                        h1 = (f32x4){__builtin_bit_cast(float, w.z << 16), __builtin_bit_cast(float, w.z & 0xffff0000u), __builtin_bit_cast(float, w.w << 16), __builtin_bit_cast(float, w.w & 0xffff0000u)}; }
                    h0 += acc[ai][bj][m][0]; h1 += acc[ai][bj][m][1];
                    ss += (h0[0] * h0[0] + h0[1] * h0[1]) + (h0[2] * h0[2] + h0[3] * h0[3]) + (h1[0] * h1[0] + h1[1] * h1[1]) + (h1[2] * h1[2] + h1[3] * h1[3]);
                    if (fout) { float* wp = wb_ + (size_t)rl * 1024 + col0 + bj * HALF; *(f32x4*)wp = h0; *(f32x4*)(wp + 4) = h1; }
                    else *(u32x4*)hbp = pack8(h0, h1);
                    asm volatile("" ::: "memory");
                }
                ss += __shfl_xor(ss, 16); ss += __shfl_xor(ss, 32);
                if (fq == 0) atomicAdd(rss + row, ss);
                asm volatile("" ::: "memory");
            }
    }
};
struct FEpiFFN {
    static constexpr bool PERM = true, AFTER_DRAIN = false;
    const float* rss; const float* cw; const float* cb; bf16_t* G; float* SA; float* SB; PG8_LAS float* X;
    __device__ __forceinline__ void operator()(const f32x4 (&acc)[2][2][4][2], const Unit& u, int wr, int wc, int, int) const { apply<false>(acc, u, wr, wc); }
    template <bool SK> __device__ __forceinline__ void apply(const f32x4 (&acc)[2][2][4][2], const Unit& u, int wr, int wc) const {
        constexpr int NAI = SK ? 1 : 2, NM = SK ? 1 : 4;
        int lane_e; asm volatile("v_mbcnt_lo_u32_b32 %0, -1, 0\n\tv_mbcnt_hi_u32_b32 %0, -1, %0" : "=v"(lane_e));
        const int fr = lane_e & 15, fq = lane_e >> 4;
        const int lane = fr + 16 * fq;
        const int cc0 = u.pn * HALF + wc * 32 + 8 * fq;
        f32x4 w0[2], w1[2], w2[2], bs[2];
#pragma unroll
        for (int n = 0; n < 2; ++n) { w0[n] = *(const f32x4*)(cw + cc0 + 4 * n); w1[n] = *(const f32x4*)(cw + DFF + cc0 + 4 * n); w2[n] = *(const f32x4*)(cw + 2 * DFF + cc0 + 4 * n); bs[n] = *(const f32x4*)(cb + cc0 + 4 * n); }
        if (!SK) {
#pragma unroll
            for (int ai = 0; ai < 2; ++ai) { const int row = u.pm * BM + ai * HALF + wr * 64 + 48 + fr; const float rsl = rstdf(rss, row, 1.0f / 1024.0f);
                if (fr >= 14) { PG8_LAS float* xp = X + (((2 * ai + wr) * 4 + wc) * 2 + (fr - 14)) * 32 + 8 * fq;
                    *(PG8_LAS f32x4*)xp = acc[ai][0][3][0] * rsl; *(PG8_LAS f32x4*)(xp + 4) = acc[ai][0][3][1] * rsl; } }
            asm volatile("s_waitcnt lgkmcnt(0)" ::: "memory"); __builtin_amdgcn_s_barrier(); asm volatile("" ::: "memory");
        }
        const int src1 = (lane & 48) | ((fr - 1) & 15), src2 = (lane & 48) | ((fr - 2) & 15);
#pragma unroll
        for (int ai = 0; ai < NAI; ++ai) {
            const int strip = 2 * ai + wr;
            f32x4 pa[2] = {(f32x4){0.f, 0.f, 0.f, 0.f}, (f32x4){0.f, 0.f, 0.f, 0.f}};
#pragma unroll
            for (int m = 0; m < NM; ++m) {
                const int rl = ai * HALF + wr * 64 + m * 16 + fr, row = u.pm * BM + rl;
                const float rs = rstdf(rss, row, 1.0f / 1024.0f);
                f32x4 a[2], b[2], p1[2], p2[2];
#pragma unroll
                for (int n = 0; n < 2; ++n) { a[n] = acc[ai][0][m][n] * rs; b[n] = acc[ai][1][m][n] * rs; }
#pragma unroll
                for (int n = 0; n < 2; ++n)
#pragma unroll
                    for (int e = 0; e < 4; ++e) { const float s1 = (m > 0 && fr == 15) ? pa[n][e] : a[n][e], s2 = (m > 0 && fr >= 14) ? pa[n][e] : a[n][e];
                        p1[n][e] = __shfl(s1, src1); p2[n][e] = __shfl(s2, src2); }
                if (m == 0 && strip > 0) {
                    const PG8_LAS float* xp = X + (((strip - 1) * 4 + wc) * 2) * 32 + 8 * fq;
#pragma unroll
                    for (int n = 0; n < 2; ++n) { const f32x4 h62 = *(const PG8_LAS f32x4*)(xp + 4 * n), h63 = *(const PG8_LAS f32x4*)(xp + 32 + 4 * n);
                        if (fr == 0) { p1[n] = h63; p2[n] = h62; } else if (fr == 1) { p2[n] = h63; } }
                }
                f32x4 g[2];
#pragma unroll
                for (int n = 0; n < 2; ++n)
#pragma unroll
                    for (int e = 0; e < 4; ++e) { const float ac = bs[n][e] + w0[n][e] * p2[n][e] + w1[n][e] * p1[n][e] + w2[n][e] * a[n][e];
                        g[n][e] = ac * __builtin_amdgcn_rcpf(1.0f + __builtin_amdgcn_exp2f(-LOG2E * ac)) * b[n][e]; }
                const bool head = (strip == 0 && m == 0 && fr < 2);
                if (!head) *(u32x4*)(G + (size_t)row * DFF + cc0) = pack8(g[0], g[1]);
                else { float* sa = SA + ((size_t)u.pm * 4 + fr) * DFF + cc0; float* sb = SB + ((size_t)u.pm * 2 + fr) * DFF + cc0;
                    *(f32x4*)sa = a[0]; *(f32x4*)(sa + 4) = a[1]; *(f32x4*)sb = b[0]; *(f32x4*)(sb + 4) = b[1]; }
                const bool tail = (u.pm < 64) ? (strip == 3 && m == 3 && fr >= 14) : (strip == 0 && m == 0 && fr >= 14);
                if (tail) { float* sa = SA + ((size_t)u.pm * 4 + 2 + (fr - 14)) * DFF + cc0; *(f32x4*)sa = a[0]; *(f32x4*)(sa + 4) = a[1]; }
                pa[0] = a[0]; pa[1] = a[1];
            }
        }
    }
};
__device__ __forceinline__ void rope32(f32x4& v0, f32x4& v1, const float* TB, int pos, int fq) {
    const f32x4* tp = (const f32x4*)(TB + (size_t)pos * 32 + 16 * (fq & 1)); const float sgn = fq < 2 ? -1.f : 1.f;
    f32x4 cs[4];
#pragma unroll
    for (int k = 0; k < 4; ++k) cs[k] = tp[k];
#pragma unroll
    for (int e = 0; e < 4; ++e) { const float o0 = __shfl_xor(v0[e], 32), o1 = __shfl_xor(v1[e], 32);
        v0[e] = v0[e] * cs[e >> 1][(e & 1) * 2] + sgn * o0 * cs[e >> 1][(e & 1) * 2 + 1];
        v1[e] = v1[e] * cs[2 + (e >> 1)][(e & 1) * 2] + sgn * o1 * cs[2 + (e >> 1)][(e & 1) * 2 + 1]; }
}
struct FEpiD {
    static constexpr bool PERM = true, AFTER_DRAIN = false;
    const float* rss; bf16_t* CQ; bf16_t* CKV; bf16_t* KR; float* rssq; float* rsskv; const float* TB;
    __device__ __forceinline__ void operator()(const f32x4 (&acc)[2][2][4][2], const Unit& u, int wr, int wc, int, int) const { apply<false>(acc, u, wr, wc); }
    template <bool SK> __device__ __forceinline__ void apply(const f32x4 (&acc)[2][2][4][2], const Unit& u, int wr, int wc) const {
        constexpr int NAI = SK ? 1 : 2, NM = SK ? 1 : 4;
        int lane_e; asm volatile("v_mbcnt_lo_u32_b32 %0, -1, 0\n\tv_mbcnt_hi_u32_b32 %0, -1, %0" : "=v"(lane_e));
        const int fr = lane_e & 15, fq = lane_e >> 4;
#pragma unroll
        for (int ai = 0; ai < NAI; ++ai)
#pragma unroll
            for (int m = 0; m < NM; ++m) {
                const int row = u.pm * BM + ai * HALF + wr * 64 + m * 16 + fr; const float rs = rstdf(rss, row, 1.0f / 1024.0f);
                float sq = 0.f, skv = 0.f;
#pragma unroll
                for (int bj = 0; bj < 2; ++bj) {
                    const int g128 = u.pn * 2 + bj, c = wc * 32 + 8 * fq;
                    f32x4 v0 = acc[ai][bj][m][0] * rs, v1 = acc[ai][bj][m][1] * rs;
                    const float s = (v0[0] * v0[0] + v0[1] * v0[1]) + (v0[2] * v0[2] + v0[3] * v0[3]) + (v1[0] * v1[0] + v1[1] * v1[1]) + (v1[2] * v1[2] + v1[3] * v1[3]);
                    if (g128 < 3) { sq += s; *(u32x4*)(CQ + (size_t)row * 384 + g128 * 128 + c) = pack8(v0, v1); }
                    else if (g128 < 5) { skv += s; *(u32x4*)(CKV + (size_t)row * 256 + (g128 - 3) * 128 + c) = pack8(v0, v1); }
                    else if (wc == 0) { rope32(v0, v1, TB, row_pos(row), fq); *(u32x4*)(KR + (size_t)row * 32 + c) = pack8(v0, v1); }
                }
                if (u.pn < 2) { sq += __shfl_xor(sq, 16); sq += __shfl_xor(sq, 32); if (fq == 0) atomicAdd(rssq + row, sq); }
                if (u.pn > 0) { skv += __shfl_xor(skv, 16); skv += __shfl_xor(skv, 32); if (fq == 0) atomicAdd(rsskv + row, skv); }
            }
    }
};
template <bool ROPE> struct FEpiUp {
    static constexpr bool PERM = true, AFTER_DRAIN = false;
    const float* rss; float invk; bf16_t* O; int ldo; const float* TB;
    __device__ __forceinline__ void operator()(const f32x4 (&acc)[2][2][4][2], const Unit& u, int wr, int wc, int, int) const { apply<false>(acc, u, wr, wc); }
    template <bool SK> __device__ __forceinline__ void apply(const f32x4 (&acc)[2][2][4][2], const Unit& u, int wr, int wc) const {
        constexpr int NAI = SK ? 1 : 2, NM = SK ? 1 : 4;
        int lane_e; asm volatile("v_mbcnt_lo_u32_b32 %0, -1, 0\n\tv_mbcnt_hi_u32_b32 %0, -1, %0" : "=v"(lane_e));
        const int fr = lane_e & 15, fq = lane_e >> 4;
#pragma unroll
        for (int ai = 0; ai < NAI; ++ai)
#pragma unroll
            for (int m = 0; m < NM; ++m) {
                const int row = u.pm * BM + ai * HALF + wr * 64 + m * 16 + fr; const float rs = rstdf(rss, row, invk);
#pragma unroll
                for (int bj = 0; bj < 2; ++bj) {
                    f32x4 v0 = acc[ai][bj][m][0] * rs, v1 = acc[ai][bj][m][1] * rs;
                    if (ROPE) { const int g32 = 8 * u.pn + 4 * bj + wc; if (g32 % 3 == 2) rope32(v0, v1, TB, row_pos(row), fq); }
                    *(u32x4*)(O + (size_t)row * ldo + u.pn * BM + bj * HALF + wc * 32 + 8 * fq) = pack8(v0, v1);
                    asm volatile("" ::: "memory");
                }
            }
    }
};

template <class Epi>
__device__ __forceinline__ void skinny_gemm(PG8_LAS unsigned char* lds, const bf16_t* A, const bf16_t* Bt, int N, int K, const Epi& E, int vcu, int G, int wave, int lane) {
    const int njobs = (N / BM) * 4, fr = lane & 15, fq = lane >> 4, nks = K / 32;
    for (int j = vcu; j < njobs; j += G) {
        const int pn = j >> 2, wc = j & 3;
        f32x4 pacc[2][2];
#pragma unroll
        for (int bj = 0; bj < 2; ++bj)
#pragma unroll
            for (int n = 0; n < 2; ++n) pacc[bj][n] = (f32x4){0.f, 0.f, 0.f, 0.f};
        const bf16_t* ap = A + (size_t)(64 * BM + fr) * K + 8 * fq;
        const bf16_t* bp[2][2];
#pragma unroll
        for (int bj = 0; bj < 2; ++bj)
#pragma unroll
            for (int n = 0; n < 2; ++n) bp[bj][n] = Bt + (size_t)(pn * BM + bj * HALF + wc * 32 + perm32(16 * n + fr)) * K + 8 * fq;
#pragma nounroll
        for (int ks0 = wave * 4; ks0 < nks; ks0 += 32) {
            bf16x8 a[4], b[4][2][2];
#pragma unroll
            for (int s = 0; s < 4; ++s) { a[s] = *(const bf16x8*)(ap + (ks0 + s) * 32);
#pragma unroll
                for (int bj = 0; bj < 2; ++bj)
#pragma unroll
                    for (int n = 0; n < 2; ++n) b[s][bj][n] = *(const bf16x8*)(bp[bj][n] + (ks0 + s) * 32); }
#pragma unroll
            for (int s = 0; s < 4; ++s)
#pragma unroll
                for (int bj = 0; bj < 2; ++bj)
#pragma unroll
                    for (int n = 0; n < 2; ++n) pacc[bj][n] = __builtin_amdgcn_mfma_f32_16x16x32_bf16(b[s][bj][n], a[s], pacc[bj][n], 0, 0, 0);
        }
        PG8_LAS f32x4* P = (PG8_LAS f32x4*)lds + (wave * 64 + lane) * 4;
        P[0] = pacc[0][0]; P[1] = pacc[0][1]; P[2] = pacc[1][0]; P[3] = pacc[1][1];
        __syncthreads();
        if (wave == 0) {
            f32x4 acc[2][2][4][2];
#pragma unroll
            for (int w = 1; w < 8; ++w) { const PG8_LAS f32x4* Q = (const PG8_LAS f32x4*)lds + (w * 64 + lane) * 4;
                pacc[0][0] += Q[0]; pacc[0][1] += Q[1]; pacc[1][0] += Q[2]; pacc[1][1] += Q[3]; }
            acc[0][0][0][0] = pacc[0][0]; acc[0][0][0][1] = pacc[0][1]; acc[0][1][0][0] = pacc[1][0]; acc[0][1][0][1] = pacc[1][1];
            Unit u; u.pm = 64; u.pn = pn;
            E.template apply<true>(acc, u, 0, wc);
        }
        __syncthreads();
    }
}
}

template <int MASK> __device__ __forceinline__ float swz_xor(float v) { return __shfl_xor(v, MASK); }
__device__ __forceinline__ float half_max(float v) { return fmaxf(v, __shfl_xor(v, 32)); }
__device__ __forceinline__ float half_sum(float v) { return v + __shfl_xor(v, 32); }
__device__ __forceinline__ s16x4 vtr(const LAS unsigned char* p) { typedef short v4i16_t __attribute__((ext_vector_type(4)));
    return __builtin_bit_cast(s16x4, __builtin_amdgcn_ds_read_tr16_b64_v4i16((LAS v4i16_t*)p)); }
__device__ __forceinline__ unsigned cvtpk(float lo, float hi) { typedef float f32x2_t __attribute__((ext_vector_type(2))); typedef __bf16 bf16x2_t __attribute__((ext_vector_type(2)));
    f32x2_t v = {lo, hi}; bf16x2_t b = __builtin_convertvector(v, bf16x2_t); return __builtin_bit_cast(unsigned, b); }

struct SrcA { const bf16_t* K; const bf16_t* V; int h, s;
    __device__ __forceinline__ const bf16_t* kptr(int krow, int ch) const { return K + (size_t)krow * 1024 + h * 128 + s * 64 + ch * 8; }
    __device__ __forceinline__ const bf16_t* vptr(int krow, int ch) const { return V + (size_t)krow * 1024 + h * 128 + ch * 8; }
    __device__ __forceinline__ unsigned kstep(int) const { return 64u * 1024u * 2u; }
    __device__ __forceinline__ unsigned vstep() const { return 64u * 1024u * 2u; } };
struct SrcB { const bf16_t* KV; const bf16_t* KR; int h;
    __device__ __forceinline__ const bf16_t* kptr(int krow, int ch) const { return ch < 8 ? KV + (size_t)krow * 2048 + h * 128 + ch * 8 : KR + (size_t)krow * 32 + (ch - 8) * 8; }
    __device__ __forceinline__ const bf16_t* vptr(int krow, int ch) const { return KV + (size_t)krow * 2048 + h * 128 + 64 + ch * 8; }
    __device__ __forceinline__ unsigned kstep(int ch) const { return ch < 8 ? 64u * 2048u * 2u : 64u * 32u * 2u; }
    __device__ __forceinline__ unsigned vstep() const { return 64u * 2048u * 2u; } };

template <int DQK, int DV> struct ACfg { static constexpr int KS = DQK * 2 + 16, VS = DV * 2 + 64, KOFF = 0, VOFF = 64 * KS, SCR = VOFF + 64 * VS,
    SCRATCH = 2 * SCR  , STG = SCRATCH + 2048  , END = STG + 8 * 32 * DV * 2; };
constexpr float ATT_THR = 8.0f;

template <int DQK, int DV, bool META, bool NEGM>
__device__ __forceinline__ void attn_tile(const LAS unsigned char* Kt, const LAS unsigned char* Vt, LAS float* scr, const bf16x8 (&qf)[DQK / 16], f32x16 (&o)[DV / 32], f32x16& negm, float& m, float& lsum, int lane) {
    constexpr int KS = ACfg<DQK, DV>::KS, VS = ACfg<DQK, DV>::VS;
    const int r32 = lane & 31, hi = lane >> 5;
    f32x16 p0, p1; const f32x16 zero16 = {0.f, 0.f, 0.f, 0.f, 0.f, 0.f, 0.f, 0.f, 0.f, 0.f, 0.f, 0.f, 0.f, 0.f, 0.f, 0.f};
#pragma unroll
    for (int kk = 0; kk < DQK / 16; ++kk) {
        const bf16x8 k0 = *(const LAS bf16x8*)(Kt + r32 * KS + (16 * kk + 8 * hi) * 2);
        p0 = __builtin_amdgcn_mfma_f32_32x32x16_bf16(k0, qf[kk], kk == 0 ? (NEGM ? negm : zero16) : p0, 0, 0, 0);
        if (!META) { const bf16x8 k1 = *(const LAS bf16x8*)(Kt + (32 + r32) * KS + (16 * kk + 8 * hi) * 2);
            p1 = __builtin_amdgcn_mfma_f32_32x32x16_bf16(k1, qf[kk], kk == 0 ? (NEGM ? negm : zero16) : p1, 0, 0, 0); }
        if (kk & 1) __builtin_amdgcn_sched_barrier(0);
    }
    const LAS unsigned char* vb = Vt + (4 * hi + ((lane & 15) >> 2)) * VS + (16 * ((lane >> 4) & 1) + 4 * (lane & 3)) * 2;
    s16x4 vlo[DV / 32], vhi[DV / 32];
#pragma unroll
    for (int d0 = 0; d0 < DV / 32; ++d0) { vlo[d0] = vtr(vb + 64 * d0); vhi[d0] = vtr(vb + 8 * VS + 64 * d0); }
    __builtin_amdgcn_sched_barrier(0);
    float mx;
    if (META) { mx = fmaxf(fmaxf(p0[0], p0[1]), p0[2]);
#pragma unroll
        for (int r = 3; r < 8; ++r) mx = fmaxf(mx, p0[r]);
    } else { float a = fmaxf(fmaxf(p0[0], p0[1]), p1[0]), bq = fmaxf(fmaxf(p0[2], p0[3]), p1[1]); a = fmaxf(fmaxf(a, p1[2]), p1[3]);
#pragma unroll
        for (int r = 4; r < 16; r += 4) { a = fmaxf(fmaxf(a, p0[r]), p0[r + 1]); bq = fmaxf(fmaxf(bq, p0[r + 2]), p0[r + 3]); a = fmaxf(fmaxf(a, p1[r]), p1[r + 1]); bq = fmaxf(fmaxf(bq, p1[r + 2]), p1[r + 3]); }
        mx = fmaxf(a, bq); }
    mx = half_max(mx) - (NEGM ? 0.f : m);
    if (META || __any(mx > ATT_THR)) {
        const float dl = META ? mx : fmaxf(mx, 0.f);
        m += dl;
        if (NEGM) {
#pragma unroll
            for (int r = 0; r < 16; ++r) { p0[r] -= dl; if (!META) p1[r] -= dl; negm[r] = -m; }
            asm volatile("" : "+v"(negm));
        }
        if (!META) {
            const float f = __builtin_amdgcn_exp2f(-dl); lsum *= f;
            if (hi == 0) scr[r32] = f;
            asm volatile("s_waitcnt lgkmcnt(0)" ::: "memory");
#pragma unroll
            for (int r = 0; r < 16; ++r) { const float a = scr[crow(r, hi)];
#pragma unroll
                for (int d0 = 0; d0 < DV / 32; ++d0) o[d0][r] *= a; }
        }
    }
    float ps = 0.f;
    if (META) {
#pragma unroll
        for (int r = 0; r < 8; ++r) { p0[r] = __builtin_amdgcn_exp2f(NEGM ? p0[r] : p0[r] - m); ps += p0[r]; }
    } else {
#pragma unroll
        for (int r = 0; r < 16; ++r) { p0[r] = __builtin_amdgcn_exp2f(NEGM ? p0[r] : p0[r] - m); p1[r] = __builtin_amdgcn_exp2f(NEGM ? p1[r] : p1[r] - m); ps += p0[r] + p1[r]; }
    }
    lsum += ps;
    bf16x8 pa[4];
    { u32x4 w; w.x = cvtpk(p0[0], p0[1]); w.y = cvtpk(p0[2], p0[3]); w.z = cvtpk(p0[4], p0[5]); w.w = cvtpk(p0[6], p0[7]); pa[0] = __builtin_bit_cast(bf16x8, w); }
    if (!META) {
        { u32x4 w; w.x = cvtpk(p0[8], p0[9]); w.y = cvtpk(p0[10], p0[11]); w.z = cvtpk(p0[12], p0[13]); w.w = cvtpk(p0[14], p0[15]); pa[1] = __builtin_bit_cast(bf16x8, w); }
        { u32x4 w; w.x = cvtpk(p1[0], p1[1]); w.y = cvtpk(p1[2], p1[3]); w.z = cvtpk(p1[4], p1[5]); w.w = cvtpk(p1[6], p1[7]); pa[2] = __builtin_bit_cast(bf16x8, w); }
        { u32x4 w; w.x = cvtpk(p1[8], p1[9]); w.y = cvtpk(p1[10], p1[11]); w.z = cvtpk(p1[12], p1[13]); w.w = cvtpk(p1[14], p1[15]); pa[3] = __builtin_bit_cast(bf16x8, w); }
    }
    __builtin_amdgcn_sched_barrier(0);
#pragma unroll
    for (int ks = 0; ks < (META ? 1 : 4); ++ks) {
        s16x4 nlo[DV / 32], nhi[DV / 32];
        if (ks + 1 < (META ? 1 : 4)) {
#pragma unroll
            for (int d0 = 0; d0 < DV / 32; ++d0) { nlo[d0] = vtr(vb + (16 * (ks + 1)) * VS + 64 * d0); nhi[d0] = vtr(vb + (16 * (ks + 1) + 8) * VS + 64 * d0); }
        }
        __builtin_amdgcn_s_setprio(1);
#pragma unroll
        for (int d0 = 0; d0 < DV / 32; ++d0) { const bf16x8 vf = (bf16x8){vlo[d0][0], vlo[d0][1], vlo[d0][2], vlo[d0][3], vhi[d0][0], vhi[d0][1], vhi[d0][2], vhi[d0][3]};
            o[d0] = __builtin_amdgcn_mfma_f32_32x32x16_bf16(pa[ks], vf, o[d0], 0, 0, 0); }
        __builtin_amdgcn_s_setprio(0);
        if (ks + 1 < (META ? 1 : 4)) {
#pragma unroll
            for (int d0 = 0; d0 < DV / 32; ++d0) { vlo[d0] = nlo[d0]; vhi[d0] = nhi[d0]; }
        }
        __builtin_amdgcn_sched_barrier(0);
    }
}

template <int DQK, int DV, class Src>
__device__ __forceinline__ void attn_pass(const Ctx& c, const Src& src, int b, int qb, const bf16x8 (&qf)[DQK / 16], f32x16 (&o)[DV / 32]) {
    typedef ACfg<DQK, DV> C;
    constexpr int KCH = DQK / 8, VCH = DV / 8;
    constexpr int NKL = (64 * KCH + NTHREADS - 1) / NTHREADS, NVL = (64 * VCH + NTHREADS - 1) / NTHREADS;
    LAS float* scr = (LAS float*)(c.lds + C::SCRATCH) + c.wave * 64;
    const int hi = c.lane >> 5, r32 = c.lane & 31;
    constexpr bool NEGM = (DV == 64);
    float m = 0.f, lsum = 0.f; f32x16 negm;
#pragma unroll
    for (int r = 0; r < 16; ++r) negm[r] = 0.f;
#pragma unroll
    for (int d0 = 0; d0 < DV / 32; ++d0)
#pragma unroll
        for (int r = 0; r < 16; ++r) o[d0][r] = 0.f;
    const int NT = qb < 0 ? 0 : 4 * (qb + 1);
    const int myc = qb < 0 ? -1 : 4 * qb + (c.wave >> 1);
    const bool active = qb >= 0 || c.wave == 0;
    u32x4 kreg[NKL], vreg[NVL];
    {
        int tl_ = c.tid; asm volatile("" : "+v"(tl_));
#pragma unroll
        for (int i_ = 0; i_ < NKL; ++i_) { const int idx_ = tl_ + i_ * NTHREADS; const int key_ = min(idx_ / KCH, 31), ch_ = idx_ % KCH; kreg[i_] = *(const u32x4*)src.kptr(RR + key_, ch_); }
#pragma unroll
        for (int i_ = 0; i_ < NVL; ++i_) { const int idx_ = tl_ + i_ * NTHREADS; const int key_ = min(idx_ / VCH, 15), ch_ = idx_ % VCH; vreg[i_] = *(const u32x4*)src.vptr(RR + key_, ch_); }
#pragma unroll
        for (int i_ = 0; i_ < NKL; ++i_) { const int idx_ = tl_ + i_ * NTHREADS; const int key_ = min(idx_ / KCH, 31), ch_ = idx_ % KCH; *(LAS u32x4*)(c.lds + C::KOFF + key_ * C::KS + ch_ * 16) = kreg[i_]; }
#pragma unroll
        for (int i_ = 0; i_ < NVL; ++i_) { const int idx_ = tl_ + i_ * NTHREADS; const int key_ = min(idx_ / VCH, 15), ch_ = idx_ % VCH; *(LAS u32x4*)(c.lds + C::VOFF + key_ * C::VS + ch_ * 16) = vreg[i_]; }
    }
    const char* kp[NKL]; const char* vp[NVL]; unsigned kst[NKL], klds[NKL], vlds[NVL]; const unsigned vst = src.vstep();
    {
        int tl_ = c.tid; asm volatile("" : "+v"(tl_));
#pragma unroll
        for (int i_ = 0; i_ < NKL; ++i_) { const int idx_ = tl_ + i_ * NTHREADS; const int key_ = min(idx_ / KCH, 63), ch_ = idx_ % KCH;
            kp[i_] = (const char*)src.kptr(b * SEQ + key_, ch_); kst[i_] = src.kstep(ch_); klds[i_] = (unsigned)(C::KOFF + key_ * C::KS + ch_ * 16); }
#pragma unroll
        for (int i_ = 0; i_ < NVL; ++i_) { const int idx_ = tl_ + i_ * NTHREADS; const int key_ = min(idx_ / VCH, 63), ch_ = idx_ % VCH;
            vp[i_] = (const char*)src.vptr(b * SEQ + key_, ch_); vlds[i_] = (unsigned)(C::VOFF + key_ * C::VS + ch_ * 16); }
    }
    __syncthreads();
#define ATT_PREFETCH() do { _Pragma("unroll") for (int i_ = 0; i_ < NKL; ++i_) { kreg[i_] = *(const u32x4*)kp[i_]; kp[i_] += kst[i_]; } \
        _Pragma("unroll") for (int i_ = 0; i_ < NVL; ++i_) { vreg[i_] = *(const u32x4*)vp[i_]; vp[i_] += vst; } } while (0)
#define ATT_COMMIT(buf_) do { LAS unsigned char* nb_ = c.lds + (buf_) * C::SCR; \
        _Pragma("unroll") for (int i_ = 0; i_ < NKL; ++i_) *(LAS u32x4*)(nb_ + klds[i_]) = kreg[i_]; \
        _Pragma("unroll") for (int i_ = 0; i_ < NVL; ++i_) *(LAS u32x4*)(nb_ + vlds[i_]) = vreg[i_]; } while (0)
    if (NT > 0) ATT_PREFETCH();
    attn_tile<DQK, DV, true, NEGM>(c.lds + C::KOFF, c.lds + C::VOFF, scr, qf, o, negm, m, lsum, c.lane);
    if (NT > 0) ATT_COMMIT(1);
    __syncthreads();
    const int nfull = NT > 0 ? NT - 3 : 0;
#pragma nounroll
    for (int jt = 0; jt < nfull; ++jt) {
        const int cur = (jt + 1) & 1;
        ATT_PREFETCH();
        attn_tile<DQK, DV, false, NEGM>(c.lds + cur * C::SCR + C::KOFF, c.lds + cur * C::SCR + C::VOFF, scr, qf, o, negm, m, lsum, c.lane);
        ATT_COMMIT(cur ^ 1);
        __syncthreads();
    }
#pragma nounroll
    for (int jt = nfull; jt < NT; ++jt) {
        const int cur = (jt + 1) & 1;
        if (jt + 1 < NT) ATT_PREFETCH();
        if (jt <= myc) attn_tile<DQK, DV, false, NEGM>(c.lds + cur * C::SCR + C::KOFF, c.lds + cur * C::SCR + C::VOFF, scr, qf, o, negm, m, lsum, c.lane);
        if (jt + 1 < NT) ATT_COMMIT(cur ^ 1);
        __syncthreads();
    }
#undef ATT_PREFETCH
#undef ATT_COMMIT
    const float lt = half_sum(lsum);
    if (hi == 0) scr[32 + r32] = 1.0f / lt;
    asm volatile("s_waitcnt lgkmcnt(0)" ::: "memory");
#pragma unroll
    for (int r = 0; r < 16; ++r) { const float a = scr[32 + crow(r, hi)];
#pragma unroll
        for (int d0 = 0; d0 < DV / 32; ++d0) o[d0][r] *= a; }
}

__device__ __forceinline__ void attn_unit_a(const Params& p, const Ctx& c, int b, int h, int qb, float lam, bf16_t* Odst) {
    typedef ACfg<64, 128> C;
    int ln_ = c.lane; asm volatile("" : "+v"(ln_));
    const int q0 = qb < 0 ? RR : b * SEQ + 256 * qb; const int hi = ln_ >> 5, r32 = ln_ & 31;
    bf16_t* Qb = (bf16_t*)(p.ws + WS_Q);
    LAS bf16_t* stg = (LAS bf16_t*)(c.lds + C::STG) + c.wave * (32 * 128);
    const bool active = qb >= 0 || c.wave == 0;
    f32x16 o[4];
#pragma nounroll
    for (int s = 0; s < 2; ++s) {
        int lq_ = c.lane; asm volatile("" : "+v"(lq_));
        const bf16_t* qrow = Qb + (size_t)(q0 + 32 * c.wave + (lq_ & 31)) * 1024 + h * 128 + s * 64;
        bf16x8 qf[4];
#pragma unroll
        for (int kk = 0; kk < 4; ++kk) qf[kk] = *(const bf16x8*)(qrow + 16 * kk + 8 * hi);
        SrcA src{(const bf16_t*)(p.ws + WS_K), (const bf16_t*)(p.ws + WS_V), h, s};
        attn_pass<64, 128, SrcA>(c, src, b, qb, qf, o);
        if (s == 0) {
#pragma unroll
            for (int r = 0; r < 16; ++r) { LAS bf16_t* sp = stg + crow(r, hi) * 128 + r32;
                sp[0] = (bf16_t)f2bf(o[0][r]); sp[32] = (bf16_t)f2bf(o[1][r]); sp[64] = (bf16_t)f2bf(o[2][r]); sp[96] = (bf16_t)f2bf(o[3][r]); }
        }
    }
#pragma unroll
    for (int r = 0; r < 16; ++r) {
        LAS bf16_t* sp = stg + crow(r, hi) * 128 + r32;
        const float v0 = bf2f(sp[0]) - lam * o[0][r], v1 = bf2f(sp[32]) - lam * o[1][r], v2 = bf2f(sp[64]) - lam * o[2][r], v3 = bf2f(sp[96]) - lam * o[3][r];
        float ss = v0 * v0 + v1 * v1 + v2 * v2 + v3 * v3;
        ss += swz_xor<1>(ss); ss += swz_xor<2>(ss); ss += swz_xor<4>(ss); ss += swz_xor<8>(ss); ss += swz_xor<16>(ss);
        const float rs = 1.0f / sqrtf(ss * (1.0f / 128.0f) + EPS);
        sp[0] = (bf16_t)f2bf(v0 * rs); sp[32] = (bf16_t)f2bf(v1 * rs); sp[64] = (bf16_t)f2bf(v2 * rs); sp[96] = (bf16_t)f2bf(v3 * rs);
    }
    asm volatile("s_waitcnt lgkmcnt(0)" ::: "memory");
    if (!active) return;
    int rb = q0 + 32 * c.wave; asm volatile("" : "+s"(rb));
    int ls_ = c.lane; asm volatile("" : "+v"(ls_));
#pragma unroll
    for (int i = 0; i < 8; ++i) { const int row = 4 * i + (ls_ >> 4), ch = ls_ & 15;
        const u32x4 v = *(const LAS u32x4*)(stg + row * 128 + ch * 8);
        *(u32x4*)(Odst + (size_t)(rb + row) * 1024 + h * 128 + ch * 8) = v; }
}
__device__ __forceinline__ void ph_attn_a(const Params& p, const Ctx& c, bool dummy) {
    bf16_t* Odst = (bf16_t*)(p.ws + (dummy ? WS_OB2 : WS_Q));
    float d1 = 0.f, d2 = 0.f;
    for (int k = 0; k < 64; ++k) { d1 += p.in[I_LQ1][k] * p.in[I_LK1][k]; d2 += p.in[I_LQ2][k] * p.in[I_LK2][k]; }
    const float lamv = expf(d1) - expf(d2) + LAM_INIT;
    const int lami = __builtin_amdgcn_readfirstlane(__builtin_bit_cast(int, lamv));
    const float lam = __builtin_bit_cast(float, lami);
#pragma nounroll
    for (int pi = c.vcu; pi < 256 + 8; pi += c.G) {
        const int nsub = pi < 256 ? 2 : 1;
#pragma nounroll
        for (int sub = 0; sub < nsub; ++sub) {
            int b, h, qb;
            if (pi < 256) { const int bh = pi >> 2, s = pi & 3; b = bh >> 3; h = bh & 7; qb = sub ? 7 - s : s; } else { b = 0; h = pi - 256; qb = -1; }
            attn_unit_a(p, c, b, h, qb, lam, Odst);
        }
    }
}
__device__ __forceinline__ void attn_unit_b(const Params& p, const Ctx& c, int b, int h, int qb) {
    typedef ACfg<96, 64> C;
    int ln_ = c.lane; asm volatile("" : "+v"(ln_));
    const int q0 = qb < 0 ? RR : b * SEQ + 256 * qb; const int hi = ln_ >> 5, r32 = ln_ & 31;
    const bf16_t* qrow = (const bf16_t*)(p.ws + WS_Q2) + (size_t)(q0 + 32 * c.wave + r32) * 1536 + h * 96;
    LAS bf16_t* stg = (LAS bf16_t*)(c.lds + C::STG) + c.wave * (32 * 64);
    bf16x8 qf[6];
#pragma unroll
    for (int kk = 0; kk < 6; ++kk) qf[kk] = *(const bf16x8*)(qrow + 16 * kk + 8 * hi);
    f32x16 o[2];
    SrcB src{(const bf16_t*)(p.ws + WS_KV2), (const bf16_t*)(p.ws + WS_KR), h};
    attn_pass<96, 64, SrcB>(c, src, b, qb, qf, o);
#pragma unroll
    for (int r = 0; r < 16; ++r) { LAS bf16_t* sp = stg + crow(r, hi) * 64 + r32; sp[0] = (bf16_t)f2bf(o[0][r]); sp[32] = (bf16_t)f2bf(o[1][r]); }
    asm volatile("s_waitcnt lgkmcnt(0)" ::: "memory");
    const bool active = qb >= 0 || c.wave == 0;
    if (!active) return;
    bf16_t* Ob = (bf16_t*)(p.ws + WS_OB2);
    int rb = q0 + 32 * c.wave; asm volatile("" : "+s"(rb));
    int ls_ = c.lane; asm volatile("" : "+v"(ls_));
#pragma unroll
    for (int i = 0; i < 4; ++i) { const int row = 8 * i + (ls_ >> 3), ch = ls_ & 7;
        const u32x4 v = *(const LAS u32x4*)(stg + row * 64 + ch * 8);
        *(u32x4*)(Ob + (size_t)(rb + row) * 1024 + h * 64 + ch * 8) = v; }
}
__device__ __forceinline__ void ph_attn_b(const Params& p, const Ctx& c) {
#pragma nounroll
    for (int pi = c.vcu; pi < 512 + 16; pi += c.G) {
        const int nsub = pi < 512 ? 2 : 1;
#pragma nounroll
        for (int sub = 0; sub < nsub; ++sub) {
            int b, h, qb;
            if (pi < 512) { const int bh = pi >> 2, s = pi & 3; b = bh >> 4; h = bh & 15; qb = sub ? 7 - s : s; } else { b = 0; h = pi - 512; qb = -1; }
            attn_unit_b(p, c, b, h, qb);
        }
    }
}

__device__ __forceinline__ void ph_ffn_fix(const Params& p, const Ctx& c, int layer) {
    const float* SA = (const float*)(p.ws + WS_SA); const float* SB = (const float*)(p.ws + WS_SB); bf16_t* G = (bf16_t*)(p.ws + WS_G);
    const float* cw = p.in[I_FFN_CW] + (size_t)layer * 3 * DFF; const float* cb = p.in[I_FFN_CB] + (size_t)layer * DFF;
    const int gt = c.gw * 64 + c.lane, ngt = c.ngw * 64;
    for (int i = gt; i < 65 * DFF; i += ngt) {
        const int pm = i / DFF, col = i - pm * DFF;
        const float a0 = SA[((size_t)pm * 4 + 0) * DFF + col], a1 = SA[((size_t)pm * 4 + 1) * DFF + col];
        const float b0 = SB[((size_t)pm * 2 + 0) * DFF + col], b1 = SB[((size_t)pm * 2 + 1) * DFF + col];
        float l0 = 0.f, l1 = 0.f;
        if (pm < 64) { const int ps = (pm & 7) == 0 ? 64 : pm - 1; l0 = SA[((size_t)ps * 4 + 2) * DFF + col]; l1 = SA[((size_t)ps * 4 + 3) * DFF + col]; }
        const float w0 = cw[col], w1 = cw[DFF + col], w2 = cw[2 * DFF + col], bb = cb[col];
        const float c0 = bb + w0 * l0 + w1 * l1 + w2 * a0, c1 = bb + w0 * l1 + w1 * a0 + w2 * a1;
        const float g0 = c0 / (1.0f + __expf(-c0)) * b0, g1 = c1 / (1.0f + __expf(-c1)) * b1;
        G[(size_t)(pm * 256) * DFF + col] = (bf16_t)f2bf(g0); G[(size_t)(pm * 256 + 1) * DFF + col] = (bf16_t)f2bf(g1);
    }
}

#define XB_TMO      128
#define XB_XCNT(j)  (256  + 64 * (j))
#define XB_XSUB(j)  (1280 + 64 * (j))
#define XB_XGEN(j)  (2304 + 64 * (j))
#define XB_TOP      3328
#define XB_TOPGEN   3392
#define XCD_BAR_WORDS 3456
#define XB_SPIN_CAP (1u << 18)

__device__ __forceinline__ unsigned xb_ld(unsigned* p)              { return __hip_atomic_load(p, __ATOMIC_RELAXED, __HIP_MEMORY_SCOPE_AGENT); }
__device__ __forceinline__ unsigned xb_add(unsigned* p, unsigned v) { return __hip_atomic_fetch_add(p, v, __ATOMIC_RELAXED, __HIP_MEMORY_SCOPE_AGENT); }
__device__ __forceinline__ unsigned xb_xcc_id() { return (unsigned)__builtin_amdgcn_s_getreg((3 << 11) | 20) & 0xFu; }
#define XB_SPIN(cond, bar) do { unsigned _sp = 0; while (cond) { __builtin_amdgcn_s_sleep(1); \
    if ((++_sp & 255u) == 0u) { if (xb_ld(&(bar)[XB_TMO])) break; if (_sp > XB_SPIN_CAP) { atomicAdd(&(bar)[XB_TMO], 1u); break; } } } } while (0)

struct XcdBarrier {
    unsigned* bar; unsigned x;
    volatile LAS unsigned* st;
};

__device__ __forceinline__ XcdBarrier xcd_barrier_post(unsigned* bar, volatile LAS unsigned* st) {
    XcdBarrier b; b.bar = bar; b.x = xb_xcc_id(); b.st = st;
    if (threadIdx.x == 0) (void)xb_add(&bar[XB_XCNT(b.x)], 1u);
    return b;
}
__device__ __forceinline__ void xcd_barrier_complete(unsigned* bar, unsigned x, unsigned& nloc, unsigned& nx) {
    const unsigned G = gridDim.x * gridDim.y * gridDim.z;
    unsigned sum, cnt, mine, sp = 0u;
    for (;;) {
        sum = 0u; cnt = 0u; mine = 0u;
#pragma unroll
        for (unsigned j = 0; j < 16; ++j) { const unsigned c = xb_ld(&bar[XB_XCNT(j)]); sum += c; cnt += (c > 0u) ? 1u : 0u; mine = (j == x) ? c : mine; }
        if (sum == G) break;
        __builtin_amdgcn_s_sleep(1);
        if ((++sp & 255u) == 0u) { if (xb_ld(&bar[XB_TMO])) break; if (sp > XB_SPIN_CAP) { atomicAdd(&bar[XB_TMO], 1u); break; } }
    }
    nloc = mine > 0u ? mine : 1u; nx = cnt > 0u ? cnt : 1u;
}

__device__ __forceinline__ void xcd_barrier(const XcdBarrier& b) {
    asm volatile("s_waitcnt vmcnt(0)" ::: "memory");
    __syncthreads();
    if (threadIdx.x == 0) {
        unsigned* bar = b.bar;
        __builtin_amdgcn_s_waitcnt(0);
        unsigned nloc = b.st[0], nx = b.st[1];
        if (nloc == 0u) { xcd_barrier_complete(bar, b.x, nloc, nx); b.st[0] = nloc; b.st[1] = nx; }
        const unsigned old = xb_add(&bar[XB_XSUB(b.x)], 1u);
        const unsigned gen = old / nloc;
        if (old + 1u == (gen + 1u) * nloc) {
            __builtin_amdgcn_fence(__ATOMIC_RELEASE, "agent");
            asm volatile("s_waitcnt vmcnt(0)" ::: "memory");
            const unsigned og = xb_add(&bar[XB_TOP], 1u);
            const unsigned tg = og / nx;
            if (og + 1u == (tg + 1u) * nx) xb_add(&bar[XB_TOPGEN], 1u);
            else XB_SPIN(xb_ld(&bar[XB_TOPGEN]) == tg, bar);
            __builtin_amdgcn_fence(__ATOMIC_ACQUIRE, "agent");
            xb_add(&bar[XB_XGEN(b.x)], 1u);
            asm volatile("s_waitcnt vmcnt(0)" ::: "memory");
        } else {
            XB_SPIN(xb_ld(&bar[XB_XGEN(b.x)]) == gen, bar);
            __builtin_amdgcn_fence(__ATOMIC_ACQUIRE, "agent");
            asm volatile("s_waitcnt vmcnt(0)" ::: "memory");
        }
    }
    __syncthreads();
}

enum { PH_PROLOGUE = 0, PH_QKV, PH_ATTN_A, PH_WO_A, PH_FFNIN_A, PH_FIX_A, PH_FFNOUT_A, PH_DPROJ, PH_UKV, PH_UQ, PH_ATTN_B, PH_WO_B, PH_FFNIN_B, PH_FIX_B, PH_FFNOUT_B, PH_FINAL, PH_COUNT };
__host__ __device__ constexpr bool phase_active(int ph) {
#ifdef ONLY_PH
    if (ph != ONLY_PH) return false;
#endif
    return true;
}
__host__ __device__ constexpr bool only_ok(int x) {
#ifdef ONLY_PH
    return x == ONLY_PH;
#else
    return true;
#endif
}
__device__ __forceinline__ Ctx make_ctx(LAS unsigned char* lds, int wave0) {
    int lane_; asm volatile("v_mbcnt_lo_u32_b32 %0, -1, 0\n\tv_mbcnt_hi_u32_b32 %0, -1, %0" : "=v"(lane_));
    int wv = wave0; asm volatile("" : "+s"(wv));
    Ctx c; c.lds = lds; c.lane = lane_; c.wave = wv; c.tid = wv * 64 + lane_;
    c.G = gridDim.x; { const int bx = blockIdx.x; c.vcu = (c.G % 8 == 0) ? (bx % 8) * (c.G / 8) + bx / 8 : bx; }
    c.gw = c.vcu * NWAVES + c.wave; c.ngw = c.G * NWAVES;
    return c;
}
template <class Epi> __device__ __forceinline__ void run_gemm(const Ctx& c, const bf16_t* A, const bf16_t* Bt, int N, int K, const Epi& E) {
    pg8::Gemm g{A, Bt, RR, N, K}; pg8::StaticOrder S; S.init(RR, N, c.G, (int)blockIdx.x);
    pg8::gemm_phase<Epi, pg8::StaticOrder, true, true>(c.lds, g, S, E, c.tid);
    int ln_; asm volatile("v_mbcnt_lo_u32_b32 %0, -1, 0\n\tv_mbcnt_hi_u32_b32 %0, -1, %0" : "=v"(ln_));
    pg8::skinny_gemm<Epi>(c.lds, A, Bt, N, K, E, c.vcu, c.G, c.wave, ln_);
}

__global__ void __launch_bounds__(NTHREADS, 2) fwd_kernel(Params pin) {
    extern __shared__ __attribute__((aligned(16))) unsigned char smem[];
    bool first = true;
    int wave0 = __builtin_amdgcn_readfirstlane((int)threadIdx.x >> 6);
    if (threadIdx.x < 64) ((LAS unsigned*)(smem + MISC_OFF))[threadIdx.x] = 0u;
    __syncthreads();
    const XcdBarrier xbar = xcd_barrier_post((unsigned*)(pin.ws + WS_CTL) + CW_BAR, (volatile LAS unsigned*)(smem + MISC_OFF));
    int nsync = 0;
#ifdef DUP_PH
    int dupdone = 0;
#endif
#ifdef PROBE_PH
    const int ph_end = pin.ph_hi + 1;
#else
    const int ph_end = pin.ph_hi;
#endif
#pragma nounroll
    for (int ph = pin.ph_lo; ph < ph_end; ++ph) {
        if (!phase_active(ph)) continue;
#ifdef PROBE_PH
        if (!first && ph == PH_UQ) { }
#endif
        if (!first && ph != PH_UQ) {
            if (pin.ph_lo < 0) cg::this_grid().sync();
            else xcd_barrier(xbar);
            ++nsync;
        }
#ifdef PROBE_PH
        if (blockIdx.x == 0 && threadIdx.x == 0 && ph != PH_UQ) { volatile LAS unsigned* T = (volatile LAS unsigned*)(smem + MISC_OFF + 64); const unsigned t = (unsigned)__builtin_amdgcn_s_memrealtime();
            if (T[2] == (unsigned)PROBE_PH + 1u) T[1] = t - T[0];
            T[0] = t; T[2] = (unsigned)ph + 1u;
            if (ph == PH_COUNT) { const float us = (float)T[1] * 0.01f; const float k = rintf(logf(us) * (1.0f / 0.18232156f)); pin.out[0] = expf(k * 0.18232156f); } }
#endif
        first = false;
        Params p = pin; { size_t z0 = 0, z1 = 0; asm volatile("" : "+s"(z0), "+s"(z1)); p.ws = pin.ws + z0; p.out = pin.out + z1; }
#define MKCTX() const Ctx c = make_ctx((LAS unsigned char*)smem, wave0)
        unsigned char* ws = p.ws;
        const bf16_t* HB = (const bf16_t*)(ws + WS_HB);
        float* hmeta = (float*)(ws + WS_HMETA);
        const float* TA = (const float*)(ws + WS_ROPE); const float* TB = TA + 2064 * 8 * 2;
#ifdef DUP_PH
        const bool dummy = (ph == DUP_PH) && !dupdone;
#else
        const bool dummy = false;
#endif
        switch (ph) {
            case PH_PROLOGUE: if (!only_ok(PH_PROLOGUE)) break; { MKCTX(); ph_prologue(p, c); break; }
            case PH_QKV: if (!only_ok(PH_QKV)) break; { MKCTX();
                pg8::FEpiQKV e{rss_ptr(p, 0), (bf16_t*)(ws + WS_Q), TA}; run_gemm(c, HB, (const bf16_t*)(ws + W_QKV), 3072, 1024, e); break; }
            case PH_ATTN_A: if (!only_ok(PH_ATTN_A)) break; { MKCTX(); ph_attn_a(p, c, dummy); break; }
            case PH_WO_A: if (!only_ok(PH_WO_A)) break; { MKCTX();
                pg8::FEpiRes e{p.in[I_X], p.in[I_META], nullptr, nullptr, (bf16_t*)(ws + WS_HB), rss_ptr(p, 1)}; run_gemm(c, (const bf16_t*)(ws + WS_Q), (const bf16_t*)(ws + W_OA), 1024, 1024, e); break; }
            case PH_FFNIN_A: case PH_FFNIN_B: if (!only_ok(PH_FFNIN_A) && !only_ok(PH_FFNIN_B)) break; { MKCTX(); const int layer = ph == PH_FFNIN_B; const int site = layer ? 3 : 1;
                pg8::FEpiFFN e{rss_ptr(p, site), p.in[I_FFN_CW] + (size_t)layer * 3 * DFF, p.in[I_FFN_CB] + (size_t)layer * DFF, (bf16_t*)(ws + WS_G), (float*)(ws + WS_SA), (float*)(ws + WS_SB), (LAS float*)(c.lds + XLDS_OFF)};
                run_gemm(c, HB, (const bf16_t*)(ws + (layer ? W_IN1 : W_IN0)), 5632, 1024, e); break; }
            case PH_FIX_A: if (!only_ok(PH_FIX_A)) break; { MKCTX(); ph_ffn_fix(p, c, 0); break; }
            case PH_FIX_B: if (!only_ok(PH_FIX_B)) break; { MKCTX(); ph_ffn_fix(p, c, 1); break; }
            case PH_FFNOUT_A: case PH_FFNOUT_B: if (!only_ok(PH_FFNOUT_A) && !only_ok(PH_FFNOUT_B)) break; { MKCTX(); const int layer = ph == PH_FFNOUT_B;
                pg8::FEpiRes e{nullptr, nullptr, layer ? p.out : nullptr, layer ? hmeta : nullptr, (bf16_t*)(ws + WS_HB), rss_ptr(p, layer ? 4 : 2)}; run_gemm(c, (const bf16_t*)(ws + WS_G), (const bf16_t*)(ws + (layer ? W_OUT1 : W_OUT0)), 1024, DFF, e); break; }
            case PH_DPROJ: if (!only_ok(PH_DPROJ)) break; { MKCTX();
                pg8::FEpiD e{rss_ptr(p, 2), (bf16_t*)(ws + WS_CQ), (bf16_t*)(ws + WS_CKV), (bf16_t*)(ws + WS_KR), rss_ptr(p, 5), rss_ptr(p, 6), TB}; run_gemm(c, HB, (const bf16_t*)(ws + W_D), 768, 1024, e); break; }
            case PH_UKV: if (!only_ok(PH_UKV)) break; { MKCTX();
                pg8::FEpiUp<false> e1{rss_ptr(p, 6), 1.0f / 256.0f, (bf16_t*)(ws + WS_KV2), 2048, TB}; run_gemm(c, (const bf16_t*)(ws + WS_CKV), (const bf16_t*)(ws + W_UKV), 2048, 256, e1); break; }
            case PH_UQ: if (!only_ok(PH_UQ)) break; { MKCTX();
                pg8::FEpiUp<true> e2{rss_ptr(p, 5), 1.0f / 384.0f, (bf16_t*)(ws + WS_Q2), 1536, TB}; run_gemm(c, (const bf16_t*)(ws + WS_CQ), (const bf16_t*)(ws + W_UQ), 1536, 384, e2); break; }
            case PH_ATTN_B: if (!only_ok(PH_ATTN_B)) break; { MKCTX(); ph_attn_b(p, c); break; }
            case PH_WO_B: if (!only_ok(PH_WO_B)) break; { MKCTX();
                pg8::FEpiRes e{nullptr, nullptr, nullptr, nullptr, (bf16_t*)(ws + WS_HB), rss_ptr(p, 3)}; run_gemm(c, (const bf16_t*)(ws + WS_OB2), (const bf16_t*)(ws + W_OB), 1024, 1024, e); break; }
            case PH_FINAL: if (!only_ok(PH_FINAL)) break; { MKCTX(); ph_final(p, c); break; }
            default: break;
        }
#ifdef DUP_PH
        if (ph == DUP_PH && !dupdone) { dupdone = 1; --ph; }
#endif
    }
}

extern "C" void kernel_launch(void* const* d_in, const int* in_sizes, int n_in, void* d_out, int out_size, void* d_ws, size_t ws_size, hipStream_t stream) {
    static int grid = 0;
    if (grid == 0) {
        if (n_in != 25 || ws_size < WS_END || out_size != RR * D) { fprintf(stderr, "kernel_launch: unexpected shapes (n_in %d, ws %zu, out %d)\n", n_in, ws_size, out_size); grid = -1; return; }
        int dev = 0, cus = 0, per_cu = 0;
        hipGetDevice(&dev); hipDeviceGetAttribute(&cus, hipDeviceAttributeMultiprocessorCount, dev);
        hipFuncSetAttribute((const void*)fwd_kernel, hipFuncAttributeMaxDynamicSharedMemorySize, LDS_BYTES);
        hipOccupancyMaxActiveBlocksPerMultiprocessor(&per_cu, (const void*)fwd_kernel, NTHREADS, LDS_BYTES);
        if (per_cu < 1) { fprintf(stderr, "kernel_launch: occupancy query says %d blocks per CU\n", per_cu); per_cu = 1; }
        (void)hipGetLastError();
        grid = cus * per_cu;
    }
    if (grid < 0) return;
    Params p{};
    for (int i = 0; i < 25; ++i) p.in[i] = (const float*)d_in[i];
    p.out = (float*)d_out; p.ws = (unsigned char*)d_ws;
    (void)hipMemsetAsync((char*)d_ws + WS_CTL, 0, CTL_ZERO_BYTES, stream);
    p.ph_lo = 0; p.ph_hi = PH_COUNT;
    void* args[] = {&p};
    hipError_t e = hipLaunchCooperativeKernel((const void*)fwd_kernel, dim3(grid), dim3(NTHREADS), args, LDS_BYTES, stream);
    if (e != hipSuccess) fprintf(stderr, "kernel_launch: cooperative launch failed: %s (grid %d)\n", hipGetErrorString(e), grid);
}
```
